# Optimizing an MI355X kernel written in HIP

```python
import jax, jax.numpy as jnp
from jax import lax
import numpy as np

D_MODEL = 1024
BATCH = 2
SEQ = 8192
DEPTH = 1

N_META = 16
HGRN_DK = 128
HGRN_HEADS = D_MODEL // HGRN_DK
HGRN_DV = D_MODEL // HGRN_HEADS
HGRN_WIDTH = HGRN_HEADS * HGRN_DK
CHUNK = 64
POOL_WINDOWS = (2, 4, 8, 16)
POOL_GROUPS = len(POOL_WINDOWS)
POOL_GROUP_DIM = 128
POOL_WIDTH = POOL_GROUPS * POOL_GROUP_DIM
D_FF = -(-8 * D_MODEL // (3 * 256)) * 256
EPS = 1e-6
SPLIT_SIZES = (HGRN_WIDTH, HGRN_WIDTH, HGRN_HEADS * HGRN_DV, HGRN_HEADS * HGRN_DV,
               POOL_WIDTH, D_MODEL, D_MODEL)
SPLIT_POINTS = tuple(int(v) for v in np.cumsum(SPLIT_SIZES)[:-1])
IN_WIDTH = int(sum(SPLIT_SIZES))

kernel_name = "hgrn2_pool_gated_hybrid"


def rmsnorm(x, g):
    xf = x.astype(jnp.float32)
    y = xf * lax.rsqrt(jnp.mean(xf * xf, axis=-1, keepdims=True) + EPS)
    return (y * g.astype(jnp.float32)).astype(x.dtype)


def hgrn2_chunked(q, k, v, log_f):
    B, L, H, DK = q.shape
    DV = v.shape[-1]
    nc = L // CHUNK

    def to_chunks(t):
        return t.reshape(B, nc, CHUNK, H, t.shape[-1]).transpose(1, 0, 3, 2, 4)

    qc, kc, vc, gc = to_chunks(q), to_chunks(k), to_chunks(v), to_chunks(log_f)
    causal = jnp.tril(jnp.ones((CHUNK, CHUNK), dtype=bool))[None, None, :, :, None]

    def step(S, inp):
        qi, ki, vi, gi = inp
        b = jnp.cumsum(gi, axis=2)
        b_last = b[:, :, -1:, :]
        o_inter = jnp.einsum('bhtd,bhde->bhte', qi * jnp.exp(b), S)
        diff = b[:, :, :, None, :] - b[:, :, None, :, :]
        decay = jnp.exp(jnp.where(causal, diff, -jnp.inf))
        scores = jnp.einsum('bhtd,bhsd,bhtsd->bhts', qi, ki, decay)
        o_intra = jnp.einsum('bhts,bhse->bhte', scores, vi)
        S_new = (jnp.exp(b_last)[:, :, 0, :, None] * S
                 + jnp.einsum('bhsd,bhse->bhde', ki * jnp.exp(b_last - b), vi))
        return S_new, o_inter + o_intra

    S0 = jnp.zeros((B, H, DK, DV), dtype=jnp.float32)
    _, o = lax.scan(step, S0, (qc, kc, vc, gc))
    return o.transpose(1, 0, 3, 2, 4).reshape(B, L, H, DV)


def causal_multiscale_pool(u):
    B, L, _ = u.shape
    uf = u.astype(jnp.float32).reshape(B, L, POOL_GROUPS, POOL_GROUP_DIM)
    cs = jnp.cumsum(uf, axis=1)
    pos = jnp.arange(1, L + 1, dtype=jnp.float32)
    outs = []
    for gi, w in enumerate(POOL_WINDOWS):
        c = cs[:, :, gi]
        shifted = jnp.pad(c, ((0, 0), (w, 0), (0, 0)))[:, :L]
        cnt = jnp.minimum(pos, float(w))[None, :, None]
        outs.append((c - shifted) / cnt - uf[:, :, gi])
    return jnp.stack(outs, axis=2)


def setup_inputs(seed: int = 0) -> dict:
    key = jax.random.key(seed)
    ks = jax.random.split(key, 17)
    f32 = jnp.float32

    def w(k, shape, fan_in):
        return jax.random.normal(k, shape, f32) * (fan_in ** -0.5)

    def gain(k, shape):
        return 1.0 + 0.02 * jax.random.normal(k, shape, f32)

    return {
        "x": jax.random.normal(ks[0], (BATCH, SEQ, D_MODEL), f32),
        "meta_tokens": jax.random.normal(ks[1], (N_META, D_MODEL), f32),
        "norm_mix_g": gain(ks[2], (DEPTH, D_MODEL)),
        "w_in": w(ks[3], (DEPTH, D_MODEL, IN_WIDTH), D_MODEL),
        "lb_raw": 0.5 * jax.random.normal(ks[4], (DEPTH + 1, HGRN_WIDTH), f32),
        "hgrn_norm_g": gain(ks[5], (DEPTH, HGRN_DV)),
        "pool_w": w(ks[6], (DEPTH, POOL_GROUPS, POOL_GROUP_DIM, POOL_GROUP_DIM), POOL_GROUP_DIM),
        "pool_scale": gain(ks[7], (DEPTH, POOL_WIDTH)),
        "w_branch_a": w(ks[8], (DEPTH, HGRN_HEADS * HGRN_DV, D_MODEL), HGRN_HEADS * HGRN_DV),
        "w_branch_b": w(ks[9], (DEPTH, POOL_WIDTH, D_MODEL), POOL_WIDTH),
        "w_out": w(ks[10], (DEPTH, D_MODEL, D_MODEL), D_MODEL),
        "norm_ffn_g": gain(ks[11], (DEPTH, D_MODEL)),
        "w_ffn_gate": w(ks[12], (DEPTH, D_MODEL, D_FF), D_MODEL),
        "w_ffn_up": w(ks[13], (DEPTH, D_MODEL, D_FF), D_MODEL),
        "w_ffn_down": w(ks[14], (DEPTH, D_FF, D_MODEL), D_FF),
        "norm_final_g": gain(ks[15], (D_MODEL,)),
    }


def reference(x, meta_tokens, norm_mix_g, w_in, lb_raw, hgrn_norm_g, pool_w, pool_scale,
              w_branch_a, w_branch_b, w_out, norm_ffn_g, w_ffn_gate, w_ffn_up, w_ffn_down,
              norm_final_g):
    f32 = jnp.float32
    B = x.shape[0]
    meta = jnp.broadcast_to(meta_tokens[None].astype(x.dtype), (B, N_META, D_MODEL))
    h = jnp.concatenate([meta, x], axis=1)
    L = h.shape[1]
    pad = CHUNK - N_META
    lb_all = jnp.cumsum(jax.nn.softmax(lb_raw.astype(f32), axis=0), axis=0)

    def front_pad_heads(t):
        return jnp.pad(t, ((0, 0), (pad, 0), (0, 0))).reshape(B, pad + L, HGRN_HEADS, -1)

    for l in range(DEPTH):
        n = rmsnorm(h, norm_mix_g[l])
        proj = n @ w_in[l]
        zq, zf, zi, zog, zpool, zga, zgb = jnp.split(proj, SPLIT_POINTS, axis=-1)

        lb = lb_all[l]
        q = jax.nn.silu(zq.astype(f32))
        f = lb + (1.0 - lb) * jax.nn.sigmoid(zf.astype(f32))
        k = 1.0 - f
        log_f = jnp.log(f)
        v = zi.astype(f32)
        o = hgrn2_chunked(front_pad_heads(q), front_pad_heads(k),
                          front_pad_heads(v), front_pad_heads(log_f))[:, pad:]
        o = rmsnorm(o, hgrn_norm_g[l]).reshape(B, L, HGRN_HEADS * HGRN_DV)
        y_a = (o * jax.nn.silu(zog.astype(f32))).astype(h.dtype)

        pooled = causal_multiscale_pool(zpool)
        y_b = jnp.einsum('blgc,gcd->blgd', pooled, pool_w[l].astype(f32)).reshape(B, L, POOL_WIDTH)
        y_b = (y_b * pool_scale[l].astype(f32)).astype(h.dtype)

        merged = (jax.nn.sigmoid(zga) * (y_a @ w_branch_a[l])
                  + jax.nn.sigmoid(zgb) * (y_b @ w_branch_b[l]))
        h = h + merged @ w_out[l]

        n2 = rmsnorm(h, norm_ffn_g[l])
        h = h + (jax.nn.silu(n2 @ w_ffn_gate[l]) * (n2 @ w_ffn_up[l])) @ w_ffn_down[l]

    return rmsnorm(h, norm_final_g)[:, N_META:]
```

```cpp
#include <hip/hip_runtime.h>
#include <hip/hip_cooperative_groups.h>
#include <cstdio>
#include <cstdint>
namespace cg = cooperative_groups;

#ifndef MK_COOP
#define MK_COOP 1
#endif

#define LAS __attribute__((address_space(3)))
typedef unsigned short u16;
typedef short bf16x8 __attribute__((ext_vector_type(8)));
typedef float f32x4 __attribute__((ext_vector_type(4)));
typedef unsigned u32x4 __attribute__((ext_vector_type(4)));
typedef unsigned u32x2 __attribute__((ext_vector_type(2)));

typedef __bf16 bf16v2_t __attribute__((ext_vector_type(2)));
typedef float f32v2_t __attribute__((ext_vector_type(2)));
__device__ __forceinline__ unsigned cvt_pk_bf16(float lo, float hi) { const f32v2_t f = {lo, hi}; const bf16v2_t v = __builtin_convertvector(f, bf16v2_t); return __builtin_bit_cast(unsigned, v); }
__device__ __forceinline__ float bf_lo(unsigned w) { return __uint_as_float(w << 16); }
__device__ __forceinline__ float bf_hi(unsigned w) { return __uint_as_float(w & 0xffff0000u); }
__device__ __forceinline__ float bf1(u16 w) { return __uint_as_float((unsigned)w << 16); }
__device__ __forceinline__ unsigned pk_h(float a, float b) { const _Float16 x = (_Float16)a, y = (_Float16)b; return (unsigned)__builtin_bit_cast(unsigned short, x) | ((unsigned)__builtin_bit_cast(unsigned short, y) << 16); }
__device__ __forceinline__ float h2f(u16 w) { return (float)__builtin_bit_cast(_Float16, w); }
__device__ __forceinline__ float sigm(float z) { return __builtin_amdgcn_rcpf(1.0f + __expf(-z)); }

namespace pg8 {
constexpr int BM = 256, BK = 64, HALF = 128, HTB = HALF * BK * 2, STAGE_BYTES = 8 * HTB, NXCD = 8, WGM = 8;
__host__ __device__ __forceinline__ int lds_byte(int r, int c) { const int st = (r >> 4) * 2 + (c >> 5), rr = r & 15, cc = c & 31, ob = rr * 64 + cc * 2; return st * 1024 + (ob ^ (((ob >> 9) & 1) << 5)); }
__host__ __device__ __forceinline__ void stage_rc(int b, int& R, int& C) { const int st = b / 1024, sb = b % 1024, swz = sb ^ (((sb >> 9) & 1) << 5); R = (st >> 1) * 16 + swz / 64; C = (st & 1) * 32 + (swz % 64) / 2; }
__host__ __device__ __forceinline__ int perm32(int rho) { const int n = rho >> 4, i = rho & 15; return 8 * (i >> 2) + 4 * n + (i & 3); }
struct Unit { int pm, pn; };
struct Gemm { const u16* A; const u16* Bt; int M, N, K, lda, ksplit; long a2delta; };
struct StaticOrder {
    int nM, nN, nwg, G, c;
    __host__ __device__ void init(int M, int N, int G_, int c_) { nM = M / BM; nN = N / BM; nwg = nM * nN; G = G_; c = c_; }
    __host__ __device__ bool next(int i, Unit& u) const {
        const long L = (long)i * G + c; if (L >= nwg) return false;
        int wgid = (int)L; { const int q = nwg / NXCD, r = nwg % NXCD, xcd = wgid % NXCD, off = wgid / NXCD; wgid = (xcd < r ? xcd * (q + 1) : r * (q + 1) + (xcd - r) * q) + off; }
        const int nig = WGM * nN, gid = wgid / nig, fm = gid * WGM, gsz = (nM - fm) < WGM ? (nM - fm) : WGM;
        u.pm = fm + ((wgid % nig) % gsz); u.pn = (wgid % nig) / gsz; return true;
    }
};
template <class Epi, bool ALIGN_EPI>
__device__ __forceinline__ void gemm_phase(LAS unsigned char* lds, const Gemm g, const StaticOrder& S, const Epi& E) {
    const int tid = threadIdx.x, wid = __builtin_amdgcn_readfirstlane(tid >> 6), lane = tid & 63, wr = wid >> 2, wc = wid & 3, fr = lane & 15, fq = lane >> 4;
    const int K = g.K, nt = K / BK, lda = g.lda;
    unsigned voffA[2], voffB[2];
#pragma unroll
    for (int i = 0; i < 2; ++i) { int R, C; stage_rc(tid * 16 + i * 8192, R, C); const int Rb = Epi::PERM ? ((R & ~31) + perm32(R & 31)) : R;
        voffA[i] = (unsigned)(R * lda + C) * 2u; voffB[i] = (unsigned)(Rb * K + C) * 2u; }
    const size_t kstep = (size_t)(BK * 2);
    const size_t hstepA = (size_t)HALF * lda * 2, tstepA = 2 * hstepA;
    const size_t hstepB = (size_t)HALF * K * 2, tstepB = 2 * hstepB;
    const unsigned ldsw = (unsigned)wid * 1024u;
    const int aoff = lds_byte(wr * 64 + fr, fq * 8), boff = lds_byte(wc * 32 + fr, fq * 8);
#define PG8_SA(b, h) (((b) * 2 + (h)) * HTB)
#define PG8_SB(b, h) ((4 + (b) * 2 + (h)) * HTB)
#define PG8_STAGE(bufoff, gbase, voff) do { _Pragma("unroll") for (int _i = 0; _i < 2; ++_i) \
        __builtin_amdgcn_global_load_lds((const unsigned*)((const char*)(gbase) + (voff)[_i]), (LAS unsigned*)(lds + (bufoff) + ldsw + _i * 8192), 16, 0, 0); } while (0)
#define PG8_LDA(dst, b, h) do { _Pragma("unroll") for (int m = 0; m < 4; ++m) _Pragma("unroll") for (int k = 0; k < 2; ++k) dst[m][k] = *(const LAS bf16x8*)(lds + PG8_SA(b, h) + aoff + m * 2048 + k * 1024); } while (0)
#define PG8_LDB(dst, b, h) do { _Pragma("unroll") for (int n = 0; n < 2; ++n) _Pragma("unroll") for (int k = 0; k < 2; ++k) dst[n][k] = *(const LAS bf16x8*)(lds + PG8_SB(b, h) + boff + n * 2048 + k * 1024); } while (0)
#define PG8_MMA(ai, bj, At, Bt) do { __builtin_amdgcn_s_setprio(1); _Pragma("unroll") for (int m = 0; m < 4; ++m) _Pragma("unroll") for (int n = 0; n < 2; ++n) _Pragma("unroll") for (int k = 0; k < 2; ++k) \
        acc[ai][bj][m][n] = __builtin_amdgcn_mfma_f32_16x16x32_bf16(Bt[n][k], At[m][k], acc[ai][bj][m][n], 0, 0, 0); __builtin_amdgcn_s_setprio(0); } while (0)
#define PG8_WAIT_V(n) asm volatile("s_waitcnt vmcnt(" #n ")" ::: "memory")
#define PG8_WAIT_L(n) asm volatile("s_waitcnt lgkmcnt(" #n ")" ::: "memory")
#define PG8_BAR __builtin_amdgcn_s_barrier()
#define PG8_SCHED __builtin_amdgcn_sched_barrier(0)
    Unit cur, nxt; int ui = 0;
    if (!S.next(0, cur)) return;
    f32x4 acc[2][2][4][2];
#pragma unroll
    for (int a = 0; a < 2; ++a)
#pragma unroll
        for (int b = 0; b < 2; ++b)
#pragma unroll
            for (int m = 0; m < 4; ++m)
#pragma unroll
                for (int n = 0; n < 2; ++n) acc[a][b][m][n] = (f32x4){0.f, 0.f, 0.f, 0.f};
    bf16x8 At[4][2], B0[2][2], B1[2][2];
    const char* cA = (const char*)g.A + (size_t)cur.pm * tstepA; const char* cB = (const char*)g.Bt + (size_t)cur.pn * tstepB;
    PG8_STAGE(PG8_SB(0, 0), cB, voffB); PG8_STAGE(PG8_SB(0, 1), cB + hstepB, voffB); PG8_STAGE(PG8_SA(0, 0), cA, voffA); PG8_STAGE(PG8_SA(0, 1), cA + hstepA, voffA);
    if (wr == 1) PG8_BAR;
    PG8_WAIT_V(2); PG8_BAR;
    PG8_STAGE(PG8_SB(1, 0), cB + kstep, voffB); PG8_STAGE(PG8_SA(1, 0), cA + kstep, voffA); PG8_STAGE(PG8_SB(1, 1), cB + hstepB + kstep, voffB);
    PG8_WAIT_V(6); PG8_BAR;
    for (;;) {
        const bool has_next = S.next(ui + 1, nxt);
        const char* nA = has_next ? (const char*)g.A + (size_t)nxt.pm * tstepA : cA; const char* nB = has_next ? (const char*)g.Bt + (size_t)nxt.pn * tstepB : cB;
        for (int t = 0; t < nt; t += 2) {
            const bool last = (t == nt - 2);
            if constexpr (Epi::MID) { if (t == g.ksplit) E.mid(acc, cur, wr, wc, fr, fq); }
            const char* a1 = cA + (size_t)(t + 1) * kstep + (t >= g.ksplit ? g.a2delta : 0L);
            const char* a2 = last ? nA : cA + (size_t)(t + 2) * kstep + (t + 2 >= g.ksplit ? g.a2delta : 0L);
            const char* b2 = last ? nB : cB + (size_t)(t + 2) * kstep;
            const char* a3 = a2 + kstep; const char* b3 = b2 + kstep;
            PG8_LDB(B0, 0, 0); PG8_LDB(B1, 0, 1); PG8_SCHED; PG8_LDA(At, 0, 0); PG8_STAGE(PG8_SA(1, 1), a1 + hstepA, voffA);
            PG8_WAIT_V(8); PG8_WAIT_L(0); PG8_BAR; PG8_MMA(0, 0, At, B0); PG8_MMA(0, 1, At, B1); PG8_BAR; PG8_SCHED;
            PG8_LDA(At, 0, 1); PG8_STAGE(PG8_SB(0, 0), b2, voffB); PG8_STAGE(PG8_SB(0, 1), b2 + hstepB, voffB); PG8_STAGE(PG8_SA(0, 0), a2, voffA);
            PG8_WAIT_V(8); PG8_WAIT_L(0); PG8_BAR; PG8_MMA(1, 0, At, B0); PG8_MMA(1, 1, At, B1); PG8_BAR; PG8_SCHED;
            PG8_LDB(B0, 1, 0); PG8_LDB(B1, 1, 1); PG8_SCHED; PG8_LDA(At, 1, 0); PG8_STAGE(PG8_SA(0, 1), a2 + hstepA, voffA);
            PG8_WAIT_V(8); PG8_WAIT_L(0); PG8_BAR; PG8_MMA(0, 0, At, B0); PG8_MMA(0, 1, At, B1); PG8_BAR; PG8_SCHED;
            PG8_LDA(At, 1, 1); PG8_STAGE(PG8_SB(1, 0), b3, voffB); PG8_STAGE(PG8_SB(1, 1), b3 + hstepB, voffB); PG8_STAGE(PG8_SA(1, 0), a3, voffA);
            PG8_WAIT_V(8); PG8_WAIT_L(0); PG8_BAR; PG8_MMA(1, 0, At, B0); PG8_MMA(1, 1, At, B1); PG8_BAR; PG8_SCHED;
        }
        if constexpr (ALIGN_EPI) { if (wr == 0) PG8_BAR; }
        if constexpr (!Epi::AFTER) E(acc, cur, wr, wc, fr, fq);
        if (!has_next) break;
#pragma unroll
        for (int a = 0; a < 2; ++a)
#pragma unroll
            for (int b = 0; b < 2; ++b)
#pragma unroll
                for (int m = 0; m < 4; ++m)
#pragma unroll
                    for (int n = 0; n < 2; ++n) acc[a][b][m][n] = (f32x4){0.f, 0.f, 0.f, 0.f};
        cur = nxt; cA = nA; cB = nB; ++ui;
        if constexpr (ALIGN_EPI) { if (wr == 1) PG8_BAR; }
    }
    PG8_WAIT_V(0);
    if constexpr (!ALIGN_EPI) { if (wr == 0) PG8_BAR; }
    PG8_BAR;
    if constexpr (Epi::AFTER) E.after(acc, cur, wr, wc, fr, fq, lds, wid, lane);
#undef PG8_SA
#undef PG8_SB
#undef PG8_STAGE
#undef PG8_LDA
#undef PG8_LDB
#undef PG8_MMA
#undef PG8_WAIT_V
#undef PG8_WAIT_L
#undef PG8_BAR
#undef PG8_SCHED
}
}

constexpr int NWAVES = 8, NTHR = 512;
constexpr int SEQ = 8192, BATCH = 2, DM = 1024, M = BATCH * SEQ, NMETA = 16, INW = 6656, DFF = 2816, NGU = 2 * DFF, CHK = 64, NCH = SEQ / CHK;
constexpr float EPS = 1e-6f;
constexpr size_t KiB = 1024, MiB = 1u << 20;
constexpr size_t WS_LB = 0, WS_GM = 64 * KiB, WS_VM = 128 * KiB, WS_PLM = 192 * KiB, WS_PWT = 256 * KiB, WS_UM = 512 * KiB, WS_DK = 1 * MiB, WS_RSQ = 2 * MiB;
constexpr size_t WS_WAB = 3 * MiB, WS_WOUT = 6 * MiB, WS_WD = 8 * MiB, WS_WIN = 14 * MiB, WS_WGU = 14 * MiB;
constexpr size_t WS_Q = 28 * MiB, WS_G = 60 * MiB, WS_V = 92 * MiB, WS_OG = 124 * MiB, WS_GA = 156 * MiB, WS_GB = 188 * MiB, WS_PB = 220 * MiB, WS_END = 252 * MiB;
constexpr size_t WS_MG = WS_G, WS_H1B = WS_GB, WS_ACT = WS_Q;
static_assert(WS_WD + (size_t)DM * DFF * 2 <= WS_WIN && WS_WIN + (size_t)INW * DM * 2 <= WS_Q && WS_WGU + (size_t)NGU * DM * 2 <= WS_Q && WS_ACT + (size_t)M * DFF * 2 <= WS_H1B, "ws map");
constexpr int LDS_BYTES = 163840;
constexpr size_t WS_BAR = 16 * KiB, WS_CNT = 32 * KiB, CTL_ZERO = 32 * KiB;

struct Args {
    const float *x, *meta, *g_mix, *w_in, *lb_raw, *g_hn, *pool_w, *pool_scale, *w_a, *w_b, *w_out, *g_ffn, *w_gate, *w_up, *w_down, *g_fin;
    float* out; unsigned char* ws; int ph_lo, ph_hi;
};

#define LDS_WAIT() asm volatile("s_waitcnt lgkmcnt(0)" ::: "memory")
__device__ __forceinline__ float wave_sum(float v) {
#pragma unroll
    for (int o = 1; o < 64; o <<= 1) v += __shfl_xor(v, o);
    return v;
}

__device__ __forceinline__ void tr_item(const float* W, int N, int k0, int n0, u16* WT, int drow0, int dpitch, int dk0, const float* ks, LAS float* scr, int lane) {
#pragma unroll
    for (int i = 0; i < 32; ++i) { const int kk = 2 * i + (lane >> 5); float w = W[(size_t)(k0 + kk) * N + n0 + (lane & 31)]; if (ks) w *= ks[k0 + kk]; scr[kk * 33 + (lane & 31)] = w; }
    LDS_WAIT(); asm volatile("" ::: "memory");
    const int c = lane & 7;
#pragma unroll
    for (int j = 0; j < 4; ++j) { const int n = (lane >> 3) + 8 * j; const LAS float* s = scr + (8 * c) * 33 + n;
        u32x4 o; o.x = cvt_pk_bf16(s[0 * 33], s[1 * 33]); o.y = cvt_pk_bf16(s[2 * 33], s[3 * 33]); o.z = cvt_pk_bf16(s[4 * 33], s[5 * 33]); o.w = cvt_pk_bf16(s[6 * 33], s[7 * 33]);
        *(u32x4*)(WT + (size_t)(drow0 + n) * dpitch + dk0 + k0 + 8 * c) = o; }
    LDS_WAIT(); asm volatile("" ::: "memory");
}
__device__ __forceinline__ void rms_row_bf16(const float* xrow, const float* g, u16* orow, int lane) {
    const f32x4* xr = (const f32x4*)xrow + lane; const f32x4* gr = (const f32x4*)g + lane;
    f32x4 v[4]; float s = 0.f;
#pragma unroll
    for (int j = 0; j < 4; ++j) { v[j] = xr[64 * j]; s += (v[j].x * v[j].x + v[j].y * v[j].y) + (v[j].z * v[j].z + v[j].w * v[j].w); }
    const float rstd = rsqrtf(wave_sum(s) * (1.f / DM) + EPS);
    u32x2* o8 = (u32x2*)orow + lane;
#pragma unroll
    for (int j = 0; j < 4; ++j) { const f32x4 gv = gr[64 * j]; u32x2 o; o.x = cvt_pk_bf16(v[j].x * rstd * gv.x, v[j].y * rstd * gv.y); o.y = cvt_pk_bf16(v[j].z * rstd * gv.z, v[j].w * rstd * gv.w); o8[64 * j] = o; }
}

__device__ __forceinline__ void p0_meta(const Args& a, LAS unsigned char* lds, int j, int tid, int wave, int lane) {
    LAS float* nm = (LAS float*)lds;
    LAS float* part = (LAS float*)(lds + 65536);
#pragma unroll
    for (int rr = 0; rr < 2; ++rr) { const int r = 2 * wave + rr; const f32x4* xr = (const f32x4*)(a.meta + (size_t)r * DM) + lane; const f32x4* gr = (const f32x4*)a.g_mix + lane;
        f32x4 v[4]; float s = 0.f;
#pragma unroll
        for (int q = 0; q < 4; ++q) { v[q] = xr[64 * q]; s += (v[q].x * v[q].x + v[q].y * v[q].y) + (v[q].z * v[q].z + v[q].w * v[q].w); }
        const float rstd = rsqrtf(wave_sum(s) * (1.f / DM) + EPS);
#pragma unroll
        for (int q = 0; q < 4; ++q) { const f32x4 gv = gr[64 * q]; *(LAS f32x4*)(nm + r * 1024 + 4 * (lane + 64 * q)) = (f32x4){v[q].x * rstd * gv.x, v[q].y * rstd * gv.y, v[q].z * rstd * gv.z, v[q].w * rstd * gv.w}; }
    }
    __syncthreads();
    const int colbase = j < 16 ? 1024 + 64 * j : (j < 32 ? 2048 + 64 * (j - 16) : 4096 + 64 * (j - 32));
    {
        const int col = colbase + lane; float acc[16];
#pragma unroll
        for (int r = 0; r < 16; ++r) acc[r] = 0.f;
#pragma unroll 4
        for (int k = 128 * wave; k < 128 * wave + 128; k += 4) {
            const float w0 = a.w_in[(size_t)(k + 0) * INW + col], w1 = a.w_in[(size_t)(k + 1) * INW + col], w2 = a.w_in[(size_t)(k + 2) * INW + col], w3 = a.w_in[(size_t)(k + 3) * INW + col];
#pragma unroll
            for (int r = 0; r < 16; ++r) { const f32x4 n4 = *(const LAS f32x4*)(nm + r * 1024 + k); acc[r] += (n4.x * w0 + n4.y * w1) + (n4.z * w2 + n4.w * w3); }
        }
#pragma unroll
        for (int r = 0; r < 16; ++r) part[(wave * 16 + r) * 64 + lane] = acc[r];
    }
    __syncthreads();
#pragma unroll
    for (int o = 0; o < 2; ++o) {
        const int idx = tid + o * NTHR, r = idx >> 6, cl = idx & 63; float z = 0.f;
#pragma unroll
        for (int w = 0; w < 8; ++w) z += part[(w * 16 + r) * 64 + cl];
        const int col = colbase + cl;
        if (col < 2048) { const int c = col - 1024; const float lb = 1.0f / (1.0f + __expf(a.lb_raw[1024 + c] - a.lb_raw[c])); const float f = lb + (1.0f - lb) * sigm(z);
            const _Float16 hv = (_Float16)__logf(f); ((u16*)(a.ws + WS_GM))[r * 1024 + c] = __builtin_bit_cast(unsigned short, hv); }
        else if (col < 3072) { ((u16*)(a.ws + WS_VM))[r * 1024 + (col - 2048)] = (u16)(cvt_pk_bf16(z, 0.f) & 0xffffu); }
        else { ((u16*)(a.ws + WS_PLM))[r * 512 + (col - 4096)] = (u16)(cvt_pk_bf16(z, 0.f) & 0xffffu); }
    }
    __syncthreads();
}

__device__ __forceinline__ void late_weights(const Args& a, LAS unsigned char* lds, int gw, int NGW) {
    const int lane = threadIdx.x & 63, wave = __builtin_amdgcn_readfirstlane(threadIdx.x >> 6);
    LAS float* scr = (LAS float*)(lds + wave * 16384);
    constexpr int I_A = 16 * 32, I_B = 8 * 32, I_O = 16 * 32, I_D = 44 * 32, I_P = 32;
    constexpr int NIT = I_A + I_B + I_O + I_D + I_P;
    for (int it = gw; it < NIT; it += NGW) {
        int r = it;
        if (r < I_A) { tr_item(a.w_a, 1024, 64 * (r / 32), 32 * (r % 32), (u16*)(a.ws + WS_WAB), 32 * (r % 32), 1536, 0, nullptr, scr, lane); continue; } r -= I_A;
        if (r < I_B) { tr_item(a.w_b, 1024, 64 * (r / 32), 32 * (r % 32), (u16*)(a.ws + WS_WAB), 32 * (r % 32), 1536, 1024, nullptr, scr, lane); continue; } r -= I_B;
        if (r < I_O) { tr_item(a.w_out, 1024, 64 * (r / 32), 32 * (r % 32), (u16*)(a.ws + WS_WOUT), 32 * (r % 32), 1024, 0, nullptr, scr, lane); continue; } r -= I_O;
        if (r < I_D) { tr_item(a.w_down, 1024, 64 * (r / 32), 32 * (r % 32), (u16*)(a.ws + WS_WD), 32 * (r % 32), DFF, 0, nullptr, scr, lane); continue; } r -= I_D;
        { const int gi = r >> 3, q = r & 7; tr_item(a.pool_w + (size_t)gi * 16384, 128, 64 * (q >> 2), 32 * (q & 3), (u16*)(a.ws + WS_PWT) + (size_t)gi * 16384, 32 * (q & 3), 128, 0, nullptr, scr, lane); }
    }
}

__device__ __forceinline__ void p0_prologue(const Args& a, LAS unsigned char* lds, int G, int skip = 0) {
    const int tid = threadIdx.x, lane = tid & 63, wave = __builtin_amdgcn_readfirstlane(tid >> 6);
    const bool split = G > 80;
    if ((int)blockIdx.x < 40) { if (!(skip & 4)) p0_meta(a, lds, (int)blockIdx.x, tid, wave, lane); if (split) return; }
    if (blockIdx.x == 40 || (G <= 40 && blockIdx.x == 0)) { for (int c = tid; c < 1024; c += NTHR) ((float*)(a.ws + WS_LB))[c] = 1.0f / (1.0f + __expf(a.lb_raw[1024 + c] - a.lb_raw[c])); }
    LAS float* scr = (LAS float*)(lds + wave * 16384);
    const int gw = ((int)blockIdx.x - (split ? 40 : 0)) * NWAVES + wave, NGW = (G - (split ? 40 : 0)) * NWAVES;
    constexpr int I_IN = 16 * 208;
    for (int it = gw; it < I_IN && !(skip & 1); it += NGW) tr_item(a.w_in, INW, 64 * (it / 208), 32 * (it % 208), (u16*)(a.ws + WS_WIN), 32 * (it % 208), 1024, 0, nullptr, scr, lane);
    if (G != 256) late_weights(a, lds, gw, NGW);
    u16* XN = (u16*)a.out;
    {
        const f32x4* gr = (const f32x4*)a.g_mix + lane; f32x4 gv[4];
#pragma unroll
        for (int j = 0; j < 4; ++j) gv[j] = gr[64 * j];
        for (int m = 2 * gw; m < M && !(skip & 2); m += 2 * NGW) {
            const f32x4* xr = (const f32x4*)(a.x + (size_t)m * DM) + lane; f32x4 v[8]; float s0 = 0.f, s1 = 0.f;
#pragma unroll
            for (int j = 0; j < 8; ++j) v[j] = xr[64 * j];
#pragma unroll
            for (int j = 0; j < 4; ++j) { s0 += (v[j].x * v[j].x + v[j].y * v[j].y) + (v[j].z * v[j].z + v[j].w * v[j].w); s1 += (v[4 + j].x * v[4 + j].x + v[4 + j].y * v[4 + j].y) + (v[4 + j].z * v[4 + j].z + v[4 + j].w * v[4 + j].w); }
#pragma unroll
            for (int o = 1; o < 64; o <<= 1) { s0 += __shfl_xor(s0, o); s1 += __shfl_xor(s1, o); }
            const float r0 = rsqrtf(s0 * (1.f / DM) + EPS), r1 = rsqrtf(s1 * (1.f / DM) + EPS);
            u32x2* o8 = (u32x2*)(XN + (size_t)m * DM) + lane;
#pragma unroll
            for (int j = 0; j < 8; ++j) { const float rs = j < 4 ? r0 : r1; const f32x4 g4 = gv[j & 3]; u32x2 o; o.x = cvt_pk_bf16(v[j].x * rs * g4.x, v[j].y * rs * g4.y); o.y = cvt_pk_bf16(v[j].z * rs * g4.z, v[j].w * rs * g4.w); o8[64 * j] = o; }
        }
    }
}

struct EpiIn {
    static constexpr bool PERM = true, MID = false, AFTER = false;
    unsigned char* ws;
    __device__ __forceinline__ void mid(f32x4 (&)[2][2][4][2], const pg8::Unit&, int, int, int, int) const {}
    __device__ __forceinline__ void operator()(f32x4 (&acc)[2][2][4][2], const pg8::Unit& u, int wr, int wc, int fr, int fq) const {
        const int colt = u.pn * 256; int type, c0; size_t boff;
        if (colt < 1024) { type = 1; boff = WS_Q; c0 = colt; }
        else if (colt < 2048) { type = 3; boff = WS_G; c0 = colt - 1024; }
        else if (colt < 3072) { type = 0; boff = WS_V; c0 = colt - 2048; }
        else if (colt < 4096) { type = 1; boff = WS_OG; c0 = colt - 3072; }
        else if (colt < 4608) { type = 0; boff = WS_PB; c0 = colt - 4096 + 512; }
        else if (colt < 5632) { type = 2; boff = WS_GA; c0 = colt - 4608; }
        else { type = 2; boff = WS_GB; c0 = colt - 5632; }
        u16* base = (u16*)(ws + boff);
        const int col0 = c0 + wc * 32 + 8 * fq, row0 = u.pm * 256 + wr * 64 + fr;
        const float* LB = (const float*)(ws + WS_LB);
        f32x4 lbv[2][2];
        if (type == 3) {
#pragma unroll
            for (int bj = 0; bj < 2; ++bj) { lbv[bj][0] = *(const f32x4*)(LB + col0 + bj * 128); lbv[bj][1] = *(const f32x4*)(LB + col0 + bj * 128 + 4); }
        } else {
#pragma unroll
            for (int bj = 0; bj < 2; ++bj) { lbv[bj][0] = (f32x4){0.f, 0.f, 0.f, 0.f}; lbv[bj][1] = (f32x4){0.f, 0.f, 0.f, 0.f}; }
        }
#pragma unroll
        for (int ai = 0; ai < 2; ++ai)
#pragma unroll
            for (int m = 0; m < 4; ++m) { u16* rowp = base + (size_t)(row0 + ai * 128 + m * 16) * 1024 + col0;
#pragma unroll
                for (int bj = 0; bj < 2; ++bj) { f32x4 v0 = acc[ai][bj][m][0], v1 = acc[ai][bj][m][1]; u32x4 w;
                    if (type == 3) {
                        const f32x4 l0 = lbv[bj][0], l1 = lbv[bj][1];
#pragma unroll
                        for (int e = 0; e < 4; ++e) { v0[e] = __logf(l0[e] + (1.0f - l0[e]) * sigm(v0[e])); v1[e] = __logf(l1[e] + (1.0f - l1[e]) * sigm(v1[e])); }
                        w.x = pk_h(v0[0], v0[1]); w.y = pk_h(v0[2], v0[3]); w.z = pk_h(v1[0], v1[1]); w.w = pk_h(v1[2], v1[3]);
                    } else {
                        if (type == 1) {
#pragma unroll
                            for (int e = 0; e < 4; ++e) { v0[e] = v0[e] * sigm(v0[e]); v1[e] = v1[e] * sigm(v1[e]); }
                        } else if (type == 2) {
#pragma unroll
                            for (int e = 0; e < 4; ++e) { v0[e] = sigm(v0[e]); v1[e] = sigm(v1[e]); }
                        }
                        w.x = cvt_pk_bf16(v0[0], v0[1]); w.y = cvt_pk_bf16(v0[2], v0[3]); w.z = cvt_pk_bf16(v1[0], v1[1]); w.w = cvt_pk_bf16(v1[2], v1[3]);
                    }
                    *(u32x4*)(rowp + bj * 128) = w; } }
    }
};
struct EpiMerge {
    static constexpr bool PERM = true, MID = true, AFTER = false;
    const u16 *GA, *GB; u16* MG;
    __device__ __forceinline__ void mid(f32x4 (&acc)[2][2][4][2], const pg8::Unit& u, int wr, int wc, int fr, int fq) const {
        int zz = 0; asm volatile("" : "+v"(zz));
        const int col0 = u.pn * 256 + wc * 32 + 8 * fq, row0 = u.pm * 256 + wr * 64 + fr + zz;
#pragma unroll
        for (int ai = 0; ai < 2; ++ai)
#pragma unroll
            for (int m = 0; m < 4; ++m) { const size_t off = (size_t)(row0 + ai * 128 + m * 16) * 1024 + col0;
#pragma unroll
                for (int bj = 0; bj < 2; ++bj) { const u32x4 ga = *(const u32x4*)(GA + off + bj * 128), gb = *(const u32x4*)(GB + off + bj * 128);
#pragma unroll
                    for (int e = 0; e < 2; ++e) { acc[ai][bj][m][0][2 * e] *= bf_lo(ga[e]) * __builtin_amdgcn_rcpf(bf_lo(gb[e])); acc[ai][bj][m][0][2 * e + 1] *= bf_hi(ga[e]) * __builtin_amdgcn_rcpf(bf_hi(gb[e]));
                        acc[ai][bj][m][1][2 * e] *= bf_lo(ga[2 + e]) * __builtin_amdgcn_rcpf(bf_lo(gb[2 + e])); acc[ai][bj][m][1][2 * e + 1] *= bf_hi(ga[2 + e]) * __builtin_amdgcn_rcpf(bf_hi(gb[2 + e])); } }
                asm volatile("" ::: "memory"); }
    }
    __device__ __forceinline__ void operator()(f32x4 (&acc)[2][2][4][2], const pg8::Unit& u, int wr, int wc, int fr, int fq) const {
        const int col0 = u.pn * 256 + wc * 32 + 8 * fq, row0 = u.pm * 256 + wr * 64 + fr;
#pragma unroll
        for (int ai = 0; ai < 2; ++ai)
#pragma unroll
            for (int m = 0; m < 4; ++m) { const size_t off = (size_t)(row0 + ai * 128 + m * 16) * 1024 + col0;
#pragma unroll
                for (int bj = 0; bj < 2; ++bj) { const u32x4 gb = *(const u32x4*)(GB + off + bj * 128);
                    acc[ai][bj][m][0] *= (f32x4){bf_lo(gb[0]), bf_hi(gb[0]), bf_lo(gb[1]), bf_hi(gb[1])}; acc[ai][bj][m][1] *= (f32x4){bf_lo(gb[2]), bf_hi(gb[2]), bf_lo(gb[3]), bf_hi(gb[3])}; } }
#pragma unroll
        for (int ai = 0; ai < 2; ++ai)
#pragma unroll
            for (int m = 0; m < 4; ++m) { const size_t off = (size_t)(row0 + ai * 128 + m * 16) * 1024 + col0;
#pragma unroll
                for (int bj = 0; bj < 2; ++bj) { const f32x4 v0 = acc[ai][bj][m][0], v1 = acc[ai][bj][m][1]; u32x4 w;
                    w.x = cvt_pk_bf16(v0[0], v0[1]); w.y = cvt_pk_bf16(v0[2], v0[3]); w.z = cvt_pk_bf16(v1[0], v1[1]); w.w = cvt_pk_bf16(v1[2], v1[3]);
                    *(u32x4*)(MG + off + bj * 128) = w; } }
    }
};
template <bool WITH_BF16>
struct EpiRes {
    static constexpr bool PERM = false, MID = false, AFTER = false;
    const float* base; float* H; u16* Hb; float* rsq;
    __device__ __forceinline__ void mid(f32x4 (&)[2][2][4][2], const pg8::Unit&, int, int, int, int) const {}
    __device__ __forceinline__ void operator()(f32x4 (&acc)[2][2][4][2], const pg8::Unit& u, int wr, int wc, int fr, int fq) const {
        const int col0 = u.pn * 256 + wc * 32 + 4 * fq, row0 = u.pm * 256 + wr * 64 + fr;
#pragma unroll
        for (int ai = 0; ai < 2; ++ai) {
            f32x4 pre[4][2][2];
#pragma unroll
            for (int m = 0; m < 4; ++m) { const size_t off = (size_t)(row0 + ai * 128 + m * 16) * 1024 + col0;
#pragma unroll
                for (int bj = 0; bj < 2; ++bj)
#pragma unroll
                    for (int n = 0; n < 2; ++n) pre[m][bj][n] = *(const f32x4*)(base + off + bj * 128 + n * 16); }
            asm volatile("" ::: "memory");
#pragma unroll
            for (int m = 0; m < 4; ++m) { const int row = row0 + ai * 128 + m * 16; const size_t off = (size_t)row * 1024 + col0; float s = 0.f;
#pragma unroll
                for (int bj = 0; bj < 2; ++bj)
#pragma unroll
                    for (int n = 0; n < 2; ++n) { const f32x4 hv = pre[m][bj][n] + acc[ai][bj][m][n];
                        *(f32x4*)(H + off + bj * 128 + n * 16) = hv; s += (hv[0] * hv[0] + hv[1] * hv[1]) + (hv[2] * hv[2] + hv[3] * hv[3]);
                        if (WITH_BF16) { u32x2 w; w.x = cvt_pk_bf16(hv[0], hv[1]); w.y = cvt_pk_bf16(hv[2], hv[3]); *(u32x2*)(Hb + off + bj * 128 + n * 16) = w; } }
                s += __shfl_xor(s, 16); s += __shfl_xor(s, 32);
                if (fq == 0) rsq[(size_t)row * 16 + u.pn * 4 + wc] = s; }
            asm volatile("" ::: "memory");
        }
    }
};
struct EpiFfn1 {
    static constexpr bool PERM = true, MID = false, AFTER = false;
    const float* rsq; u16* ACT;
    __device__ __forceinline__ void mid(f32x4 (&)[2][2][4][2], const pg8::Unit&, int, int, int, int) const {}
    __device__ __forceinline__ void operator()(const f32x4 (&acc)[2][2][4][2], const pg8::Unit& u, int wr, int wc, int fr, int fq) const {
        const int col0 = u.pn * 128 + wc * 32 + 8 * fq, row0 = u.pm * 256 + wr * 64 + fr;
        float rstdv[2][4];
#pragma unroll
        for (int ai = 0; ai < 2; ++ai)
#pragma unroll
            for (int m = 0; m < 4; ++m) { const int row = row0 + ai * 128 + m * 16; const f32x4* rp = (const f32x4*)(rsq + (size_t)row * 16);
                const f32x4 r0 = rp[0], r1 = rp[1], r2 = rp[2], r3 = rp[3];
                const float ss = ((r0[0] + r0[1]) + (r0[2] + r0[3])) + ((r1[0] + r1[1]) + (r1[2] + r1[3])) + ((r2[0] + r2[1]) + (r2[2] + r2[3])) + ((r3[0] + r3[1]) + (r3[2] + r3[3]));
                rstdv[ai][m] = rsqrtf(ss * (1.f / DM) + EPS); }
#pragma unroll
        for (int ai = 0; ai < 2; ++ai)
#pragma unroll
            for (int m = 0; m < 4; ++m) { const int row = row0 + ai * 128 + m * 16;
                const float rstd = rstdv[ai][m];
                float o[8];
#pragma unroll
                for (int n = 0; n < 2; ++n)
#pragma unroll
                    for (int e = 0; e < 4; ++e) { const float gt = acc[ai][0][m][n][e] * rstd, up = acc[ai][1][m][n][e] * rstd; o[4 * n + e] = gt * sigm(gt) * up; }
                u32x4 w; w.x = cvt_pk_bf16(o[0], o[1]); w.y = cvt_pk_bf16(o[2], o[3]); w.z = cvt_pk_bf16(o[4], o[5]); w.w = cvt_pk_bf16(o[6], o[7]);
                *(u32x4*)(ACT + (size_t)row * DFF + col0) = w; }
    }
};

struct EpiResNorm {
    static constexpr bool PERM = false, MID = false, AFTER = true;
    const float* base; float* out; const float* gfin; float* slots; unsigned* cnt;
    __device__ __forceinline__ void mid(f32x4 (&)[2][2][4][2], const pg8::Unit&, int, int, int, int) const {}
    __device__ __forceinline__ void operator()(const f32x4 (&)[2][2][4][2], const pg8::Unit&, int, int, int, int) const {}
    __device__ __forceinline__ void after(f32x4 (&acc)[2][2][4][2], const pg8::Unit& u, int wr, int wc, int fr, int fq, LAS unsigned char* lds, int wid, int lane) const {
        LAS float* P = (LAS float*)lds; LAS float* R = (LAS float*)(lds + 4096);
        const int col0 = u.pn * 256 + wc * 32 + 4 * fq;
#pragma unroll
        for (int ai = 0; ai < 2; ++ai)
#pragma unroll
            for (int m = 0; m < 4; ++m) { const int rl = ai * 128 + wr * 64 + m * 16 + fr; const size_t off = (size_t)(u.pm * 256 + rl) * 1024 + col0; float s = 0.f;
#pragma unroll
                for (int bj = 0; bj < 2; ++bj)
#pragma unroll
                    for (int n = 0; n < 2; ++n) { const f32x4 hv = *(const f32x4*)(base + off + bj * 128 + n * 16) + acc[ai][bj][m][n]; acc[ai][bj][m][n] = hv; s += (hv[0] * hv[0] + hv[1] * hv[1]) + (hv[2] * hv[2] + hv[3] * hv[3]); }
                s += __shfl_xor(s, 16); s += __shfl_xor(s, 32);
                if (fq == 0) P[rl * 4 + wc] = s;
                if (m & 1) asm volatile("" ::: "memory"); }
        asm volatile("s_waitcnt lgkmcnt(0)" ::: "memory"); __builtin_amdgcn_s_barrier(); asm volatile("" ::: "memory");
        const int row = wid * 32 + (lane & 31);
        unsigned* slot = (unsigned*)slots + (size_t)(u.pm * 256 + row) * 16;
        if (lane < 32) { const float t = (P[row * 4 + 0] + P[row * 4 + 1]) + (P[row * 4 + 2] + P[row * 4 + 3]);
            __hip_atomic_store(slot + u.pn, __float_as_uint(t), __ATOMIC_RELAXED, __HIP_MEMORY_SCOPE_AGENT); }
        asm volatile("s_waitcnt vmcnt(0)" ::: "memory");
        if (lane == 0) __hip_atomic_fetch_add(cnt + 64 * u.pm, 1u, __ATOMIC_RELAXED, __HIP_MEMORY_SCOPE_AGENT);
        if (wid == 0) { unsigned sp = 0;
            while ((unsigned)__builtin_amdgcn_readfirstlane(__hip_atomic_load(cnt + 64 * u.pm, __ATOMIC_RELAXED, __HIP_MEMORY_SCOPE_AGENT)) < 32u) { __builtin_amdgcn_s_sleep(2); if (++sp > (1u << 20)) break; }
            __builtin_amdgcn_fence(__ATOMIC_ACQUIRE, "agent"); }
        asm volatile("s_waitcnt vmcnt(0) lgkmcnt(0)" ::: "memory"); __builtin_amdgcn_s_barrier(); asm volatile("" ::: "memory");
        if (lane < 32) { float t = 0.f;
#pragma unroll
            for (int k = 0; k < 4; ++k) t += __uint_as_float(__hip_atomic_load(slot + k, __ATOMIC_RELAXED, __HIP_MEMORY_SCOPE_AGENT));
            R[row] = rsqrtf(t * (1.f / DM) + EPS); }
        asm volatile("s_waitcnt lgkmcnt(0)" ::: "memory"); __builtin_amdgcn_s_barrier(); asm volatile("" ::: "memory");
        f32x4 gv[2][2];
#pragma unroll
        for (int bj = 0; bj < 2; ++bj)
#pragma unroll
            for (int n = 0; n < 2; ++n) gv[bj][n] = *(const f32x4*)(gfin + col0 + bj * 128 + n * 16);
#pragma unroll
        for (int ai = 0; ai < 2; ++ai)
#pragma unroll
            for (int m = 0; m < 4; ++m) { const int rl = ai * 128 + wr * 64 + m * 16 + fr; const size_t off = (size_t)(u.pm * 256 + rl) * 1024 + col0; const float rs = R[rl];
#pragma unroll
                for (int bj = 0; bj < 2; ++bj)
#pragma unroll
                    for (int n = 0; n < 2; ++n) *(f32x4*)(out + off + bj * 128 + n * 16) = acc[ai][bj][m][n] * rs * gv[bj][n]; }
    }
};
#define RLX_AGENT __ATOMIC_RELAXED, __HIP_MEMORY_SCOPE_AGENT
#define XB_TMO      128
#define XB_XCNT(j)  (256  + 64 * (j))
#define XB_XSUB(j)  (1280 + 64 * (j))
#define XB_XGEN(j)  (2304 + 64 * (j))
#define XB_TOP      3328
#define XB_TOPGEN   3392
#define XCD_BAR_WORDS 3456
#define XB_SPIN_CAP (1u << 18)

__device__ __forceinline__ unsigned xb_ld(unsigned* p)              { return __hip_atomic_load(p, __ATOMIC_RELAXED, __HIP_MEMORY_SCOPE_AGENT); }
__device__ __forceinline__ unsigned xb_add(unsigned* p, unsigned v) { return __hip_atomic_fetch_add(p, v, __ATOMIC_RELAXED, __HIP_MEMORY_SCOPE_AGENT); }
__device__ __forceinline__ unsigned xb_xcc_id() { return (unsigned)__builtin_amdgcn_s_getreg((3 << 11) | 20) & 0xFu; }
#define XB_SPIN(cond, bar) do { unsigned _sp = 0; while (cond) { __builtin_amdgcn_s_sleep(1); \
    if ((++_sp & 255u) == 0u) { if (xb_ld(&(bar)[XB_TMO])) break; if (_sp > XB_SPIN_CAP) { atomicAdd(&(bar)[XB_TMO], 1u); break; } } } } while (0)

struct XcdBarrier {
    unsigned* bar; unsigned x;
    volatile LAS unsigned* st;
};

__device__ __forceinline__ XcdBarrier xcd_barrier_post(unsigned* bar, volatile LAS unsigned* st) {
    XcdBarrier b; b.bar = bar; b.x = xb_xcc_id(); b.st = st;
    if (threadIdx.x == 0) (void)xb_add(&bar[XB_XCNT(b.x)], 1u);
    return b;
}
__device__ __forceinline__ void xcd_barrier_complete(unsigned* bar, unsigned x, unsigned& nloc, unsigned& nx) {
    const unsigned G = gridDim.x * gridDim.y * gridDim.z;
    unsigned sum, cnt, mine, sp = 0u;
    for (;;) {
        sum = 0u; cnt = 0u; mine = 0u;
#pragma unroll
        for (unsigned j = 0; j < 16; ++j) { const unsigned c = xb_ld(&bar[XB_XCNT(j)]); sum += c; cnt += (c > 0u) ? 1u : 0u; mine = (j == x) ? c : mine; }
        if (sum == G) break;
        __builtin_amdgcn_s_sleep(1);
        if ((++sp & 255u) == 0u) { if (xb_ld(&bar[XB_TMO])) break; if (sp > XB_SPIN_CAP) { atomicAdd(&bar[XB_TMO], 1u); break; } }
    }
    nloc = mine > 0u ? mine : 1u; nx = cnt > 0u ? cnt : 1u;
}

__device__ __forceinline__ void xcd_barrier(const XcdBarrier& b) {
    asm volatile("s_waitcnt vmcnt(0)" ::: "memory");
    __syncthreads();
    if (threadIdx.x == 0) {
        unsigned* bar = b.bar;
        __builtin_amdgcn_s_waitcnt(0);
        unsigned nloc = b.st[0], nx = b.st[1];
        if (nloc == 0u) { xcd_barrier_complete(bar, b.x, nloc, nx); b.st[0] = nloc; b.st[1] = nx; }
        const unsigned old = xb_add(&bar[XB_XSUB(b.x)], 1u);
        const unsigned gen = old / nloc;
        if (old + 1u == (gen + 1u) * nloc) {
            __builtin_amdgcn_fence(__ATOMIC_RELEASE, "agent");
            asm volatile("s_waitcnt vmcnt(0)" ::: "memory");
            const unsigned og = xb_add(&bar[XB_TOP], 1u);
            const unsigned tg = og / nx;
            if (og + 1u == (tg + 1u) * nx) xb_add(&bar[XB_TOPGEN], 1u);
            else XB_SPIN(xb_ld(&bar[XB_TOPGEN]) == tg, bar);
            __builtin_amdgcn_fence(__ATOMIC_ACQUIRE, "agent");
            xb_add(&bar[XB_XGEN(b.x)], 1u);
            asm volatile("s_waitcnt vmcnt(0)" ::: "memory");
        } else {
            XB_SPIN(xb_ld(&bar[XB_XGEN(b.x)]) == gen, bar);
            __builtin_amdgcn_fence(__ATOMIC_ACQUIRE, "agent");
            asm volatile("s_waitcnt vmcnt(0)" ::: "memory");
        }
    }
    __syncthreads();
}

__device__ __forceinline__ void p2_wave(const u16* Gp, const u16* Vp, int nrows, int h, u16* Uout, float* dk, int lane) {
    const int r = lane & 15, q = lane >> 4;
    bf16x8 kf[8][2]; float tot1[8];
#pragma unroll
    for (int kk = 0; kk < 2; ++kk) { const int ks = 1 - kk;
#pragma unroll
        for (int dg = 0; dg < 2; ++dg) {
            int zz = 0; asm volatile("" : "+v"(zz));
            u32x4 wq[4];
#pragma unroll
            for (int d4 = 0; d4 < 4; ++d4) { const int dt = 4 * dg + d4; const int d = 16 * dt + r + zz; float gv[8];
#pragma unroll
                for (int j = 0; j < 8; ++j) { const int s = 32 * ks + 8 * q + j; gv[j] = s < nrows ? h2f(Gp[(size_t)s * 1024 + h * 128 + d]) : 0.f; }
                float suf[8]; float run = 0.f;
#pragma unroll
                for (int j = 7; j >= 0; --j) { suf[j] = run; run += gv[j]; }
                const float T = run, ta = __shfl_xor(T, 16), tb = __shfl_xor(T, 32), tc = __shfl_xor(ta, 32);
                const float after = ((q ^ 1) > q ? ta : 0.f) + ((q ^ 2) > q ? tb : 0.f) + ((q ^ 3) > q ? tc : 0.f);
                const float tot = (T + ta) + (tb + tc);
                float base;
                if (ks == 1) { tot1[dt] = tot; base = after; } else { base = after + tot1[dt]; if (dk && q == 0) dk[h * 128 + d] = __expf(tot + tot1[dt]); }
                float kh[8];
#pragma unroll
                for (int j = 0; j < 8; ++j) kh[j] = (1.0f - __expf(gv[j])) * __expf(suf[j] + base);
                wq[d4].x = cvt_pk_bf16(kh[0], kh[1]); wq[d4].y = cvt_pk_bf16(kh[2], kh[3]); wq[d4].z = cvt_pk_bf16(kh[4], kh[5]); wq[d4].w = cvt_pk_bf16(kh[6], kh[7]); }
            asm volatile("" : "+v"(wq[0].x), "+v"(wq[0].y), "+v"(wq[0].z), "+v"(wq[0].w), "+v"(wq[1].x), "+v"(wq[1].y), "+v"(wq[1].z), "+v"(wq[1].w),
                              "+v"(wq[2].x), "+v"(wq[2].y), "+v"(wq[2].z), "+v"(wq[2].w), "+v"(wq[3].x), "+v"(wq[3].y), "+v"(wq[3].z), "+v"(wq[3].w));
#pragma unroll
            for (int d4 = 0; d4 < 4; ++d4) kf[4 * dg + d4][ks] = __builtin_bit_cast(bf16x8, wq[d4]); } }
#pragma unroll 1
    for (int ep = 0; ep < 4; ++ep) {
        int zz = 0; asm volatile("" : "+v"(zz)); const int rz = r + zz;
        bf16x8 vf[2][2];
#pragma unroll
        for (int e2 = 0; e2 < 2; ++e2)
#pragma unroll
            for (int ks = 0; ks < 2; ++ks) { unsigned short t[8];
#pragma unroll
                for (int j = 0; j < 8; ++j) { const int s = 32 * ks + 8 * q + j; t[j] = s < nrows ? Vp[(size_t)s * 1024 + h * 128 + 16 * (2 * ep + e2) + rz] : (unsigned short)0; }
                u32x4 w; w.x = t[0] | ((unsigned)t[1] << 16); w.y = t[2] | ((unsigned)t[3] << 16); w.z = t[4] | ((unsigned)t[5] << 16); w.w = t[6] | ((unsigned)t[7] << 16);
                vf[e2][ks] = __builtin_bit_cast(bf16x8, w); }
#pragma unroll
        for (int e2 = 0; e2 < 2; ++e2) { const int et = 2 * ep + e2;
            f32x4 acc[8];
#pragma unroll
            for (int dt = 0; dt < 8; ++dt) { acc[dt] = (f32x4){0.f, 0.f, 0.f, 0.f};
#pragma unroll
                for (int ks = 0; ks < 2; ++ks) acc[dt] = __builtin_amdgcn_mfma_f32_16x16x32_bf16(kf[dt][ks], vf[e2][ks], acc[dt], 0, 0, 0); }
#pragma unroll
            for (int dt = 0; dt < 8; ++dt) { u32x2 w; w.x = cvt_pk_bf16(acc[dt][0], acc[dt][1]); w.y = cvt_pk_bf16(acc[dt][2], acc[dt][3]);
                *(u32x2*)(Uout + (size_t)(16 * et + r) * 128 + 16 * dt + 4 * q) = w; } }
    }
}
__device__ __forceinline__ void p2_states(const Args& a, int G) {
    const int tid = threadIdx.x, lane = tid & 63, wave = __builtin_amdgcn_readfirstlane(tid >> 6);
    const u16* Gb = (const u16*)(a.ws + WS_G); const u16* Vb = (const u16*)(a.ws + WS_V); u16* US = (u16*)a.out; float* DK = (float*)(a.ws + WS_DK);
    for (int it = blockIdx.x; it < BATCH * NCH + 1; it += G) {
        if (it < BATCH * NCH) { const size_t row0 = (size_t)it * CHK;
            p2_wave(Gb + row0 * 1024, Vb + row0 * 1024, CHK, wave, US + ((size_t)it * 8 + wave) * 16384, DK + (size_t)it * 1024, lane); }
        else p2_wave((const u16*)(a.ws + WS_GM), (const u16*)(a.ws + WS_VM), NMETA, wave, (u16*)(a.ws + WS_UM) + (size_t)wave * 16384, nullptr, lane);
    }
}

__device__ __forceinline__ void p3_scan(const Args& a, LAS unsigned char* lds, int G) {
    const int tid = threadIdx.x, lane = tid & 63, wave = __builtin_amdgcn_readfirstlane(tid >> 6);
    {
        LAS float* scr = (LAS float*)(lds + wave * 16384);
        const int gw = (int)blockIdx.x * NWAVES + wave, NGW = G * NWAVES;
        for (int it = gw; it < 2 * 16 * 88; it += NGW) { const int up = it >= 16 * 88, r = up ? it - 16 * 88 : it, kb = r / 88, nb = r % 88, n0 = 32 * nb;
            tr_item(up ? a.w_up : a.w_gate, DFF, 64 * kb, n0, (u16*)(a.ws + WS_WGU), (n0 >> 7) * 256 + (n0 & 127) + (up ? 128 : 0), 1024, 0, a.g_ffn, scr, lane); }
    }
    u16* US = (u16*)a.out; const float* DK = (const float*)(a.ws + WS_DK); const u16* UM = (const u16*)(a.ws + WS_UM);
    for (int idx = blockIdx.x * NTHR + tid; idx < BATCH * 8 * 128 * 64; idx += G * NTHR) {
        const int dp = idx & 63, e = (idx >> 6) & 127, h = (idx >> 13) & 7, b = idx >> 16;
        const unsigned um = *(const unsigned*)(UM + (size_t)h * 16384 + e * 128 + 2 * dp);
        float s0 = bf_lo(um), s1 = bf_hi(um);
        unsigned* up = (unsigned*)(US + ((size_t)(b * NCH) * 8 + h) * 16384 + e * 128 + 2 * dp);
        const float* dkp = DK + (size_t)(b * NCH) * 1024 + h * 128 + 2 * dp;
#pragma unroll 1
        for (int c0 = 0; c0 < NCH; c0 += 16) {
            unsigned uu[16]; float dd0[16], dd1[16];
#pragma unroll
            for (int i = 0; i < 16; ++i) { uu[i] = up[(size_t)(c0 + i) * 8 * 8192]; dd0[i] = dkp[(size_t)(c0 + i) * 1024]; dd1[i] = dkp[(size_t)(c0 + i) * 1024 + 1]; }
#pragma unroll
            for (int i = 0; i < 16; ++i) { up[(size_t)(c0 + i) * 8 * 8192] = cvt_pk_bf16(s0, s1); s0 = dd0[i] * s0 + bf_lo(uu[i]); s1 = dd1[i] * s1 + bf_hi(uu[i]); }
        }
    }
}

constexpr int P4_PITCH = 272, P4_MAT = 64 * P4_PITCH  , P4_VPITCH = 136, P4_HS = 4 * P4_MAT  , P4_TOT = 2 * P4_HS  , P4_PLD = P4_TOT + 4096  ;
static_assert(P4_PLD + P4_MAT + 64 <= LDS_BYTES, "LDS map");
__device__ __forceinline__ unsigned ld_pl(const u16* PB, const u16* PLM, int b, int tx, int cofs) {
    return tx >= 0 ? *(const unsigned*)(PB + (size_t)(b * SEQ + tx) * 1024 + 512 + cofs) : *(const unsigned*)(PLM + (size_t)(NMETA + tx) * 512 + cofs);
}
__device__ __forceinline__ void p4_outputs(const Args& a, LAS unsigned char* lds, int G, int skip = 0) {
    (void)skip;
    const int tid = threadIdx.x, lane = tid & 63, wave = __builtin_amdgcn_readfirstlane(tid >> 6);
    const int r = lane & 15, q = lane >> 4;
    u16* Qb = (u16*)(a.ws + WS_Q); const u16* Gb = (const u16*)(a.ws + WS_G); const u16* Vb = (const u16*)(a.ws + WS_V); const u16* OGb = (const u16*)(a.ws + WS_OG);
    u16* PB = (u16*)(a.ws + WS_PB); const u16* PLM = (const u16*)(a.ws + WS_PLM); const u16* PWT = (const u16*)(a.ws + WS_PWT); const u16* US = (const u16*)a.out;
    LAS unsigned char* PLD = lds + P4_PLD;
    for (int item = blockIdx.x; item < BATCH * NCH * 4; item += G) {
        const int hp = item & 3, bc = item >> 2, c = bc & (NCH - 1), b = bc >> 7;
        const size_t row0 = (size_t)b * SEQ + (size_t)c * CHK;
        const int hs = wave >> 2, tq = wave & 3, h = 2 * hp + hs;
        LAS unsigned char* L = lds + hs * P4_HS;
        LAS unsigned char* KT = L, *QT = L + P4_MAT, *QH = L + 2 * P4_MAT, *VT = L + 3 * P4_MAT;
        LAS float* TOT = (LAS float*)(lds + P4_TOT) + hs * 512;
        const int d0 = 2 * lane; const size_t cofs = (size_t)h * 128 + d0;
        unsigned gp[16], qv[16], vv[16];
#pragma unroll
        for (int i = 0; i < 16; ++i) { const size_t o = (row0 + 16 * tq + i) * 1024 + cofs; gp[i] = *(const unsigned*)(Gb + o); qv[i] = *(const unsigned*)(Qb + o); vv[i] = *(const unsigned*)(Vb + o); }
        const int gi = hp, wlen = 2 << gi; const float inv = 1.0f / (float)wlen;
        const int t0 = 8 * wave, pcofs = gi * 128 + 2 * lane, tx0 = c * CHK + t0;
        unsigned pu[23];
#pragma unroll
        for (int j = 1; j < 16; ++j) pu[15 - j] = (j < wlen) ? ld_pl(PB, PLM, b, tx0 - j, pcofs) : 0u;
#pragma unroll
        for (int i = 0; i < 8; ++i) pu[15 + i] = ld_pl(PB, PLM, b, tx0 + i, pcofs);
        bf16x8 wf[4];
#pragma unroll
        for (int kd = 0; kd < 4; ++kd) wf[kd] = *(const bf16x8*)(PWT + (size_t)(gi * 128 + 16 * wave + r) * 128 + 32 * kd + 8 * q);
        float s0 = 0.f, s1 = 0.f;
#pragma unroll
        for (int i = 0; i < 16; ++i) { s0 += h2f((u16)(gp[i] & 0xffffu)); s1 += h2f((u16)(gp[i] >> 16)); }
        TOT[tq * 128 + d0] = s0; TOT[tq * 128 + d0 + 1] = s1;
        __syncthreads();
        {
            float w0 = 0.f, w1 = 0.f;
#pragma unroll
            for (int j = 1; j < 16; ++j) if (j < wlen) { w0 += bf_lo(pu[15 - j]); w1 += bf_hi(pu[15 - j]); }
#pragma unroll
            for (int i = 0; i < 8; ++i) { const float u0 = bf_lo(pu[15 + i]), u1 = bf_hi(pu[15 + i]); w0 += u0; w1 += u1;
                *(LAS unsigned*)(PLD + (t0 + i) * P4_PITCH + 4 * lane) = cvt_pk_bf16(w0 * inv - u0, w1 * inv - u1);
                const unsigned o = wlen == 2 ? pu[15 + i - 1] : (wlen == 4 ? pu[15 + i - 3] : (wlen == 8 ? pu[15 + i - 7] : pu[15 + i - 15]));
                w0 -= bf_lo(o); w1 -= bf_hi(o); }
        }
        float b0 = 0.f, b1 = 0.f;
#pragma unroll
        for (int t2 = 0; t2 < 3; ++t2) if (t2 < tq) { b0 += TOT[t2 * 128 + d0]; b1 += TOT[t2 * 128 + d0 + 1]; }
        const float bm0 = TOT[d0] + TOT[128 + d0], bm1 = TOT[d0 + 1] + TOT[128 + d0 + 1];
#pragma unroll
        for (int i = 0; i < 16; ++i) { const int t = 16 * tq + i; const float g0 = h2f((u16)(gp[i] & 0xffffu)), g1 = h2f((u16)(gp[i] >> 16)); b0 += g0; b1 += g1;
            const unsigned q2 = qv[i], v2 = vv[i];
            const float q0 = bf_lo(q2), q1 = bf_hi(q2), k0 = 1.0f - __expf(g0), k1 = 1.0f - __expf(g1);
            const float eb0 = __expf(b0), eb1 = __expf(b1), em0 = __expf(fminf(b0 - bm0, 80.f)), em1 = __expf(fminf(b1 - bm1, 80.f)), ek0 = __expf(fminf(bm0 - b0, 80.f)), ek1 = __expf(fminf(bm1 - b1, 80.f));
            *(LAS unsigned*)(QT + t * P4_PITCH + d0 * 2) = cvt_pk_bf16(q0 * em0, q1 * em1);
            *(LAS unsigned*)(QH + t * P4_PITCH + d0 * 2) = cvt_pk_bf16(q0 * eb0, q1 * eb1);
            *(LAS unsigned*)(KT + t * P4_PITCH + d0 * 2) = cvt_pk_bf16(k0 * ek0, k1 * ek1);
            *(LAS u16*)(VT + d0 * P4_VPITCH + t * 2) = (u16)(v2 & 0xffffu); *(LAS u16*)(VT + (d0 + 1) * P4_VPITCH + t * 2) = (u16)(v2 >> 16); }
        const u16* Sp = US + ((size_t)bc * 8 + h) * 16384;
        bf16x8 sfr[8][4];
#pragma unroll
        for (int et = 0; et < 8; ++et)
#pragma unroll
            for (int kd = 0; kd < 4; ++kd) sfr[et][kd] = *(const bf16x8*)(Sp + (size_t)(16 * et + r) * 128 + 32 * kd + 8 * q);
        const int tt = tq;
        const size_t orow = (row0 + 16 * tt + r) * 1024 + (size_t)h * 128;
        __syncthreads();
        u32x2 ogv[8];
#pragma unroll
        for (int et = 0; et < 8; ++et) ogv[et] = *(const u32x2*)(OGb + orow + 16 * et + 4 * q);
        {
            f32x4 acc[4];
#pragma unroll
            for (int t4 = 0; t4 < 4; ++t4) acc[t4] = (f32x4){0.f, 0.f, 0.f, 0.f};
#pragma unroll
            for (int kd = 0; kd < 4; ++kd)
#pragma unroll
                for (int t4 = 0; t4 < 4; ++t4) { const bf16x8 pfr = *(const LAS bf16x8*)(PLD + (16 * t4 + r) * P4_PITCH + (32 * kd + 8 * q) * 2); acc[t4] = __builtin_amdgcn_mfma_f32_16x16x32_bf16(wf[kd], pfr, acc[t4], 0, 0, 0); }
            const int n0 = gi * 128 + 16 * wave + 4 * q; const f32x4 psc = *(const f32x4*)(a.pool_scale + n0);
#pragma unroll
            for (int t4 = 0; t4 < 4; ++t4) { u32x2 w; w.x = cvt_pk_bf16(acc[t4][0] * psc[0], acc[t4][1] * psc[1]); w.y = cvt_pk_bf16(acc[t4][2] * psc[2], acc[t4][3] * psc[3]);
                *(u32x2*)(PB + (row0 + 16 * t4 + r) * 1024 + n0) = w; }
        }
        bf16x8 qt[4], qh[4];
#pragma unroll
        for (int kd = 0; kd < 4; ++kd) { qt[kd] = *(const LAS bf16x8*)(QT + (16 * tt + r) * P4_PITCH + (32 * kd + 8 * q) * 2); qh[kd] = *(const LAS bf16x8*)(QH + (16 * tt + r) * P4_PITCH + (32 * kd + 8 * q) * 2); }
        f32x4 sc[4];
#pragma unroll
        for (int st = 0; st < 4; ++st) { f32x4 acc = (f32x4){0.f, 0.f, 0.f, 0.f};
            if (st <= tt) {
#pragma unroll
                for (int kd = 0; kd < 4; ++kd) { const bf16x8 kfr = *(const LAS bf16x8*)(KT + (16 * st + r) * P4_PITCH + (32 * kd + 8 * q) * 2); acc = __builtin_amdgcn_mfma_f32_16x16x32_bf16(kfr, qt[kd], acc, 0, 0, 0); }
                if (st == tt) {
#pragma unroll
                    for (int i = 0; i < 4; ++i) if (4 * q + i > r) acc[i] = 0.f; }
            }
            sc[st] = acc; }
        bf16x8 pf[2];
#pragma unroll
        for (int ks = 0; ks < 2; ++ks) { u32x4 w; w.x = cvt_pk_bf16(sc[2 * ks][0], sc[2 * ks][1]); w.y = cvt_pk_bf16(sc[2 * ks][2], sc[2 * ks][3]); w.z = cvt_pk_bf16(sc[2 * ks + 1][0], sc[2 * ks + 1][1]); w.w = cvt_pk_bf16(sc[2 * ks + 1][2], sc[2 * ks + 1][3]);
            pf[ks] = __builtin_bit_cast(bf16x8, w); }
        f32x4 oa[8]; float ss = 0.f;
#pragma unroll
        for (int et = 0; et < 8; ++et) { f32x4 acc = (f32x4){0.f, 0.f, 0.f, 0.f};
#pragma unroll
            for (int kd = 0; kd < 4; ++kd) acc = __builtin_amdgcn_mfma_f32_16x16x32_bf16(sfr[et][kd], qh[kd], acc, 0, 0, 0);
#pragma unroll
            for (int ks = 0; ks < 2; ++ks) if (2 * ks <= tt) {
                const u32x2 lo = *(const LAS u32x2*)(VT + (16 * et + r) * P4_VPITCH + (32 * ks + 4 * q) * 2), hi = *(const LAS u32x2*)(VT + (16 * et + r) * P4_VPITCH + (32 * ks + 16 + 4 * q) * 2);
                const u32x4 w = (u32x4){lo.x, lo.y, hi.x, hi.y};
                acc = __builtin_amdgcn_mfma_f32_16x16x32_bf16(__builtin_bit_cast(bf16x8, w), pf[ks], acc, 0, 0, 0); }
            oa[et] = acc; ss += (acc[0] * acc[0] + acc[1] * acc[1]) + (acc[2] * acc[2] + acc[3] * acc[3]); }
        ss += __shfl_xor(ss, 16); ss += __shfl_xor(ss, 32);
        const float rstd = rsqrtf(ss * (1.f / 128.f) + EPS);
#pragma unroll
        for (int et = 0; et < 8; ++et) { const int e0 = 16 * et + 4 * q; const f32x4 gn = *(const f32x4*)(a.g_hn + e0); const u32x2 og = ogv[et];
            u32x2 w; w.x = cvt_pk_bf16(oa[et][0] * rstd * gn[0] * bf_lo(og.x), oa[et][1] * rstd * gn[1] * bf_hi(og.x)); w.y = cvt_pk_bf16(oa[et][2] * rstd * gn[2] * bf_lo(og.y), oa[et][3] * rstd * gn[3] * bf_hi(og.y));
            *(LAS u32x2*)(QT + (16 * tt + r) * P4_PITCH + e0 * 2) = w; }
        asm volatile("s_waitcnt lgkmcnt(0)" ::: "memory");
#pragma unroll
        for (int i = 0; i < 4; ++i) { const int rr = 16 * tt + 4 * i + (lane >> 4); const u32x4 v = *(const LAS u32x4*)(QT + rr * P4_PITCH + (lane & 15) * 16);
            *(u32x4*)(Qb + (row0 + rr) * 1024 + (size_t)h * 128 + (lane & 15) * 8) = v; }
    }
    __syncthreads();
}

__device__ __forceinline__ void p9_final(const Args& a, int G) {
    const int tid = threadIdx.x, lane = tid & 63, wave = __builtin_amdgcn_readfirstlane(tid >> 6);
    const float* rsq = (const float*)(a.ws + WS_RSQ);
    const f32x4* gr = (const f32x4*)a.g_fin + lane; f32x4 gv[4];
#pragma unroll
    for (int j = 0; j < 4; ++j) gv[j] = gr[64 * j];
    for (int m = 2 * (blockIdx.x * NWAVES + wave); m < M; m += 2 * G * NWAVES) {
        float p = lane < 32 ? rsq[(size_t)m * 16 + lane] : 0.f;
        f32x4* xr = (f32x4*)(a.out + (size_t)m * DM) + lane; f32x4 v[8];
#pragma unroll
        for (int j = 0; j < 8; ++j) v[j] = xr[64 * j];
        p += __shfl_xor(p, 1); p += __shfl_xor(p, 2); p += __shfl_xor(p, 4); p += __shfl_xor(p, 8);
        const float r0 = rsqrtf(__shfl(p, 0) * (1.f / DM) + EPS), r1 = rsqrtf(__shfl(p, 16) * (1.f / DM) + EPS);
#pragma unroll
        for (int j = 0; j < 8; ++j) { const float rs = j < 4 ? r0 : r1; const f32x4 g4 = gv[j & 3]; xr[64 * j] = (f32x4){v[j].x * rs * g4.x, v[j].y * rs * g4.y, v[j].z * rs * g4.z, v[j].w * rs * g4.w}; }
    }
}

#ifdef PROBE_STOP
__device__ __forceinline__ void p_dump(const Args& a, int G) {
    const u16* Qb = (const u16*)(a.ws + WS_Q); const u16* Gb = (const u16*)(a.ws + WS_G); const u16* Vb = (const u16*)(a.ws + WS_V); const u16* OGb = (const u16*)(a.ws + WS_OG);
    const u16* GAb = (const u16*)(a.ws + WS_GA); const u16* GBb = (const u16*)(a.ws + WS_GB); const u16* PB = (const u16*)(a.ws + WS_PB);
    for (size_t i = (size_t)blockIdx.x * NTHR + threadIdx.x; i < (size_t)M * DM; i += (size_t)G * NTHR) {
        float v = 0.f;
        if (PROBE_STOP == 1) v = bf1(Qb[i]) + h2f(Gb[i]) + bf1(Vb[i]) + bf1(OGb[i]) + bf1(GAb[i]) + bf1(GBb[i]) + bf1(PB[i]);
        else if (PROBE_STOP == 2 || PROBE_STOP == 3) { float t = bf1(((const u16*)a.out)[i]) + bf1(((const u16*)a.out)[i + (size_t)M * DM]); if (!(fabsf(t) < 1e30f)) t = 12345.f; ((float*)(a.ws + WS_GA))[i] = t; continue; }
        else if (PROBE_STOP == 4) v = bf1(Qb[i]) + bf1(PB[i]);
        else if (PROBE_STOP == 5) v = bf1(Gb[i]);
        else continue;
        a.out[i] = v;
    }
}
#endif
__device__ __forceinline__ void flat_barrier(unsigned* cnt) {
    asm volatile("s_waitcnt vmcnt(0)" ::: "memory");
    __syncthreads();
    if (threadIdx.x == 0) {
        const unsigned Gn = gridDim.x;
        __builtin_amdgcn_fence(__ATOMIC_RELEASE, "agent");
        asm volatile("s_waitcnt vmcnt(0)" ::: "memory");
        const unsigned old = __hip_atomic_fetch_add(cnt, 1u, __ATOMIC_RELAXED, __HIP_MEMORY_SCOPE_AGENT);
        const unsigned target = (old / Gn + 1u) * Gn; unsigned sp = 0;
        while (__hip_atomic_load(cnt, __ATOMIC_RELAXED, __HIP_MEMORY_SCOPE_AGENT) < target) { __builtin_amdgcn_s_sleep(1); if (++sp > (1u << 22)) break; }
        __builtin_amdgcn_fence(__ATOMIC_ACQUIRE, "agent");
        asm volatile("s_waitcnt vmcnt(0)" ::: "memory");
    }
    __syncthreads();
}
constexpr int NPH = 10;
__global__ void __launch_bounds__(NTHR, 2) mega(Args a) {
    extern __shared__ __attribute__((aligned(16))) unsigned char lds_raw[];
    LAS unsigned char* lds = (LAS unsigned char*)lds_raw;
    cg::grid_group grid = cg::this_grid();
    const int G = gridDim.x, lo = a.ph_lo, hi = a.ph_hi;
    unsigned char* ws = a.ws;
    volatile LAS unsigned* MISC = (volatile LAS unsigned*)(lds + LDS_BYTES - 64);
    if (threadIdx.x < 16) MISC[threadIdx.x] = 0u;
    __syncthreads();
    XcdBarrier bar; bar.bar = (unsigned*)(ws + WS_BAR); bar.x = 0; bar.st = nullptr;
    if (hi - lo > 1) bar = xcd_barrier_post((unsigned*)(ws + WS_BAR), MISC);
    if (hi < 0) grid.sync();
#ifndef PHMASK
#define PHMASK 0x3ff
#endif
#define IN(k) (((PHMASK >> (k)) & 1) && lo <= (k) && (k) < hi)
#ifndef CG_SEAMS
#define CG_SEAMS 0x0
#endif
#define SEAM(k) do { if (IN(k) && IN((k) + 1)) { if ((CG_SEAMS >> (k)) & 1) grid.sync(); else xcd_barrier(bar); } } while (0)
#ifndef PROBE_DUP
#define PROBE_DUP 0
#endif
#ifndef PROBE_XSYNC
#define PROBE_XSYNC 0
#endif
#define DUP(k) (((PROBE_DUP >> (k)) & 1) ? 2 : 1)
    if (IN(0)) { p0_prologue(a, lds, G); } SEAM(0);
#ifdef PROBE_XBAR
    for (int xs = 0; xs < PROBE_XBAR; ++xs) flat_barrier((unsigned*)(ws + WS_BAR + 14 * KiB));
#endif
    if (IN(1)) { pg8::Gemm g{(const u16*)a.out, (const u16*)(ws + WS_WIN), M, INW, DM, DM, 1 << 30, 0L}; pg8::StaticOrder S; S.init(M, INW, G, (int)blockIdx.x);
        EpiIn E{ws}; pg8::gemm_phase<EpiIn, true>(lds, g, S, E);
        if (G == 256 && blockIdx.x >= 128) late_weights(a, lds, ((int)blockIdx.x - 128) * NWAVES + (int)(threadIdx.x >> 6), 128 * NWAVES); }
    SEAM(1);
    if (IN(2)) { p2_states(a, G); } SEAM(2);
    if (IN(3)) { p3_scan(a, lds, G); } SEAM(3);
    if (IN(4)) { p4_outputs(a, lds, G); } SEAM(4);
    if (IN(5)) { pg8::Gemm g{(const u16*)(ws + WS_Q), (const u16*)(ws + WS_WAB), M, DM, 1536, DM, 16, (long)(WS_PB - WS_Q) - 16L * 128L}; pg8::StaticOrder S; S.init(M, DM, G, (int)blockIdx.x);
        EpiMerge E{(const u16*)(ws + WS_GA), (const u16*)(ws + WS_GB), (u16*)(ws + WS_MG)}; pg8::gemm_phase<EpiMerge, false>(lds, g, S, E); } SEAM(5);
    if (IN(6)) { pg8::Gemm g{(const u16*)(ws + WS_MG), (const u16*)(ws + WS_WOUT), M, DM, DM, DM, 1 << 30, 0L}; pg8::StaticOrder S; S.init(M, DM, G, (int)blockIdx.x);
        EpiRes<true> E{a.x, a.out, (u16*)(ws + WS_H1B), (float*)(ws + WS_RSQ)}; pg8::gemm_phase<EpiRes<true>, false>(lds, g, S, E); } SEAM(6);
    if (IN(7)) { pg8::Gemm g{(const u16*)(ws + WS_H1B), (const u16*)(ws + WS_WGU), M, NGU, DM, DM, 1 << 30, 0L}; pg8::StaticOrder S; S.init(M, NGU, G, (int)blockIdx.x);
        EpiFfn1 E{(const float*)(ws + WS_RSQ), (u16*)(ws + WS_ACT)}; pg8::gemm_phase<EpiFfn1, true>(lds, g, S, E); } SEAM(7);
    const bool fuse9 = (G == (M / 256) * (DM / 256)) && (hi - lo > 1);
    if (IN(8)) { pg8::Gemm g{(const u16*)(ws + WS_ACT), (const u16*)(ws + WS_WD), M, DM, DFF, DFF, 1 << 30, 0L}; pg8::StaticOrder S; S.init(M, DM, G, (int)blockIdx.x);
        if (fuse9) { EpiResNorm E{a.out, a.out, a.g_fin, (float*)(ws + WS_RSQ), (unsigned*)(ws + WS_CNT)}; pg8::gemm_phase<EpiResNorm, false>(lds, g, S, E); }
        else { EpiRes<false> E{a.out, a.out, nullptr, (float*)(ws + WS_RSQ)}; pg8::gemm_phase<EpiRes<false>, false>(lds, g, S, E); } }
    if (!fuse9) { SEAM(8);
    if (IN(9)) { p9_final(a, G); } }
#ifdef PROBE_LIST
    if (lo == 20) p0_prologue(a, lds, G, 1);
    if (lo == 30) p0_prologue(a, lds, G, 2);
    if (lo == 40) p0_prologue(a, lds, G, 4);
    if (lo == 14) p4_outputs(a, lds, G, 1);
    if (lo == 24) p4_outputs(a, lds, G, 2);
    if (lo == 34) p4_outputs(a, lds, G, 2 | 4);
    if (lo == 44) p4_outputs(a, lds, G, 2 | 8);
    if (lo == 54) p4_outputs(a, lds, G, 2 | 16);
    if (lo == 64) p4_outputs(a, lds, G, 2 | 32);
    if (lo == 74) p4_outputs(a, lds, G, 2 | 64);
    if (lo == 18) { pg8::Gemm g{(const u16*)(ws + WS_ACT), (const u16*)(ws + WS_WD), M, DM, DFF, DFF, 1 << 30, 0L}; pg8::StaticOrder S; S.init(M, DM, G, (int)blockIdx.x);
        EpiRes<false> E{(const float*)(ws + WS_GA), (float*)(ws + WS_GA), nullptr, (float*)(ws + WS_OG)}; pg8::gemm_phase<EpiRes<false>, false>(lds, g, S, E); }
    if (lo == 19) { Args b = a; b.out = (float*)(ws + WS_GA); p9_final(b, G); }
#endif
#ifdef PROBE_STOP
    if (lo == 10) p_dump(a, G);
    if (lo == 11 && (PROBE_STOP == 2 || PROBE_STOP == 3)) { for (size_t i = (size_t)blockIdx.x * NTHR + threadIdx.x; i < (size_t)M * DM; i += (size_t)G * NTHR) a.out[i] = ((const float*)(a.ws + WS_GA))[i]; }
#endif
#undef IN
#undef SEAM
}

extern "C" void kernel_launch(void* const* d_in, const int* in_sizes, int n_in, void* d_out, int out_size, void* d_ws, size_t ws_size, hipStream_t stream) {
    static int grid = 0;
    if (grid == 0) {
        if (n_in != 16 || in_sizes[0] != M * DM || out_size != M * DM || ws_size < WS_END) { fprintf(stderr, "kernel_launch: unexpected shapes (n_in %d, in0 %d, out %d, ws %zu); nothing launched\n", n_in, n_in > 0 ? in_sizes[0] : -1, out_size, ws_size); grid = -1; return; }
        int dev = 0, cus = 0, per_cu = 0;
        (void)hipGetDevice(&dev); (void)hipDeviceGetAttribute(&cus, hipDeviceAttributeMultiprocessorCount, dev);
        if (hipFuncSetAttribute((const void*)mega, hipFuncAttributeMaxDynamicSharedMemorySize, LDS_BYTES) != hipSuccess) { fprintf(stderr, "kernel_launch: hipFuncSetAttribute failed\n"); }
        if (hipOccupancyMaxActiveBlocksPerMultiprocessor(&per_cu, (const void*)mega, NTHR, LDS_BYTES) != hipSuccess || per_cu < 1) per_cu = 1;
        (void)hipGetLastError();
        if (cus <= 0) cus = 256;
        grid = cus * per_cu;
    }
    if (grid < 0) return;
#if MK_COOP
    if (hipMemsetAsync((char*)d_ws + WS_BAR, 0, CTL_ZERO, stream) != hipSuccess) { fprintf(stderr, "kernel_launch: hipMemsetAsync of the barrier words failed\n"); return; }
#endif
    Args a{};
    a.x = (const float*)d_in[0]; a.meta = (const float*)d_in[1]; a.g_mix = (const float*)d_in[2]; a.w_in = (const float*)d_in[3]; a.lb_raw = (const float*)d_in[4]; a.g_hn = (const float*)d_in[5];
    a.pool_w = (const float*)d_in[6]; a.pool_scale = (const float*)d_in[7]; a.w_a = (const float*)d_in[8]; a.w_b = (const float*)d_in[9]; a.w_out = (const float*)d_in[10]; a.g_ffn = (const float*)d_in[11];
    a.w_gate = (const float*)d_in[12]; a.w_up = (const float*)d_in[13]; a.w_down = (const float*)d_in[14]; a.g_fin = (const float*)d_in[15];
    a.out = (float*)d_out; a.ws = (unsigned char*)d_ws;
#if MK_COOP
    a.ph_lo = 0; a.ph_hi = NPH;
    void* args[] = {&a};
    const hipError_t e = hipLaunchCooperativeKernel((const void*)mega, dim3(grid), dim3(NTHR), args, LDS_BYTES, stream);
    if (e != hipSuccess) fprintf(stderr, "kernel_launch: cooperative launch failed: %s (grid %d)\n", hipGetErrorString(e), grid);
#else
#ifdef PROBE_STOP
    for (int ph = 0; ph <= PROBE_STOP; ++ph) { a.ph_lo = ph; a.ph_hi = ph + 1; hipLaunchKernelGGL(mega, dim3(grid), dim3(NTHR), LDS_BYTES, stream, a); }
    a.ph_lo = 10; a.ph_hi = 11; hipLaunchKernelGGL(mega, dim3(grid), dim3(NTHR), LDS_BYTES, stream, a);
    a.ph_lo = 11; a.ph_hi = 12; hipLaunchKernelGGL(mega, dim3(grid), dim3(NTHR), LDS_BYTES, stream, a);
#else
#ifdef PROBE_LIST
    { const int lst[] = PROBE_LIST; for (int i = 0; i < (int)(sizeof(lst) / sizeof(int)); ++i) { a.ph_lo = lst[i]; a.ph_hi = lst[i] + 1; hipLaunchKernelGGL(mega, dim3(grid), dim3(NTHR), LDS_BYTES, stream, a); } }
#else
    for (int ph = 0; ph < NPH; ++ph) { a.ph_lo = ph; a.ph_hi = ph + 1; hipLaunchKernelGGL(mega, dim3(grid), dim3(NTHR), LDS_BYTES, stream, a); }
#endif
#endif
#endif
}
```

```cpp
#include <hip/hip_runtime.h>
#include <hip/hip_cooperative_groups.h>
#include <cstdio>
#include <cstdint>
namespace cg = cooperative_groups;

#ifndef MK_COOP
#define MK_COOP 1
#endif

#define LAS __attribute__((address_space(3)))
typedef unsigned short u16;
typedef short bf16x8 __attribute__((ext_vector_type(8)));
typedef float f32x4 __attribute__((ext_vector_type(4)));
typedef unsigned u32x4 __attribute__((ext_vector_type(4)));
typedef unsigned u32x2 __attribute__((ext_vector_type(2)));

typedef __bf16 bf16v2_t __attribute__((ext_vector_type(2)));
typedef float f32v2_t __attribute__((ext_vector_type(2)));
__device__ __forceinline__ unsigned cvt_pk_bf16(float lo, float hi) { const f32v2_t f = {lo, hi}; const bf16v2_t v = __builtin_convertvector(f, bf16v2_t); return __builtin_bit_cast(unsigned, v); }
__device__ __forceinline__ float bf_lo(unsigned w) { return __uint_as_float(w << 16); }
__device__ __forceinline__ float bf_hi(unsigned w) { return __uint_as_float(w & 0xffff0000u); }
__device__ __forceinline__ float bf1(u16 w) { return __uint_as_float((unsigned)w << 16); }
__device__ __forceinline__ unsigned pk_h(float a, float b) { const _Float16 x = (_Float16)a, y = (_Float16)b; return (unsigned)__builtin_bit_cast(unsigned short, x) | ((unsigned)__builtin_bit_cast(unsigned short, y) << 16); }
__device__ __forceinline__ float h2f(u16 w) { return (float)__builtin_bit_cast(_Float16, w); }
__device__ __forceinline__ float sigm(float z) { return __builtin_amdgcn_rcpf(1.0f + __expf(-z)); }

namespace pg8 {
constexpr int BM = 256, BK = 64, HALF = 128, HTB = HALF * BK * 2, STAGE_BYTES = 8 * HTB, NXCD = 8, WGM = 8;
__host__ __device__ __forceinline__ int lds_byte(int r, int c) { const int st = (r >> 4) * 2 + (c >> 5), rr = r & 15, cc = c & 31, ob = rr * 64 + cc * 2; return st * 1024 + (ob ^ (((ob >> 9) & 1) << 5)); }
__host__ __device__ __forceinline__ void stage_rc(int b, int& R, int& C) { const int st = b / 1024, sb = b % 1024, swz = sb ^ (((sb >> 9) & 1) << 5); R = (st >> 1) * 16 + swz / 64; C = (st & 1) * 32 + (swz % 64) / 2; }
__host__ __device__ __forceinline__ int perm32(int rho) { const int n = rho >> 4, i = rho & 15; return 8 * (i >> 2) + 4 * n + (i & 3); }
struct Unit { int pm, pn; };
struct Gemm { const u16* A; const u16* Bt; int M, N, K, lda, ksplit; long a2delta; };
struct StaticOrder {
    int nM, nN, nwg, G, c;
    __host__ __device__ void init(int M, int N, int G_, int c_) { nM = M / BM; nN = N / BM; nwg = nM * nN; G = G_; c = c_; }
    __host__ __device__ bool next(int i, Unit& u) const {
        const long L = (long)i * G + c; if (L >= nwg) return false;
        int wgid = (int)L; { const int q = nwg / NXCD, r = nwg % NXCD, xcd = wgid % NXCD, off = wgid / NXCD; wgid = (xcd < r ? xcd * (q + 1) : r * (q + 1) + (xcd - r) * q) + off; }
        const int nig = WGM * nN, gid = wgid / nig, fm = gid * WGM, gsz = (nM - fm) < WGM ? (nM - fm) : WGM;
        u.pm = fm + ((wgid % nig) % gsz); u.pn = (wgid % nig) / gsz; return true;
    }
};
template <class Epi, bool ALIGN_EPI>
__device__ __forceinline__ void gemm_phase(LAS unsigned char* lds, const Gemm g, const StaticOrder& S, const Epi& E) {
    const int tid = threadIdx.x, wid = __builtin_amdgcn_readfirstlane(tid >> 6), lane = tid & 63, wr = wid >> 2, wc = wid & 3, fr = lane & 15, fq = lane >> 4;
    const int K = g.K, nt = K / BK, lda = g.lda;
    unsigned voffA[2], voffB[2];
#pragma unroll
    for (int i = 0; i < 2; ++i) { int R, C; stage_rc(tid * 16 + i * 8192, R, C); const int Rb = Epi::PERM ? ((R & ~31) + perm32(R & 31)) : R;
        voffA[i] = (unsigned)(R * lda + C) * 2u; voffB[i] = (unsigned)(Rb * K + C) * 2u; }
    const size_t kstep = (size_t)(BK * 2);
    const size_t hstepA = (size_t)HALF * lda * 2, tstepA = 2 * hstepA;
    const size_t hstepB = (size_t)HALF * K * 2, tstepB = 2 * hstepB;
    const unsigned ldsw = (unsigned)wid * 1024u;
    const int aoff = lds_byte(wr * 64 + fr, fq * 8), boff = lds_byte(wc * 32 + fr, fq * 8);
#define PG8_SA(b, h) (((b) * 2 + (h)) * HTB)
#define PG8_SB(b, h) ((4 + (b) * 2 + (h)) * HTB)
#define PG8_STAGE(bufoff, gbase, voff) do { _Pragma("unroll") for (int _i = 0; _i < 2; ++_i) \
        __builtin_amdgcn_global_load_lds((const unsigned*)((const char*)(gbase) + (voff)[_i]), (LAS unsigned*)(lds + (bufoff) + ldsw + _i * 8192), 16, 0, 0); } while (0)
#define PG8_LDA(dst, b, h) do { _Pragma("unroll") for (int m = 0; m < 4; ++m) _Pragma("unroll") for (int k = 0; k < 2; ++k) dst[m][k] = *(const LAS bf16x8*)(lds + PG8_SA(b, h) + aoff + m * 2048 + k * 1024); } while (0)
#define PG8_LDB(dst, b, h) do { _Pragma("unroll") for (int n = 0; n < 2; ++n) _Pragma("unroll") for (int k = 0; k < 2; ++k) dst[n][k] = *(const LAS bf16x8*)(lds + PG8_SB(b, h) + boff + n * 2048 + k * 1024); } while (0)
#define PG8_MMA(ai, bj, At, Bt) do { __builtin_amdgcn_s_setprio(1); _Pragma("unroll") for (int m = 0; m < 4; ++m) _Pragma("unroll") for (int n = 0; n < 2; ++n) _Pragma("unroll") for (int k = 0; k < 2; ++k) \
        acc[ai][bj][m][n] = __builtin_amdgcn_mfma_f32_16x16x32_bf16(Bt[n][k], At[m][k], acc[ai][bj][m][n], 0, 0, 0); __builtin_amdgcn_s_setprio(0); } while (0)
#define PG8_WAIT_V(n) asm volatile("s_waitcnt vmcnt(" #n ")" ::: "memory")
#define PG8_WAIT_L(n) asm volatile("s_waitcnt lgkmcnt(" #n ")" ::: "memory")
#define PG8_BAR __builtin_amdgcn_s_barrier()
#define PG8_SCHED __builtin_amdgcn_sched_barrier(0)
    Unit cur, nxt; int ui = 0;
    if (!S.next(0, cur)) return;
    f32x4 acc[2][2][4][2];
#pragma unroll
    for (int a = 0; a < 2; ++a)
#pragma unroll
        for (int b = 0; b < 2; ++b)
#pragma unroll
            for (int m = 0; m < 4; ++m)
#pragma unroll
                for (int n = 0; n < 2; ++n) acc[a][b][m][n] = (f32x4){0.f, 0.f, 0.f, 0.f};
    bf16x8 At[4][2], B0[2][2], B1[2][2];
    const char* cA = (const char*)g.A + (size_t)cur.pm * tstepA; const char* cB = (const char*)g.Bt + (size_t)cur.pn * tstepB;
    PG8_STAGE(PG8_SB(0, 0), cB, voffB); PG8_STAGE(PG8_SB(0, 1), cB + hstepB, voffB); PG8_STAGE(PG8_SA(0, 0), cA, voffA); PG8_STAGE(PG8_SA(0, 1), cA + hstepA, voffA);
    if (wr == 1) PG8_BAR;
    PG8_WAIT_V(2); PG8_BAR;
    PG8_STAGE(PG8_SB(1, 0), cB + kstep, voffB); PG8_STAGE(PG8_SA(1, 0), cA + kstep, voffA); PG8_STAGE(PG8_SB(1, 1), cB + hstepB + kstep, voffB);
    PG8_WAIT_V(6); PG8_BAR;
    for (;;) {
        const bool has_next = S.next(ui + 1, nxt);
        const char* nA = has_next ? (const char*)g.A + (size_t)nxt.pm * tstepA : cA; const char* nB = has_next ? (const char*)g.Bt + (size_t)nxt.pn * tstepB : cB;
        for (int t = 0; t < nt; t += 2) {
            const bool last = (t == nt - 2);
            if constexpr (Epi::MID) { if (t == g.ksplit) E.mid(acc, cur, wr, wc, fr, fq); }
            const char* a1 = cA + (size_t)(t + 1) * kstep + (t >= g.ksplit ? g.a2delta : 0L);
            const char* a2 = last ? nA : cA + (size_t)(t + 2) * kstep + (t + 2 >= g.ksplit ? g.a2delta : 0L);
            const char* b2 = last ? nB : cB + (size_t)(t + 2) * kstep;
            const char* a3 = a2 + kstep; const char* b3 = b2 + kstep;
            PG8_LDB(B0, 0, 0); PG8_LDB(B1, 0, 1); PG8_SCHED; PG8_LDA(At, 0, 0); PG8_STAGE(PG8_SA(1, 1), a1 + hstepA, voffA);
            PG8_WAIT_V(8); PG8_WAIT_L(0); PG8_BAR; PG8_MMA(0, 0, At, B0); PG8_MMA(0, 1, At, B1); PG8_BAR; PG8_SCHED;
            PG8_LDA(At, 0, 1); PG8_STAGE(PG8_SB(0, 0), b2, voffB); PG8_STAGE(PG8_SB(0, 1), b2 + hstepB, voffB); PG8_STAGE(PG8_SA(0, 0), a2, voffA);
            PG8_WAIT_V(8); PG8_WAIT_L(0); PG8_BAR; PG8_MMA(1, 0, At, B0); PG8_MMA(1, 1, At, B1); PG8_BAR; PG8_SCHED;
            PG8_LDB(B0, 1, 0); PG8_LDB(B1, 1, 1); PG8_SCHED; PG8_LDA(At, 1, 0); PG8_STAGE(PG8_SA(0, 1), a2 + hstepA, voffA);
            PG8_WAIT_V(8); PG8_WAIT_L(0); PG8_BAR; PG8_MMA(0, 0, At, B0); PG8_MMA(0, 1, At, B1); PG8_BAR; PG8_SCHED;
            PG8_LDA(At, 1, 1); PG8_STAGE(PG8_SB(1, 0), b3, voffB); PG8_STAGE(PG8_SB(1, 1), b3 + hstepB, voffB); PG8_STAGE(PG8_SA(1, 0), a3, voffA);
            PG8_WAIT_V(8); PG8_WAIT_L(0); PG8_BAR; PG8_MMA(1, 0, At, B0); PG8_MMA(1, 1, At, B1); PG8_BAR; PG8_SCHED;
        }
        if constexpr (ALIGN_EPI) { if (wr == 0) PG8_BAR; }
        if constexpr (!Epi::AFTER) E(acc, cur, wr, wc, fr, fq);
        if (!has_next) break;
#pragma unroll
        for (int a = 0; a < 2; ++a)
#pragma unroll
            for (int b = 0; b < 2; ++b)
#pragma unroll
                for (int m = 0; m < 4; ++m)
#pragma unroll
                    for (int n = 0; n < 2; ++n) acc[a][b][m][n] = (f32x4){0.f, 0.f, 0.f, 0.f};
        cur = nxt; cA = nA; cB = nB; ++ui;
        if constexpr (ALIGN_EPI) { if (wr == 1) PG8_BAR; }
    }
    PG8_WAIT_V(0);
    if constexpr (!ALIGN_EPI) { if (wr == 0) PG8_BAR; }
    PG8_BAR;
    if constexpr (Epi::AFTER) E.after(acc, cur, wr, wc, fr, fq, lds, wid, lane);
#undef PG8_SA
#undef PG8_SB
#undef PG8_STAGE
#undef PG8_LDA
#undef PG8_LDB
#undef PG8_MMA
#undef PG8_WAIT_V
#undef PG8_WAIT_L
#undef PG8_BAR
#undef PG8_SCHED
}
}

constexpr int NWAVES = 8, NTHR = 512;
constexpr int SEQ = 8192, BATCH = 2, DM = 1024, M = BATCH * SEQ, NMETA = 16, INW = 6656, DFF = 2816, NGU = 2 * DFF, CHK = 64, NCH = SEQ / CHK;
constexpr float EPS = 1e-6f;
constexpr size_t KiB = 1024, MiB = 1u << 20;
constexpr size_t WS_LB = 0, WS_GM = 64 * KiB, WS_VM = 128 * KiB, WS_PLM = 192 * KiB, WS_PWT = 256 * KiB, WS_UM = 512 * KiB, WS_DK = 1 * MiB, WS_RSQ = 2 * MiB;
constexpr size_t WS_WAB = 3 * MiB, WS_WOUT = 6 * MiB, WS_WD = 8 * MiB, WS_WIN = 14 * MiB, WS_WGU = 14 * MiB;
constexpr size_t WS_Q = 28 * MiB, WS_G = 60 * MiB, WS_V = 92 * MiB, WS_OG = 124 * MiB, WS_GA = 156 * MiB, WS_GB = 188 * MiB, WS_PB = 220 * MiB, WS_END = 252 * MiB;
constexpr size_t WS_MG = WS_G, WS_H1B = WS_GB, WS_ACT = WS_Q;
static_assert(WS_WD + (size_t)DM * DFF * 2 <= WS_WIN && WS_WIN + (size_t)INW * DM * 2 <= WS_Q && WS_WGU + (size_t)NGU * DM * 2 <= WS_Q && WS_ACT + (size_t)M * DFF * 2 <= WS_H1B, "ws map");
constexpr int LDS_BYTES = 163840;
constexpr size_t WS_BAR = 16 * KiB, WS_CNT = 32 * KiB, CTL_ZERO = 32 * KiB;

struct Args {
    const float *x, *meta, *g_mix, *w_in, *lb_raw, *g_hn, *pool_w, *pool_scale, *w_a, *w_b, *w_out, *g_ffn, *w_gate, *w_up, *w_down, *g_fin;
    float* out; unsigned char* ws; int ph_lo, ph_hi;
};

#define LDS_WAIT() asm volatile("s_waitcnt lgkmcnt(0)" ::: "memory")
__device__ __forceinline__ float wave_sum(float v) {
#pragma unroll
    for (int o = 1; o < 64; o <<= 1) v += __shfl_xor(v, o);
    return v;
}

__device__ __forceinline__ void tr_item(const float* W, int N, int k0, int n0, u16* WT, int drow0, int dpitch, int dk0, const float* ks, LAS float* scr, int lane) {
#pragma unroll
    for (int i = 0; i < 32; ++i) { const int kk = 2 * i + (lane >> 5); float w = W[(size_t)(k0 + kk) * N + n0 + (lane & 31)]; if (ks) w *= ks[k0 + kk]; scr[kk * 33 + (lane & 31)] = w; }
    LDS_WAIT(); asm volatile("" ::: "memory");
    const int c = lane & 7;
#pragma unroll
    for (int j = 0; j < 4; ++j) { const int n = (lane >> 3) + 8 * j; const LAS float* s = scr + (8 * c) * 33 + n;
        u32x4 o; o.x = cvt_pk_bf16(s[0 * 33], s[1 * 33]); o.y = cvt_pk_bf16(s[2 * 33], s[3 * 33]); o.z = cvt_pk_bf16(s[4 * 33], s[5 * 33]); o.w = cvt_pk_bf16(s[6 * 33], s[7 * 33]);
        *(u32x4*)(WT + (size_t)(drow0 + n) * dpitch + dk0 + k0 + 8 * c) = o; }
    LDS_WAIT(); asm volatile("" ::: "memory");
}
__device__ __forceinline__ void rms_row_bf16(const float* xrow, const float* g, u16* orow, int lane) {
    const f32x4* xr = (const f32x4*)xrow + lane; const f32x4* gr = (const f32x4*)g + lane;
    f32x4 v[4]; float s = 0.f;
#pragma unroll
    for (int j = 0; j < 4; ++j) { v[j] = xr[64 * j]; s += (v[j].x * v[j].x + v[j].y * v[j].y) + (v[j].z * v[j].z + v[j].w * v[j].w); }
    const float rstd = rsqrtf(wave_sum(s) * (1.f / DM) + EPS);
    u32x2* o8 = (u32x2*)orow + lane;
#pragma unroll
    for (int j = 0; j < 4; ++j) { const f32x4 gv = gr[64 * j]; u32x2 o; o.x = cvt_pk_bf16(v[j].x * rstd * gv.x, v[j].y * rstd * gv.y); o.y = cvt_pk_bf16(v[j].z * rstd * gv.z, v[j].w * rstd * gv.w); o8[64 * j] = o; }
}

__device__ __forceinline__ void p0_meta(const Args& a, LAS unsigned char* lds, int j, int tid, int wave, int lane) {
    LAS float* nm = (LAS float*)lds;
    LAS float* part = (LAS float*)(lds + 65536);
#pragma unroll
    for (int rr = 0; rr < 2; ++rr) { const int r = 2 * wave + rr; const f32x4* xr = (const f32x4*)(a.meta + (size_t)r * DM) + lane; const f32x4* gr = (const f32x4*)a.g_mix + lane;
        f32x4 v[4]; float s = 0.f;
#pragma unroll
        for (int q = 0; q < 4; ++q) { v[q] = xr[64 * q]; s += (v[q].x * v[q].x + v[q].y * v[q].y) + (v[q].z * v[q].z + v[q].w * v[q].w); }
        const float rstd = rsqrtf(wave_sum(s) * (1.f / DM) + EPS);
#pragma unroll
        for (int q = 0; q < 4; ++q) { const f32x4 gv = gr[64 * q]; *(LAS f32x4*)(nm + r * 1024 + 4 * (lane + 64 * q)) = (f32x4){v[q].x * rstd * gv.x, v[q].y * rstd * gv.y, v[q].z * rstd * gv.z, v[q].w * rstd * gv.w}; }
    }
    __syncthreads();
    const int colbase = j < 16 ? 1024 + 64 * j : (j < 32 ? 2048 + 64 * (j - 16) : 4096 + 64 * (j - 32));
    {
        const int col = colbase + lane; float acc[16];
#pragma unroll
        for (int r = 0; r < 16; ++r) acc[r] = 0.f;
#pragma unroll 4
        for (int k = 128 * wave; k < 128 * wave + 128; k += 4) {
            const float w0 = a.w_in[(size_t)(k + 0) * INW + col], w1 = a.w_in[(size_t)(k + 1) * INW + col], w2 = a.w_in[(size_t)(k + 2) * INW + col], w3 = a.w_in[(size_t)(k + 3) * INW + col];
#pragma unroll
            for (int r = 0; r < 16; ++r) { const f32x4 n4 = *(const LAS f32x4*)(nm + r * 1024 + k); acc[r] += (n4.x * w0 + n4.y * w1) + (n4.z * w2 + n4.w * w3); }
        }
#pragma unroll
        for (int r = 0; r < 16; ++r) part[(wave * 16 + r) * 64 + lane] = acc[r];
    }
    __syncthreads();
#pragma unroll
    for (int o = 0; o < 2; ++o) {
        const int idx = tid + o * NTHR, r = idx >> 6, cl = idx & 63; float z = 0.f;
#pragma unroll
        for (int w = 0; w < 8; ++w) z += part[(w * 16 + r) * 64 + cl];
        const int col = colbase + cl;
        if (col < 2048) { const int c = col - 1024; const float lb = 1.0f / (1.0f + __expf(a.lb_raw[1024 + c] - a.lb_raw[c])); const float f = lb + (1.0f - lb) * sigm(z);
            const _Float16 hv = (_Float16)__logf(f); ((u16*)(a.ws + WS_GM))[r * 1024 + c] = __builtin_bit_cast(unsigned short, hv); }
        else if (col < 3072) { ((u16*)(a.ws + WS_VM))[r * 1024 + (col - 2048)] = (u16)(cvt_pk_bf16(z, 0.f) & 0xffffu); }
        else { ((u16*)(a.ws + WS_PLM))[r * 512 + (col - 4096)] = (u16)(cvt_pk_bf16(z, 0.f) & 0xffffu); }
    }
    __syncthreads();
}

__device__ __forceinline__ void late_weights(const Args& a, LAS unsigned char* lds, int gw, int NGW) {
    const int lane = threadIdx.x & 63, wave = __builtin_amdgcn_readfirstlane(threadIdx.x >> 6);
    LAS float* scr = (LAS float*)(lds + wave * 16384);
    constexpr int I_A = 16 * 32, I_B = 8 * 32, I_O = 16 * 32, I_D = 44 * 32, I_P = 32;
    constexpr int NIT = I_A + I_B + I_O + I_D + I_P;
    for (int it = gw; it < NIT; it += NGW) {
        int r = it;
        if (r < I_A) { tr_item(a.w_a, 1024, 64 * (r / 32), 32 * (r % 32), (u16*)(a.ws + WS_WAB), 32 * (r % 32), 1536, 0, nullptr, scr, lane); continue; } r -= I_A;
        if (r < I_B) { tr_item(a.w_b, 1024, 64 * (r / 32), 32 * (r % 32), (u16*)(a.ws + WS_WAB), 32 * (r % 32), 1536, 1024, nullptr, scr, lane); continue; } r -= I_B;
        if (r < I_O) { tr_item(a.w_out, 1024, 64 * (r / 32), 32 * (r % 32), (u16*)(a.ws + WS_WOUT), 32 * (r % 32), 1024, 0, nullptr, scr, lane); continue; } r -= I_O;
        if (r < I_D) { tr_item(a.w_down, 1024, 64 * (r / 32), 32 * (r % 32), (u16*)(a.ws + WS_WD), 32 * (r % 32), DFF, 0, nullptr, scr, lane); continue; } r -= I_D;
        { const int gi = r >> 3, q = r & 7; tr_item(a.pool_w + (size_t)gi * 16384, 128, 64 * (q >> 2), 32 * (q & 3), (u16*)(a.ws + WS_PWT) + (size_t)gi * 16384, 32 * (q & 3), 128, 0, nullptr, scr, lane); }
    }
}

__device__ __forceinline__ void p0_prologue(const Args& a, LAS unsigned char* lds, int G, int skip = 0) {
    const int tid = threadIdx.x, lane = tid & 63, wave = __builtin_amdgcn_readfirstlane(tid >> 6);
    const bool split = G > 80;
    if ((int)blockIdx.x < 40) { if (!(skip & 4)) p0_meta(a, lds, (int)blockIdx.x, tid, wave, lane); if (split) return; }
    if (blockIdx.x == 40 || (G <= 40 && blockIdx.x == 0)) { for (int c = tid; c < 1024; c += NTHR) ((float*)(a.ws + WS_LB))[c] = 1.0f / (1.0f + __expf(a.lb_raw[1024 + c] - a.lb_raw[c])); }
    LAS float* scr = (LAS float*)(lds + wave * 16384);
    const int gw = ((int)blockIdx.x - (split ? 40 : 0)) * NWAVES + wave, NGW = (G - (split ? 40 : 0)) * NWAVES;
    constexpr int I_IN = 16 * 208;
    for (int it = gw; it < I_IN && !(skip & 1); it += NGW) tr_item(a.w_in, INW, 64 * (it / 208), 32 * (it % 208), (u16*)(a.ws + WS_WIN), 32 * (it % 208), 1024, 0, nullptr, scr, lane);
    if (G != 256) late_weights(a, lds, gw, NGW);
    u16* XN = (u16*)a.out;
    {
        const f32x4* gr = (const f32x4*)a.g_mix + lane; f32x4 gv[4];
#pragma unroll
        for (int j = 0; j < 4; ++j) gv[j] = gr[64 * j];
        for (int m = 4 * gw; m < M && !(skip & 2); m += 4 * NGW) {
            const f32x4* xr = (const f32x4*)(a.x + (size_t)m * DM) + lane; f32x4 v[16]; float ss[4];
#pragma unroll
            for (int j = 0; j < 16; ++j) v[j] = xr[64 * j];
#pragma unroll
            for (int rr = 0; rr < 4; ++rr) { float t = 0.f;
#pragma unroll
                for (int j = 0; j < 4; ++j) { const f32x4 w = v[4 * rr + j]; t += (w.x * w.x + w.y * w.y) + (w.z * w.z + w.w * w.w); }
                ss[rr] = t; }
#pragma unroll
            for (int o = 1; o < 64; o <<= 1) {
#pragma unroll
                for (int rr = 0; rr < 4; ++rr) ss[rr] += __shfl_xor(ss[rr], o); }
            u32x2* o8 = (u32x2*)(XN + (size_t)m * DM) + lane;
#pragma unroll
            for (int j = 0; j < 16; ++j) { const float rs = rsqrtf(ss[j >> 2] * (1.f / DM) + EPS); const f32x4 g4 = gv[j & 3]; u32x2 o; o.x = cvt_pk_bf16(v[j].x * rs * g4.x, v[j].y * rs * g4.y); o.y = cvt_pk_bf16(v[j].z * rs * g4.z, v[j].w * rs * g4.w); o8[64 * j] = o; }
        }
    }
}

struct EpiIn {
    static constexpr bool PERM = true, MID = false, AFTER = false;
    unsigned char* ws;
    __device__ __forceinline__ void mid(f32x4 (&)[2][2][4][2], const pg8::Unit&, int, int, int, int) const {}
    __device__ __forceinline__ void operator()(f32x4 (&acc)[2][2][4][2], const pg8::Unit& u, int wr, int wc, int fr, int fq) const {
        const int colt = u.pn * 256; int type, c0; size_t boff;
        if (colt < 1024) { type = 1; boff = WS_Q; c0 = colt; }
        else if (colt < 2048) { type = 3; boff = WS_G; c0 = colt - 1024; }
        else if (colt < 3072) { type = 0; boff = WS_V; c0 = colt - 2048; }
        else if (colt < 4096) { type = 1; boff = WS_OG; c0 = colt - 3072; }
        else if (colt < 4608) { type = 0; boff = WS_PB; c0 = colt - 4096 + 512; }
        else if (colt < 5632) { type = 2; boff = WS_GA; c0 = colt - 4608; }
        else { type = 2; boff = WS_GB; c0 = colt - 5632; }
        u16* base = (u16*)(ws + boff);
        const int col0 = c0 + wc * 32 + 8 * fq, row0 = u.pm * 256 + wr * 64 + fr;
        const float* LB = (const float*)(ws + WS_LB);
        f32x4 lbv[2][2];
        if (type == 3) {
#pragma unroll
            for (int bj = 0; bj < 2; ++bj) { lbv[bj][0] = *(const f32x4*)(LB + col0 + bj * 128); lbv[bj][1] = *(const f32x4*)(LB + col0 + bj * 128 + 4); }
        } else {
#pragma unroll
            for (int bj = 0; bj < 2; ++bj) { lbv[bj][0] = (f32x4){0.f, 0.f, 0.f, 0.f}; lbv[bj][1] = (f32x4){0.f, 0.f, 0.f, 0.f}; }
        }
#pragma unroll
        for (int ai = 0; ai < 2; ++ai)
#pragma unroll
            for (int m = 0; m < 4; ++m) { u16* rowp = base + (size_t)(row0 + ai * 128 + m * 16) * 1024 + col0;
#pragma unroll
                for (int bj = 0; bj < 2; ++bj) { f32x4 v0 = acc[ai][bj][m][0], v1 = acc[ai][bj][m][1]; u32x4 w;
                    if (type == 3) {
                        const f32x4 l0 = lbv[bj][0], l1 = lbv[bj][1];
#pragma unroll
                        for (int e = 0; e < 4; ++e) { v0[e] = __logf(l0[e] + (1.0f - l0[e]) * sigm(v0[e])); v1[e] = __logf(l1[e] + (1.0f - l1[e]) * sigm(v1[e])); }
                        w.x = pk_h(v0[0], v0[1]); w.y = pk_h(v0[2], v0[3]); w.z = pk_h(v1[0], v1[1]); w.w = pk_h(v1[2], v1[3]);
                    } else {
                        if (type == 1) {
#pragma unroll
                            for (int e = 0; e < 4; ++e) { v0[e] = v0[e] * sigm(v0[e]); v1[e] = v1[e] * sigm(v1[e]); }
                        } else if (type == 2) {
#pragma unroll
                            for (int e = 0; e < 4; ++e) { v0[e] = sigm(v0[e]); v1[e] = sigm(v1[e]); }
                        }
                        w.x = cvt_pk_bf16(v0[0], v0[1]); w.y = cvt_pk_bf16(v0[2], v0[3]); w.z = cvt_pk_bf16(v1[0], v1[1]); w.w = cvt_pk_bf16(v1[2], v1[3]);
                    }
                    *(u32x4*)(rowp + bj * 128) = w; } }
    }
};
struct EpiMerge {
    static constexpr bool PERM = true, MID = true, AFTER = false;
    const u16 *GA, *GB; u16* MG;
    __device__ __forceinline__ void mid(f32x4 (&acc)[2][2][4][2], const pg8::Unit& u, int wr, int wc, int fr, int fq) const {
        int zz = 0; asm volatile("" : "+v"(zz));
        const int col0 = u.pn * 256 + wc * 32 + 8 * fq, row0 = u.pm * 256 + wr * 64 + fr + zz;
#pragma unroll
        for (int ai = 0; ai < 2; ++ai)
#pragma unroll
            for (int m = 0; m < 4; ++m) { const size_t off = (size_t)(row0 + ai * 128 + m * 16) * 1024 + col0;
#pragma unroll
                for (int bj = 0; bj < 2; ++bj) { const u32x4 ga = *(const u32x4*)(GA + off + bj * 128), gb = *(const u32x4*)(GB + off + bj * 128);
#pragma unroll
                    for (int e = 0; e < 2; ++e) { acc[ai][bj][m][0][2 * e] *= bf_lo(ga[e]) * __builtin_amdgcn_rcpf(bf_lo(gb[e])); acc[ai][bj][m][0][2 * e + 1] *= bf_hi(ga[e]) * __builtin_amdgcn_rcpf(bf_hi(gb[e]));
                        acc[ai][bj][m][1][2 * e] *= bf_lo(ga[2 + e]) * __builtin_amdgcn_rcpf(bf_lo(gb[2 + e])); acc[ai][bj][m][1][2 * e + 1] *= bf_hi(ga[2 + e]) * __builtin_amdgcn_rcpf(bf_hi(gb[2 + e])); } }
                asm volatile("" ::: "memory"); }
    }
    __device__ __forceinline__ void operator()(f32x4 (&acc)[2][2][4][2], const pg8::Unit& u, int wr, int wc, int fr, int fq) const {
        const int col0 = u.pn * 256 + wc * 32 + 8 * fq, row0 = u.pm * 256 + wr * 64 + fr;
#pragma unroll
        for (int ai = 0; ai < 2; ++ai)
#pragma unroll
            for (int m = 0; m < 4; ++m) { const size_t off = (size_t)(row0 + ai * 128 + m * 16) * 1024 + col0;
#pragma unroll
                for (int bj = 0; bj < 2; ++bj) { const u32x4 gb = *(const u32x4*)(GB + off + bj * 128);
                    acc[ai][bj][m][0] *= (f32x4){bf_lo(gb[0]), bf_hi(gb[0]), bf_lo(gb[1]), bf_hi(gb[1])}; acc[ai][bj][m][1] *= (f32x4){bf_lo(gb[2]), bf_hi(gb[2]), bf_lo(gb[3]), bf_hi(gb[3])}; } }
#pragma unroll
        for (int ai = 0; ai < 2; ++ai)
#pragma unroll
            for (int m = 0; m < 4; ++m) { const size_t off = (size_t)(row0 + ai * 128 + m * 16) * 1024 + col0;
#pragma unroll
                for (int bj = 0; bj < 2; ++bj) { const f32x4 v0 = acc[ai][bj][m][0], v1 = acc[ai][bj][m][1]; u32x4 w;
                    w.x = cvt_pk_bf16(v0[0], v0[1]); w.y = cvt_pk_bf16(v0[2], v0[3]); w.z = cvt_pk_bf16(v1[0], v1[1]); w.w = cvt_pk_bf16(v1[2], v1[3]);
                    *(u32x4*)(MG + off + bj * 128) = w; } }
    }
};
template <bool WITH_BF16>
struct EpiRes {
    static constexpr bool PERM = false, MID = false, AFTER = false;
    const float* base; float* H; u16* Hb; float* rsq;
    __device__ __forceinline__ void mid(f32x4 (&)[2][2][4][2], const pg8::Unit&, int, int, int, int) const {}
    __device__ __forceinline__ void operator()(f32x4 (&acc)[2][2][4][2], const pg8::Unit& u, int wr, int wc, int fr, int fq) const {
        const int col0 = u.pn * 256 + wc * 32 + 4 * fq, row0 = u.pm * 256 + wr * 64 + fr;
#pragma unroll
        for (int ai = 0; ai < 2; ++ai) {
            f32x4 pre[4][2][2];
#pragma unroll
            for (int m = 0; m < 4; ++m) { const size_t off = (size_t)(row0 + ai * 128 + m * 16) * 1024 + col0;
#pragma unroll
                for (int bj = 0; bj < 2; ++bj)
#pragma unroll
                    for (int n = 0; n < 2; ++n) pre[m][bj][n] = *(const f32x4*)(base + off + bj * 128 + n * 16); }
            asm volatile("" ::: "memory");
#pragma unroll
            for (int m = 0; m < 4; ++m) { const int row = row0 + ai * 128 + m * 16; const size_t off = (size_t)row * 1024 + col0; float s = 0.f;
#pragma unroll
                for (int bj = 0; bj < 2; ++bj)
#pragma unroll
                    for (int n = 0; n < 2; ++n) { const f32x4 hv = pre[m][bj][n] + acc[ai][bj][m][n];
                        *(f32x4*)(H + off + bj * 128 + n * 16) = hv; s += (hv[0] * hv[0] + hv[1] * hv[1]) + (hv[2] * hv[2] + hv[3] * hv[3]);
                        if (WITH_BF16) { u32x2 w; w.x = cvt_pk_bf16(hv[0], hv[1]); w.y = cvt_pk_bf16(hv[2], hv[3]); *(u32x2*)(Hb + off + bj * 128 + n * 16) = w; } }
                s += __shfl_xor(s, 16); s += __shfl_xor(s, 32);
                if (fq == 0) rsq[(size_t)row * 16 + u.pn * 4 + wc] = s; }
            asm volatile("" ::: "memory");
        }
    }
};
struct EpiFfn1 {
    static constexpr bool PERM = true, MID = false, AFTER = false;
    const float* rsq; u16* ACT;
    __device__ __forceinline__ void mid(f32x4 (&)[2][2][4][2], const pg8::Unit&, int, int, int, int) const {}
    __device__ __forceinline__ void operator()(const f32x4 (&acc)[2][2][4][2], const pg8::Unit& u, int wr, int wc, int fr, int fq) const {
        const int col0 = u.pn * 128 + wc * 32 + 8 * fq, row0 = u.pm * 256 + wr * 64 + fr;
        float rstdv[2][4];
#pragma unroll
        for (int ai = 0; ai < 2; ++ai)
#pragma unroll
            for (int m = 0; m < 4; ++m) { const int row = row0 + ai * 128 + m * 16; const f32x4* rp = (const f32x4*)(rsq + (size_t)row * 16);
                const f32x4 r0 = rp[0], r1 = rp[1], r2 = rp[2], r3 = rp[3];
                const float ss = ((r0[0] + r0[1]) + (r0[2] + r0[3])) + ((r1[0] + r1[1]) + (r1[2] + r1[3])) + ((r2[0] + r2[1]) + (r2[2] + r2[3])) + ((r3[0] + r3[1]) + (r3[2] + r3[3]));
                rstdv[ai][m] = rsqrtf(ss * (1.f / DM) + EPS); }
#pragma unroll
        for (int ai = 0; ai < 2; ++ai)
#pragma unroll
            for (int m = 0; m < 4; ++m) { const int row = row0 + ai * 128 + m * 16;
                const float rstd = rstdv[ai][m];
                float o[8];
#pragma unroll
                for (int n = 0; n < 2; ++n)
#pragma unroll
                    for (int e = 0; e < 4; ++e) { const float gt = acc[ai][0][m][n][e] * rstd, up = acc[ai][1][m][n][e] * rstd; o[4 * n + e] = gt * sigm(gt) * up; }
                u32x4 w; w.x = cvt_pk_bf16(o[0], o[1]); w.y = cvt_pk_bf16(o[2], o[3]); w.z = cvt_pk_bf16(o[4], o[5]); w.w = cvt_pk_bf16(o[6], o[7]);
                *(u32x4*)(ACT + (size_t)row * DFF + col0) = w; }
    }
};

struct EpiResNorm {
    static constexpr bool PERM = false, MID = false, AFTER = true;
    const float* base; float* out; const float* gfin; float* slots; unsigned* cnt;
    __device__ __forceinline__ void mid(f32x4 (&)[2][2][4][2], const pg8::Unit&, int, int, int, int) const {}
    __device__ __forceinline__ void operator()(const f32x4 (&)[2][2][4][2], const pg8::Unit&, int, int, int, int) const {}
    __device__ __forceinline__ void after(f32x4 (&acc)[2][2][4][2], const pg8::Unit& u, int wr, int wc, int fr, int fq, LAS unsigned char* lds, int wid, int lane) const {
        LAS float* P = (LAS float*)lds; LAS float* R = (LAS float*)(lds + 4096);
        const int col0 = u.pn * 256 + wc * 32 + 4 * fq;
#pragma unroll
        for (int ai = 0; ai < 2; ++ai)
#pragma unroll
            for (int m = 0; m < 4; ++m) { const int rl = ai * 128 + wr * 64 + m * 16 + fr; const size_t off = (size_t)(u.pm * 256 + rl) * 1024 + col0; float s = 0.f;
#pragma unroll
                for (int bj = 0; bj < 2; ++bj)
#pragma unroll
                    for (int n = 0; n < 2; ++n) { const f32x4 hv = *(const f32x4*)(base + off + bj * 128 + n * 16) + acc[ai][bj][m][n]; acc[ai][bj][m][n] = hv; s += (hv[0] * hv[0] + hv[1] * hv[1]) + (hv[2] * hv[2] + hv[3] * hv[3]); }
                s += __shfl_xor(s, 16); s += __shfl_xor(s, 32);
                if (fq == 0) P[rl * 4 + wc] = s;
                if (m & 1) asm volatile("" ::: "memory"); }
        asm volatile("s_waitcnt lgkmcnt(0)" ::: "memory"); __builtin_amdgcn_s_barrier(); asm volatile("" ::: "memory");
        const int row = wid * 32 + (lane & 31);
        unsigned* slot = (unsigned*)slots + (size_t)(u.pm * 256 + row) * 16;
        if (lane < 32) { const float t = (P[row * 4 + 0] + P[row * 4 + 1]) + (P[row * 4 + 2] + P[row * 4 + 3]);
            __hip_atomic_store(slot + u.pn, __float_as_uint(t), __ATOMIC_RELAXED, __HIP_MEMORY_SCOPE_AGENT); }
        asm volatile("s_waitcnt vmcnt(0)" ::: "memory");
        if (lane == 0) __hip_atomic_fetch_add(cnt + 64 * u.pm, 1u, __ATOMIC_RELAXED, __HIP_MEMORY_SCOPE_AGENT);
        if (wid == 0) { unsigned sp = 0;
            while ((unsigned)__builtin_amdgcn_readfirstlane(__hip_atomic_load(cnt + 64 * u.pm, __ATOMIC_RELAXED, __HIP_MEMORY_SCOPE_AGENT)) < 32u) { __builtin_amdgcn_s_sleep(2); if (++sp > (1u << 20)) break; }
            __builtin_amdgcn_fence(__ATOMIC_ACQUIRE, "agent"); }
        asm volatile("s_waitcnt vmcnt(0) lgkmcnt(0)" ::: "memory"); __builtin_amdgcn_s_barrier(); asm volatile("" ::: "memory");
        if (lane < 32) { float t = 0.f;
#pragma unroll
            for (int k = 0; k < 4; ++k) t += __uint_as_float(__hip_atomic_load(slot + k, __ATOMIC_RELAXED, __HIP_MEMORY_SCOPE_AGENT));
            R[row] = rsqrtf(t * (1.f / DM) + EPS); }
        asm volatile("s_waitcnt lgkmcnt(0)" ::: "memory"); __builtin_amdgcn_s_barrier(); asm volatile("" ::: "memory");
        f32x4 gv[2][2];
#pragma unroll
        for (int bj = 0; bj < 2; ++bj)
#pragma unroll
            for (int n = 0; n < 2; ++n) gv[bj][n] = *(const f32x4*)(gfin + col0 + bj * 128 + n * 16);
#pragma unroll
        for (int ai = 0; ai < 2; ++ai)
#pragma unroll
            for (int m = 0; m < 4; ++m) { const int rl = ai * 128 + wr * 64 + m * 16 + fr; const size_t off = (size_t)(u.pm * 256 + rl) * 1024 + col0; const float rs = R[rl];
#pragma unroll
                for (int bj = 0; bj < 2; ++bj)
#pragma unroll
                    for (int n = 0; n < 2; ++n) *(f32x4*)(out + off + bj * 128 + n * 16) = acc[ai][bj][m][n] * rs * gv[bj][n]; }
    }
};
#define RLX_AGENT __ATOMIC_RELAXED, __HIP_MEMORY_SCOPE_AGENT
#define XB_TMO      128
#define XB_XCNT(j)  (256  + 64 * (j))
#define XB_XSUB(j)  (1280 + 64 * (j))
#define XB_XGEN(j)  (2304 + 64 * (j))
#define XB_TOP      3328
#define XB_TOPGEN   3392
#define XCD_BAR_WORDS 3456
#define XB_SPIN_CAP (1u << 18)

__device__ __forceinline__ unsigned xb_ld(unsigned* p)              { return __hip_atomic_load(p, __ATOMIC_RELAXED, __HIP_MEMORY_SCOPE_AGENT); }
__device__ __forceinline__ unsigned xb_add(unsigned* p, unsigned v) { return __hip_atomic_fetch_add(p, v, __ATOMIC_RELAXED, __HIP_MEMORY_SCOPE_AGENT); }
__device__ __forceinline__ unsigned xb_xcc_id() { return (unsigned)__builtin_amdgcn_s_getreg((3 << 11) | 20) & 0xFu; }
#define XB_SPIN(cond, bar) do { unsigned _sp = 0; while (cond) { __builtin_amdgcn_s_sleep(1); \
    if ((++_sp & 255u) == 0u) { if (xb_ld(&(bar)[XB_TMO])) break; if (_sp > XB_SPIN_CAP) { atomicAdd(&(bar)[XB_TMO], 1u); break; } } } } while (0)

struct XcdBarrier {
    unsigned* bar; unsigned x;
    volatile LAS unsigned* st;
};

__device__ __forceinline__ XcdBarrier xcd_barrier_post(unsigned* bar, volatile LAS unsigned* st) {
    XcdBarrier b; b.bar = bar; b.x = xb_xcc_id(); b.st = st;
    if (threadIdx.x == 0) (void)xb_add(&bar[XB_XCNT(b.x)], 1u);
    return b;
}
__device__ __forceinline__ void xcd_barrier_complete(unsigned* bar, unsigned x, unsigned& nloc, unsigned& nx) {
    const unsigned G = gridDim.x * gridDim.y * gridDim.z;
    unsigned sum, cnt, mine, sp = 0u;
    for (;;) {
        sum = 0u; cnt = 0u; mine = 0u;
#pragma unroll
        for (unsigned j = 0; j < 16; ++j) { const unsigned c = xb_ld(&bar[XB_XCNT(j)]); sum += c; cnt += (c > 0u) ? 1u : 0u; mine = (j == x) ? c : mine; }
        if (sum == G) break;
        __builtin_amdgcn_s_sleep(1);
        if ((++sp & 255u) == 0u) { if (xb_ld(&bar[XB_TMO])) break; if (sp > XB_SPIN_CAP) { atomicAdd(&bar[XB_TMO], 1u); break; } }
    }
    nloc = mine > 0u ? mine : 1u; nx = cnt > 0u ? cnt : 1u;
}

__device__ __forceinline__ void xcd_barrier(const XcdBarrier& b) {
    asm volatile("s_waitcnt vmcnt(0)" ::: "memory");
    __syncthreads();
    if (threadIdx.x == 0) {
        unsigned* bar = b.bar;
        __builtin_amdgcn_s_waitcnt(0);
        unsigned nloc = b.st[0], nx = b.st[1];
        if (nloc == 0u) { xcd_barrier_complete(bar, b.x, nloc, nx); b.st[0] = nloc; b.st[1] = nx; }
        const unsigned old = xb_add(&bar[XB_XSUB(b.x)], 1u);
        const unsigned gen = old / nloc;
        if (old + 1u == (gen + 1u) * nloc) {
            __builtin_amdgcn_fence(__ATOMIC_RELEASE, "agent");
            asm volatile("s_waitcnt vmcnt(0)" ::: "memory");
            const unsigned og = xb_add(&bar[XB_TOP], 1u);
            const unsigned tg = og / nx;
            if (og + 1u == (tg + 1u) * nx) xb_add(&bar[XB_TOPGEN], 1u);
            else XB_SPIN(xb_ld(&bar[XB_TOPGEN]) == tg, bar);
            __builtin_amdgcn_fence(__ATOMIC_ACQUIRE, "agent");
            xb_add(&bar[XB_XGEN(b.x)], 1u);
            asm volatile("s_waitcnt vmcnt(0)" ::: "memory");
        } else {
            XB_SPIN(xb_ld(&bar[XB_XGEN(b.x)]) == gen, bar);
            __builtin_amdgcn_fence(__ATOMIC_ACQUIRE, "agent");
            asm volatile("s_waitcnt vmcnt(0)" ::: "memory");
        }
    }
    __syncthreads();
}

__device__ __forceinline__ void p2_wave(const u16* Gp, const u16* Vp, int nrows, int h, u16* Uout, float* dk, int lane) {
    const int r = lane & 15, q = lane >> 4;
    bf16x8 kf[8][2]; float tot1[8];
#pragma unroll
    for (int kk = 0; kk < 2; ++kk) { const int ks = 1 - kk;
#pragma unroll
        for (int dg = 0; dg < 2; ++dg) {
            int zz = 0; asm volatile("" : "+v"(zz));
            u32x4 wq[4];
#pragma unroll
            for (int p2 = 0; p2 < 2; ++p2) { const int dp = 2 * dg + p2; const int dcol = 32 * dp + 2 * r + zz; unsigned gw[8];
#pragma unroll
                for (int j = 0; j < 8; ++j) { const int s = 32 * ks + 8 * q + j; gw[j] = s < nrows ? *(const unsigned*)(Gp + (size_t)s * 1024 + h * 128 + dcol) : 0u; }
#pragma unroll
                for (int par = 0; par < 2; ++par) { const int dt = 2 * dp + par; float gv[8];
#pragma unroll
                    for (int j = 0; j < 8; ++j) gv[j] = h2f((u16)(par ? (gw[j] >> 16) : (gw[j] & 0xffffu)));
                    float suf[8]; float run = 0.f;
#pragma unroll
                    for (int j = 7; j >= 0; --j) { suf[j] = run; run += gv[j]; }
                    const float T = run, ta = __shfl_xor(T, 16), tb = __shfl_xor(T, 32), tc = __shfl_xor(ta, 32);
                    const float after = ((q ^ 1) > q ? ta : 0.f) + ((q ^ 2) > q ? tb : 0.f) + ((q ^ 3) > q ? tc : 0.f);
                    const float tot = (T + ta) + (tb + tc);
                    float base;
                    if (ks == 1) { tot1[dt] = tot; base = after; } else { base = after + tot1[dt]; if (dk && q == 0) dk[h * 128 + dcol + par] = __expf(tot + tot1[dt]); }
                    float kh[8];
#pragma unroll
                    for (int j = 0; j < 8; ++j) kh[j] = (1.0f - __expf(gv[j])) * __expf(suf[j] + base);
                    u32x4& w = wq[2 * p2 + par];
                    w.x = cvt_pk_bf16(kh[0], kh[1]); w.y = cvt_pk_bf16(kh[2], kh[3]); w.z = cvt_pk_bf16(kh[4], kh[5]); w.w = cvt_pk_bf16(kh[6], kh[7]); } }
            asm volatile("" : "+v"(wq[0].x), "+v"(wq[0].y), "+v"(wq[0].z), "+v"(wq[0].w), "+v"(wq[1].x), "+v"(wq[1].y), "+v"(wq[1].z), "+v"(wq[1].w),
                              "+v"(wq[2].x), "+v"(wq[2].y), "+v"(wq[2].z), "+v"(wq[2].w), "+v"(wq[3].x), "+v"(wq[3].y), "+v"(wq[3].z), "+v"(wq[3].w));
#pragma unroll
            for (int d4 = 0; d4 < 4; ++d4) kf[4 * dg + d4][ks] = __builtin_bit_cast(bf16x8, wq[d4]); } }
#pragma unroll 1
    for (int ep = 0; ep < 4; ++ep) {
        int zz = 0; asm volatile("" : "+v"(zz)); const int ecol = 32 * ep + 2 * r + zz;
        unsigned vw[2][8];
#pragma unroll
        for (int ks = 0; ks < 2; ++ks)
#pragma unroll
            for (int j = 0; j < 8; ++j) { const int s = 32 * ks + 8 * q + j; vw[ks][j] = s < nrows ? *(const unsigned*)(Vp + (size_t)s * 1024 + h * 128 + ecol) : 0u; }
#pragma unroll
        for (int par = 0; par < 2; ++par) {
            bf16x8 vf[2];
#pragma unroll
            for (int ks = 0; ks < 2; ++ks) { u32x4 w;
                if (par == 0) { w.x = (vw[ks][0] & 0xffffu) | (vw[ks][1] << 16); w.y = (vw[ks][2] & 0xffffu) | (vw[ks][3] << 16); w.z = (vw[ks][4] & 0xffffu) | (vw[ks][5] << 16); w.w = (vw[ks][6] & 0xffffu) | (vw[ks][7] << 16); }
                else { w.x = (vw[ks][0] >> 16) | (vw[ks][1] & 0xffff0000u); w.y = (vw[ks][2] >> 16) | (vw[ks][3] & 0xffff0000u); w.z = (vw[ks][4] >> 16) | (vw[ks][5] & 0xffff0000u); w.w = (vw[ks][6] >> 16) | (vw[ks][7] & 0xffff0000u); }
                vf[ks] = __builtin_bit_cast(bf16x8, w); }
            f32x4 acc[8];
#pragma unroll
            for (int dt = 0; dt < 8; ++dt) { acc[dt] = (f32x4){0.f, 0.f, 0.f, 0.f};
#pragma unroll
                for (int ks = 0; ks < 2; ++ks) acc[dt] = __builtin_amdgcn_mfma_f32_16x16x32_bf16(kf[dt][ks], vf[ks], acc[dt], 0, 0, 0); }
#pragma unroll
            for (int dp = 0; dp < 4; ++dp) { u32x4 w; w.x = cvt_pk_bf16(acc[2 * dp][0], acc[2 * dp + 1][0]); w.y = cvt_pk_bf16(acc[2 * dp][1], acc[2 * dp + 1][1]); w.z = cvt_pk_bf16(acc[2 * dp][2], acc[2 * dp + 1][2]); w.w = cvt_pk_bf16(acc[2 * dp][3], acc[2 * dp + 1][3]);
                *(u32x4*)(Uout + (size_t)(32 * ep + 2 * r + par) * 128 + 32 * dp + 8 * q) = w; } }
    }
}
__device__ __forceinline__ void p2_states(const Args& a, int G) {
    const int tid = threadIdx.x, lane = tid & 63, wave = __builtin_amdgcn_readfirstlane(tid >> 6);
    const u16* Gb = (const u16*)(a.ws + WS_G); const u16* Vb = (const u16*)(a.ws + WS_V); u16* US = (u16*)a.out; float* DK = (float*)(a.ws + WS_DK);
    for (int it = blockIdx.x; it < BATCH * NCH + 1; it += G) {
        if (it < BATCH * NCH) { const size_t row0 = (size_t)it * CHK;
            p2_wave(Gb + row0 * 1024, Vb + row0 * 1024, CHK, wave, US + ((size_t)it * 8 + wave) * 16384, DK + (size_t)it * 1024, lane); }
        else p2_wave((const u16*)(a.ws + WS_GM), (const u16*)(a.ws + WS_VM), NMETA, wave, (u16*)(a.ws + WS_UM) + (size_t)wave * 16384, nullptr, lane);
    }
}

__device__ __forceinline__ void p3_scan(const Args& a, LAS unsigned char* lds, int G) {
    const int tid = threadIdx.x, lane = tid & 63, wave = __builtin_amdgcn_readfirstlane(tid >> 6);
    {
        LAS float* scr = (LAS float*)(lds + wave * 16384);
        const int gw = (int)blockIdx.x * NWAVES + wave, NGW = G * NWAVES;
        for (int it = gw; it < 2 * 16 * 88; it += NGW) { const int up = it >= 16 * 88, r = up ? it - 16 * 88 : it, kb = r / 88, nb = r % 88, n0 = 32 * nb;
            tr_item(up ? a.w_up : a.w_gate, DFF, 64 * kb, n0, (u16*)(a.ws + WS_WGU), (n0 >> 7) * 256 + (n0 & 127) + (up ? 128 : 0), 1024, 0, a.g_ffn, scr, lane); }
    }
    u16* US = (u16*)a.out; const float* DK = (const float*)(a.ws + WS_DK); const u16* UM = (const u16*)(a.ws + WS_UM);
    for (int idx = blockIdx.x * NTHR + tid; idx < BATCH * 8 * 128 * 64; idx += G * NTHR) {
        const int dp = idx & 63, e = (idx >> 6) & 127, h = (idx >> 13) & 7, b = idx >> 16;
        const unsigned um = *(const unsigned*)(UM + (size_t)h * 16384 + e * 128 + 2 * dp);
        float s0 = bf_lo(um), s1 = bf_hi(um);
        unsigned* up = (unsigned*)(US + ((size_t)(b * NCH) * 8 + h) * 16384 + e * 128 + 2 * dp);
        const float* dkp = DK + (size_t)(b * NCH) * 1024 + h * 128 + 2 * dp;
#pragma unroll 1
        for (int c0 = 0; c0 < NCH; c0 += 16) {
            unsigned uu[16]; float dd0[16], dd1[16];
#pragma unroll
            for (int i = 0; i < 16; ++i) { uu[i] = up[(size_t)(c0 + i) * 8 * 8192]; dd0[i] = dkp[(size_t)(c0 + i) * 1024]; dd1[i] = dkp[(size_t)(c0 + i) * 1024 + 1]; }
#pragma unroll
            for (int i = 0; i < 16; ++i) { up[(size_t)(c0 + i) * 8 * 8192] = cvt_pk_bf16(s0, s1); s0 = dd0[i] * s0 + bf_lo(uu[i]); s1 = dd1[i] * s1 + bf_hi(uu[i]); }
        }
    }
}

constexpr int P4_PITCH = 272, P4_MAT = 64 * P4_PITCH  , P4_VPITCH = 136, P4_HS = 4 * P4_MAT  , P4_TOT = 2 * P4_HS  , P4_PLD = P4_TOT + 4096  ;
static_assert(P4_PLD + P4_MAT + 64 <= LDS_BYTES, "LDS map");
__device__ __forceinline__ unsigned ld_pl(const u16* PB, const u16* PLM, int b, int tx, int cofs) {
    return tx >= 0 ? *(const unsigned*)(PB + (size_t)(b * SEQ + tx) * 1024 + 512 + cofs) : *(const unsigned*)(PLM + (size_t)(NMETA + tx) * 512 + cofs);
}
__device__ __forceinline__ void p4_outputs(const Args& a, LAS unsigned char* lds, int G, int skip = 0) {
    (void)skip;
    const int tid = threadIdx.x, lane = tid & 63, wave = __builtin_amdgcn_readfirstlane(tid >> 6);
    const int r = lane & 15, q = lane >> 4;
    u16* Qb = (u16*)(a.ws + WS_Q); const u16* Gb = (const u16*)(a.ws + WS_G); const u16* Vb = (const u16*)(a.ws + WS_V); const u16* OGb = (const u16*)(a.ws + WS_OG);
    u16* PB = (u16*)(a.ws + WS_PB); const u16* PLM = (const u16*)(a.ws + WS_PLM); const u16* PWT = (const u16*)(a.ws + WS_PWT); const u16* US = (const u16*)a.out;
    LAS unsigned char* PLD = lds + P4_PLD;
    for (int item = blockIdx.x; item < BATCH * NCH * 4; item += G) {
        const int hp = item & 3, bc = item >> 2, c = bc & (NCH - 1), b = bc >> 7;
        const size_t row0 = (size_t)b * SEQ + (size_t)c * CHK;
        const int hs = wave >> 2, tq = wave & 3, h = 2 * hp + hs;
        LAS unsigned char* L = lds + hs * P4_HS;
        LAS unsigned char* KT = L, *QT = L + P4_MAT, *QH = L + 2 * P4_MAT, *VT = L + 3 * P4_MAT;
        LAS float* TOT = (LAS float*)(lds + P4_TOT) + hs * 512;
        const int d0 = 2 * lane; const size_t cofs = (size_t)h * 128 + d0;
        unsigned gp[16], qv[16], vv[16];
#pragma unroll
        for (int i = 0; i < 16; ++i) { const size_t o = (row0 + 16 * tq + i) * 1024 + cofs; gp[i] = *(const unsigned*)(Gb + o); qv[i] = *(const unsigned*)(Qb + o); vv[i] = *(const unsigned*)(Vb + o); }
        const int gi = hp, wlen = 2 << gi; const float inv = 1.0f / (float)wlen;
        const int t0 = 8 * wave, pcofs = gi * 128 + 2 * lane, tx0 = c * CHK + t0;
        unsigned pu[23];
#pragma unroll
        for (int j = 1; j < 16; ++j) pu[15 - j] = (j < wlen) ? ld_pl(PB, PLM, b, tx0 - j, pcofs) : 0u;
#pragma unroll
        for (int i = 0; i < 8; ++i) pu[15 + i] = ld_pl(PB, PLM, b, tx0 + i, pcofs);
        bf16x8 wf[4];
#pragma unroll
        for (int kd = 0; kd < 4; ++kd) wf[kd] = *(const bf16x8*)(PWT + (size_t)(gi * 128 + 16 * wave + r) * 128 + 32 * kd + 8 * q);
        float s0 = 0.f, s1 = 0.f;
#pragma unroll
        for (int i = 0; i < 16; ++i) { s0 += h2f((u16)(gp[i] & 0xffffu)); s1 += h2f((u16)(gp[i] >> 16)); }
        TOT[tq * 128 + d0] = s0; TOT[tq * 128 + d0 + 1] = s1;
        __syncthreads();
        {
            float w0 = 0.f, w1 = 0.f;
#pragma unroll
            for (int j = 1; j < 16; ++j) if (j < wlen) { w0 += bf_lo(pu[15 - j]); w1 += bf_hi(pu[15 - j]); }
#pragma unroll
            for (int i = 0; i < 8; ++i) { const float u0 = bf_lo(pu[15 + i]), u1 = bf_hi(pu[15 + i]); w0 += u0; w1 += u1;
                *(LAS unsigned*)(PLD + (t0 + i) * P4_PITCH + 4 * lane) = cvt_pk_bf16(w0 * inv - u0, w1 * inv - u1);
                const unsigned o = wlen == 2 ? pu[15 + i - 1] : (wlen == 4 ? pu[15 + i - 3] : (wlen == 8 ? pu[15 + i - 7] : pu[15 + i - 15]));
                w0 -= bf_lo(o); w1 -= bf_hi(o); }
        }
        float b0 = 0.f, b1 = 0.f;
#pragma unroll
        for (int t2 = 0; t2 < 3; ++t2) if (t2 < tq) { b0 += TOT[t2 * 128 + d0]; b1 += TOT[t2 * 128 + d0 + 1]; }
        const float bm0 = TOT[d0] + TOT[128 + d0], bm1 = TOT[d0 + 1] + TOT[128 + d0 + 1];
#pragma unroll
        for (int i = 0; i < 16; ++i) { const int t = 16 * tq + i; const float g0 = h2f((u16)(gp[i] & 0xffffu)), g1 = h2f((u16)(gp[i] >> 16)); b0 += g0; b1 += g1;
            const unsigned q2 = qv[i], v2 = vv[i];
            const float q0 = bf_lo(q2), q1 = bf_hi(q2), k0 = 1.0f - __expf(g0), k1 = 1.0f - __expf(g1);
            const float eb0 = __expf(b0), eb1 = __expf(b1), em0 = __expf(fminf(b0 - bm0, 80.f)), em1 = __expf(fminf(b1 - bm1, 80.f)), ek0 = __expf(fminf(bm0 - b0, 80.f)), ek1 = __expf(fminf(bm1 - b1, 80.f));
            *(LAS unsigned*)(QT + t * P4_PITCH + d0 * 2) = cvt_pk_bf16(q0 * em0, q1 * em1);
            *(LAS unsigned*)(QH + t * P4_PITCH + d0 * 2) = cvt_pk_bf16(q0 * eb0, q1 * eb1);
            *(LAS unsigned*)(KT + t * P4_PITCH + d0 * 2) = cvt_pk_bf16(k0 * ek0, k1 * ek1);
            *(LAS u16*)(VT + d0 * P4_VPITCH + t * 2) = (u16)(v2 & 0xffffu); *(LAS u16*)(VT + (d0 + 1) * P4_VPITCH + t * 2) = (u16)(v2 >> 16); }
        const u16* Sp = US + ((size_t)bc * 8 + h) * 16384;
        bf16x8 sfr[8][4];
#pragma unroll
        for (int et = 0; et < 8; ++et)
#pragma unroll
            for (int kd = 0; kd < 4; ++kd) sfr[et][kd] = *(const bf16x8*)(Sp + (size_t)(16 * et + r) * 128 + 32 * kd + 8 * q);
        const int tt = tq;
        const size_t orow = (row0 + 16 * tt + r) * 1024 + (size_t)h * 128;
        __syncthreads();
        u32x2 ogv[8];
#pragma unroll
        for (int et = 0; et < 8; ++et) ogv[et] = *(const u32x2*)(OGb + orow + 16 * et + 4 * q);
        {
            f32x4 acc[4];
#pragma unroll
            for (int t4 = 0; t4 < 4; ++t4) acc[t4] = (f32x4){0.f, 0.f, 0.f, 0.f};
#pragma unroll
            for (int kd = 0; kd < 4; ++kd)
#pragma unroll
                for (int t4 = 0; t4 < 4; ++t4) { const bf16x8 pfr = *(const LAS bf16x8*)(PLD + (16 * t4 + r) * P4_PITCH + (32 * kd + 8 * q) * 2); acc[t4] = __builtin_amdgcn_mfma_f32_16x16x32_bf16(wf[kd], pfr, acc[t4], 0, 0, 0); }
            const int n0 = gi * 128 + 16 * wave + 4 * q; const f32x4 psc = *(const f32x4*)(a.pool_scale + n0);
#pragma unroll
            for (int t4 = 0; t4 < 4; ++t4) { u32x2 w; w.x = cvt_pk_bf16(acc[t4][0] * psc[0], acc[t4][1] * psc[1]); w.y = cvt_pk_bf16(acc[t4][2] * psc[2], acc[t4][3] * psc[3]);
                *(u32x2*)(PB + (row0 + 16 * t4 + r) * 1024 + n0) = w; }
        }
        bf16x8 qt[4], qh[4];
#pragma unroll
        for (int kd = 0; kd < 4; ++kd) { qt[kd] = *(const LAS bf16x8*)(QT + (16 * tt + r) * P4_PITCH + (32 * kd + 8 * q) * 2); qh[kd] = *(const LAS bf16x8*)(QH + (16 * tt + r) * P4_PITCH + (32 * kd + 8 * q) * 2); }
        f32x4 sc[4];
#pragma unroll
        for (int st = 0; st < 4; ++st) { f32x4 acc = (f32x4){0.f, 0.f, 0.f, 0.f};
            if (st <= tt) {
#pragma unroll
                for (int kd = 0; kd < 4; ++kd) { const bf16x8 kfr = *(const LAS bf16x8*)(KT + (16 * st + r) * P4_PITCH + (32 * kd + 8 * q) * 2); acc = __builtin_amdgcn_mfma_f32_16x16x32_bf16(kfr, qt[kd], acc, 0, 0, 0); }
                if (st == tt) {
#pragma unroll
                    for (int i = 0; i < 4; ++i) if (4 * q + i > r) acc[i] = 0.f; }
            }
            sc[st] = acc; }
        bf16x8 pf[2];
#pragma unroll
        for (int ks = 0; ks < 2; ++ks) { u32x4 w; w.x = cvt_pk_bf16(sc[2 * ks][0], sc[2 * ks][1]); w.y = cvt_pk_bf16(sc[2 * ks][2], sc[2 * ks][3]); w.z = cvt_pk_bf16(sc[2 * ks + 1][0], sc[2 * ks + 1][1]); w.w = cvt_pk_bf16(sc[2 * ks + 1][2], sc[2 * ks + 1][3]);
            pf[ks] = __builtin_bit_cast(bf16x8, w); }
        f32x4 oa[8]; float ss = 0.f;
#pragma unroll
        for (int et = 0; et < 8; ++et) { f32x4 acc = (f32x4){0.f, 0.f, 0.f, 0.f};
#pragma unroll
            for (int kd = 0; kd < 4; ++kd) acc = __builtin_amdgcn_mfma_f32_16x16x32_bf16(sfr[et][kd], qh[kd], acc, 0, 0, 0);
#pragma unroll
            for (int ks = 0; ks < 2; ++ks) if (2 * ks <= tt) {
                const u32x2 lo = *(const LAS u32x2*)(VT + (16 * et + r) * P4_VPITCH + (32 * ks + 4 * q) * 2), hi = *(const LAS u32x2*)(VT + (16 * et + r) * P4_VPITCH + (32 * ks + 16 + 4 * q) * 2);
                const u32x4 w = (u32x4){lo.x, lo.y, hi.x, hi.y};
                acc = __builtin_amdgcn_mfma_f32_16x16x32_bf16(__builtin_bit_cast(bf16x8, w), pf[ks], acc, 0, 0, 0); }
            oa[et] = acc; ss += (acc[0] * acc[0] + acc[1] * acc[1]) + (acc[2] * acc[2] + acc[3] * acc[3]); }
        ss += __shfl_xor(ss, 16); ss += __shfl_xor(ss, 32);
        const float rstd = rsqrtf(ss * (1.f / 128.f) + EPS);
#pragma unroll
        for (int et = 0; et < 8; ++et) { const int e0 = 16 * et + 4 * q; const f32x4 gn = *(const f32x4*)(a.g_hn + e0); const u32x2 og = ogv[et];
            u32x2 w; w.x = cvt_pk_bf16(oa[et][0] * rstd * gn[0] * bf_lo(og.x), oa[et][1] * rstd * gn[1] * bf_hi(og.x)); w.y = cvt_pk_bf16(oa[et][2] * rstd * gn[2] * bf_lo(og.y), oa[et][3] * rstd * gn[3] * bf_hi(og.y));
            *(LAS u32x2*)(QT + (16 * tt + r) * P4_PITCH + e0 * 2) = w; }
        asm volatile("s_waitcnt lgkmcnt(0)" ::: "memory");
#pragma unroll
        for (int i = 0; i < 4; ++i) { const int rr = 16 * tt + 4 * i + (lane >> 4); const u32x4 v = *(const LAS u32x4*)(QT + rr * P4_PITCH + (lane & 15) * 16);
            *(u32x4*)(Qb + (row0 + rr) * 1024 + (size_t)h * 128 + (lane & 15) * 8) = v; }
    }
    __syncthreads();
}

__device__ __forceinline__ void p9_final(const Args& a, int G) {
    const int tid = threadIdx.x, lane = tid & 63, wave = __builtin_amdgcn_readfirstlane(tid >> 6);
    const float* rsq = (const float*)(a.ws + WS_RSQ);
    const f32x4* gr = (const f32x4*)a.g_fin + lane; f32x4 gv[4];
#pragma unroll
    for (int j = 0; j < 4; ++j) gv[j] = gr[64 * j];
    for (int m = 2 * (blockIdx.x * NWAVES + wave); m < M; m += 2 * G * NWAVES) {
        float p = lane < 32 ? rsq[(size_t)m * 16 + lane] : 0.f;
        f32x4* xr = (f32x4*)(a.out + (size_t)m * DM) + lane; f32x4 v[8];
#pragma unroll
        for (int j = 0; j < 8; ++j) v[j] = xr[64 * j];
        p += __shfl_xor(p, 1); p += __shfl_xor(p, 2); p += __shfl_xor(p, 4); p += __shfl_xor(p, 8);
        const float r0 = rsqrtf(__shfl(p, 0) * (1.f / DM) + EPS), r1 = rsqrtf(__shfl(p, 16) * (1.f / DM) + EPS);
#pragma unroll
        for (int j = 0; j < 8; ++j) { const float rs = j < 4 ? r0 : r1; const f32x4 g4 = gv[j & 3]; xr[64 * j] = (f32x4){v[j].x * rs * g4.x, v[j].y * rs * g4.y, v[j].z * rs * g4.z, v[j].w * rs * g4.w}; }
    }
}

#ifdef PROBE_STOP
__device__ __forceinline__ void p_dump(const Args& a, int G) {
    const u16* Qb = (const u16*)(a.ws + WS_Q); const u16* Gb = (const u16*)(a.ws + WS_G); const u16* Vb = (const u16*)(a.ws + WS_V); const u16* OGb = (const u16*)(a.ws + WS_OG);
    const u16* GAb = (const u16*)(a.ws + WS_GA); const u16* GBb = (const u16*)(a.ws + WS_GB); const u16* PB = (const u16*)(a.ws + WS_PB);
    for (size_t i = (size_t)blockIdx.x * NTHR + threadIdx.x; i < (size_t)M * DM; i += (size_t)G * NTHR) {
        float v = 0.f;
        if (PROBE_STOP == 1) v = bf1(Qb[i]) + h2f(Gb[i]) + bf1(Vb[i]) + bf1(OGb[i]) + bf1(GAb[i]) + bf1(GBb[i]) + bf1(PB[i]);
        else if (PROBE_STOP == 2 || PROBE_STOP == 3) { float t = bf1(((const u16*)a.out)[i]) + bf1(((const u16*)a.out)[i + (size_t)M * DM]); if (!(fabsf(t) < 1e30f)) t = 12345.f; ((float*)(a.ws + WS_GA))[i] = t; continue; }
        else if (PROBE_STOP == 4) v = bf1(Qb[i]) + bf1(PB[i]);
        else if (PROBE_STOP == 5) v = bf1(Gb[i]);
        else continue;
        a.out[i] = v;
    }
}
#endif
__device__ __forceinline__ void flat_barrier(unsigned* cnt) {
    asm volatile("s_waitcnt vmcnt(0)" ::: "memory");
    __syncthreads();
    if (threadIdx.x == 0) {
        const unsigned Gn = gridDim.x;
        __builtin_amdgcn_fence(__ATOMIC_RELEASE, "agent");
        asm volatile("s_waitcnt vmcnt(0)" ::: "memory");
        const unsigned old = __hip_atomic_fetch_add(cnt, 1u, __ATOMIC_RELAXED, __HIP_MEMORY_SCOPE_AGENT);
        const unsigned target = (old / Gn + 1u) * Gn; unsigned sp = 0;
        while (__hip_atomic_load(cnt, __ATOMIC_RELAXED, __HIP_MEMORY_SCOPE_AGENT) < target) { __builtin_amdgcn_s_sleep(1); if (++sp > (1u << 22)) break; }
        __builtin_amdgcn_fence(__ATOMIC_ACQUIRE, "agent");
        asm volatile("s_waitcnt vmcnt(0)" ::: "memory");
    }
    __syncthreads();
}
constexpr int NPH = 10;
__global__ void __launch_bounds__(NTHR, 2) mega(Args a) {
    extern __shared__ __attribute__((aligned(16))) unsigned char lds_raw[];
    LAS unsigned char* lds = (LAS unsigned char*)lds_raw;
    cg::grid_group grid = cg::this_grid();
    const int G = gridDim.x, lo = a.ph_lo, hi = a.ph_hi;
    unsigned char* ws = a.ws;
    volatile LAS unsigned* MISC = (volatile LAS unsigned*)(lds + LDS_BYTES - 64);
    if (threadIdx.x < 16) MISC[threadIdx.x] = 0u;
    __syncthreads();
    XcdBarrier bar; bar.bar = (unsigned*)(ws + WS_BAR); bar.x = 0; bar.st = nullptr;
    if (hi - lo > 1) bar = xcd_barrier_post((unsigned*)(ws + WS_BAR), MISC);
    if (hi < 0) grid.sync();
#ifndef PHMASK
#define PHMASK 0x3ff
#endif
#define IN(k) (((PHMASK >> (k)) & 1) && lo <= (k) && (k) < hi)
#ifndef CG_SEAMS
#define CG_SEAMS 0x0
#endif
#define SEAM(k) do { if (IN(k) && IN((k) + 1)) { if ((CG_SEAMS >> (k)) & 1) grid.sync(); else xcd_barrier(bar); } } while (0)
#ifndef PROBE_DUP
#define PROBE_DUP 0
#endif
#ifndef PROBE_XSYNC
#define PROBE_XSYNC 0
#endif
#define DUP(k) (((PROBE_DUP >> (k)) & 1) ? 2 : 1)
    if (IN(0)) { p0_prologue(a, lds, G); } SEAM(0);
#ifdef PROBE_XBAR
    for (int xs = 0; xs < PROBE_XBAR; ++xs) flat_barrier((unsigned*)(ws + WS_BAR + 14 * KiB));
#endif
    if (IN(1)) { pg8::Gemm g{(const u16*)a.out, (const u16*)(ws + WS_WIN), M, INW, DM, DM, 1 << 30, 0L}; pg8::StaticOrder S; S.init(M, INW, G, (int)blockIdx.x);
        EpiIn E{ws}; pg8::gemm_phase<EpiIn, true>(lds, g, S, E);
        if (G == 256 && blockIdx.x >= 128) late_weights(a, lds, ((int)blockIdx.x - 128) * NWAVES + (int)(threadIdx.x >> 6), 128 * NWAVES); }
    SEAM(1);
    if (IN(2)) { p2_states(a, G); } SEAM(2);
    if (IN(3)) { p3_scan(a, lds, G); } SEAM(3);
    if (IN(4)) { p4_outputs(a, lds, G); } SEAM(4);
    if (IN(5)) { pg8::Gemm g{(const u16*)(ws + WS_Q), (const u16*)(ws + WS_WAB), M, DM, 1536, DM, 16, (long)(WS_PB - WS_Q) - 16L * 128L}; pg8::StaticOrder S; S.init(M, DM, G, (int)blockIdx.x);
        EpiMerge E{(const u16*)(ws + WS_GA), (const u16*)(ws + WS_GB), (u16*)(ws + WS_MG)}; pg8::gemm_phase<EpiMerge, false>(lds, g, S, E); } SEAM(5);
    if (IN(6)) { pg8::Gemm g{(const u16*)(ws + WS_MG), (const u16*)(ws + WS_WOUT), M, DM, DM, DM, 1 << 30, 0L}; pg8::StaticOrder S; S.init(M, DM, G, (int)blockIdx.x);
        EpiRes<true> E{a.x, a.out, (u16*)(ws + WS_H1B), (float*)(ws + WS_RSQ)}; pg8::gemm_phase<EpiRes<true>, false>(lds, g, S, E); } SEAM(6);
    if (IN(7)) { pg8::Gemm g{(const u16*)(ws + WS_H1B), (const u16*)(ws + WS_WGU), M, NGU, DM, DM, 1 << 30, 0L}; pg8::StaticOrder S; S.init(M, NGU, G, (int)blockIdx.x);
        EpiFfn1 E{(const float*)(ws + WS_RSQ), (u16*)(ws + WS_ACT)}; pg8::gemm_phase<EpiFfn1, true>(lds, g, S, E); } SEAM(7);
    const bool fuse9 = (G == (M / 256) * (DM / 256)) && (hi - lo > 1);
    if (IN(8)) { pg8::Gemm g{(const u16*)(ws + WS_ACT), (const u16*)(ws + WS_WD), M, DM, DFF, DFF, 1 << 30, 0L}; pg8::StaticOrder S; S.init(M, DM, G, (int)blockIdx.x);
        if (fuse9) { EpiResNorm E{a.out, a.out, a.g_fin, (float*)(ws + WS_RSQ), (unsigned*)(ws + WS_CNT)}; pg8::gemm_phase<EpiResNorm, false>(lds, g, S, E); }
        else { EpiRes<false> E{a.out, a.out, nullptr, (float*)(ws + WS_RSQ)}; pg8::gemm_phase<EpiRes<false>, false>(lds, g, S, E); } }
    if (!fuse9) { SEAM(8);
    if (IN(9)) { p9_final(a, G); } }
#ifdef PROBE_LIST
    if (lo == 20) p0_prologue(a, lds, G, 1);
    if (lo == 30) p0_prologue(a, lds, G, 2);
    if (lo == 40) p0_prologue(a, lds, G, 4);
    if (lo == 14) p4_outputs(a, lds, G, 1);
    if (lo == 24) p4_outputs(a, lds, G, 2);
    if (lo == 34) p4_outputs(a, lds, G, 2 | 4);
    if (lo == 44) p4_outputs(a, lds, G, 2 | 8);
    if (lo == 54) p4_outputs(a, lds, G, 2 | 16);
    if (lo == 64) p4_outputs(a, lds, G, 2 | 32);
    if (lo == 74) p4_outputs(a, lds, G, 2 | 64);
    if (lo == 18) { pg8::Gemm g{(const u16*)(ws + WS_ACT), (const u16*)(ws + WS_WD), M, DM, DFF, DFF, 1 << 30, 0L}; pg8::StaticOrder S; S.init(M, DM, G, (int)blockIdx.x);
        EpiRes<false> E{(const float*)(ws + WS_GA), (float*)(ws + WS_GA), nullptr, (float*)(ws + WS_OG)}; pg8::gemm_phase<EpiRes<false>, false>(lds, g, S, E); }
    if (lo == 19) { Args b = a; b.out = (float*)(ws + WS_GA); p9_final(b, G); }
#endif
#ifdef PROBE_STOP
    if (lo == 10) p_dump(a, G);
    if (lo == 11 && (PROBE_STOP == 2 || PROBE_STOP == 3)) { for (size_t i = (size_t)blockIdx.x * NTHR + threadIdx.x; i < (size_t)M * DM; i += (size_t)G * NTHR) a.out[i] = ((const float*)(a.ws + WS_GA))[i]; }
#endif
#undef IN
#undef SEAM
}

extern "C" void kernel_launch(void* const* d_in, const int* in_sizes, int n_in, void* d_out, int out_size, void* d_ws, size_t ws_size, hipStream_t stream) {
    static int grid = 0;
    if (grid == 0) {
        if (n_in != 16 || in_sizes[0] != M * DM || out_size != M * DM || ws_size < WS_END) { fprintf(stderr, "kernel_launch: unexpected shapes (n_in %d, in0 %d, out %d, ws %zu); nothing launched\n", n_in, n_in > 0 ? in_sizes[0] : -1, out_size, ws_size); grid = -1; return; }
        int dev = 0, cus = 0, per_cu = 0;
        (void)hipGetDevice(&dev); (void)hipDeviceGetAttribute(&cus, hipDeviceAttributeMultiprocessorCount, dev);
        if (hipFuncSetAttribute((const void*)mega, hipFuncAttributeMaxDynamicSharedMemorySize, LDS_BYTES) != hipSuccess) { fprintf(stderr, "kernel_launch: hipFuncSetAttribute failed\n"); }
        if (hipOccupancyMaxActiveBlocksPerMultiprocessor(&per_cu, (const void*)mega, NTHR, LDS_BYTES) != hipSuccess || per_cu < 1) per_cu = 1;
        (void)hipGetLastError();
        if (cus <= 0) cus = 256;
        grid = cus * per_cu;
    }
    if (grid < 0) return;
#if MK_COOP
    if (hipMemsetAsync((char*)d_ws + WS_BAR, 0, CTL_ZERO, stream) != hipSuccess) { fprintf(stderr, "kernel_launch: hipMemsetAsync of the barrier words failed\n"); return; }
#endif
    Args a{};
    a.x = (const float*)d_in[0]; a.meta = (const float*)d_in[1]; a.g_mix = (const float*)d_in[2]; a.w_in = (const float*)d_in[3]; a.lb_raw = (const float*)d_in[4]; a.g_hn = (const float*)d_in[5];
    a.pool_w = (const float*)d_in[6]; a.pool_scale = (const float*)d_in[7]; a.w_a = (const float*)d_in[8]; a.w_b = (const float*)d_in[9]; a.w_out = (const float*)d_in[10]; a.g_ffn = (const float*)d_in[11];
    a.w_gate = (const float*)d_in[12]; a.w_up = (const float*)d_in[13]; a.w_down = (const float*)d_in[14]; a.g_fin = (const float*)d_in[15];
    a.out = (float*)d_out; a.ws = (unsigned char*)d_ws;
#if MK_COOP
    a.ph_lo = 0; a.ph_hi = NPH;
    void* args[] = {&a};
    const hipError_t e = hipLaunchCooperativeKernel((const void*)mega, dim3(grid), dim3(NTHR), args, LDS_BYTES, stream);
    if (e != hipSuccess) fprintf(stderr, "kernel_launch: cooperative launch failed: %s (grid %d)\n", hipGetErrorString(e), grid);
#else
#ifdef PROBE_STOP
    for (int ph = 0; ph <= PROBE_STOP; ++ph) { a.ph_lo = ph; a.ph_hi = ph + 1; hipLaunchKernelGGL(mega, dim3(grid), dim3(NTHR), LDS_BYTES, stream, a); }
    a.ph_lo = 10; a.ph_hi = 11; hipLaunchKernelGGL(mega, dim3(grid), dim3(NTHR), LDS_BYTES, stream, a);
    a.ph_lo = 11; a.ph_hi = 12; hipLaunchKernelGGL(mega, dim3(grid), dim3(NTHR), LDS_BYTES, stream, a);
#else
#ifdef PROBE_LIST
    { const int lst[] = PROBE_LIST; for (int i = 0; i < (int)(sizeof(lst) / sizeof(int)); ++i) { a.ph_lo = lst[i]; a.ph_hi = lst[i] + 1; hipLaunchKernelGGL(mega, dim3(grid), dim3(NTHR), LDS_BYTES, stream, a); } }
#else
    for (int ph = 0; ph < NPH; ++ph) { a.ph_lo = ph; a.ph_hi = ph + 1; hipLaunchKernelGGL(mega, dim3(grid), dim3(NTHR), LDS_BYTES, stream, a); }
#endif
#endif
#endif
}
```

```cpp
#include <hip/hip_runtime.h>
#include <hip/hip_cooperative_groups.h>
#include <cstdio>
#include <cstdint>
namespace cg = cooperative_groups;

#ifndef MK_COOP
#define MK_COOP 1
#endif

#define LAS __attribute__((address_space(3)))
typedef unsigned short u16;
typedef short bf16x8 __attribute__((ext_vector_type(8)));
typedef float f32x4 __attribute__((ext_vector_type(4)));
typedef unsigned u32x4 __attribute__((ext_vector_type(4)));
typedef unsigned u32x2 __attribute__((ext_vector_type(2)));

typedef __bf16 bf16v2_t __attribute__((ext_vector_type(2)));
typedef float f32v2_t __attribute__((ext_vector_type(2)));
__device__ __forceinline__ unsigned cvt_pk_bf16(float lo, float hi) { const f32v2_t f = {lo, hi}; const bf16v2_t v = __builtin_convertvector(f, bf16v2_t); return __builtin_bit_cast(unsigned, v); }
__device__ __forceinline__ float bf_lo(unsigned w) { return __uint_as_float(w << 16); }
__device__ __forceinline__ float bf_hi(unsigned w) { return __uint_as_float(w & 0xffff0000u); }
__device__ __forceinline__ float bf1(u16 w) { return __uint_as_float((unsigned)w << 16); }
__device__ __forceinline__ unsigned pk_h(float a, float b) { const _Float16 x = (_Float16)a, y = (_Float16)b; return (unsigned)__builtin_bit_cast(unsigned short, x) | ((unsigned)__builtin_bit_cast(unsigned short, y) << 16); }
__device__ __forceinline__ float h2f(u16 w) { return (float)__builtin_bit_cast(_Float16, w); }
__device__ __forceinline__ float sigm(float z) { return __builtin_amdgcn_rcpf(1.0f + __expf(-z)); }

namespace pg8 {
constexpr int BM = 256, BK = 64, HALF = 128, HTB = HALF * BK * 2, STAGE_BYTES = 8 * HTB, NXCD = 8, WGM = 8;
__host__ __device__ __forceinline__ int lds_byte(int r, int c) { const int st = (r >> 4) * 2 + (c >> 5), rr = r & 15, cc = c & 31, ob = rr * 64 + cc * 2; return st * 1024 + (ob ^ (((ob >> 9) & 1) << 5)); }
__host__ __device__ __forceinline__ void stage_rc(int b, int& R, int& C) { const int st = b / 1024, sb = b % 1024, swz = sb ^ (((sb >> 9) & 1) << 5); R = (st >> 1) * 16 + swz / 64; C = (st & 1) * 32 + (swz % 64) / 2; }
__host__ __device__ __forceinline__ int perm32(int rho) { const int n = rho >> 4, i = rho & 15; return 8 * (i >> 2) + 4 * n + (i & 3); }
struct Unit { int pm, pn; };
struct Gemm { const u16* A; const u16* Bt; int M, N, K, lda, ksplit; long a2delta; };
struct StaticOrder {
    int nM, nN, nwg, G, c;
    __host__ __device__ void init(int M, int N, int G_, int c_) { nM = M / BM; nN = N / BM; nwg = nM * nN; G = G_; c = c_; }
    __host__ __device__ bool next(int i, Unit& u) const {
        const long L = (long)i * G + c; if (L >= nwg) return false;
        int wgid = (int)L; { const int q = nwg / NXCD, r = nwg % NXCD, xcd = wgid % NXCD, off = wgid / NXCD; wgid = (xcd < r ? xcd * (q + 1) : r * (q + 1) + (xcd - r) * q) + off; }
        const int nig = WGM * nN, gid = wgid / nig, fm = gid * WGM, gsz = (nM - fm) < WGM ? (nM - fm) : WGM;
        u.pm = fm + ((wgid % nig) % gsz); u.pn = (wgid % nig) / gsz; return true;
    }
};
template <class Epi, bool ALIGN_EPI>
__device__ __forceinline__ void gemm_phase(LAS unsigned char* lds, const Gemm g, const StaticOrder& S, const Epi& E) {
    const int tid = threadIdx.x, wid = __builtin_amdgcn_readfirstlane(tid >> 6), lane = tid & 63, wr = wid >> 2, wc = wid & 3, fr = lane & 15, fq = lane >> 4;
    const int K = g.K, nt = K / BK, lda = g.lda;
    unsigned voffA[2], voffB[2];
#pragma unroll
    for (int i = 0; i < 2; ++i) { int R, C; stage_rc(tid * 16 + i * 8192, R, C); const int Rb = Epi::PERM ? ((R & ~31) + perm32(R & 31)) : R;
        voffA[i] = (unsigned)(R * lda + C) * 2u; voffB[i] = (unsigned)(Rb * K + C) * 2u; }
    const size_t kstep = (size_t)(BK * 2);
    const size_t hstepA = (size_t)HALF * lda * 2, tstepA = 2 * hstepA;
    const size_t hstepB = (size_t)HALF * K * 2, tstepB = 2 * hstepB;
    const unsigned ldsw = (unsigned)wid * 1024u;
    const int aoff = lds_byte(wr * 64 + fr, fq * 8), boff = lds_byte(wc * 32 + fr, fq * 8);
#define PG8_SA(b, h) (((b) * 2 + (h)) * HTB)
#define PG8_SB(b, h) ((4 + (b) * 2 + (h)) * HTB)
#define PG8_STAGE(bufoff, gbase, voff) do { _Pragma("unroll") for (int _i = 0; _i < 2; ++_i) \
        __builtin_amdgcn_global_load_lds((const unsigned*)((const char*)(gbase) + (voff)[_i]), (LAS unsigned*)(lds + (bufoff) + ldsw + _i * 8192), 16, 0, 0); } while (0)
#define PG8_LDA(dst, b, h) do { _Pragma("unroll") for (int m = 0; m < 4; ++m) _Pragma("unroll") for (int k = 0; k < 2; ++k) dst[m][k] = *(const LAS bf16x8*)(lds + PG8_SA(b, h) + aoff + m * 2048 + k * 1024); } while (0)
#define PG8_LDB(dst, b, h) do { _Pragma("unroll") for (int n = 0; n < 2; ++n) _Pragma("unroll") for (int k = 0; k < 2; ++k) dst[n][k] = *(const LAS bf16x8*)(lds + PG8_SB(b, h) + boff + n * 2048 + k * 1024); } while (0)
#define PG8_MMA(ai, bj, At, Bt) do { __builtin_amdgcn_s_setprio(1); _Pragma("unroll") for (int m = 0; m < 4; ++m) _Pragma("unroll") for (int n = 0; n < 2; ++n) _Pragma("unroll") for (int k = 0; k < 2; ++k) \
        acc[ai][bj][m][n] = __builtin_amdgcn_mfma_f32_16x16x32_bf16(Bt[n][k], At[m][k], acc[ai][bj][m][n], 0, 0, 0); __builtin_amdgcn_s_setprio(0); } while (0)
#define PG8_WAIT_V(n) asm volatile("s_waitcnt vmcnt(" #n ")" ::: "memory")
#define PG8_WAIT_L(n) asm volatile("s_waitcnt lgkmcnt(" #n ")" ::: "memory")
#define PG8_BAR __builtin_amdgcn_s_barrier()
#define PG8_SCHED __builtin_amdgcn_sched_barrier(0)
    Unit cur, nxt; int ui = 0;
    if (!S.next(0, cur)) return;
    f32x4 acc[2][2][4][2];
#pragma unroll
    for (int a = 0; a < 2; ++a)
#pragma unroll
        for (int b = 0; b < 2; ++b)
#pragma unroll
            for (int m = 0; m < 4; ++m)
#pragma unroll
                for (int n = 0; n < 2; ++n) acc[a][b][m][n] = (f32x4){0.f, 0.f, 0.f, 0.f};
    bf16x8 At[4][2], B0[2][2], B1[2][2];
    const char* cA = (const char*)g.A + (size_t)cur.pm * tstepA; const char* cB = (const char*)g.Bt + (size_t)cur.pn * tstepB;
    PG8_STAGE(PG8_SB(0, 0), cB, voffB); PG8_STAGE(PG8_SB(0, 1), cB + hstepB, voffB); PG8_STAGE(PG8_SA(0, 0), cA, voffA); PG8_STAGE(PG8_SA(0, 1), cA + hstepA, voffA);
    if (wr == 1) PG8_BAR;
    PG8_WAIT_V(2); PG8_BAR;
    PG8_STAGE(PG8_SB(1, 0), cB + kstep, voffB); PG8_STAGE(PG8_SA(1, 0), cA + kstep, voffA); PG8_STAGE(PG8_SB(1, 1), cB + hstepB + kstep, voffB);
    PG8_WAIT_V(6); PG8_BAR;
    for (;;) {
        const bool has_next = S.next(ui + 1, nxt);
        const char* nA = has_next ? (const char*)g.A + (size_t)nxt.pm * tstepA : cA; const char* nB = has_next ? (const char*)g.Bt + (size_t)nxt.pn * tstepB : cB;
        for (int t = 0; t < nt; t += 2) {
            const bool last = (t == nt - 2);
            if constexpr (Epi::MID) { if (t == g.ksplit) E.mid(acc, cur, wr, wc, fr, fq); }
            const char* a1 = cA + (size_t)(t + 1) * kstep + (t >= g.ksplit ? g.a2delta : 0L);
            const char* a2 = last ? nA : cA + (size_t)(t + 2) * kstep + (t + 2 >= g.ksplit ? g.a2delta : 0L);
            const char* b2 = last ? nB : cB + (size_t)(t + 2) * kstep;
            const char* a3 = a2 + kstep; const char* b3 = b2 + kstep;
            PG8_LDB(B0, 0, 0); PG8_LDB(B1, 0, 1); PG8_SCHED; PG8_LDA(At, 0, 0); PG8_STAGE(PG8_SA(1, 1), a1 + hstepA, voffA);
            PG8_WAIT_V(8); PG8_WAIT_L(0); PG8_BAR; PG8_MMA(0, 0, At, B0); PG8_MMA(0, 1, At, B1); PG8_BAR; PG8_SCHED;
            PG8_LDA(At, 0, 1); PG8_STAGE(PG8_SB(0, 0), b2, voffB); PG8_STAGE(PG8_SB(0, 1), b2 + hstepB, voffB); PG8_STAGE(PG8_SA(0, 0), a2, voffA);
            PG8_WAIT_V(8); PG8_WAIT_L(0); PG8_BAR; PG8_MMA(1, 0, At, B0); PG8_MMA(1, 1, At, B1); PG8_BAR; PG8_SCHED;
            PG8_LDB(B0, 1, 0); PG8_LDB(B1, 1, 1); PG8_SCHED; PG8_LDA(At, 1, 0); PG8_STAGE(PG8_SA(0, 1), a2 + hstepA, voffA);
            PG8_WAIT_V(8); PG8_WAIT_L(0); PG8_BAR; PG8_MMA(0, 0, At, B0); PG8_MMA(0, 1, At, B1); PG8_BAR; PG8_SCHED;
            PG8_LDA(At, 1, 1); PG8_STAGE(PG8_SB(1, 0), b3, voffB); PG8_STAGE(PG8_SB(1, 1), b3 + hstepB, voffB); PG8_STAGE(PG8_SA(1, 0), a3, voffA);
            PG8_WAIT_V(8); PG8_WAIT_L(0); PG8_BAR; PG8_MMA(1, 0, At, B0); PG8_MMA(1, 1, At, B1); PG8_BAR; PG8_SCHED;
        }
        if constexpr (ALIGN_EPI) { if (wr == 0) PG8_BAR; }
        if constexpr (!Epi::AFTER) E(acc, cur, wr, wc, fr, fq);
        if (!has_next) break;
#pragma unroll
        for (int a = 0; a < 2; ++a)
#pragma unroll
            for (int b = 0; b < 2; ++b)
#pragma unroll
                for (int m = 0; m < 4; ++m)
#pragma unroll
                    for (int n = 0; n < 2; ++n) acc[a][b][m][n] = (f32x4){0.f, 0.f, 0.f, 0.f};
        cur = nxt; cA = nA; cB = nB; ++ui;
        if constexpr (ALIGN_EPI) { if (wr == 1) PG8_BAR; }
    }
    PG8_WAIT_V(0);
    if constexpr (!ALIGN_EPI) { if (wr == 0) PG8_BAR; }
    PG8_BAR;
    if constexpr (Epi::AFTER) E.after(acc, cur, wr, wc, fr, fq, lds, wid, lane);
#undef PG8_SA
#undef PG8_SB
#undef PG8_STAGE
#undef PG8_LDA
#undef PG8_LDB
#undef PG8_MMA
#undef PG8_WAIT_V
#undef PG8_WAIT_L
#undef PG8_BAR
#undef PG8_SCHED
}
}

constexpr int NWAVES = 8, NTHR = 512;
constexpr int SEQ = 8192, BATCH = 2, DM = 1024, M = BATCH * SEQ, NMETA = 16, INW = 6656, DFF = 2816, NGU = 2 * DFF, CHK = 64, NCH = SEQ / CHK;
constexpr float EPS = 1e-6f;
constexpr size_t KiB = 1024, MiB = 1u << 20;
constexpr size_t WS_LB = 0, WS_GM = 64 * KiB, WS_VM = 128 * KiB, WS_PLM = 192 * KiB, WS_PWT = 256 * KiB, WS_UM = 512 * KiB, WS_DK = 1 * MiB, WS_RSQ = 2 * MiB;
constexpr size_t WS_WAB = 3 * MiB, WS_WOUT = 6 * MiB, WS_WD = 8 * MiB, WS_WIN = 14 * MiB, WS_WGU = 14 * MiB;
constexpr size_t WS_Q = 28 * MiB, WS_G = 60 * MiB, WS_V = 92 * MiB, WS_OG = 124 * MiB, WS_GA = 156 * MiB, WS_GB = 188 * MiB, WS_PB = 220 * MiB, WS_END = 252 * MiB;
constexpr size_t WS_MG = WS_G, WS_H1B = WS_GB, WS_ACT = WS_Q;
static_assert(WS_WD + (size_t)DM * DFF * 2 <= WS_WIN && WS_WIN + (size_t)INW * DM * 2 <= WS_Q && WS_WGU + (size_t)NGU * DM * 2 <= WS_Q && WS_ACT + (size_t)M * DFF * 2 <= WS_H1B, "ws map");
constexpr int LDS_BYTES = 163840;
constexpr size_t WS_BAR = 16 * KiB, WS_CNT = 32 * KiB, CTL_ZERO = 32 * KiB;

struct Args {
    const float *x, *meta, *g_mix, *w_in, *lb_raw, *g_hn, *pool_w, *pool_scale, *w_a, *w_b, *w_out, *g_ffn, *w_gate, *w_up, *w_down, *g_fin;
    float* out; unsigned char* ws; int ph_lo, ph_hi;
};

#define LDS_WAIT() asm volatile("s_waitcnt lgkmcnt(0)" ::: "memory")
__device__ __forceinline__ float wave_sum(float v) {
#pragma unroll
    for (int o = 1; o < 64; o <<= 1) v += __shfl_xor(v, o);
    return v;
}

__device__ __forceinline__ void tr_item(const float* W, int N, int k0, int n0, u16* WT, int drow0, int dpitch, int dk0, const float* ks, LAS float* scr, int lane) {
#pragma unroll
    for (int i = 0; i < 32; ++i) { const int kk = 2 * i + (lane >> 5); float w = W[(size_t)(k0 + kk) * N + n0 + (lane & 31)]; if (ks) w *= ks[k0 + kk]; scr[kk * 33 + (lane & 31)] = w; }
    LDS_WAIT(); asm volatile("" ::: "memory");
    const int c = lane & 7;
#pragma unroll
    for (int j = 0; j < 4; ++j) { const int n = (lane >> 3) + 8 * j; const LAS float* s = scr + (8 * c) * 33 + n;
        u32x4 o; o.x = cvt_pk_bf16(s[0 * 33], s[1 * 33]); o.y = cvt_pk_bf16(s[2 * 33], s[3 * 33]); o.z = cvt_pk_bf16(s[4 * 33], s[5 * 33]); o.w = cvt_pk_bf16(s[6 * 33], s[7 * 33]);
        *(u32x4*)(WT + (size_t)(drow0 + n) * dpitch + dk0 + k0 + 8 * c) = o; }
    LDS_WAIT(); asm volatile("" ::: "memory");
}
__device__ __forceinline__ void rms_row_bf16(const float* xrow, const float* g, u16* orow, int lane) {
    const f32x4* xr = (const f32x4*)xrow + lane; const f32x4* gr = (const f32x4*)g + lane;
    f32x4 v[4]; float s = 0.f;
#pragma unroll
    for (int j = 0; j < 4; ++j) { v[j] = xr[64 * j]; s += (v[j].x * v[j].x + v[j].y * v[j].y) + (v[j].z * v[j].z + v[j].w * v[j].w); }
    const float rstd = rsqrtf(wave_sum(s) * (1.f / DM) + EPS);
    u32x2* o8 = (u32x2*)orow + lane;
#pragma unroll
    for (int j = 0; j < 4; ++j) { const f32x4 gv = gr[64 * j]; u32x2 o; o.x = cvt_pk_bf16(v[j].x * rstd * gv.x, v[j].y * rstd * gv.y); o.y = cvt_pk_bf16(v[j].z * rstd * gv.z, v[j].w * rstd * gv.w); o8[64 * j] = o; }
}

__device__ __forceinline__ void p0_meta(const Args& a, LAS unsigned char* lds, int j, int tid, int wave, int lane) {
    LAS float* nm = (LAS float*)lds;
    LAS float* part = (LAS float*)(lds + 65536);
#pragma unroll
    for (int rr = 0; rr < 2; ++rr) { const int r = 2 * wave + rr; const f32x4* xr = (const f32x4*)(a.meta + (size_t)r * DM) + lane; const f32x4* gr = (const f32x4*)a.g_mix + lane;
        f32x4 v[4]; float s = 0.f;
#pragma unroll
        for (int q = 0; q < 4; ++q) { v[q] = xr[64 * q]; s += (v[q].x * v[q].x + v[q].y * v[q].y) + (v[q].z * v[q].z + v[q].w * v[q].w); }
        const float rstd = rsqrtf(wave_sum(s) * (1.f / DM) + EPS);
#pragma unroll
        for (int q = 0; q < 4; ++q) { const f32x4 gv = gr[64 * q]; *(LAS f32x4*)(nm + r * 1024 + 4 * (lane + 64 * q)) = (f32x4){v[q].x * rstd * gv.x, v[q].y * rstd * gv.y, v[q].z * rstd * gv.z, v[q].w * rstd * gv.w}; }
    }
    __syncthreads();
    const int colbase = j < 16 ? 1024 + 64 * j : (j < 32 ? 2048 + 64 * (j - 16) : 4096 + 64 * (j - 32));
    {
        const int col = colbase + lane; float acc[16];
#pragma unroll
        for (int r = 0; r < 16; ++r) acc[r] = 0.f;
#pragma unroll 4
        for (int k = 128 * wave; k < 128 * wave + 128; k += 4) {
            const float w0 = a.w_in[(size_t)(k + 0) * INW + col], w1 = a.w_in[(size_t)(k + 1) * INW + col], w2 = a.w_in[(size_t)(k + 2) * INW + col], w3 = a.w_in[(size_t)(k + 3) * INW + col];
#pragma unroll
            for (int r = 0; r < 16; ++r) { const f32x4 n4 = *(const LAS f32x4*)(nm + r * 1024 + k); acc[r] += (n4.x * w0 + n4.y * w1) + (n4.z * w2 + n4.w * w3); }
        }
#pragma unroll
        for (int r = 0; r < 16; ++r) part[(wave * 16 + r) * 64 + lane] = acc[r];
    }
    __syncthreads();
#pragma unroll
    for (int o = 0; o < 2; ++o) {
        const int idx = tid + o * NTHR, r = idx >> 6, cl = idx & 63; float z = 0.f;
#pragma unroll
        for (int w = 0; w < 8; ++w) z += part[(w * 16 + r) * 64 + cl];
        const int col = colbase + cl;
        if (col < 2048) { const int c = col - 1024; const float lb = 1.0f / (1.0f + __expf(a.lb_raw[1024 + c] - a.lb_raw[c])); const float f = lb + (1.0f - lb) * sigm(z);
            const _Float16 hv = (_Float16)__logf(f); ((u16*)(a.ws + WS_GM))[r * 1024 + c] = __builtin_bit_cast(unsigned short, hv); }
        else if (col < 3072) { ((u16*)(a.ws + WS_VM))[r * 1024 + (col - 2048)] = (u16)(cvt_pk_bf16(z, 0.f) & 0xffffu); }
        else { ((u16*)(a.ws + WS_PLM))[r * 512 + (col - 4096)] = (u16)(cvt_pk_bf16(z, 0.f) & 0xffffu); }
    }
    __syncthreads();
}

__device__ __forceinline__ void late_weights(const Args& a, LAS unsigned char* lds, int gw, int NGW) {
    const int lane = threadIdx.x & 63, wave = __builtin_amdgcn_readfirstlane(threadIdx.x >> 6);
    LAS float* scr = (LAS float*)(lds + wave * 16384);
    constexpr int I_A = 16 * 32, I_B = 8 * 32, I_O = 16 * 32, I_D = 44 * 32, I_P = 32;
    constexpr int NIT = I_A + I_B + I_O + I_D + I_P;
    for (int it = gw; it < NIT; it += NGW) {
        int r = it;
        if (r < I_A) { tr_item(a.w_a, 1024, 64 * (r / 32), 32 * (r % 32), (u16*)(a.ws + WS_WAB), 32 * (r % 32), 1536, 0, nullptr, scr, lane); continue; } r -= I_A;
        if (r < I_B) { tr_item(a.w_b, 1024, 64 * (r / 32), 32 * (r % 32), (u16*)(a.ws + WS_WAB), 32 * (r % 32), 1536, 1024, nullptr, scr, lane); continue; } r -= I_B;
        if (r < I_O) { tr_item(a.w_out, 1024, 64 * (r / 32), 32 * (r % 32), (u16*)(a.ws + WS_WOUT), 32 * (r % 32), 1024, 0, nullptr, scr, lane); continue; } r -= I_O;
        if (r < I_D) { tr_item(a.w_down, 1024, 64 * (r / 32), 32 * (r % 32), (u16*)(a.ws + WS_WD), 32 * (r % 32), DFF, 0, nullptr, scr, lane); continue; } r -= I_D;
        { const int gi = r >> 3, q = r & 7; tr_item(a.pool_w + (size_t)gi * 16384, 128, 64 * (q >> 2), 32 * (q & 3), (u16*)(a.ws + WS_PWT) + (size_t)gi * 16384, 32 * (q & 3), 128, 0, nullptr, scr, lane); }
    }
}

__device__ __forceinline__ void p0_prologue(const Args& a, LAS unsigned char* lds, int G, int skip = 0) {
    const int tid = threadIdx.x, lane = tid & 63, wave = __builtin_amdgcn_readfirstlane(tid >> 6);
    const bool split = G > 80;
    if ((int)blockIdx.x < 40) { if (!(skip & 4)) p0_meta(a, lds, (int)blockIdx.x, tid, wave, lane); if (split) return; }
    if (blockIdx.x == 40 || (G <= 40 && blockIdx.x == 0)) { for (int c = tid; c < 1024; c += NTHR) ((float*)(a.ws + WS_LB))[c] = 1.0f / (1.0f + __expf(a.lb_raw[1024 + c] - a.lb_raw[c])); }
    LAS float* scr = (LAS float*)(lds + wave * 16384);
    const int gw = ((int)blockIdx.x - (split ? 40 : 0)) * NWAVES + wave, NGW = (G - (split ? 40 : 0)) * NWAVES;
    constexpr int I_IN = 16 * 208;
    for (int it = gw; it < I_IN && !(skip & 1); it += NGW) tr_item(a.w_in, INW, 64 * (it / 208), 32 * (it % 208), (u16*)(a.ws + WS_WIN), 32 * (it % 208), 1024, 0, nullptr, scr, lane);
    if (G != 256) late_weights(a, lds, gw, NGW);
    u16* XN = (u16*)a.out;
    {
        const f32x4* gr = (const f32x4*)a.g_mix + lane; f32x4 gv[4];
#pragma unroll
        for (int j = 0; j < 4; ++j) gv[j] = gr[64 * j];
        for (int m = 4 * gw; m < M && !(skip & 2); m += 4 * NGW) {
            const f32x4* xr = (const f32x4*)(a.x + (size_t)m * DM) + lane; f32x4 v[16]; float ss[4];
#pragma unroll
            for (int j = 0; j < 16; ++j) v[j] = xr[64 * j];
#pragma unroll
            for (int rr = 0; rr < 4; ++rr) { float t = 0.f;
#pragma unroll
                for (int j = 0; j < 4; ++j) { const f32x4 w = v[4 * rr + j]; t += (w.x * w.x + w.y * w.y) + (w.z * w.z + w.w * w.w); }
                ss[rr] = t; }
#pragma unroll
            for (int o = 1; o < 64; o <<= 1) {
#pragma unroll
                for (int rr = 0; rr < 4; ++rr) ss[rr] += __shfl_xor(ss[rr], o); }
            u32x2* o8 = (u32x2*)(XN + (size_t)m * DM) + lane;
#pragma unroll
            for (int j = 0; j < 16; ++j) { const float rs = rsqrtf(ss[j >> 2] * (1.f / DM) + EPS); const f32x4 g4 = gv[j & 3]; u32x2 o; o.x = cvt_pk_bf16(v[j].x * rs * g4.x, v[j].y * rs * g4.y); o.y = cvt_pk_bf16(v[j].z * rs * g4.z, v[j].w * rs * g4.w); o8[64 * j] = o; }
        }
    }
}

struct EpiIn {
    static constexpr bool PERM = true, MID = false, AFTER = false;
    unsigned char* ws;
    __device__ __forceinline__ void mid(f32x4 (&)[2][2][4][2], const pg8::Unit&, int, int, int, int) const {}
    __device__ __forceinline__ void operator()(f32x4 (&acc)[2][2][4][2], const pg8::Unit& u, int wr, int wc, int fr, int fq) const {
        const int colt = u.pn * 256; int type, c0; size_t boff;
        if (colt < 1024) { type = 1; boff = WS_Q; c0 = colt; }
        else if (colt < 2048) { type = 3; boff = WS_G; c0 = colt - 1024; }
        else if (colt < 3072) { type = 0; boff = WS_V; c0 = colt - 2048; }
        else if (colt < 4096) { type = 1; boff = WS_OG; c0 = colt - 3072; }
        else if (colt < 4608) { type = 0; boff = WS_PB; c0 = colt - 4096 + 512; }
        else if (colt < 5632) { type = 2; boff = WS_GA; c0 = colt - 4608; }
        else { type = 2; boff = WS_GB; c0 = colt - 5632; }
        u16* base = (u16*)(ws + boff);
        const int col0 = c0 + wc * 32 + 8 * fq, row0 = u.pm * 256 + wr * 64 + fr;
        const float* LB = (const float*)(ws + WS_LB);
        f32x4 lbv[2][2];
        if (type == 3) {
#pragma unroll
            for (int bj = 0; bj < 2; ++bj) { lbv[bj][0] = *(const f32x4*)(LB + col0 + bj * 128); lbv[bj][1] = *(const f32x4*)(LB + col0 + bj * 128 + 4); }
        } else {
#pragma unroll
            for (int bj = 0; bj < 2; ++bj) { lbv[bj][0] = (f32x4){0.f, 0.f, 0.f, 0.f}; lbv[bj][1] = (f32x4){0.f, 0.f, 0.f, 0.f}; }
        }
#pragma unroll
        for (int ai = 0; ai < 2; ++ai)
#pragma unroll
            for (int m = 0; m < 4; ++m) { u16* rowp = base + (size_t)(row0 + ai * 128 + m * 16) * 1024 + col0;
#pragma unroll
                for (int bj = 0; bj < 2; ++bj) { f32x4 v0 = acc[ai][bj][m][0], v1 = acc[ai][bj][m][1]; u32x4 w;
                    if (type == 3) {
                        const f32x4 l0 = lbv[bj][0], l1 = lbv[bj][1];
#pragma unroll
                        for (int e = 0; e < 4; ++e) { v0[e] = __logf(l0[e] + (1.0f - l0[e]) * sigm(v0[e])); v1[e] = __logf(l1[e] + (1.0f - l1[e]) * sigm(v1[e])); }
                        w.x = pk_h(v0[0], v0[1]); w.y = pk_h(v0[2], v0[3]); w.z = pk_h(v1[0], v1[1]); w.w = pk_h(v1[2], v1[3]);
                    } else {
                        if (type == 1) {
#pragma unroll
                            for (int e = 0; e < 4; ++e) { v0[e] = v0[e] * sigm(v0[e]); v1[e] = v1[e] * sigm(v1[e]); }
                        } else if (type == 2) {
#pragma unroll
                            for (int e = 0; e < 4; ++e) { v0[e] = sigm(v0[e]); v1[e] = sigm(v1[e]); }
                        }
                        w.x = cvt_pk_bf16(v0[0], v0[1]); w.y = cvt_pk_bf16(v0[2], v0[3]); w.z = cvt_pk_bf16(v1[0], v1[1]); w.w = cvt_pk_bf16(v1[2], v1[3]);
                    }
                    *(u32x4*)(rowp + bj * 128) = w; } }
    }
};
struct EpiMerge {
    static constexpr bool PERM = true, MID = true, AFTER = false;
    const u16 *GA, *GB; u16* MG;
    __device__ __forceinline__ void mid(f32x4 (&acc)[2][2][4][2], const pg8::Unit& u, int wr, int wc, int fr, int fq) const {
        int zz = 0; asm volatile("" : "+v"(zz));
        const int col0 = u.pn * 256 + wc * 32 + 8 * fq, row0 = u.pm * 256 + wr * 64 + fr + zz;
#pragma unroll
        for (int ai = 0; ai < 2; ++ai)
#pragma unroll
            for (int m = 0; m < 4; ++m) { const size_t off = (size_t)(row0 + ai * 128 + m * 16) * 1024 + col0;
#pragma unroll
                for (int bj = 0; bj < 2; ++bj) { const u32x4 ga = *(const u32x4*)(GA + off + bj * 128), gb = *(const u32x4*)(GB + off + bj * 128);
#pragma unroll
                    for (int e = 0; e < 2; ++e) { acc[ai][bj][m][0][2 * e] *= bf_lo(ga[e]) * __builtin_amdgcn_rcpf(bf_lo(gb[e])); acc[ai][bj][m][0][2 * e + 1] *= bf_hi(ga[e]) * __builtin_amdgcn_rcpf(bf_hi(gb[e]));
                        acc[ai][bj][m][1][2 * e] *= bf_lo(ga[2 + e]) * __builtin_amdgcn_rcpf(bf_lo(gb[2 + e])); acc[ai][bj][m][1][2 * e + 1] *= bf_hi(ga[2 + e]) * __builtin_amdgcn_rcpf(bf_hi(gb[2 + e])); } }
                asm volatile("" ::: "memory"); }
    }
    __device__ __forceinline__ void operator()(f32x4 (&acc)[2][2][4][2], const pg8::Unit& u, int wr, int wc, int fr, int fq) const {
        const int col0 = u.pn * 256 + wc * 32 + 8 * fq, row0 = u.pm * 256 + wr * 64 + fr;
#pragma unroll
        for (int ai = 0; ai < 2; ++ai)
#pragma unroll
            for (int m = 0; m < 4; ++m) { const size_t off = (size_t)(row0 + ai * 128 + m * 16) * 1024 + col0;
#pragma unroll
                for (int bj = 0; bj < 2; ++bj) { const u32x4 gb = *(const u32x4*)(GB + off + bj * 128);
                    acc[ai][bj][m][0] *= (f32x4){bf_lo(gb[0]), bf_hi(gb[0]), bf_lo(gb[1]), bf_hi(gb[1])}; acc[ai][bj][m][1] *= (f32x4){bf_lo(gb[2]), bf_hi(gb[2]), bf_lo(gb[3]), bf_hi(gb[3])}; } }
#pragma unroll
        for (int ai = 0; ai < 2; ++ai)
#pragma unroll
            for (int m = 0; m < 4; ++m) { const size_t off = (size_t)(row0 + ai * 128 + m * 16) * 1024 + col0;
#pragma unroll
                for (int bj = 0; bj < 2; ++bj) { const f32x4 v0 = acc[ai][bj][m][0], v1 = acc[ai][bj][m][1]; u32x4 w;
                    w.x = cvt_pk_bf16(v0[0], v0[1]); w.y = cvt_pk_bf16(v0[2], v0[3]); w.z = cvt_pk_bf16(v1[0], v1[1]); w.w = cvt_pk_bf16(v1[2], v1[3]);
                    *(u32x4*)(MG + off + bj * 128) = w; } }
    }
};
template <bool WITH_BF16>
struct EpiRes {
    static constexpr bool PERM = false, MID = false, AFTER = false;
    const float* base; float* H; u16* Hb; float* rsq;
    __device__ __forceinline__ void mid(f32x4 (&)[2][2][4][2], const pg8::Unit&, int, int, int, int) const {}
    __device__ __forceinline__ void operator()(f32x4 (&acc)[2][2][4][2], const pg8::Unit& u, int wr, int wc, int fr, int fq) const {
        const int col0 = u.pn * 256 + wc * 32 + 4 * fq, row0 = u.pm * 256 + wr * 64 + fr;
#pragma unroll
        for (int ai = 0; ai < 2; ++ai) {
            f32x4 pre[4][2][2];
#pragma unroll
            for (int m = 0; m < 4; ++m) { const size_t off = (size_t)(row0 + ai * 128 + m * 16) * 1024 + col0;
#pragma unroll
                for (int bj = 0; bj < 2; ++bj)
#pragma unroll
                    for (int n = 0; n < 2; ++n) pre[m][bj][n] = *(const f32x4*)(base + off + bj * 128 + n * 16); }
            asm volatile("" ::: "memory");
#pragma unroll
            for (int m = 0; m < 4; ++m) { const int row = row0 + ai * 128 + m * 16; const size_t off = (size_t)row * 1024 + col0; float s = 0.f;
#pragma unroll
                for (int bj = 0; bj < 2; ++bj)
#pragma unroll
                    for (int n = 0; n < 2; ++n) { const f32x4 hv = pre[m][bj][n] + acc[ai][bj][m][n];
                        *(f32x4*)(H + off + bj * 128 + n * 16) = hv; s += (hv[0] * hv[0] + hv[1] * hv[1]) + (hv[2] * hv[2] + hv[3] * hv[3]);
                        if (WITH_BF16) { u32x2 w; w.x = cvt_pk_bf16(hv[0], hv[1]); w.y = cvt_pk_bf16(hv[2], hv[3]); *(u32x2*)(Hb + off + bj * 128 + n * 16) = w; } }
                s += __shfl_xor(s, 16); s += __shfl_xor(s, 32);
                if (fq == 0) rsq[(size_t)row * 16 + u.pn * 4 + wc] = s; }
            asm volatile("" ::: "memory");
        }
    }
};
struct EpiFfn1 {
    static constexpr bool PERM = true, MID = false, AFTER = false;
    const float* rsq; u16* ACT;
    __device__ __forceinline__ void mid(f32x4 (&)[2][2][4][2], const pg8::Unit&, int, int, int, int) const {}
    __device__ __forceinline__ void operator()(const f32x4 (&acc)[2][2][4][2], const pg8::Unit& u, int wr, int wc, int fr, int fq) const {
        const int col0 = u.pn * 128 + wc * 32 + 8 * fq, row0 = u.pm * 256 + wr * 64 + fr;
        float rstdv[2][4];
#pragma unroll
        for (int ai = 0; ai < 2; ++ai)
#pragma unroll
            for (int m = 0; m < 4; ++m) { const int row = row0 + ai * 128 + m * 16; const f32x4* rp = (const f32x4*)(rsq + (size_t)row * 16);
                const f32x4 r0 = rp[0], r1 = rp[1], r2 = rp[2], r3 = rp[3];
                const float ss = ((r0[0] + r0[1]) + (r0[2] + r0[3])) + ((r1[0] + r1[1]) + (r1[2] + r1[3])) + ((r2[0] + r2[1]) + (r2[2] + r2[3])) + ((r3[0] + r3[1]) + (r3[2] + r3[3]));
                rstdv[ai][m] = rsqrtf(ss * (1.f / DM) + EPS); }
#pragma unroll
        for (int ai = 0; ai < 2; ++ai)
#pragma unroll
            for (int m = 0; m < 4; ++m) { const int row = row0 + ai * 128 + m * 16;
                const float rstd = rstdv[ai][m];
                float o[8];
#pragma unroll
                for (int n = 0; n < 2; ++n)
#pragma unroll
                    for (int e = 0; e < 4; ++e) { const float gt = acc[ai][0][m][n][e] * rstd, up = acc[ai][1][m][n][e] * rstd; o[4 * n + e] = gt * sigm(gt) * up; }
                u32x4 w; w.x = cvt_pk_bf16(o[0], o[1]); w.y = cvt_pk_bf16(o[2], o[3]); w.z = cvt_pk_bf16(o[4], o[5]); w.w = cvt_pk_bf16(o[6], o[7]);
                *(u32x4*)(ACT + (size_t)row * DFF + col0) = w; }
    }
};

struct EpiResNorm {
    static constexpr bool PERM = false, MID = false, AFTER = true;
    const float* base; float* out; const float* gfin; float* slots; unsigned* cnt;
    __device__ __forceinline__ void mid(f32x4 (&)[2][2][4][2], const pg8::Unit&, int, int, int, int) const {}
    __device__ __forceinline__ void operator()(const f32x4 (&)[2][2][4][2], const pg8::Unit&, int, int, int, int) const {}
    __device__ __forceinline__ void after(f32x4 (&acc)[2][2][4][2], const pg8::Unit& u, int wr, int wc, int fr, int fq, LAS unsigned char* lds, int wid, int lane) const {
        LAS float* P = (LAS float*)lds; LAS float* R = (LAS float*)(lds + 4096);
        const int col0 = u.pn * 256 + wc * 32 + 4 * fq;
#pragma unroll
        for (int ai = 0; ai < 2; ++ai)
#pragma unroll
            for (int m = 0; m < 4; ++m) { const int rl = ai * 128 + wr * 64 + m * 16 + fr; const size_t off = (size_t)(u.pm * 256 + rl) * 1024 + col0; float s = 0.f;
#pragma unroll
                for (int bj = 0; bj < 2; ++bj)
#pragma unroll
                    for (int n = 0; n < 2; ++n) { const f32x4 hv = *(const f32x4*)(base + off + bj * 128 + n * 16) + acc[ai][bj][m][n]; acc[ai][bj][m][n] = hv; s += (hv[0] * hv[0] + hv[1] * hv[1]) + (hv[2] * hv[2] + hv[3] * hv[3]); }
                s += __shfl_xor(s, 16); s += __shfl_xor(s, 32);
                if (fq == 0) P[rl * 4 + wc] = s;
                if (m & 1) asm volatile("" ::: "memory"); }
        asm volatile("s_waitcnt lgkmcnt(0)" ::: "memory"); __builtin_amdgcn_s_barrier(); asm volatile("" ::: "memory");
        const int row = wid * 32 + (lane & 31);
        unsigned* slot = (unsigned*)slots + (size_t)(u.pm * 256 + row) * 16;
        if (lane < 32) { const float t = (P[row * 4 + 0] + P[row * 4 + 1]) + (P[row * 4 + 2] + P[row * 4 + 3]);
            __hip_atomic_store(slot + u.pn, __float_as_uint(t), __ATOMIC_RELAXED, __HIP_MEMORY_SCOPE_AGENT); }
        asm volatile("s_waitcnt vmcnt(0)" ::: "memory");
        if (lane == 0) __hip_atomic_fetch_add(cnt + 64 * u.pm, 1u, __ATOMIC_RELAXED, __HIP_MEMORY_SCOPE_AGENT);
        if (wid == 0) { unsigned sp = 0;
            while ((unsigned)__builtin_amdgcn_readfirstlane(__hip_atomic_load(cnt + 64 * u.pm, __ATOMIC_RELAXED, __HIP_MEMORY_SCOPE_AGENT)) < 32u) { __builtin_amdgcn_s_sleep(2); if (++sp > (1u << 20)) break; }
            __builtin_amdgcn_fence(__ATOMIC_ACQUIRE, "agent"); }
        asm volatile("s_waitcnt vmcnt(0) lgkmcnt(0)" ::: "memory"); __builtin_amdgcn_s_barrier(); asm volatile("" ::: "memory");
        if (lane < 32) { float t = 0.f;
#pragma unroll
            for (int k = 0; k < 4; ++k) t += __uint_as_float(__hip_atomic_load(slot + k, __ATOMIC_RELAXED, __HIP_MEMORY_SCOPE_AGENT));
            R[row] = rsqrtf(t * (1.f / DM) + EPS); }
        asm volatile("s_waitcnt lgkmcnt(0)" ::: "memory"); __builtin_amdgcn_s_barrier(); asm volatile("" ::: "memory");
        f32x4 gv[2][2];
#pragma unroll
        for (int bj = 0; bj < 2; ++bj)
#pragma unroll
            for (int n = 0; n < 2; ++n) gv[bj][n] = *(const f32x4*)(gfin + col0 + bj * 128 + n * 16);
#pragma unroll
        for (int ai = 0; ai < 2; ++ai)
#pragma unroll
            for (int m = 0; m < 4; ++m) { const int rl = ai * 128 + wr * 64 + m * 16 + fr; const size_t off = (size_t)(u.pm * 256 + rl) * 1024 + col0; const float rs = R[rl];
#pragma unroll
                for (int bj = 0; bj < 2; ++bj)
#pragma unroll
                    for (int n = 0; n < 2; ++n) *(f32x4*)(out + off + bj * 128 + n * 16) = acc[ai][bj][m][n] * rs * gv[bj][n]; }
    }
};
#define RLX_AGENT __ATOMIC_RELAXED, __HIP_MEMORY_SCOPE_AGENT
#define XB_TMO      128
#define XB_XCNT(j)  (256  + 64 * (j))
#define XB_XSUB(j)  (1280 + 64 * (j))
#define XB_XGEN(j)  (2304 + 64 * (j))
#define XB_TOP      3328
#define XB_TOPGEN   3392
#define XCD_BAR_WORDS 3456
#define XB_SPIN_CAP (1u << 18)

__device__ __forceinline__ unsigned xb_ld(unsigned* p)              { return __hip_atomic_load(p, __ATOMIC_RELAXED, __HIP_MEMORY_SCOPE_AGENT); }
__device__ __forceinline__ unsigned xb_add(unsigned* p, unsigned v) { return __hip_atomic_fetch_add(p, v, __ATOMIC_RELAXED, __HIP_MEMORY_SCOPE_AGENT); }
__device__ __forceinline__ unsigned xb_xcc_id() { return (unsigned)__builtin_amdgcn_s_getreg((3 << 11) | 20) & 0xFu; }
#define XB_SPIN(cond, bar) do { unsigned _sp = 0; while (cond) { __builtin_amdgcn_s_sleep(1); \
    if ((++_sp & 255u) == 0u) { if (xb_ld(&(bar)[XB_TMO])) break; if (_sp > XB_SPIN_CAP) { atomicAdd(&(bar)[XB_TMO], 1u); break; } } } } while (0)

struct XcdBarrier {
    unsigned* bar; unsigned x;
    volatile LAS unsigned* st;
};

__device__ __forceinline__ XcdBarrier xcd_barrier_post(unsigned* bar, volatile LAS unsigned* st) {
    XcdBarrier b; b.bar = bar; b.x = xb_xcc_id(); b.st = st;
    if (threadIdx.x == 0) (void)xb_add(&bar[XB_XCNT(b.x)], 1u);
    return b;
}
__device__ __forceinline__ void xcd_barrier_complete(unsigned* bar, unsigned x, unsigned& nloc, unsigned& nx) {
    const unsigned G = gridDim.x * gridDim.y * gridDim.z;
    unsigned sum, cnt, mine, sp = 0u;
    for (;;) {
        sum = 0u; cnt = 0u; mine = 0u;
#pragma unroll
        for (unsigned j = 0; j < 16; ++j) { const unsigned c = xb_ld(&bar[XB_XCNT(j)]); sum += c; cnt += (c > 0u) ? 1u : 0u; mine = (j == x) ? c : mine; }
        if (sum == G) break;
        __builtin_amdgcn_s_sleep(1);
        if ((++sp & 255u) == 0u) { if (xb_ld(&bar[XB_TMO])) break; if (sp > XB_SPIN_CAP) { atomicAdd(&bar[XB_TMO], 1u); break; } }
    }
    nloc = mine > 0u ? mine : 1u; nx = cnt > 0u ? cnt : 1u;
}

__device__ __forceinline__ void xcd_barrier(const XcdBarrier& b) {
    asm volatile("s_waitcnt vmcnt(0)" ::: "memory");
    __syncthreads();
    if (threadIdx.x == 0) {
        unsigned* bar = b.bar;
        __builtin_amdgcn_s_waitcnt(0);
        unsigned nloc = b.st[0], nx = b.st[1];
        if (nloc == 0u) { xcd_barrier_complete(bar, b.x, nloc, nx); b.st[0] = nloc; b.st[1] = nx; }
        const unsigned old = xb_add(&bar[XB_XSUB(b.x)], 1u);
        const unsigned gen = old / nloc;
        if (old + 1u == (gen + 1u) * nloc) {
            __builtin_amdgcn_fence(__ATOMIC_RELEASE, "agent");
            asm volatile("s_waitcnt vmcnt(0)" ::: "memory");
            const unsigned og = xb_add(&bar[XB_TOP], 1u);
            const unsigned tg = og / nx;
            if (og + 1u == (tg + 1u) * nx) xb_add(&bar[XB_TOPGEN], 1u);
            else XB_SPIN(xb_ld(&bar[XB_TOPGEN]) == tg, bar);
            __builtin_amdgcn_fence(__ATOMIC_ACQUIRE, "agent");
            xb_add(&bar[XB_XGEN(b.x)], 1u);
            asm volatile("s_waitcnt vmcnt(0)" ::: "memory");
        } else {
            XB_SPIN(xb_ld(&bar[XB_XGEN(b.x)]) == gen, bar);
            __builtin_amdgcn_fence(__ATOMIC_ACQUIRE, "agent");
            asm volatile("s_waitcnt vmcnt(0)" ::: "memory");
        }
    }
    __syncthreads();
}

__device__ __forceinline__ void p2_wave(const u16* Gp, const u16* Vp, int nrows, int h, u16* Uout, float* dk, int lane) {
    const int r = lane & 15, q = lane >> 4;
    bf16x8 kf[8][2]; float tot1[8];
#pragma unroll
    for (int kk = 0; kk < 2; ++kk) { const int ks = 1 - kk;
#pragma unroll
        for (int dg = 0; dg < 2; ++dg) {
            int zz = 0; asm volatile("" : "+v"(zz));
            u32x4 wq[4];
#pragma unroll
            for (int p2 = 0; p2 < 2; ++p2) { const int dp = 2 * dg + p2; const int dcol = 32 * dp + 2 * r + zz; unsigned gw[8];
#pragma unroll
                for (int j = 0; j < 8; ++j) { const int s = 32 * ks + 8 * q + j; gw[j] = s < nrows ? *(const unsigned*)(Gp + (size_t)s * 1024 + h * 128 + dcol) : 0u; }
#pragma unroll
                for (int par = 0; par < 2; ++par) { const int dt = 2 * dp + par; float gv[8];
#pragma unroll
                    for (int j = 0; j < 8; ++j) gv[j] = h2f((u16)(par ? (gw[j] >> 16) : (gw[j] & 0xffffu)));
                    float suf[8]; float run = 0.f;
#pragma unroll
                    for (int j = 7; j >= 0; --j) { suf[j] = run; run += gv[j]; }
                    const float T = run, ta = __shfl_xor(T, 16), tb = __shfl_xor(T, 32), tc = __shfl_xor(ta, 32);
                    const float after = ((q ^ 1) > q ? ta : 0.f) + ((q ^ 2) > q ? tb : 0.f) + ((q ^ 3) > q ? tc : 0.f);
                    const float tot = (T + ta) + (tb + tc);
                    float base;
                    if (ks == 1) { tot1[dt] = tot; base = after; } else { base = after + tot1[dt]; if (dk && q == 0) dk[h * 128 + dcol + par] = __expf(tot + tot1[dt]); }
                    float kh[8];
#pragma unroll
                    for (int j = 0; j < 8; ++j) kh[j] = (1.0f - __expf(gv[j])) * __expf(suf[j] + base);
                    u32x4& w = wq[2 * p2 + par];
                    w.x = cvt_pk_bf16(kh[0], kh[1]); w.y = cvt_pk_bf16(kh[2], kh[3]); w.z = cvt_pk_bf16(kh[4], kh[5]); w.w = cvt_pk_bf16(kh[6], kh[7]); } }
            asm volatile("" : "+v"(wq[0].x), "+v"(wq[0].y), "+v"(wq[0].z), "+v"(wq[0].w), "+v"(wq[1].x), "+v"(wq[1].y), "+v"(wq[1].z), "+v"(wq[1].w),
                              "+v"(wq[2].x), "+v"(wq[2].y), "+v"(wq[2].z), "+v"(wq[2].w), "+v"(wq[3].x), "+v"(wq[3].y), "+v"(wq[3].z), "+v"(wq[3].w));
#pragma unroll
            for (int d4 = 0; d4 < 4; ++d4) kf[4 * dg + d4][ks] = __builtin_bit_cast(bf16x8, wq[d4]); } }
#pragma unroll 1
    for (int ep = 0; ep < 4; ++ep) {
        int zz = 0; asm volatile("" : "+v"(zz)); const int ecol = 32 * ep + 2 * r + zz;
        unsigned vw[2][8];
#pragma unroll
        for (int ks = 0; ks < 2; ++ks)
#pragma unroll
            for (int j = 0; j < 8; ++j) { const int s = 32 * ks + 8 * q + j; vw[ks][j] = s < nrows ? *(const unsigned*)(Vp + (size_t)s * 1024 + h * 128 + ecol) : 0u; }
#pragma unroll
        for (int par = 0; par < 2; ++par) {
            bf16x8 vf[2];
#pragma unroll
            for (int ks = 0; ks < 2; ++ks) { u32x4 w;
                if (par == 0) { w.x = (vw[ks][0] & 0xffffu) | (vw[ks][1] << 16); w.y = (vw[ks][2] & 0xffffu) | (vw[ks][3] << 16); w.z = (vw[ks][4] & 0xffffu) | (vw[ks][5] << 16); w.w = (vw[ks][6] & 0xffffu) | (vw[ks][7] << 16); }
                else { w.x = (vw[ks][0] >> 16) | (vw[ks][1] & 0xffff0000u); w.y = (vw[ks][2] >> 16) | (vw[ks][3] & 0xffff0000u); w.z = (vw[ks][4] >> 16) | (vw[ks][5] & 0xffff0000u); w.w = (vw[ks][6] >> 16) | (vw[ks][7] & 0xffff0000u); }
                vf[ks] = __builtin_bit_cast(bf16x8, w); }
            f32x4 acc[8];
#pragma unroll
            for (int dt = 0; dt < 8; ++dt) { acc[dt] = (f32x4){0.f, 0.f, 0.f, 0.f};
#pragma unroll
                for (int ks = 0; ks < 2; ++ks) acc[dt] = __builtin_amdgcn_mfma_f32_16x16x32_bf16(kf[dt][ks], vf[ks], acc[dt], 0, 0, 0); }
#pragma unroll
            for (int dp = 0; dp < 4; ++dp) { u32x4 w; w.x = cvt_pk_bf16(acc[2 * dp][0], acc[2 * dp + 1][0]); w.y = cvt_pk_bf16(acc[2 * dp][1], acc[2 * dp + 1][1]); w.z = cvt_pk_bf16(acc[2 * dp][2], acc[2 * dp + 1][2]); w.w = cvt_pk_bf16(acc[2 * dp][3], acc[2 * dp + 1][3]);
                { const int e = 32 * ep + 2 * r + par;
                  *(u32x4*)(Uout + ((size_t)((e >> 4) * 4 + dp) * 64 + q * 16 + (e & 15)) * 8) = w; } } }
    }
}
__device__ __forceinline__ void p2_states(const Args& a, int G) {
    const int tid = threadIdx.x, lane = tid & 63, wave = __builtin_amdgcn_readfirstlane(tid >> 6);
    const u16* Gb = (const u16*)(a.ws + WS_G); const u16* Vb = (const u16*)(a.ws + WS_V); u16* US = (u16*)a.out; float* DK = (float*)(a.ws + WS_DK);
    for (int it = blockIdx.x; it < BATCH * NCH + 1; it += G) {
        if (it < BATCH * NCH) { const size_t row0 = (size_t)it * CHK;
            p2_wave(Gb + row0 * 1024, Vb + row0 * 1024, CHK, wave, US + ((size_t)it * 8 + wave) * 16384, DK + (size_t)it * 1024, lane); }
        else p2_wave((const u16*)(a.ws + WS_GM), (const u16*)(a.ws + WS_VM), NMETA, wave, (u16*)(a.ws + WS_UM) + (size_t)wave * 16384, nullptr, lane);
    }
}

__device__ __forceinline__ void p3_scan(const Args& a, LAS unsigned char* lds, int G) {
    const int tid = threadIdx.x, lane = tid & 63, wave = __builtin_amdgcn_readfirstlane(tid >> 6);
    {
        LAS float* scr = (LAS float*)(lds + wave * 16384);
        const int gw = (int)blockIdx.x * NWAVES + wave, NGW = G * NWAVES;
        for (int it = gw; it < 2 * 16 * 88; it += NGW) { const int up = it >= 16 * 88, r = up ? it - 16 * 88 : it, kb = r / 88, nb = r % 88, n0 = 32 * nb;
            tr_item(up ? a.w_up : a.w_gate, DFF, 64 * kb, n0, (u16*)(a.ws + WS_WGU), (n0 >> 7) * 256 + (n0 & 127) + (up ? 128 : 0), 1024, 0, a.g_ffn, scr, lane); }
    }
    u16* US = (u16*)a.out; const float* DK = (const float*)(a.ws + WS_DK); const u16* UM = (const u16*)(a.ws + WS_UM);
    for (int idx = blockIdx.x * NTHR + tid; idx < BATCH * 8 * 128 * 64; idx += G * NTHR) {
        const int pr = idx & 8191, h = (idx >> 13) & 7, b = idx >> 16;
        const int d = 32 * ((pr >> 8) & 3) + 8 * ((pr >> 6) & 3) + 2 * (pr & 3);
        const unsigned um = *(const unsigned*)(UM + (size_t)h * 16384 + 2 * pr);
        float s0 = bf_lo(um), s1 = bf_hi(um);
        unsigned* up = (unsigned*)(US + ((size_t)(b * NCH) * 8 + h) * 16384 + 2 * pr);
        const float* dkp = DK + (size_t)(b * NCH) * 1024 + h * 128 + d;
#pragma unroll 1
        for (int c0 = 0; c0 < NCH; c0 += 16) {
            unsigned uu[16]; float dd0[16], dd1[16];
#pragma unroll
            for (int i = 0; i < 16; ++i) { uu[i] = up[(size_t)(c0 + i) * 8 * 8192]; dd0[i] = dkp[(size_t)(c0 + i) * 1024]; dd1[i] = dkp[(size_t)(c0 + i) * 1024 + 1]; }
#pragma unroll
            for (int i = 0; i < 16; ++i) { up[(size_t)(c0 + i) * 8 * 8192] = cvt_pk_bf16(s0, s1); s0 = dd0[i] * s0 + bf_lo(uu[i]); s1 = dd1[i] * s1 + bf_hi(uu[i]); }
        }
    }
}

constexpr int P4_PITCH = 272, P4_MAT = 64 * P4_PITCH  , P4_VPITCH = 136, P4_HS = 4 * P4_MAT  , P4_TOT = 2 * P4_HS  , P4_PLD = P4_TOT + 4096  ;
static_assert(P4_PLD + P4_MAT + 64 <= LDS_BYTES, "LDS map");
__device__ __forceinline__ unsigned ld_pl(const u16* PB, const u16* PLM, int b, int tx, int cofs) {
    return tx >= 0 ? *(const unsigned*)(PB + (size_t)(b * SEQ + tx) * 1024 + 512 + cofs) : *(const unsigned*)(PLM + (size_t)(NMETA + tx) * 512 + cofs);
}
__device__ __forceinline__ void p4_outputs(const Args& a, LAS unsigned char* lds, int G, int skip = 0) {
    (void)skip;
    const int tid = threadIdx.x, lane = tid & 63, wave = __builtin_amdgcn_readfirstlane(tid >> 6);
    const int r = lane & 15, q = lane >> 4;
    u16* Qb = (u16*)(a.ws + WS_Q); const u16* Gb = (const u16*)(a.ws + WS_G); const u16* Vb = (const u16*)(a.ws + WS_V); const u16* OGb = (const u16*)(a.ws + WS_OG);
    u16* PB = (u16*)(a.ws + WS_PB); const u16* PLM = (const u16*)(a.ws + WS_PLM); const u16* PWT = (const u16*)(a.ws + WS_PWT); const u16* US = (const u16*)a.out;
    LAS unsigned char* PLD = lds + P4_PLD;
    for (int item = blockIdx.x; item < BATCH * NCH * 4; item += G) {
        const int hp = item & 3, bc = item >> 2, c = bc & (NCH - 1), b = bc >> 7;
        const size_t row0 = (size_t)b * SEQ + (size_t)c * CHK;
        const int hs = wave >> 2, tq = wave & 3, h = 2 * hp + hs;
        LAS unsigned char* L = lds + hs * P4_HS;
        LAS unsigned char* KT = L, *QT = L + P4_MAT, *QH = L + 2 * P4_MAT, *VT = L + 3 * P4_MAT;
        LAS float* TOT = (LAS float*)(lds + P4_TOT) + hs * 512;
        const int d0 = 2 * lane; const size_t cofs = (size_t)h * 128 + d0;
        unsigned gp[16], qv[16], vv[16];
#pragma unroll
        for (int i = 0; i < 16; ++i) { const size_t o = (row0 + 16 * tq + i) * 1024 + cofs; gp[i] = *(const unsigned*)(Gb + o); qv[i] = *(const unsigned*)(Qb + o); vv[i] = *(const unsigned*)(Vb + o); }
        const int gi = hp, wlen = 2 << gi; const float inv = 1.0f / (float)wlen;
        const int t0 = 8 * wave, pcofs = gi * 128 + 2 * lane, tx0 = c * CHK + t0;
        unsigned pu[23];
#pragma unroll
        for (int j = 1; j < 16; ++j) pu[15 - j] = (j < wlen) ? ld_pl(PB, PLM, b, tx0 - j, pcofs) : 0u;
#pragma unroll
        for (int i = 0; i < 8; ++i) pu[15 + i] = ld_pl(PB, PLM, b, tx0 + i, pcofs);
        bf16x8 wf[4];
#pragma unroll
        for (int kd = 0; kd < 4; ++kd) wf[kd] = *(const bf16x8*)(PWT + (size_t)(gi * 128 + 16 * wave + r) * 128 + 32 * kd + 8 * q);
        float s0 = 0.f, s1 = 0.f;
#pragma unroll
        for (int i = 0; i < 16; ++i) { s0 += h2f((u16)(gp[i] & 0xffffu)); s1 += h2f((u16)(gp[i] >> 16)); }
        TOT[tq * 128 + d0] = s0; TOT[tq * 128 + d0 + 1] = s1;
        __syncthreads();
        {
            float w0 = 0.f, w1 = 0.f;
#pragma unroll
            for (int j = 1; j < 16; ++j) if (j < wlen) { w0 += bf_lo(pu[15 - j]); w1 += bf_hi(pu[15 - j]); }
#pragma unroll
            for (int i = 0; i < 8; ++i) { const float u0 = bf_lo(pu[15 + i]), u1 = bf_hi(pu[15 + i]); w0 += u0; w1 += u1;
                *(LAS unsigned*)(PLD + (t0 + i) * P4_PITCH + 4 * lane) = cvt_pk_bf16(w0 * inv - u0, w1 * inv - u1);
                const unsigned o = wlen == 2 ? pu[15 + i - 1] : (wlen == 4 ? pu[15 + i - 3] : (wlen == 8 ? pu[15 + i - 7] : pu[15 + i - 15]));
                w0 -= bf_lo(o); w1 -= bf_hi(o); }
        }
        float b0 = 0.f, b1 = 0.f;
#pragma unroll
        for (int t2 = 0; t2 < 3; ++t2) if (t2 < tq) { b0 += TOT[t2 * 128 + d0]; b1 += TOT[t2 * 128 + d0 + 1]; }
        const float bm0 = TOT[d0] + TOT[128 + d0], bm1 = TOT[d0 + 1] + TOT[128 + d0 + 1];
#pragma unroll
        for (int i = 0; i < 16; ++i) { const int t = 16 * tq + i; const float g0 = h2f((u16)(gp[i] & 0xffffu)), g1 = h2f((u16)(gp[i] >> 16)); b0 += g0; b1 += g1;
            const unsigned q2 = qv[i], v2 = vv[i];
            const float q0 = bf_lo(q2), q1 = bf_hi(q2), k0 = 1.0f - __expf(g0), k1 = 1.0f - __expf(g1);
            const float eb0 = __expf(b0), eb1 = __expf(b1), em0 = __expf(fminf(b0 - bm0, 80.f)), em1 = __expf(fminf(b1 - bm1, 80.f)), ek0 = __expf(fminf(bm0 - b0, 80.f)), ek1 = __expf(fminf(bm1 - b1, 80.f));
            *(LAS unsigned*)(QT + t * P4_PITCH + d0 * 2) = cvt_pk_bf16(q0 * em0, q1 * em1);
            *(LAS unsigned*)(QH + t * P4_PITCH + d0 * 2) = cvt_pk_bf16(q0 * eb0, q1 * eb1);
            *(LAS unsigned*)(KT + t * P4_PITCH + d0 * 2) = cvt_pk_bf16(k0 * ek0, k1 * ek1);
            *(LAS u16*)(VT + d0 * P4_VPITCH + t * 2) = (u16)(v2 & 0xffffu); *(LAS u16*)(VT + (d0 + 1) * P4_VPITCH + t * 2) = (u16)(v2 >> 16); }
        const u16* Sp = US + ((size_t)bc * 8 + h) * 16384;
        bf16x8 sfr[8][4];
#pragma unroll
        for (int et = 0; et < 8; ++et)
#pragma unroll
            for (int kd = 0; kd < 4; ++kd) sfr[et][kd] = *(const bf16x8*)(Sp + ((size_t)(et * 4 + kd) * 64 + lane) * 8);
        const int tt = tq;
        const size_t orow = (row0 + 16 * tt + r) * 1024 + (size_t)h * 128;
        __syncthreads();
        u32x2 ogv[8];
#pragma unroll
        for (int et = 0; et < 8; ++et) ogv[et] = *(const u32x2*)(OGb + orow + 16 * et + 4 * q);
        {
            f32x4 acc[4];
#pragma unroll
            for (int t4 = 0; t4 < 4; ++t4) acc[t4] = (f32x4){0.f, 0.f, 0.f, 0.f};
#pragma unroll
            for (int kd = 0; kd < 4; ++kd)
#pragma unroll
                for (int t4 = 0; t4 < 4; ++t4) { const bf16x8 pfr = *(const LAS bf16x8*)(PLD + (16 * t4 + r) * P4_PITCH + (32 * kd + 8 * q) * 2); acc[t4] = __builtin_amdgcn_mfma_f32_16x16x32_bf16(wf[kd], pfr, acc[t4], 0, 0, 0); }
            const int n0 = gi * 128 + 16 * wave + 4 * q; const f32x4 psc = *(const f32x4*)(a.pool_scale + n0);
#pragma unroll
            for (int t4 = 0; t4 < 4; ++t4) { u32x2 w; w.x = cvt_pk_bf16(acc[t4][0] * psc[0], acc[t4][1] * psc[1]); w.y = cvt_pk_bf16(acc[t4][2] * psc[2], acc[t4][3] * psc[3]);
                *(u32x2*)(PB + (row0 + 16 * t4 + r) * 1024 + n0) = w; }
        }
        bf16x8 qt[4], qh[4];
#pragma unroll
        for (int kd = 0; kd < 4; ++kd) { qt[kd] = *(const LAS bf16x8*)(QT + (16 * tt + r) * P4_PITCH + (32 * kd + 8 * q) * 2); qh[kd] = *(const LAS bf16x8*)(QH + (16 * tt + r) * P4_PITCH + (32 * kd + 8 * q) * 2); }
        f32x4 sc[4];
#pragma unroll
        for (int st = 0; st < 4; ++st) { f32x4 acc = (f32x4){0.f, 0.f, 0.f, 0.f};
            if (st <= tt) {
#pragma unroll
                for (int kd = 0; kd < 4; ++kd) { const bf16x8 kfr = *(const LAS bf16x8*)(KT + (16 * st + r) * P4_PITCH + (32 * kd + 8 * q) * 2); acc = __builtin_amdgcn_mfma_f32_16x16x32_bf16(kfr, qt[kd], acc, 0, 0, 0); }
                if (st == tt) {
#pragma unroll
                    for (int i = 0; i < 4; ++i) if (4 * q + i > r) acc[i] = 0.f; }
            }
            sc[st] = acc; }
        bf16x8 pf[2];
#pragma unroll
        for (int ks = 0; ks < 2; ++ks) { u32x4 w; w.x = cvt_pk_bf16(sc[2 * ks][0], sc[2 * ks][1]); w.y = cvt_pk_bf16(sc[2 * ks][2], sc[2 * ks][3]); w.z = cvt_pk_bf16(sc[2 * ks + 1][0], sc[2 * ks + 1][1]); w.w = cvt_pk_bf16(sc[2 * ks + 1][2], sc[2 * ks + 1][3]);
            pf[ks] = __builtin_bit_cast(bf16x8, w); }
        f32x4 oa[8]; float ss = 0.f;
#pragma unroll
        for (int et = 0; et < 8; ++et) { f32x4 acc = (f32x4){0.f, 0.f, 0.f, 0.f};
#pragma unroll
            for (int kd = 0; kd < 4; ++kd) acc = __builtin_amdgcn_mfma_f32_16x16x32_bf16(sfr[et][kd], qh[kd], acc, 0, 0, 0);
#pragma unroll
            for (int ks = 0; ks < 2; ++ks) if (2 * ks <= tt) {
                const u32x2 lo = *(const LAS u32x2*)(VT + (16 * et + r) * P4_VPITCH + (32 * ks + 4 * q) * 2), hi = *(const LAS u32x2*)(VT + (16 * et + r) * P4_VPITCH + (32 * ks + 16 + 4 * q) * 2);
                const u32x4 w = (u32x4){lo.x, lo.y, hi.x, hi.y};
                acc = __builtin_amdgcn_mfma_f32_16x16x32_bf16(__builtin_bit_cast(bf16x8, w), pf[ks], acc, 0, 0, 0); }
            oa[et] = acc; ss += (acc[0] * acc[0] + acc[1] * acc[1]) + (acc[2] * acc[2] + acc[3] * acc[3]); }
        ss += __shfl_xor(ss, 16); ss += __shfl_xor(ss, 32);
        const float rstd = rsqrtf(ss * (1.f / 128.f) + EPS);
#pragma unroll
        for (int et = 0; et < 8; ++et) { const int e0 = 16 * et + 4 * q; const f32x4 gn = *(const f32x4*)(a.g_hn + e0); const u32x2 og = ogv[et];
            u32x2 w; w.x = cvt_pk_bf16(oa[et][0] * rstd * gn[0] * bf_lo(og.x), oa[et][1] * rstd * gn[1] * bf_hi(og.x)); w.y = cvt_pk_bf16(oa[et][2] * rstd * gn[2] * bf_lo(og.y), oa[et][3] * rstd * gn[3] * bf_hi(og.y));
            *(LAS u32x2*)(QT + (16 * tt + r) * P4_PITCH + e0 * 2) = w; }
        asm volatile("s_waitcnt lgkmcnt(0)" ::: "memory");
#pragma unroll
        for (int i = 0; i < 4; ++i) { const int rr = 16 * tt + 4 * i + (lane >> 4); const u32x4 v = *(const LAS u32x4*)(QT + rr * P4_PITCH + (lane & 15) * 16);
            *(u32x4*)(Qb + (row0 + rr) * 1024 + (size_t)h * 128 + (lane & 15) * 8) = v; }
    }
    __syncthreads();
}

__device__ __forceinline__ void p9_final(const Args& a, int G) {
    const int tid = threadIdx.x, lane = tid & 63, wave = __builtin_amdgcn_readfirstlane(tid >> 6);
    const float* rsq = (const float*)(a.ws + WS_RSQ);
    const f32x4* gr = (const f32x4*)a.g_fin + lane; f32x4 gv[4];
#pragma unroll
    for (int j = 0; j < 4; ++j) gv[j] = gr[64 * j];
    for (int m = 2 * (blockIdx.x * NWAVES + wave); m < M; m += 2 * G * NWAVES) {
        float p = lane < 32 ? rsq[(size_t)m * 16 + lane] : 0.f;
        f32x4* xr = (f32x4*)(a.out + (size_t)m * DM) + lane; f32x4 v[8];
#pragma unroll
        for (int j = 0; j < 8; ++j) v[j] = xr[64 * j];
        p += __shfl_xor(p, 1); p += __shfl_xor(p, 2); p += __shfl_xor(p, 4); p += __shfl_xor(p, 8);
        const float r0 = rsqrtf(__shfl(p, 0) * (1.f / DM) + EPS), r1 = rsqrtf(__shfl(p, 16) * (1.f / DM) + EPS);
#pragma unroll
        for (int j = 0; j < 8; ++j) { const float rs = j < 4 ? r0 : r1; const f32x4 g4 = gv[j & 3]; xr[64 * j] = (f32x4){v[j].x * rs * g4.x, v[j].y * rs * g4.y, v[j].z * rs * g4.z, v[j].w * rs * g4.w}; }
    }
}

#ifdef PROBE_STOP
__device__ __forceinline__ void p_dump(const Args& a, int G) {
    const u16* Qb = (const u16*)(a.ws + WS_Q); const u16* Gb = (const u16*)(a.ws + WS_G); const u16* Vb = (const u16*)(a.ws + WS_V); const u16* OGb = (const u16*)(a.ws + WS_OG);
    const u16* GAb = (const u16*)(a.ws + WS_GA); const u16* GBb = (const u16*)(a.ws + WS_GB); const u16* PB = (const u16*)(a.ws + WS_PB);
    for (size_t i = (size_t)blockIdx.x * NTHR + threadIdx.x; i < (size_t)M * DM; i += (size_t)G * NTHR) {
        float v = 0.f;
        if (PROBE_STOP == 1) v = bf1(Qb[i]) + h2f(Gb[i]) + bf1(Vb[i]) + bf1(OGb[i]) + bf1(GAb[i]) + bf1(GBb[i]) + bf1(PB[i]);
        else if (PROBE_STOP == 2 || PROBE_STOP == 3) { float t = bf1(((const u16*)a.out)[i]) + bf1(((const u16*)a.out)[i + (size_t)M * DM]); if (!(fabsf(t) < 1e30f)) t = 12345.f; ((float*)(a.ws + WS_GA))[i] = t; continue; }
        else if (PROBE_STOP == 4) v = bf1(Qb[i]) + bf1(PB[i]);
        else if (PROBE_STOP == 5) v = bf1(Gb[i]);
        else continue;
        a.out[i] = v;
    }
}
#endif
__device__ __forceinline__ void flat_barrier(unsigned* cnt) {
    asm volatile("s_waitcnt vmcnt(0)" ::: "memory");
    __syncthreads();
    if (threadIdx.x == 0) {
        const unsigned Gn = gridDim.x;
        __builtin_amdgcn_fence(__ATOMIC_RELEASE, "agent");
        asm volatile("s_waitcnt vmcnt(0)" ::: "memory");
        const unsigned old = __hip_atomic_fetch_add(cnt, 1u, __ATOMIC_RELAXED, __HIP_MEMORY_SCOPE_AGENT);
        const unsigned target = (old / Gn + 1u) * Gn; unsigned sp = 0;
        while (__hip_atomic_load(cnt, __ATOMIC_RELAXED, __HIP_MEMORY_SCOPE_AGENT) < target) { __builtin_amdgcn_s_sleep(1); if (++sp > (1u << 22)) break; }
        __builtin_amdgcn_fence(__ATOMIC_ACQUIRE, "agent");
        asm volatile("s_waitcnt vmcnt(0)" ::: "memory");
    }
    __syncthreads();
}
constexpr int NPH = 10;
__global__ void __launch_bounds__(NTHR, 2) mega(Args a) {
    extern __shared__ __attribute__((aligned(16))) unsigned char lds_raw[];
    LAS unsigned char* lds = (LAS unsigned char*)lds_raw;
    cg::grid_group grid = cg::this_grid();
    const int G = gridDim.x, lo = a.ph_lo, hi = a.ph_hi;
    unsigned char* ws = a.ws;
    volatile LAS unsigned* MISC = (volatile LAS unsigned*)(lds + LDS_BYTES - 64);
    if (threadIdx.x < 16) MISC[threadIdx.x] = 0u;
    __syncthreads();
    XcdBarrier bar; bar.bar = (unsigned*)(ws + WS_BAR); bar.x = 0; bar.st = nullptr;
    if (hi - lo > 1) bar = xcd_barrier_post((unsigned*)(ws + WS_BAR), MISC);
    if (hi < 0) grid.sync();
#ifndef PHMASK
#define PHMASK 0x3ff
#endif
#define IN(k) (((PHMASK >> (k)) & 1) && lo <= (k) && (k) < hi)
#ifndef CG_SEAMS
#define CG_SEAMS 0x0
#endif
#define SEAM(k) do { if (IN(k) && IN((k) + 1)) { if ((CG_SEAMS >> (k)) & 1) grid.sync(); else xcd_barrier(bar); } } while (0)
#ifndef PROBE_DUP
#define PROBE_DUP 0
#endif
#ifndef PROBE_XSYNC
#define PROBE_XSYNC 0
#endif
#define DUP(k) (((PROBE_DUP >> (k)) & 1) ? 2 : 1)
    if (IN(0)) { p0_prologue(a, lds, G); } SEAM(0);
#ifdef PROBE_XBAR
    for (int xs = 0; xs < PROBE_XBAR; ++xs) flat_barrier((unsigned*)(ws + WS_BAR + 14 * KiB));
#endif
    if (IN(1)) { pg8::Gemm g{(const u16*)a.out, (const u16*)(ws + WS_WIN), M, INW, DM, DM, 1 << 30, 0L}; pg8::StaticOrder S; S.init(M, INW, G, (int)blockIdx.x);
        EpiIn E{ws}; pg8::gemm_phase<EpiIn, true>(lds, g, S, E);
        if (G == 256 && blockIdx.x >= 128) late_weights(a, lds, ((int)blockIdx.x - 128) * NWAVES + (int)(threadIdx.x >> 6), 128 * NWAVES); }
    SEAM(1);
    if (IN(2)) { p2_states(a, G); } SEAM(2);
    if (IN(3)) { p3_scan(a, lds, G); } SEAM(3);
    if (IN(4)) { p4_outputs(a, lds, G); } SEAM(4);
    if (IN(5)) { pg8::Gemm g{(const u16*)(ws + WS_Q), (const u16*)(ws + WS_WAB), M, DM, 1536, DM, 16, (long)(WS_PB - WS_Q) - 16L * 128L}; pg8::StaticOrder S; S.init(M, DM, G, (int)blockIdx.x);
        EpiMerge E{(const u16*)(ws + WS_GA), (const u16*)(ws + WS_GB), (u16*)(ws + WS_MG)}; pg8::gemm_phase<EpiMerge, false>(lds, g, S, E); } SEAM(5);
    if (IN(6)) { pg8::Gemm g{(const u16*)(ws + WS_MG), (const u16*)(ws + WS_WOUT), M, DM, DM, DM, 1 << 30, 0L}; pg8::StaticOrder S; S.init(M, DM, G, (int)blockIdx.x);
        EpiRes<true> E{a.x, a.out, (u16*)(ws + WS_H1B), (float*)(ws + WS_RSQ)}; pg8::gemm_phase<EpiRes<true>, false>(lds, g, S, E); } SEAM(6);
    if (IN(7)) { pg8::Gemm g{(const u16*)(ws + WS_H1B), (const u16*)(ws + WS_WGU), M, NGU, DM, DM, 1 << 30, 0L}; pg8::StaticOrder S; S.init(M, NGU, G, (int)blockIdx.x);
        EpiFfn1 E{(const float*)(ws + WS_RSQ), (u16*)(ws + WS_ACT)}; pg8::gemm_phase<EpiFfn1, true>(lds, g, S, E); } SEAM(7);
    const bool fuse9 = (G == (M / 256) * (DM / 256)) && (hi - lo > 1);
    if (IN(8)) { pg8::Gemm g{(const u16*)(ws + WS_ACT), (const u16*)(ws + WS_WD), M, DM, DFF, DFF, 1 << 30, 0L}; pg8::StaticOrder S; S.init(M, DM, G, (int)blockIdx.x);
        if (fuse9) { EpiResNorm E{a.out, a.out, a.g_fin, (float*)(ws + WS_RSQ), (unsigned*)(ws + WS_CNT)}; pg8::gemm_phase<EpiResNorm, false>(lds, g, S, E); }
        else { EpiRes<false> E{a.out, a.out, nullptr, (float*)(ws + WS_RSQ)}; pg8::gemm_phase<EpiRes<false>, false>(lds, g, S, E); } }
    if (!fuse9) { SEAM(8);
    if (IN(9)) { p9_final(a, G); } }
#ifdef PROBE_LIST
    if (lo == 20) p0_prologue(a, lds, G, 1);
    if (lo == 30) p0_prologue(a, lds, G, 2);
    if (lo == 40) p0_prologue(a, lds, G, 4);
    if (lo == 14) p4_outputs(a, lds, G, 1);
    if (lo == 24) p4_outputs(a, lds, G, 2);
    if (lo == 34) p4_outputs(a, lds, G, 2 | 4);
    if (lo == 44) p4_outputs(a, lds, G, 2 | 8);
    if (lo == 54) p4_outputs(a, lds, G, 2 | 16);
    if (lo == 64) p4_outputs(a, lds, G, 2 | 32);
    if (lo == 74) p4_outputs(a, lds, G, 2 | 64);
    if (lo == 18) { pg8::Gemm g{(const u16*)(ws + WS_ACT), (const u16*)(ws + WS_WD), M, DM, DFF, DFF, 1 << 30, 0L}; pg8::StaticOrder S; S.init(M, DM, G, (int)blockIdx.x);
        EpiRes<false> E{(const float*)(ws + WS_GA), (float*)(ws + WS_GA), nullptr, (float*)(ws + WS_OG)}; pg8::gemm_phase<EpiRes<false>, false>(lds, g, S, E); }
    if (lo == 19) { Args b = a; b.out = (float*)(ws + WS_GA); p9_final(b, G); }
#endif
#ifdef PROBE_STOP
    if (lo == 10) p_dump(a, G);
    if (lo == 11 && (PROBE_STOP == 2 || PROBE_STOP == 3)) { for (size_t i = (size_t)blockIdx.x * NTHR + threadIdx.x; i < (size_t)M * DM; i += (size_t)G * NTHR) a.out[i] = ((const float*)(a.ws + WS_GA))[i]; }
#endif
#undef IN
#undef SEAM
}

extern "C" void kernel_launch(void* const* d_in, const int* in_sizes, int n_in, void* d_out, int out_size, void* d_ws, size_t ws_size, hipStream_t stream) {
    static int grid = 0;
    if (grid == 0) {
        if (n_in != 16 || in_sizes[0] != M * DM || out_size != M * DM || ws_size < WS_END) { fprintf(stderr, "kernel_launch: unexpected shapes (n_in %d, in0 %d, out %d, ws %zu); nothing launched\n", n_in, n_in > 0 ? in_sizes[0] : -1, out_size, ws_size); grid = -1; return; }
        int dev = 0, cus = 0, per_cu = 0;
        (void)hipGetDevice(&dev); (void)hipDeviceGetAttribute(&cus, hipDeviceAttributeMultiprocessorCount, dev);
        if (hipFuncSetAttribute((const void*)mega, hipFuncAttributeMaxDynamicSharedMemorySize, LDS_BYTES) != hipSuccess) { fprintf(stderr, "kernel_launch: hipFuncSetAttribute failed\n"); }
        if (hipOccupancyMaxActiveBlocksPerMultiprocessor(&per_cu, (const void*)mega, NTHR, LDS_BYTES) != hipSuccess || per_cu < 1) per_cu = 1;
        (void)hipGetLastError();
        if (cus <= 0) cus = 256;
        grid = cus * per_cu;
    }
    if (grid < 0) return;
#if MK_COOP
    if (hipMemsetAsync((char*)d_ws + WS_BAR, 0, CTL_ZERO, stream) != hipSuccess) { fprintf(stderr, "kernel_launch: hipMemsetAsync of the barrier words failed\n"); return; }
#endif
    Args a{};
    a.x = (const float*)d_in[0]; a.meta = (const float*)d_in[1]; a.g_mix = (const float*)d_in[2]; a.w_in = (const float*)d_in[3]; a.lb_raw = (const float*)d_in[4]; a.g_hn = (const float*)d_in[5];
    a.pool_w = (const float*)d_in[6]; a.pool_scale = (const float*)d_in[7]; a.w_a = (const float*)d_in[8]; a.w_b = (const float*)d_in[9]; a.w_out = (const float*)d_in[10]; a.g_ffn = (const float*)d_in[11];
    a.w_gate = (const float*)d_in[12]; a.w_up = (const float*)d_in[13]; a.w_down = (const float*)d_in[14]; a.g_fin = (const float*)d_in[15];
    a.out = (float*)d_out; a.ws = (unsigned char*)d_ws;
#if MK_COOP
    a.ph_lo = 0; a.ph_hi = NPH;
    void* args[] = {&a};
    const hipError_t e = hipLaunchCooperativeKernel((const void*)mega, dim3(grid), dim3(NTHR), args, LDS_BYTES, stream);
    if (e != hipSuccess) fprintf(stderr, "kernel_launch: cooperative launch failed: %s (grid %d)\n", hipGetErrorString(e), grid);
#else
#ifdef PROBE_STOP
    for (int ph = 0; ph <= PROBE_STOP; ++ph) { a.ph_lo = ph; a.ph_hi = ph + 1; hipLaunchKernelGGL(mega, dim3(grid), dim3(NTHR), LDS_BYTES, stream, a); }
    a.ph_lo = 10; a.ph_hi = 11; hipLaunchKernelGGL(mega, dim3(grid), dim3(NTHR), LDS_BYTES, stream, a);
    a.ph_lo = 11; a.ph_hi = 12; hipLaunchKernelGGL(mega, dim3(grid), dim3(NTHR), LDS_BYTES, stream, a);
#else
#ifdef PROBE_LIST
    { const int lst[] = PROBE_LIST; for (int i = 0; i < (int)(sizeof(lst) / sizeof(int)); ++i) { a.ph_lo = lst[i]; a.ph_hi = lst[i] + 1; hipLaunchKernelGGL(mega, dim3(grid), dim3(NTHR), LDS_BYTES, stream, a); } }
#else
    for (int ph = 0; ph < NPH; ++ph) { a.ph_lo = ph; a.ph_hi = ph + 1; hipLaunchKernelGGL(mega, dim3(grid), dim3(NTHR), LDS_BYTES, stream, a); }
#endif
#endif
#endif
}
```

```cpp
#include <hip/hip_runtime.h>
#include <hip/hip_cooperative_groups.h>
#include <cstdio>
#include <cstdint>
namespace cg = cooperative_groups;

#ifndef MK_COOP
#define MK_COOP 1
#endif

#define LAS __attribute__((address_space(3)))
typedef unsigned short u16;
typedef short bf16x8 __attribute__((ext_vector_type(8)));
typedef float f32x4 __attribute__((ext_vector_type(4)));
typedef unsigned u32x4 __attribute__((ext_vector_type(4)));
typedef unsigned u32x2 __attribute__((ext_vector_type(2)));

typedef __bf16 bf16v2_t __attribute__((ext_vector_type(2)));
typedef float f32v2_t __attribute__((ext_vector_type(2)));
__device__ __forceinline__ unsigned cvt_pk_bf16(float lo, float hi) { const f32v2_t f = {lo, hi}; const bf16v2_t v = __builtin_convertvector(f, bf16v2_t); return __builtin_bit_cast(unsigned, v); }
__device__ __forceinline__ float bf_lo(unsigned w) { return __uint_as_float(w << 16); }
__device__ __forceinline__ float bf_hi(unsigned w) { return __uint_as_float(w & 0xffff0000u); }
__device__ __forceinline__ float bf1(u16 w) { return __uint_as_float((unsigned)w << 16); }
__device__ __forceinline__ unsigned pk_h(float a, float b) { const _Float16 x = (_Float16)a, y = (_Float16)b; return (unsigned)__builtin_bit_cast(unsigned short, x) | ((unsigned)__builtin_bit_cast(unsigned short, y) << 16); }
__device__ __forceinline__ float h2f(u16 w) { return (float)__builtin_bit_cast(_Float16, w); }
__device__ __forceinline__ float sigm(float z) { return __builtin_amdgcn_rcpf(1.0f + __expf(-z)); }

namespace pg8 {
constexpr int BM = 256, BK = 64, HALF = 128, HTB = HALF * BK * 2, STAGE_BYTES = 8 * HTB, NXCD = 8, WGM = 8;
__host__ __device__ __forceinline__ int lds_byte(int r, int c) { const int st = (r >> 4) * 2 + (c >> 5), rr = r & 15, cc = c & 31, ob = rr * 64 + cc * 2; return st * 1024 + (ob ^ (((ob >> 9) & 1) << 5)); }
__host__ __device__ __forceinline__ void stage_rc(int b, int& R, int& C) { const int st = b / 1024, sb = b % 1024, swz = sb ^ (((sb >> 9) & 1) << 5); R = (st >> 1) * 16 + swz / 64; C = (st & 1) * 32 + (swz % 64) / 2; }
__host__ __device__ __forceinline__ int perm32(int rho) { const int n = rho >> 4, i = rho & 15; return 8 * (i >> 2) + 4 * n + (i & 3); }
struct Unit { int pm, pn; };
struct Gemm { const u16* A; const u16* Bt; int M, N, K, lda, ksplit; long a2delta; };
struct StaticOrder {
    int nM, nN, nwg, G, c;
    __host__ __device__ void init(int M, int N, int G_, int c_) { nM = M / BM; nN = N / BM; nwg = nM * nN; G = G_; c = c_; }
    __host__ __device__ bool next(int i, Unit& u) const {
        const long L = (long)i * G + c; if (L >= nwg) return false;
        int wgid = (int)L; { const int q = nwg / NXCD, r = nwg % NXCD, xcd = wgid % NXCD, off = wgid / NXCD; wgid = (xcd < r ? xcd * (q + 1) : r * (q + 1) + (xcd - r) * q) + off; }
        const int nig = WGM * nN, gid = wgid / nig, fm = gid * WGM, gsz = (nM - fm) < WGM ? (nM - fm) : WGM;
        u.pm = fm + ((wgid % nig) % gsz); u.pn = (wgid % nig) / gsz; return true;
    }
};
template <class Epi, bool ALIGN_EPI>
__device__ __forceinline__ void gemm_phase(LAS unsigned char* lds, const Gemm g, const StaticOrder& S, const Epi& E) {
    const int tid = threadIdx.x, wid = __builtin_amdgcn_readfirstlane(tid >> 6), lane = tid & 63, wr = wid >> 2, wc = wid & 3, fr = lane & 15, fq = lane >> 4;
    const int K = g.K, nt = K / BK, lda = g.lda;
    unsigned voffA[2], voffB[2];
#pragma unroll
    for (int i = 0; i < 2; ++i) { int R, C; stage_rc(tid * 16 + i * 8192, R, C); const int Rb = Epi::PERM ? ((R & ~31) + perm32(R & 31)) : R;
        voffA[i] = (unsigned)(R * lda + C) * 2u; voffB[i] = (unsigned)(Rb * K + C) * 2u; }
    const size_t kstep = (size_t)(BK * 2);
    const size_t hstepA = (size_t)HALF * lda * 2, tstepA = 2 * hstepA;
    const size_t hstepB = (size_t)HALF * K * 2, tstepB = 2 * hstepB;
    const unsigned ldsw = (unsigned)wid * 1024u;
    const int aoff = lds_byte(wr * 64 + fr, fq * 8), boff = lds_byte(wc * 32 + fr, fq * 8);
#define PG8_SA(b, h) (((b) * 2 + (h)) * HTB)
#define PG8_SB(b, h) ((4 + (b) * 2 + (h)) * HTB)
#define PG8_STAGE(bufoff, gbase, voff) do { _Pragma("unroll") for (int _i = 0; _i < 2; ++_i) \
        __builtin_amdgcn_global_load_lds((const unsigned*)((const char*)(gbase) + (voff)[_i]), (LAS unsigned*)(lds + (bufoff) + ldsw + _i * 8192), 16, 0, 0); } while (0)
#define PG8_LDA(dst, b, h) do { _Pragma("unroll") for (int m = 0; m < 4; ++m) _Pragma("unroll") for (int k = 0; k < 2; ++k) dst[m][k] = *(const LAS bf16x8*)(lds + PG8_SA(b, h) + aoff + m * 2048 + k * 1024); } while (0)
#define PG8_LDB(dst, b, h) do { _Pragma("unroll") for (int n = 0; n < 2; ++n) _Pragma("unroll") for (int k = 0; k < 2; ++k) dst[n][k] = *(const LAS bf16x8*)(lds + PG8_SB(b, h) + boff + n * 2048 + k * 1024); } while (0)
#define PG8_MMA(ai, bj, At, Bt) do { __builtin_amdgcn_s_setprio(1); _Pragma("unroll") for (int m = 0; m < 4; ++m) _Pragma("unroll") for (int n = 0; n < 2; ++n) _Pragma("unroll") for (int k = 0; k < 2; ++k) \
        acc[ai][bj][m][n] = __builtin_amdgcn_mfma_f32_16x16x32_bf16(Bt[n][k], At[m][k], acc[ai][bj][m][n], 0, 0, 0); __builtin_amdgcn_s_setprio(0); } while (0)
#define PG8_WAIT_V(n) asm volatile("s_waitcnt vmcnt(" #n ")" ::: "memory")
#define PG8_WAIT_L(n) asm volatile("s_waitcnt lgkmcnt(" #n ")" ::: "memory")
#define PG8_BAR __builtin_amdgcn_s_barrier()
#define PG8_SCHED __builtin_amdgcn_sched_barrier(0)
    Unit cur, nxt; int ui = 0;
    if (!S.next(0, cur)) return;
    f32x4 acc[2][2][4][2];
#pragma unroll
    for (int a = 0; a < 2; ++a)
#pragma unroll
        for (int b = 0; b < 2; ++b)
#pragma unroll
            for (int m = 0; m < 4; ++m)
#pragma unroll
                for (int n = 0; n < 2; ++n) acc[a][b][m][n] = (f32x4){0.f, 0.f, 0.f, 0.f};
    bf16x8 At[4][2], B0[2][2], B1[2][2];
    const char* cA = (const char*)g.A + (size_t)cur.pm * tstepA; const char* cB = (const char*)g.Bt + (size_t)cur.pn * tstepB;
    PG8_STAGE(PG8_SB(0, 0), cB, voffB); PG8_STAGE(PG8_SB(0, 1), cB + hstepB, voffB); PG8_STAGE(PG8_SA(0, 0), cA, voffA); PG8_STAGE(PG8_SA(0, 1), cA + hstepA, voffA);
    if (wr == 1) PG8_BAR;
    PG8_WAIT_V(2); PG8_BAR;
    PG8_STAGE(PG8_SB(1, 0), cB + kstep, voffB); PG8_STAGE(PG8_SA(1, 0), cA + kstep, voffA); PG8_STAGE(PG8_SB(1, 1), cB + hstepB + kstep, voffB);
    PG8_WAIT_V(6); PG8_BAR;
    for (;;) {
        const bool has_next = S.next(ui + 1, nxt);
        const char* nA = has_next ? (const char*)g.A + (size_t)nxt.pm * tstepA : cA; const char* nB = has_next ? (const char*)g.Bt + (size_t)nxt.pn * tstepB : cB;
        for (int t = 0; t < nt; t += 2) {
            const bool last = (t == nt - 2);
            if constexpr (Epi::MID) { if (t == g.ksplit) E.mid(acc, cur, wr, wc, fr, fq); }
            const char* a1 = cA + (size_t)(t + 1) * kstep + (t >= g.ksplit ? g.a2delta : 0L);
            const char* a2 = last ? nA : cA + (size_t)(t + 2) * kstep + (t + 2 >= g.ksplit ? g.a2delta : 0L);
            const char* b2 = last ? nB : cB + (size_t)(t + 2) * kstep;
            const char* a3 = a2 + kstep; const char* b3 = b2 + kstep;
            PG8_LDB(B0, 0, 0); PG8_LDB(B1, 0, 1); PG8_SCHED; PG8_LDA(At, 0, 0); PG8_STAGE(PG8_SA(1, 1), a1 + hstepA, voffA);
            PG8_WAIT_V(8); PG8_WAIT_L(0); PG8_BAR; PG8_MMA(0, 0, At, B0); PG8_MMA(0, 1, At, B1); PG8_BAR; PG8_SCHED;
            PG8_LDA(At, 0, 1); PG8_STAGE(PG8_SB(0, 0), b2, voffB); PG8_STAGE(PG8_SB(0, 1), b2 + hstepB, voffB); PG8_STAGE(PG8_SA(0, 0), a2, voffA);
            PG8_WAIT_V(8); PG8_WAIT_L(0); PG8_BAR; PG8_MMA(1, 0, At, B0); PG8_MMA(1, 1, At, B1); PG8_BAR; PG8_SCHED;
            PG8_LDB(B0, 1, 0); PG8_LDB(B1, 1, 1); PG8_SCHED; PG8_LDA(At, 1, 0); PG8_STAGE(PG8_SA(0, 1), a2 + hstepA, voffA);
            PG8_WAIT_V(8); PG8_WAIT_L(0); PG8_BAR; PG8_MMA(0, 0, At, B0); PG8_MMA(0, 1, At, B1); PG8_BAR; PG8_SCHED;
            PG8_LDA(At, 1, 1); PG8_STAGE(PG8_SB(1, 0), b3, voffB); PG8_STAGE(PG8_SB(1, 1), b3 + hstepB, voffB); PG8_STAGE(PG8_SA(1, 0), a3, voffA);
            PG8_WAIT_V(8); PG8_WAIT_L(0); PG8_BAR; PG8_MMA(1, 0, At, B0); PG8_MMA(1, 1, At, B1); PG8_BAR; PG8_SCHED;
        }
        if constexpr (ALIGN_EPI) { if (wr == 0) PG8_BAR; }
        if constexpr (!Epi::AFTER) E(acc, cur, wr, wc, fr, fq);
        if (!has_next) break;
#pragma unroll
        for (int a = 0; a < 2; ++a)
#pragma unroll
            for (int b = 0; b < 2; ++b)
#pragma unroll
                for (int m = 0; m < 4; ++m)
#pragma unroll
                    for (int n = 0; n < 2; ++n) acc[a][b][m][n] = (f32x4){0.f, 0.f, 0.f, 0.f};
        cur = nxt; cA = nA; cB = nB; ++ui;
        if constexpr (ALIGN_EPI) { if (wr == 1) PG8_BAR; }
    }
    PG8_WAIT_V(0);
    if constexpr (!ALIGN_EPI) { if (wr == 0) PG8_BAR; }
    PG8_BAR;
    if constexpr (Epi::AFTER) E.after(acc, cur, wr, wc, fr, fq, lds, wid, lane);
#undef PG8_SA
#undef PG8_SB
#undef PG8_STAGE
#undef PG8_LDA
#undef PG8_LDB
#undef PG8_MMA
#undef PG8_WAIT_V
#undef PG8_WAIT_L
#undef PG8_BAR
#undef PG8_SCHED
}
}

constexpr int NWAVES = 8, NTHR = 512;
constexpr int SEQ = 8192, BATCH = 2, DM = 1024, M = BATCH * SEQ, NMETA = 16, INW = 6656, DFF = 2816, NGU = 2 * DFF, CHK = 64, NCH = SEQ / CHK;
constexpr float EPS = 1e-6f;
constexpr size_t KiB = 1024, MiB = 1u << 20;
constexpr size_t WS_LB = 0, WS_GM = 64 * KiB, WS_VM = 128 * KiB, WS_PLM = 192 * KiB, WS_PWT = 256 * KiB, WS_UM = 512 * KiB, WS_DK = 1 * MiB, WS_RSQ = 2 * MiB;
constexpr size_t WS_WAB = 3 * MiB, WS_WOUT = 6 * MiB, WS_WD = 8 * MiB, WS_WIN = 14 * MiB, WS_WGU = 14 * MiB;
constexpr size_t WS_Q = 28 * MiB, WS_G = 60 * MiB, WS_V = 92 * MiB, WS_OG = 124 * MiB, WS_GA = 156 * MiB, WS_GB = 188 * MiB, WS_PB = 220 * MiB, WS_END = 252 * MiB;
constexpr size_t WS_MG = WS_G, WS_H1B = WS_GB, WS_ACT = WS_Q;
static_assert(WS_WD + (size_t)DM * DFF * 2 <= WS_WIN && WS_WIN + (size_t)INW * DM * 2 <= WS_Q && WS_WGU + (size_t)NGU * DM * 2 <= WS_Q && WS_ACT + (size_t)M * DFF * 2 <= WS_H1B, "ws map");
constexpr int LDS_BYTES = 163840;
constexpr size_t WS_BAR = 16 * KiB, WS_CNT = 32 * KiB, CTL_ZERO = 32 * KiB;

struct Args {
    const float *x, *meta, *g_mix, *w_in, *lb_raw, *g_hn, *pool_w, *pool_scale, *w_a, *w_b, *w_out, *g_ffn, *w_gate, *w_up, *w_down, *g_fin;
    float* out; unsigned char* ws; int ph_lo, ph_hi;
};

#define LDS_WAIT() asm volatile("s_waitcnt lgkmcnt(0)" ::: "memory")
__device__ __forceinline__ float wave_sum(float v) {
#pragma unroll
    for (int o = 1; o < 64; o <<= 1) v += __shfl_xor(v, o);
    return v;
}

__device__ __forceinline__ void tr_item(const float* W, int N, int k0, int n0, u16* WT, int drow0, int dpitch, int dk0, const float* ks, LAS float* scr, int lane) {
#pragma unroll
    for (int i = 0; i < 32; ++i) { const int kk = 2 * i + (lane >> 5); float w = W[(size_t)(k0 + kk) * N + n0 + (lane & 31)]; if (ks) w *= ks[k0 + kk]; scr[kk * 33 + (lane & 31)] = w; }
    LDS_WAIT(); asm volatile("" ::: "memory");
    const int c = lane & 7;
#pragma unroll
    for (int j = 0; j < 4; ++j) { const int n = (lane >> 3) + 8 * j; const LAS float* s = scr + (8 * c) * 33 + n;
        u32x4 o; o.x = cvt_pk_bf16(s[0 * 33], s[1 * 33]); o.y = cvt_pk_bf16(s[2 * 33], s[3 * 33]); o.z = cvt_pk_bf16(s[4 * 33], s[5 * 33]); o.w = cvt_pk_bf16(s[6 * 33], s[7 * 33]);
        *(u32x4*)(WT + (size_t)(drow0 + n) * dpitch + dk0 + k0 + 8 * c) = o; }
    LDS_WAIT(); asm volatile("" ::: "memory");
}
__device__ __forceinline__ void rms_row_bf16(const float* xrow, const float* g, u16* orow, int lane) {
    const f32x4* xr = (const f32x4*)xrow + lane; const f32x4* gr = (const f32x4*)g + lane;
    f32x4 v[4]; float s = 0.f;
#pragma unroll
    for (int j = 0; j < 4; ++j) { v[j] = xr[64 * j]; s += (v[j].x * v[j].x + v[j].y * v[j].y) + (v[j].z * v[j].z + v[j].w * v[j].w); }
    const float rstd = rsqrtf(wave_sum(s) * (1.f / DM) + EPS);
    u32x2* o8 = (u32x2*)orow + lane;
#pragma unroll
    for (int j = 0; j < 4; ++j) { const f32x4 gv = gr[64 * j]; u32x2 o; o.x = cvt_pk_bf16(v[j].x * rstd * gv.x, v[j].y * rstd * gv.y); o.y = cvt_pk_bf16(v[j].z * rstd * gv.z, v[j].w * rstd * gv.w); o8[64 * j] = o; }
}

__device__ __forceinline__ void p0_meta(const Args& a, LAS unsigned char* lds, int j, int tid, int wave, int lane) {
    LAS float* nm = (LAS float*)lds;
    LAS float* part = (LAS float*)(lds + 65536);
#pragma unroll
    for (int rr = 0; rr < 2; ++rr) { const int r = 2 * wave + rr; const f32x4* xr = (const f32x4*)(a.meta + (size_t)r * DM) + lane; const f32x4* gr = (const f32x4*)a.g_mix + lane;
        f32x4 v[4]; float s = 0.f;
#pragma unroll
        for (int q = 0; q < 4; ++q) { v[q] = xr[64 * q]; s += (v[q].x * v[q].x + v[q].y * v[q].y) + (v[q].z * v[q].z + v[q].w * v[q].w); }
        const float rstd = rsqrtf(wave_sum(s) * (1.f / DM) + EPS);
#pragma unroll
        for (int q = 0; q < 4; ++q) { const f32x4 gv = gr[64 * q]; *(LAS f32x4*)(nm + r * 1024 + 4 * (lane + 64 * q)) = (f32x4){v[q].x * rstd * gv.x, v[q].y * rstd * gv.y, v[q].z * rstd * gv.z, v[q].w * rstd * gv.w}; }
    }
    __syncthreads();
    const int colbase = j < 16 ? 1024 + 64 * j : (j < 32 ? 2048 + 64 * (j - 16) : 4096 + 64 * (j - 32));
    {
        const int col = colbase + lane; float acc[16];
#pragma unroll
        for (int r = 0; r < 16; ++r) acc[r] = 0.f;
#pragma unroll 4
        for (int k = 128 * wave; k < 128 * wave + 128; k += 4) {
            const float w0 = a.w_in[(size_t)(k + 0) * INW + col], w1 = a.w_in[(size_t)(k + 1) * INW + col], w2 = a.w_in[(size_t)(k + 2) * INW + col], w3 = a.w_in[(size_t)(k + 3) * INW + col];
#pragma unroll
            for (int r = 0; r < 16; ++r) { const f32x4 n4 = *(const LAS f32x4*)(nm + r * 1024 + k); acc[r] += (n4.x * w0 + n4.y * w1) + (n4.z * w2 + n4.w * w3); }
        }
#pragma unroll
        for (int r = 0; r < 16; ++r) part[(wave * 16 + r) * 64 + lane] = acc[r];
    }
    __syncthreads();
#pragma unroll
    for (int o = 0; o < 2; ++o) {
        const int idx = tid + o * NTHR, r = idx >> 6, cl = idx & 63; float z = 0.f;
#pragma unroll
        for (int w = 0; w < 8; ++w) z += part[(w * 16 + r) * 64 + cl];
        const int col = colbase + cl;
        if (col < 2048) { const int c = col - 1024; const float lb = 1.0f / (1.0f + __expf(a.lb_raw[1024 + c] - a.lb_raw[c])); const float f = lb + (1.0f - lb) * sigm(z);
            const _Float16 hv = (_Float16)__logf(f); ((u16*)(a.ws + WS_GM))[r * 1024 + c] = __builtin_bit_cast(unsigned short, hv); }
        else if (col < 3072) { ((u16*)(a.ws + WS_VM))[r * 1024 + (col - 2048)] = (u16)(cvt_pk_bf16(z, 0.f) & 0xffffu); }
        else { ((u16*)(a.ws + WS_PLM))[r * 512 + (col - 4096)] = (u16)(cvt_pk_bf16(z, 0.f) & 0xffffu); }
    }
    __syncthreads();
}

__device__ __forceinline__ void late_weights(const Args& a, LAS unsigned char* lds, int gw, int NGW) {
    const int lane = threadIdx.x & 63, wave = __builtin_amdgcn_readfirstlane(threadIdx.x >> 6);
    LAS float* scr = (LAS float*)(lds + wave * 16384);
    constexpr int I_A = 16 * 32, I_B = 8 * 32, I_O = 16 * 32, I_D = 44 * 32, I_P = 32;
    constexpr int NIT = I_A + I_B + I_O + I_D + I_P;
    for (int it = gw; it < NIT; it += NGW) {
        int r = it;
        if (r < I_A) { tr_item(a.w_a, 1024, 64 * (r / 32), 32 * (r % 32), (u16*)(a.ws + WS_WAB), 32 * (r % 32), 1536, 0, nullptr, scr, lane); continue; } r -= I_A;
        if (r < I_B) { tr_item(a.w_b, 1024, 64 * (r / 32), 32 * (r % 32), (u16*)(a.ws + WS_WAB), 32 * (r % 32), 1536, 1024, nullptr, scr, lane); continue; } r -= I_B;
        if (r < I_O) { tr_item(a.w_out, 1024, 64 * (r / 32), 32 * (r % 32), (u16*)(a.ws + WS_WOUT), 32 * (r % 32), 1024, 0, nullptr, scr, lane); continue; } r -= I_O;
        if (r < I_D) { tr_item(a.w_down, 1024, 64 * (r / 32), 32 * (r % 32), (u16*)(a.ws + WS_WD), 32 * (r % 32), DFF, 0, nullptr, scr, lane); continue; } r -= I_D;
        { const int gi = r >> 3, q = r & 7; tr_item(a.pool_w + (size_t)gi * 16384, 128, 64 * (q >> 2), 32 * (q & 3), (u16*)(a.ws + WS_PWT) + (size_t)gi * 16384, 32 * (q & 3), 128, 0, nullptr, scr, lane); }
    }
}

__device__ __forceinline__ void p0_prologue(const Args& a, LAS unsigned char* lds, int G, int skip = 0) {
    const int tid = threadIdx.x, lane = tid & 63, wave = __builtin_amdgcn_readfirstlane(tid >> 6);
    const bool split = G > 80;
    if ((int)blockIdx.x < 40) { if (!(skip & 4)) p0_meta(a, lds, (int)blockIdx.x, tid, wave, lane); if (split) return; }
    if (blockIdx.x == 40 || (G <= 40 && blockIdx.x == 0)) { for (int c = tid; c < 1024; c += NTHR) ((float*)(a.ws + WS_LB))[c] = 1.0f / (1.0f + __expf(a.lb_raw[1024 + c] - a.lb_raw[c])); }
    LAS float* scr = (LAS float*)(lds + wave * 16384);
    const int gw = ((int)blockIdx.x - (split ? 40 : 0)) * NWAVES + wave, NGW = (G - (split ? 40 : 0)) * NWAVES;
    constexpr int I_IN = 16 * 208;
    for (int it = gw; it < I_IN && !(skip & 1); it += NGW) tr_item(a.w_in, INW, 64 * (it / 208), 32 * (it % 208), (u16*)(a.ws + WS_WIN), 32 * (it % 208), 1024, 0, nullptr, scr, lane);
    if (G != 256) late_weights(a, lds, gw, NGW);
    u16* XN = (u16*)a.out;
    {
        const f32x4* gr = (const f32x4*)a.g_mix + lane; f32x4 gv[4];
#pragma unroll
        for (int j = 0; j < 4; ++j) gv[j] = gr[64 * j];
        for (int m = 4 * gw; m < M && !(skip & 2); m += 4 * NGW) {
            const f32x4* xr = (const f32x4*)(a.x + (size_t)m * DM) + lane; f32x4 v[16]; float ss[4];
#pragma unroll
            for (int j = 0; j < 16; ++j) v[j] = xr[64 * j];
#pragma unroll
            for (int rr = 0; rr < 4; ++rr) { float t = 0.f;
#pragma unroll
                for (int j = 0; j < 4; ++j) { const f32x4 w = v[4 * rr + j]; t += (w.x * w.x + w.y * w.y) + (w.z * w.z + w.w * w.w); }
                ss[rr] = t; }
#pragma unroll
            for (int o = 1; o < 64; o <<= 1) {
#pragma unroll
                for (int rr = 0; rr < 4; ++rr) ss[rr] += __shfl_xor(ss[rr], o); }
            u32x2* o8 = (u32x2*)(XN + (size_t)m * DM) + lane;
#pragma unroll
            for (int j = 0; j < 16; ++j) { const float rs = rsqrtf(ss[j >> 2] * (1.f / DM) + EPS); const f32x4 g4 = gv[j & 3]; u32x2 o; o.x = cvt_pk_bf16(v[j].x * rs * g4.x, v[j].y * rs * g4.y); o.y = cvt_pk_bf16(v[j].z * rs * g4.z, v[j].w * rs * g4.w); o8[64 * j] = o; }
        }
    }
}

struct EpiIn {
    static constexpr bool PERM = true, MID = false, AFTER = false;
    unsigned char* ws;
    __device__ __forceinline__ void mid(f32x4 (&)[2][2][4][2], const pg8::Unit&, int, int, int, int) const {}
    __device__ __forceinline__ void operator()(f32x4 (&acc)[2][2][4][2], const pg8::Unit& u, int wr, int wc, int fr, int fq) const {
        const int colt = u.pn * 256; int type, c0; size_t boff;
        if (colt < 1024) { type = 1; boff = WS_Q; c0 = colt; }
        else if (colt < 2048) { type = 3; boff = WS_G; c0 = colt - 1024; }
        else if (colt < 3072) { type = 0; boff = WS_V; c0 = colt - 2048; }
        else if (colt < 4096) { type = 1; boff = WS_OG; c0 = colt - 3072; }
        else if (colt < 4608) { type = 0; boff = WS_PB; c0 = colt - 4096 + 512; }
        else if (colt < 5632) { type = 2; boff = WS_GA; c0 = colt - 4608; }
        else { type = 2; boff = WS_GB; c0 = colt - 5632; }
        u16* base = (u16*)(ws + boff);
        const int col0 = c0 + wc * 32 + 8 * fq, row0 = u.pm * 256 + wr * 64 + fr;
        const float* LB = (const float*)(ws + WS_LB);
        f32x4 lbv[2][2];
        if (type == 3) {
#pragma unroll
            for (int bj = 0; bj < 2; ++bj) { lbv[bj][0] = *(const f32x4*)(LB + col0 + bj * 128); lbv[bj][1] = *(const f32x4*)(LB + col0 + bj * 128 + 4); }
        } else {
#pragma unroll
            for (int bj = 0; bj < 2; ++bj) { lbv[bj][0] = (f32x4){0.f, 0.f, 0.f, 0.f}; lbv[bj][1] = (f32x4){0.f, 0.f, 0.f, 0.f}; }
        }
#pragma unroll
        for (int ai = 0; ai < 2; ++ai)
#pragma unroll
            for (int m = 0; m < 4; ++m) { u16* rowp = base + (size_t)(row0 + ai * 128 + m * 16) * 1024 + col0;
#pragma unroll
                for (int bj = 0; bj < 2; ++bj) { f32x4 v0 = acc[ai][bj][m][0], v1 = acc[ai][bj][m][1]; u32x4 w;
                    if (type == 3) {
                        const f32x4 l0 = lbv[bj][0], l1 = lbv[bj][1];
#pragma unroll
                        for (int e = 0; e < 4; ++e) { v0[e] = __logf(l0[e] + (1.0f - l0[e]) * sigm(v0[e])); v1[e] = __logf(l1[e] + (1.0f - l1[e]) * sigm(v1[e])); }
                        w.x = pk_h(v0[0], v0[1]); w.y = pk_h(v0[2], v0[3]); w.z = pk_h(v1[0], v1[1]); w.w = pk_h(v1[2], v1[3]);
                    } else {
                        if (type == 1) {
#pragma unroll
                            for (int e = 0; e < 4; ++e) { v0[e] = v0[e] * sigm(v0[e]); v1[e] = v1[e] * sigm(v1[e]); }
                        } else if (type == 2) {
#pragma unroll
                            for (int e = 0; e < 4; ++e) { v0[e] = sigm(v0[e]); v1[e] = sigm(v1[e]); }
                        }
                        w.x = cvt_pk_bf16(v0[0], v0[1]); w.y = cvt_pk_bf16(v0[2], v0[3]); w.z = cvt_pk_bf16(v1[0], v1[1]); w.w = cvt_pk_bf16(v1[2], v1[3]);
                    }
                    __builtin_nontemporal_store(w, (u32x4*)(rowp + bj * 128)); } }
    }
};
struct EpiMerge {
    static constexpr bool PERM = true, MID = true, AFTER = false;
    const u16 *GA, *GB; u16* MG;
    __device__ __forceinline__ void mid(f32x4 (&acc)[2][2][4][2], const pg8::Unit& u, int wr, int wc, int fr, int fq) const {
        int zz = 0; asm volatile("" : "+v"(zz));
        const int col0 = u.pn * 256 + wc * 32 + 8 * fq, row0 = u.pm * 256 + wr * 64 + fr + zz;
#pragma unroll
        for (int ai = 0; ai < 2; ++ai)
#pragma unroll
            for (int m = 0; m < 4; ++m) { const size_t off = (size_t)(row0 + ai * 128 + m * 16) * 1024 + col0;
#pragma unroll
                for (int bj = 0; bj < 2; ++bj) { const u32x4 ga = *(const u32x4*)(GA + off + bj * 128), gb = *(const u32x4*)(GB + off + bj * 128);
#pragma unroll
                    for (int e = 0; e < 2; ++e) { acc[ai][bj][m][0][2 * e] *= bf_lo(ga[e]) * __builtin_amdgcn_rcpf(bf_lo(gb[e])); acc[ai][bj][m][0][2 * e + 1] *= bf_hi(ga[e]) * __builtin_amdgcn_rcpf(bf_hi(gb[e]));
                        acc[ai][bj][m][1][2 * e] *= bf_lo(ga[2 + e]) * __builtin_amdgcn_rcpf(bf_lo(gb[2 + e])); acc[ai][bj][m][1][2 * e + 1] *= bf_hi(ga[2 + e]) * __builtin_amdgcn_rcpf(bf_hi(gb[2 + e])); } }
                asm volatile("" ::: "memory"); }
    }
    __device__ __forceinline__ void operator()(f32x4 (&acc)[2][2][4][2], const pg8::Unit& u, int wr, int wc, int fr, int fq) const {
        const int col0 = u.pn * 256 + wc * 32 + 8 * fq, row0 = u.pm * 256 + wr * 64 + fr;
#pragma unroll
        for (int ai = 0; ai < 2; ++ai)
#pragma unroll
            for (int m = 0; m < 4; ++m) { const size_t off = (size_t)(row0 + ai * 128 + m * 16) * 1024 + col0;
#pragma unroll
                for (int bj = 0; bj < 2; ++bj) { const u32x4 gb = *(const u32x4*)(GB + off + bj * 128);
                    acc[ai][bj][m][0] *= (f32x4){bf_lo(gb[0]), bf_hi(gb[0]), bf_lo(gb[1]), bf_hi(gb[1])}; acc[ai][bj][m][1] *= (f32x4){bf_lo(gb[2]), bf_hi(gb[2]), bf_lo(gb[3]), bf_hi(gb[3])}; } }
#pragma unroll
        for (int ai = 0; ai < 2; ++ai)
#pragma unroll
            for (int m = 0; m < 4; ++m) { const size_t off = (size_t)(row0 + ai * 128 + m * 16) * 1024 + col0;
#pragma unroll
                for (int bj = 0; bj < 2; ++bj) { const f32x4 v0 = acc[ai][bj][m][0], v1 = acc[ai][bj][m][1]; u32x4 w;
                    w.x = cvt_pk_bf16(v0[0], v0[1]); w.y = cvt_pk_bf16(v0[2], v0[3]); w.z = cvt_pk_bf16(v1[0], v1[1]); w.w = cvt_pk_bf16(v1[2], v1[3]);
                    *(u32x4*)(MG + off + bj * 128) = w; } }
    }
};
template <bool WITH_BF16>
struct EpiRes {
    static constexpr bool PERM = false, MID = false, AFTER = false;
    const float* base; float* H; u16* Hb; float* rsq;
    __device__ __forceinline__ void mid(f32x4 (&)[2][2][4][2], const pg8::Unit&, int, int, int, int) const {}
    __device__ __forceinline__ void operator()(f32x4 (&acc)[2][2][4][2], const pg8::Unit& u, int wr, int wc, int fr, int fq) const {
        const int col0 = u.pn * 256 + wc * 32 + 4 * fq, row0 = u.pm * 256 + wr * 64 + fr;
#pragma unroll
        for (int ai = 0; ai < 2; ++ai) {
            f32x4 pre[4][2][2];
#pragma unroll
            for (int m = 0; m < 4; ++m) { const size_t off = (size_t)(row0 + ai * 128 + m * 16) * 1024 + col0;
#pragma unroll
                for (int bj = 0; bj < 2; ++bj)
#pragma unroll
                    for (int n = 0; n < 2; ++n) pre[m][bj][n] = *(const f32x4*)(base + off + bj * 128 + n * 16); }
            asm volatile("" ::: "memory");
#pragma unroll
            for (int m = 0; m < 4; ++m) { const int row = row0 + ai * 128 + m * 16; const size_t off = (size_t)row * 1024 + col0; float s = 0.f;
#pragma unroll
                for (int bj = 0; bj < 2; ++bj)
#pragma unroll
                    for (int n = 0; n < 2; ++n) { const f32x4 hv = pre[m][bj][n] + acc[ai][bj][m][n];
                        *(f32x4*)(H + off + bj * 128 + n * 16) = hv; s += (hv[0] * hv[0] + hv[1] * hv[1]) + (hv[2] * hv[2] + hv[3] * hv[3]);
                        if (WITH_BF16) { u32x2 w; w.x = cvt_pk_bf16(hv[0], hv[1]); w.y = cvt_pk_bf16(hv[2], hv[3]); *(u32x2*)(Hb + off + bj * 128 + n * 16) = w; } }
                s += __shfl_xor(s, 16); s += __shfl_xor(s, 32);
                if (fq == 0) rsq[(size_t)row * 16 + u.pn * 4 + wc] = s; }
            asm volatile("" ::: "memory");
        }
    }
};
struct EpiFfn1 {
    static constexpr bool PERM = true, MID = false, AFTER = false;
    const float* rsq; u16* ACT;
    __device__ __forceinline__ void mid(f32x4 (&)[2][2][4][2], const pg8::Unit&, int, int, int, int) const {}
    __device__ __forceinline__ void operator()(const f32x4 (&acc)[2][2][4][2], const pg8::Unit& u, int wr, int wc, int fr, int fq) const {
        const int col0 = u.pn * 128 + wc * 32 + 8 * fq, row0 = u.pm * 256 + wr * 64 + fr;
        float rstdv[2][4];
#pragma unroll
        for (int ai = 0; ai < 2; ++ai)
#pragma unroll
            for (int m = 0; m < 4; ++m) { const int row = row0 + ai * 128 + m * 16; const f32x4* rp = (const f32x4*)(rsq + (size_t)row * 16);
                const f32x4 r0 = rp[0], r1 = rp[1], r2 = rp[2], r3 = rp[3];
                const float ss = ((r0[0] + r0[1]) + (r0[2] + r0[3])) + ((r1[0] + r1[1]) + (r1[2] + r1[3])) + ((r2[0] + r2[1]) + (r2[2] + r2[3])) + ((r3[0] + r3[1]) + (r3[2] + r3[3]));
                rstdv[ai][m] = rsqrtf(ss * (1.f / DM) + EPS); }
#pragma unroll
        for (int ai = 0; ai < 2; ++ai)
#pragma unroll
            for (int m = 0; m < 4; ++m) { const int row = row0 + ai * 128 + m * 16;
                const float rstd = rstdv[ai][m];
                float o[8];
#pragma unroll
                for (int n = 0; n < 2; ++n)
#pragma unroll
                    for (int e = 0; e < 4; ++e) { const float gt = acc[ai][0][m][n][e] * rstd, up = acc[ai][1][m][n][e] * rstd; o[4 * n + e] = gt * sigm(gt) * up; }
                u32x4 w; w.x = cvt_pk_bf16(o[0], o[1]); w.y = cvt_pk_bf16(o[2], o[3]); w.z = cvt_pk_bf16(o[4], o[5]); w.w = cvt_pk_bf16(o[6], o[7]);
                __builtin_nontemporal_store(w, (u32x4*)(ACT + (size_t)row * DFF + col0)); }
    }
};

struct EpiResNorm {
    static constexpr bool PERM = false, MID = false, AFTER = true;
    const float* base; float* out; const float* gfin; float* slots; unsigned* cnt;
    __device__ __forceinline__ void mid(f32x4 (&)[2][2][4][2], const pg8::Unit&, int, int, int, int) const {}
    __device__ __forceinline__ void operator()(const f32x4 (&)[2][2][4][2], const pg8::Unit&, int, int, int, int) const {}
    __device__ __forceinline__ void after(f32x4 (&acc)[2][2][4][2], const pg8::Unit& u, int wr, int wc, int fr, int fq, LAS unsigned char* lds, int wid, int lane) const {
        LAS float* P = (LAS float*)lds; LAS float* R = (LAS float*)(lds + 4096);
        const int col0 = u.pn * 256 + wc * 32 + 4 * fq;
#pragma unroll
        for (int ai = 0; ai < 2; ++ai)
#pragma unroll
            for (int m = 0; m < 4; ++m) { const int rl = ai * 128 + wr * 64 + m * 16 + fr; const size_t off = (size_t)(u.pm * 256 + rl) * 1024 + col0; float s = 0.f;
#pragma unroll
                for (int bj = 0; bj < 2; ++bj)
#pragma unroll
                    for (int n = 0; n < 2; ++n) { const f32x4 hv = *(const f32x4*)(base + off + bj * 128 + n * 16) + acc[ai][bj][m][n]; acc[ai][bj][m][n] = hv; s += (hv[0] * hv[0] + hv[1] * hv[1]) + (hv[2] * hv[2] + hv[3] * hv[3]); }
                s += __shfl_xor(s, 16); s += __shfl_xor(s, 32);
                if (fq == 0) P[rl * 4 + wc] = s;
                if (m & 1) asm volatile("" ::: "memory"); }
        asm volatile("s_waitcnt lgkmcnt(0)" ::: "memory"); __builtin_amdgcn_s_barrier(); asm volatile("" ::: "memory");
        const int row = wid * 32 + (lane & 31);
        unsigned* slot = (unsigned*)slots + (size_t)(u.pm * 256 + row) * 16;
        if (lane < 32) { const float t = (P[row * 4 + 0] + P[row * 4 + 1]) + (P[row * 4 + 2] + P[row * 4 + 3]);
            __hip_atomic_store(slot + u.pn, __float_as_uint(t), __ATOMIC_RELAXED, __HIP_MEMORY_SCOPE_AGENT); }
        asm volatile("s_waitcnt vmcnt(0)" ::: "memory");
        if (lane == 0) __hip_atomic_fetch_add(cnt + 64 * u.pm, 1u, __ATOMIC_RELAXED, __HIP_MEMORY_SCOPE_AGENT);
        if (wid == 0) { unsigned sp = 0;
            while ((unsigned)__builtin_amdgcn_readfirstlane(__hip_atomic_load(cnt + 64 * u.pm, __ATOMIC_RELAXED, __HIP_MEMORY_SCOPE_AGENT)) < 32u) { __builtin_amdgcn_s_sleep(2); if (++sp > (1u << 20)) break; }
            __builtin_amdgcn_fence(__ATOMIC_ACQUIRE, "agent"); }
        asm volatile("s_waitcnt vmcnt(0) lgkmcnt(0)" ::: "memory"); __builtin_amdgcn_s_barrier(); asm volatile("" ::: "memory");
        if (lane < 32) { float t = 0.f;
#pragma unroll
            for (int k = 0; k < 4; ++k) t += __uint_as_float(__hip_atomic_load(slot + k, __ATOMIC_RELAXED, __HIP_MEMORY_SCOPE_AGENT));
            R[row] = rsqrtf(t * (1.f / DM) + EPS); }
        asm volatile("s_waitcnt lgkmcnt(0)" ::: "memory"); __builtin_amdgcn_s_barrier(); asm volatile("" ::: "memory");
        f32x4 gv[2][2];
#pragma unroll
        for (int bj = 0; bj < 2; ++bj)
#pragma unroll
            for (int n = 0; n < 2; ++n) gv[bj][n] = *(const f32x4*)(gfin + col0 + bj * 128 + n * 16);
#pragma unroll
        for (int ai = 0; ai < 2; ++ai)
#pragma unroll
            for (int m = 0; m < 4; ++m) { const int rl = ai * 128 + wr * 64 + m * 16 + fr; const size_t off = (size_t)(u.pm * 256 + rl) * 1024 + col0; const float rs = R[rl];
#pragma unroll
                for (int bj = 0; bj < 2; ++bj)
#pragma unroll
                    for (int n = 0; n < 2; ++n) *(f32x4*)(out + off + bj * 128 + n * 16) = acc[ai][bj][m][n] * rs * gv[bj][n]; }
    }
};
#define RLX_AGENT __ATOMIC_RELAXED, __HIP_MEMORY_SCOPE_AGENT
#define XB_TMO      128
#define XB_XCNT(j)  (256  + 64 * (j))
#define XB_XSUB(j)  (1280 + 64 * (j))
#define XB_XGEN(j)  (2304 + 64 * (j))
#define XB_TOP      3328
#define XB_TOPGEN   3392
#define XCD_BAR_WORDS 3456
#define XB_SPIN_CAP (1u << 18)

__device__ __forceinline__ unsigned xb_ld(unsigned* p)              { return __hip_atomic_load(p, __ATOMIC_RELAXED, __HIP_MEMORY_SCOPE_AGENT); }
__device__ __forceinline__ unsigned xb_add(unsigned* p, unsigned v) { return __hip_atomic_fetch_add(p, v, __ATOMIC_RELAXED, __HIP_MEMORY_SCOPE_AGENT); }
__device__ __forceinline__ unsigned xb_xcc_id() { return (unsigned)__builtin_amdgcn_s_getreg((3 << 11) | 20) & 0xFu; }
#define XB_SPIN(cond, bar) do { unsigned _sp = 0; while (cond) { __builtin_amdgcn_s_sleep(1); \
    if ((++_sp & 255u) == 0u) { if (xb_ld(&(bar)[XB_TMO])) break; if (_sp > XB_SPIN_CAP) { atomicAdd(&(bar)[XB_TMO], 1u); break; } } } } while (0)

struct XcdBarrier {
    unsigned* bar; unsigned x;
    volatile LAS unsigned* st;
};

__device__ __forceinline__ XcdBarrier xcd_barrier_post(unsigned* bar, volatile LAS unsigned* st) {
    XcdBarrier b; b.bar = bar; b.x = xb_xcc_id(); b.st = st;
    if (threadIdx.x == 0) (void)xb_add(&bar[XB_XCNT(b.x)], 1u);
    return b;
}
__device__ __forceinline__ void xcd_barrier_complete(unsigned* bar, unsigned x, unsigned& nloc, unsigned& nx) {
    const unsigned G = gridDim.x * gridDim.y * gridDim.z;
    unsigned sum, cnt, mine, sp = 0u;
    for (;;) {
        sum = 0u; cnt = 0u; mine = 0u;
#pragma unroll
        for (unsigned j = 0; j < 16; ++j) { const unsigned c = xb_ld(&bar[XB_XCNT(j)]); sum += c; cnt += (c > 0u) ? 1u : 0u; mine = (j == x) ? c : mine; }
        if (sum == G) break;
        __builtin_amdgcn_s_sleep(1);
        if ((++sp & 255u) == 0u) { if (xb_ld(&bar[XB_TMO])) break; if (sp > XB_SPIN_CAP) { atomicAdd(&bar[XB_TMO], 1u); break; } }
    }
    nloc = mine > 0u ? mine : 1u; nx = cnt > 0u ? cnt : 1u;
}

__device__ __forceinline__ void xcd_barrier(const XcdBarrier& b) {
    asm volatile("s_waitcnt vmcnt(0)" ::: "memory");
    __syncthreads();
    if (threadIdx.x == 0) {
        unsigned* bar = b.bar;
        __builtin_amdgcn_s_waitcnt(0);
        unsigned nloc = b.st[0], nx = b.st[1];
        if (nloc == 0u) { xcd_barrier_complete(bar, b.x, nloc, nx); b.st[0] = nloc; b.st[1] = nx; }
        const unsigned old = xb_add(&bar[XB_XSUB(b.x)], 1u);
        const unsigned gen = old / nloc;
        if (old + 1u == (gen + 1u) * nloc) {
            __builtin_amdgcn_fence(__ATOMIC_RELEASE, "agent");
            asm volatile("s_waitcnt vmcnt(0)" ::: "memory");
            const unsigned og = xb_add(&bar[XB_TOP], 1u);
            const unsigned tg = og / nx;
            if (og + 1u == (tg + 1u) * nx) xb_add(&bar[XB_TOPGEN], 1u);
            else XB_SPIN(xb_ld(&bar[XB_TOPGEN]) == tg, bar);
            __builtin_amdgcn_fence(__ATOMIC_ACQUIRE, "agent");
            xb_add(&bar[XB_XGEN(b.x)], 1u);
            asm volatile("s_waitcnt vmcnt(0)" ::: "memory");
        } else {
            XB_SPIN(xb_ld(&bar[XB_XGEN(b.x)]) == gen, bar);
            __builtin_amdgcn_fence(__ATOMIC_ACQUIRE, "agent");
            asm volatile("s_waitcnt vmcnt(0)" ::: "memory");
        }
    }
    __syncthreads();
}

__device__ __forceinline__ void p2_wave(const u16* Gp, const u16* Vp, int nrows, int h, u16* Uout, float* dk, int lane) {
    const int r = lane & 15, q = lane >> 4;
    bf16x8 kf[8][2]; float tot1[8];
#pragma unroll
    for (int kk = 0; kk < 2; ++kk) { const int ks = 1 - kk;
#pragma unroll
        for (int dg = 0; dg < 2; ++dg) {
            int zz = 0; asm volatile("" : "+v"(zz));
            u32x4 wq[4];
#pragma unroll
            for (int p2 = 0; p2 < 2; ++p2) { const int dp = 2 * dg + p2; const int dcol = 32 * dp + 2 * r + zz; unsigned gw[8];
#pragma unroll
                for (int j = 0; j < 8; ++j) { const int s = 32 * ks + 8 * q + j; gw[j] = s < nrows ? *(const unsigned*)(Gp + (size_t)s * 1024 + h * 128 + dcol) : 0u; }
#pragma unroll
                for (int par = 0; par < 2; ++par) { const int dt = 2 * dp + par; float gv[8];
#pragma unroll
                    for (int j = 0; j < 8; ++j) gv[j] = h2f((u16)(par ? (gw[j] >> 16) : (gw[j] & 0xffffu)));
                    float suf[8]; float run = 0.f;
#pragma unroll
                    for (int j = 7; j >= 0; --j) { suf[j] = run; run += gv[j]; }
                    const float T = run, ta = __shfl_xor(T, 16), tb = __shfl_xor(T, 32), tc = __shfl_xor(ta, 32);
                    const float after = ((q ^ 1) > q ? ta : 0.f) + ((q ^ 2) > q ? tb : 0.f) + ((q ^ 3) > q ? tc : 0.f);
                    const float tot = (T + ta) + (tb + tc);
                    float base;
                    if (ks == 1) { tot1[dt] = tot; base = after; } else { base = after + tot1[dt]; if (dk && q == 0) dk[h * 128 + dcol + par] = __expf(tot + tot1[dt]); }
                    float kh[8];
#pragma unroll
                    for (int j = 0; j < 8; ++j) kh[j] = (1.0f - __expf(gv[j])) * __expf(suf[j] + base);
                    u32x4& w = wq[2 * p2 + par];
                    w.x = cvt_pk_bf16(kh[0], kh[1]); w.y = cvt_pk_bf16(kh[2], kh[3]); w.z = cvt_pk_bf16(kh[4], kh[5]); w.w = cvt_pk_bf16(kh[6], kh[7]); } }
            asm volatile("" : "+v"(wq[0].x), "+v"(wq[0].y), "+v"(wq[0].z), "+v"(wq[0].w), "+v"(wq[1].x), "+v"(wq[1].y), "+v"(wq[1].z), "+v"(wq[1].w),
                              "+v"(wq[2].x), "+v"(wq[2].y), "+v"(wq[2].z), "+v"(wq[2].w), "+v"(wq[3].x), "+v"(wq[3].y), "+v"(wq[3].z), "+v"(wq[3].w));
#pragma unroll
            for (int d4 = 0; d4 < 4; ++d4) kf[4 * dg + d4][ks] = __builtin_bit_cast(bf16x8, wq[d4]); } }
#pragma unroll 1
    for (int ep = 0; ep < 4; ++ep) {
        int zz = 0; asm volatile("" : "+v"(zz)); const int ecol = 32 * ep + 2 * r + zz;
        unsigned vw[2][8];
#pragma unroll
        for (int ks = 0; ks < 2; ++ks)
#pragma unroll
            for (int j = 0; j < 8; ++j) { const int s = 32 * ks + 8 * q + j; vw[ks][j] = s < nrows ? *(const unsigned*)(Vp + (size_t)s * 1024 + h * 128 + ecol) : 0u; }
#pragma unroll
        for (int par = 0; par < 2; ++par) {
            bf16x8 vf[2];
#pragma unroll
            for (int ks = 0; ks < 2; ++ks) { u32x4 w;
                if (par == 0) { w.x = (vw[ks][0] & 0xffffu) | (vw[ks][1] << 16); w.y = (vw[ks][2] & 0xffffu) | (vw[ks][3] << 16); w.z = (vw[ks][4] & 0xffffu) | (vw[ks][5] << 16); w.w = (vw[ks][6] & 0xffffu) | (vw[ks][7] << 16); }
                else { w.x = (vw[ks][0] >> 16) | (vw[ks][1] & 0xffff0000u); w.y = (vw[ks][2] >> 16) | (vw[ks][3] & 0xffff0000u); w.z = (vw[ks][4] >> 16) | (vw[ks][5] & 0xffff0000u); w.w = (vw[ks][6] >> 16) | (vw[ks][7] & 0xffff0000u); }
                vf[ks] = __builtin_bit_cast(bf16x8, w); }
            f32x4 acc[8];
#pragma unroll
            for (int dt = 0; dt < 8; ++dt) { acc[dt] = (f32x4){0.f, 0.f, 0.f, 0.f};
#pragma unroll
                for (int ks = 0; ks < 2; ++ks) acc[dt] = __builtin_amdgcn_mfma_f32_16x16x32_bf16(kf[dt][ks], vf[ks], acc[dt], 0, 0, 0); }
#pragma unroll
            for (int dp = 0; dp < 4; ++dp) { u32x4 w; w.x = cvt_pk_bf16(acc[2 * dp][0], acc[2 * dp + 1][0]); w.y = cvt_pk_bf16(acc[2 * dp][1], acc[2 * dp + 1][1]); w.z = cvt_pk_bf16(acc[2 * dp][2], acc[2 * dp + 1][2]); w.w = cvt_pk_bf16(acc[2 * dp][3], acc[2 * dp + 1][3]);
                { const int e = 32 * ep + 2 * r + par;
                  *(u32x4*)(Uout + ((size_t)((e >> 4) * 4 + dp) * 64 + q * 16 + (e & 15)) * 8) = w; } } }
    }
}
__device__ __forceinline__ void p2_states(const Args& a, int G) {
    const int tid = threadIdx.x, lane = tid & 63, wave = __builtin_amdgcn_readfirstlane(tid >> 6);
    const u16* Gb = (const u16*)(a.ws + WS_G); const u16* Vb = (const u16*)(a.ws + WS_V); u16* US = (u16*)a.out; float* DK = (float*)(a.ws + WS_DK);
    for (int it = blockIdx.x; it < BATCH * NCH + 1; it += G) {
        if (it < BATCH * NCH) { const size_t row0 = (size_t)it * CHK;
            p2_wave(Gb + row0 * 1024, Vb + row0 * 1024, CHK, wave, US + ((size_t)it * 8 + wave) * 16384, DK + (size_t)it * 1024, lane); }
        else p2_wave((const u16*)(a.ws + WS_GM), (const u16*)(a.ws + WS_VM), NMETA, wave, (u16*)(a.ws + WS_UM) + (size_t)wave * 16384, nullptr, lane);
    }
}

__device__ __forceinline__ void p3_scan(const Args& a, LAS unsigned char* lds, int G) {
    const int tid = threadIdx.x, lane = tid & 63, wave = __builtin_amdgcn_readfirstlane(tid >> 6);
    {
        LAS float* scr = (LAS float*)(lds + wave * 16384);
        const int gw = (int)blockIdx.x * NWAVES + wave, NGW = G * NWAVES;
        for (int it = gw; it < 2 * 16 * 88; it += NGW) { const int up = it >= 16 * 88, r = up ? it - 16 * 88 : it, kb = r / 88, nb = r % 88, n0 = 32 * nb;
            tr_item(up ? a.w_up : a.w_gate, DFF, 64 * kb, n0, (u16*)(a.ws + WS_WGU), (n0 >> 7) * 256 + (n0 & 127) + (up ? 128 : 0), 1024, 0, a.g_ffn, scr, lane); }
    }
    u16* US = (u16*)a.out; const float* DK = (const float*)(a.ws + WS_DK); const u16* UM = (const u16*)(a.ws + WS_UM);
    for (int idx = blockIdx.x * NTHR + tid; idx < BATCH * 8 * 128 * 64; idx += G * NTHR) {
        const int pr = idx & 8191, h = (idx >> 13) & 7, b = idx >> 16;
        const int d = 32 * ((pr >> 8) & 3) + 8 * ((pr >> 6) & 3) + 2 * (pr & 3);
        const unsigned um = *(const unsigned*)(UM + (size_t)h * 16384 + 2 * pr);
        float s0 = bf_lo(um), s1 = bf_hi(um);
        unsigned* up = (unsigned*)(US + ((size_t)(b * NCH) * 8 + h) * 16384 + 2 * pr);
        const float* dkp = DK + (size_t)(b * NCH) * 1024 + h * 128 + d;
#pragma unroll 1
        for (int c0 = 0; c0 < NCH; c0 += 16) {
            unsigned uu[16]; float dd0[16], dd1[16];
#pragma unroll
            for (int i = 0; i < 16; ++i) { uu[i] = up[(size_t)(c0 + i) * 8 * 8192]; dd0[i] = dkp[(size_t)(c0 + i) * 1024]; dd1[i] = dkp[(size_t)(c0 + i) * 1024 + 1]; }
#pragma unroll
            for (int i = 0; i < 16; ++i) { up[(size_t)(c0 + i) * 8 * 8192] = cvt_pk_bf16(s0, s1); s0 = dd0[i] * s0 + bf_lo(uu[i]); s1 = dd1[i] * s1 + bf_hi(uu[i]); }
        }
    }
}

constexpr int P4_PITCH = 272, P4_MAT = 64 * P4_PITCH  , P4_VPITCH = 136, P4_HS = 4 * P4_MAT  , P4_TOT = 2 * P4_HS  , P4_PLD = P4_TOT + 4096  ;
static_assert(P4_PLD + P4_MAT + 64 <= LDS_BYTES, "LDS map");
__device__ __forceinline__ unsigned ld_pl(const u16* PB, const u16* PLM, int b, int tx, int cofs) {
    return tx >= 0 ? *(const unsigned*)(PB + (size_t)(b * SEQ + tx) * 1024 + 512 + cofs) : *(const unsigned*)(PLM + (size_t)(NMETA + tx) * 512 + cofs);
}
__device__ __forceinline__ void p4_outputs(const Args& a, LAS unsigned char* lds, int G, int skip = 0) {
    (void)skip;
    const int tid = threadIdx.x, lane = tid & 63, wave = __builtin_amdgcn_readfirstlane(tid >> 6);
    const int r = lane & 15, q = lane >> 4;
    u16* Qb = (u16*)(a.ws + WS_Q); const u16* Gb = (const u16*)(a.ws + WS_G); const u16* Vb = (const u16*)(a.ws + WS_V); const u16* OGb = (const u16*)(a.ws + WS_OG);
    u16* PB = (u16*)(a.ws + WS_PB); const u16* PLM = (const u16*)(a.ws + WS_PLM); const u16* PWT = (const u16*)(a.ws + WS_PWT); const u16* US = (const u16*)a.out;
    LAS unsigned char* PLD = lds + P4_PLD;
    for (int item = blockIdx.x; item < BATCH * NCH * 4; item += G) {
        const int hp = item & 3, bc = item >> 2, c = bc & (NCH - 1), b = bc >> 7;
        const size_t row0 = (size_t)b * SEQ + (size_t)c * CHK;
        const int hs = wave >> 2, tq = wave & 3, h = 2 * hp + hs;
        LAS unsigned char* L = lds + hs * P4_HS;
        LAS unsigned char* KT = L, *QT = L + P4_MAT, *QH = L + 2 * P4_MAT, *VT = L + 3 * P4_MAT;
        LAS float* TOT = (LAS float*)(lds + P4_TOT) + hs * 512;
        const int d0 = 2 * lane; const size_t cofs = (size_t)h * 128 + d0;
        unsigned gp[16], qv[16], vv[16];
#pragma unroll
        for (int i = 0; i < 16; ++i) { const size_t o = (row0 + 16 * tq + i) * 1024 + cofs; gp[i] = *(const unsigned*)(Gb + o); qv[i] = *(const unsigned*)(Qb + o); vv[i] = *(const unsigned*)(Vb + o); }
        const int gi = hp, wlen = 2 << gi; const float inv = 1.0f / (float)wlen;
        const int t0 = 8 * wave, pcofs = gi * 128 + 2 * lane, tx0 = c * CHK + t0;
        unsigned pu[23];
#pragma unroll
        for (int j = 1; j < 16; ++j) pu[15 - j] = (j < wlen) ? ld_pl(PB, PLM, b, tx0 - j, pcofs) : 0u;
#pragma unroll
        for (int i = 0; i < 8; ++i) pu[15 + i] = ld_pl(PB, PLM, b, tx0 + i, pcofs);
        bf16x8 wf[4];
#pragma unroll
        for (int kd = 0; kd < 4; ++kd) wf[kd] = *(const bf16x8*)(PWT + (size_t)(gi * 128 + 16 * wave + r) * 128 + 32 * kd + 8 * q);
        float s0 = 0.f, s1 = 0.f;
#pragma unroll
        for (int i = 0; i < 16; ++i) { s0 += h2f((u16)(gp[i] & 0xffffu)); s1 += h2f((u16)(gp[i] >> 16)); }
        TOT[tq * 128 + d0] = s0; TOT[tq * 128 + d0 + 1] = s1;
        __syncthreads();
        {
            float w0 = 0.f, w1 = 0.f;
#pragma unroll
            for (int j = 1; j < 16; ++j) if (j < wlen) { w0 += bf_lo(pu[15 - j]); w1 += bf_hi(pu[15 - j]); }
#pragma unroll
            for (int i = 0; i < 8; ++i) { const float u0 = bf_lo(pu[15 + i]), u1 = bf_hi(pu[15 + i]); w0 += u0; w1 += u1;
                *(LAS unsigned*)(PLD + (t0 + i) * P4_PITCH + 4 * lane) = cvt_pk_bf16(w0 * inv - u0, w1 * inv - u1);
                const unsigned o = wlen == 2 ? pu[15 + i - 1] : (wlen == 4 ? pu[15 + i - 3] : (wlen == 8 ? pu[15 + i - 7] : pu[15 + i - 15]));
                w0 -= bf_lo(o); w1 -= bf_hi(o); }
        }
        float b0 = 0.f, b1 = 0.f;
#pragma unroll
        for (int t2 = 0; t2 < 3; ++t2) if (t2 < tq) { b0 += TOT[t2 * 128 + d0]; b1 += TOT[t2 * 128 + d0 + 1]; }
        const float bm0 = TOT[d0] + TOT[128 + d0], bm1 = TOT[d0 + 1] + TOT[128 + d0 + 1];
#pragma unroll
        for (int i = 0; i < 16; ++i) { const int t = 16 * tq + i; const float g0 = h2f((u16)(gp[i] & 0xffffu)), g1 = h2f((u16)(gp[i] >> 16)); b0 += g0; b1 += g1;
            const unsigned q2 = qv[i], v2 = vv[i];
            const float q0 = bf_lo(q2), q1 = bf_hi(q2), k0 = 1.0f - __expf(g0), k1 = 1.0f - __expf(g1);
            const float eb0 = __expf(b0), eb1 = __expf(b1), em0 = __expf(fminf(b0 - bm0, 80.f)), em1 = __expf(fminf(b1 - bm1, 80.f)), ek0 = __expf(fminf(bm0 - b0, 80.f)), ek1 = __expf(fminf(bm1 - b1, 80.f));
            *(LAS unsigned*)(QT + t * P4_PITCH + d0 * 2) = cvt_pk_bf16(q0 * em0, q1 * em1);
            *(LAS unsigned*)(QH + t * P4_PITCH + d0 * 2) = cvt_pk_bf16(q0 * eb0, q1 * eb1);
            *(LAS unsigned*)(KT + t * P4_PITCH + d0 * 2) = cvt_pk_bf16(k0 * ek0, k1 * ek1);
            *(LAS u16*)(VT + d0 * P4_VPITCH + t * 2) = (u16)(v2 & 0xffffu); *(LAS u16*)(VT + (d0 + 1) * P4_VPITCH + t * 2) = (u16)(v2 >> 16); }
        const u16* Sp = US + ((size_t)bc * 8 + h) * 16384;
        bf16x8 sfr[8][4];
#pragma unroll
        for (int et = 0; et < 8; ++et)
#pragma unroll
            for (int kd = 0; kd < 4; ++kd) sfr[et][kd] = *(const bf16x8*)(Sp + ((size_t)(et * 4 + kd) * 64 + lane) * 8);
        const int tt = tq;
        const size_t orow = (row0 + 16 * tt + r) * 1024 + (size_t)h * 128;
        __syncthreads();
        u32x2 ogv[8];
#pragma unroll
        for (int et = 0; et < 8; ++et) ogv[et] = *(const u32x2*)(OGb + orow + 16 * et + 4 * q);
        {
            f32x4 acc[4];
#pragma unroll
            for (int t4 = 0; t4 < 4; ++t4) acc[t4] = (f32x4){0.f, 0.f, 0.f, 0.f};
#pragma unroll
            for (int kd = 0; kd < 4; ++kd)
#pragma unroll
                for (int t4 = 0; t4 < 4; ++t4) { const bf16x8 pfr = *(const LAS bf16x8*)(PLD + (16 * t4 + r) * P4_PITCH + (32 * kd + 8 * q) * 2); acc[t4] = __builtin_amdgcn_mfma_f32_16x16x32_bf16(wf[kd], pfr, acc[t4], 0, 0, 0); }
            const int n0 = gi * 128 + 16 * wave + 4 * q; const f32x4 psc = *(const f32x4*)(a.pool_scale + n0);
#pragma unroll
            for (int t4 = 0; t4 < 4; ++t4) { u32x2 w; w.x = cvt_pk_bf16(acc[t4][0] * psc[0], acc[t4][1] * psc[1]); w.y = cvt_pk_bf16(acc[t4][2] * psc[2], acc[t4][3] * psc[3]);
                *(u32x2*)(PB + (row0 + 16 * t4 + r) * 1024 + n0) = w; }
        }
        bf16x8 qt[4], qh[4];
#pragma unroll
        for (int kd = 0; kd < 4; ++kd) { qt[kd] = *(const LAS bf16x8*)(QT + (16 * tt + r) * P4_PITCH + (32 * kd + 8 * q) * 2); qh[kd] = *(const LAS bf16x8*)(QH + (16 * tt + r) * P4_PITCH + (32 * kd + 8 * q) * 2); }
        f32x4 sc[4];
#pragma unroll
        for (int st = 0; st < 4; ++st) { f32x4 acc = (f32x4){0.f, 0.f, 0.f, 0.f};
            if (st <= tt) {
#pragma unroll
                for (int kd = 0; kd < 4; ++kd) { const bf16x8 kfr = *(const LAS bf16x8*)(KT + (16 * st + r) * P4_PITCH + (32 * kd + 8 * q) * 2); acc = __builtin_amdgcn_mfma_f32_16x16x32_bf16(kfr, qt[kd], acc, 0, 0, 0); }
                if (st == tt) {
#pragma unroll
                    for (int i = 0; i < 4; ++i) if (4 * q + i > r) acc[i] = 0.f; }
            }
            sc[st] = acc; }
        bf16x8 pf[2];
#pragma unroll
        for (int ks = 0; ks < 2; ++ks) { u32x4 w; w.x = cvt_pk_bf16(sc[2 * ks][0], sc[2 * ks][1]); w.y = cvt_pk_bf16(sc[2 * ks][2], sc[2 * ks][3]); w.z = cvt_pk_bf16(sc[2 * ks + 1][0], sc[2 * ks + 1][1]); w.w = cvt_pk_bf16(sc[2 * ks + 1][2], sc[2 * ks + 1][3]);
            pf[ks] = __builtin_bit_cast(bf16x8, w); }
        f32x4 oa[8]; float ss = 0.f;
#pragma unroll
        for (int et = 0; et < 8; ++et) { f32x4 acc = (f32x4){0.f, 0.f, 0.f, 0.f};
#pragma unroll
            for (int kd = 0; kd < 4; ++kd) acc = __builtin_amdgcn_mfma_f32_16x16x32_bf16(sfr[et][kd], qh[kd], acc, 0, 0, 0);
#pragma unroll
            for (int ks = 0; ks < 2; ++ks) if (2 * ks <= tt) {
                const u32x2 lo = *(const LAS u32x2*)(VT + (16 * et + r) * P4_VPITCH + (32 * ks + 4 * q) * 2), hi = *(const LAS u32x2*)(VT + (16 * et + r) * P4_VPITCH + (32 * ks + 16 + 4 * q) * 2);
                const u32x4 w = (u32x4){lo.x, lo.y, hi.x, hi.y};
                acc = __builtin_amdgcn_mfma_f32_16x16x32_bf16(__builtin_bit_cast(bf16x8, w), pf[ks], acc, 0, 0, 0); }
            oa[et] = acc; ss += (acc[0] * acc[0] + acc[1] * acc[1]) + (acc[2] * acc[2] + acc[3] * acc[3]); }
        ss += __shfl_xor(ss, 16); ss += __shfl_xor(ss, 32);
        const float rstd = rsqrtf(ss * (1.f / 128.f) + EPS);
#pragma unroll
        for (int et = 0; et < 8; ++et) { const int e0 = 16 * et + 4 * q; const f32x4 gn = *(const f32x4*)(a.g_hn + e0); const u32x2 og = ogv[et];
            u32x2 w; w.x = cvt_pk_bf16(oa[et][0] * rstd * gn[0] * bf_lo(og.x), oa[et][1] * rstd * gn[1] * bf_hi(og.x)); w.y = cvt_pk_bf16(oa[et][2] * rstd * gn[2] * bf_lo(og.y), oa[et][3] * rstd * gn[3] * bf_hi(og.y));
            *(LAS u32x2*)(QT + (16 * tt + r) * P4_PITCH + e0 * 2) = w; }
        asm volatile("s_waitcnt lgkmcnt(0)" ::: "memory");
#pragma unroll
        for (int i = 0; i < 4; ++i) { const int rr = 16 * tt + 4 * i + (lane >> 4); const u32x4 v = *(const LAS u32x4*)(QT + rr * P4_PITCH + (lane & 15) * 16);
            *(u32x4*)(Qb + (row0 + rr) * 1024 + (size_t)h * 128 + (lane & 15) * 8) = v; }
    }
    __syncthreads();
}

__device__ __forceinline__ void p9_final(const Args& a, int G) {
    const int tid = threadIdx.x, lane = tid & 63, wave = __builtin_amdgcn_readfirstlane(tid >> 6);
    const float* rsq = (const float*)(a.ws + WS_RSQ);
    const f32x4* gr = (const f32x4*)a.g_fin + lane; f32x4 gv[4];
#pragma unroll
    for (int j = 0; j < 4; ++j) gv[j] = gr[64 * j];
    for (int m = 2 * (blockIdx.x * NWAVES + wave); m < M; m += 2 * G * NWAVES) {
        float p = lane < 32 ? rsq[(size_t)m * 16 + lane] : 0.f;
        f32x4* xr = (f32x4*)(a.out + (size_t)m * DM) + lane; f32x4 v[8];
#pragma unroll
        for (int j = 0; j < 8; ++j) v[j] = xr[64 * j];
        p += __shfl_xor(p, 1); p += __shfl_xor(p, 2); p += __shfl_xor(p, 4); p += __shfl_xor(p, 8);
        const float r0 = rsqrtf(__shfl(p, 0) * (1.f / DM) + EPS), r1 = rsqrtf(__shfl(p, 16) * (1.f / DM) + EPS);
#pragma unroll
        for (int j = 0; j < 8; ++j) { const float rs = j < 4 ? r0 : r1; const f32x4 g4 = gv[j & 3]; xr[64 * j] = (f32x4){v[j].x * rs * g4.x, v[j].y * rs * g4.y, v[j].z * rs * g4.z, v[j].w * rs * g4.w}; }
    }
}

#ifdef PROBE_STOP
__device__ __forceinline__ void p_dump(const Args& a, int G) {
    const u16* Qb = (const u16*)(a.ws + WS_Q); const u16* Gb = (const u16*)(a.ws + WS_G); const u16* Vb = (const u16*)(a.ws + WS_V); const u16* OGb = (const u16*)(a.ws + WS_OG);
    const u16* GAb = (const u16*)(a.ws + WS_GA); const u16* GBb = (const u16*)(a.ws + WS_GB); const u16* PB = (const u16*)(a.ws + WS_PB);
    for (size_t i = (size_t)blockIdx.x * NTHR + threadIdx.x; i < (size_t)M * DM; i += (size_t)G * NTHR) {
        float v = 0.f;
        if (PROBE_STOP == 1) v = bf1(Qb[i]) + h2f(Gb[i]) + bf1(Vb[i]) + bf1(OGb[i]) + bf1(GAb[i]) + bf1(GBb[i]) + bf1(PB[i]);
        else if (PROBE_STOP == 2 || PROBE_STOP == 3) { float t = bf1(((const u16*)a.out)[i]) + bf1(((const u16*)a.out)[i + (size_t)M * DM]); if (!(fabsf(t) < 1e30f)) t = 12345.f; ((float*)(a.ws + WS_GA))[i] = t; continue; }
        else if (PROBE_STOP == 4) v = bf1(Qb[i]) + bf1(PB[i]);
        else if (PROBE_STOP == 5) v = bf1(Gb[i]);
        else continue;
        a.out[i] = v;
    }
}
#endif
__device__ __forceinline__ void flat_barrier(unsigned* cnt) {
    asm volatile("s_waitcnt vmcnt(0)" ::: "memory");
    __syncthreads();
    if (threadIdx.x == 0) {
        const unsigned Gn = gridDim.x;
        __builtin_amdgcn_fence(__ATOMIC_RELEASE, "agent");
        asm volatile("s_waitcnt vmcnt(0)" ::: "memory");
        const unsigned old = __hip_atomic_fetch_add(cnt, 1u, __ATOMIC_RELAXED, __HIP_MEMORY_SCOPE_AGENT);
        const unsigned target = (old / Gn + 1u) * Gn; unsigned sp = 0;
        while (__hip_atomic_load(cnt, __ATOMIC_RELAXED, __HIP_MEMORY_SCOPE_AGENT) < target) { __builtin_amdgcn_s_sleep(1); if (++sp > (1u << 22)) break; }
        __builtin_amdgcn_fence(__ATOMIC_ACQUIRE, "agent");
        asm volatile("s_waitcnt vmcnt(0)" ::: "memory");
    }
    __syncthreads();
}
constexpr int NPH = 10;
__global__ void __launch_bounds__(NTHR, 2) mega(Args a) {
    extern __shared__ __attribute__((aligned(16))) unsigned char lds_raw[];
    LAS unsigned char* lds = (LAS unsigned char*)lds_raw;
    cg::grid_group grid = cg::this_grid();
    const int G = gridDim.x, lo = a.ph_lo, hi = a.ph_hi;
    unsigned char* ws = a.ws;
    volatile LAS unsigned* MISC = (volatile LAS unsigned*)(lds + LDS_BYTES - 64);
    if (threadIdx.x < 16) MISC[threadIdx.x] = 0u;
    __syncthreads();
    XcdBarrier bar; bar.bar = (unsigned*)(ws + WS_BAR); bar.x = 0; bar.st = nullptr;
    if (hi - lo > 1) bar = xcd_barrier_post((unsigned*)(ws + WS_BAR), MISC);
    if (hi < 0) grid.sync();
#ifndef PHMASK
#define PHMASK 0x3ff
#endif
#define IN(k) (((PHMASK >> (k)) & 1) && lo <= (k) && (k) < hi)
#ifndef CG_SEAMS
#define CG_SEAMS 0x0
#endif
#define SEAM(k) do { if (IN(k) && IN((k) + 1)) { if ((CG_SEAMS >> (k)) & 1) grid.sync(); else xcd_barrier(bar); } } while (0)
#ifndef PROBE_DUP
#define PROBE_DUP 0
#endif
#ifndef PROBE_XSYNC
#define PROBE_XSYNC 0
#endif
#define DUP(k) (((PROBE_DUP >> (k)) & 1) ? 2 : 1)
    if (IN(0)) { p0_prologue(a, lds, G); } SEAM(0);
#ifdef PROBE_XBAR
    for (int xs = 0; xs < PROBE_XBAR; ++xs) flat_barrier((unsigned*)(ws + WS_BAR + 14 * KiB));
#endif
    if (IN(1)) { pg8::Gemm g{(const u16*)a.out, (const u16*)(ws + WS_WIN), M, INW, DM, DM, 1 << 30, 0L}; pg8::StaticOrder S; S.init(M, INW, G, (int)blockIdx.x);
        EpiIn E{ws}; pg8::gemm_phase<EpiIn, true>(lds, g, S, E);
        if (G == 256 && blockIdx.x >= 128) late_weights(a, lds, ((int)blockIdx.x - 128) * NWAVES + (int)(threadIdx.x >> 6), 128 * NWAVES); }
    SEAM(1);
    if (IN(2)) { p2_states(a, G); } SEAM(2);
    if (IN(3)) { p3_scan(a, lds, G); } SEAM(3);
    if (IN(4)) { p4_outputs(a, lds, G); } SEAM(4);
    if (IN(5)) { pg8::Gemm g{(const u16*)(ws + WS_Q), (const u16*)(ws + WS_WAB), M, DM, 1536, DM, 16, (long)(WS_PB - WS_Q) - 16L * 128L}; pg8::StaticOrder S; S.init(M, DM, G, (int)blockIdx.x);
        EpiMerge E{(const u16*)(ws + WS_GA), (const u16*)(ws + WS_GB), (u16*)(ws + WS_MG)}; pg8::gemm_phase<EpiMerge, false>(lds, g, S, E); } SEAM(5);
    if (IN(6)) { pg8::Gemm g{(const u16*)(ws + WS_MG), (const u16*)(ws + WS_WOUT), M, DM, DM, DM, 1 << 30, 0L}; pg8::StaticOrder S; S.init(M, DM, G, (int)blockIdx.x);
        EpiRes<true> E{a.x, a.out, (u16*)(ws + WS_H1B), (float*)(ws + WS_RSQ)}; pg8::gemm_phase<EpiRes<true>, false>(lds, g, S, E); } SEAM(6);
    if (IN(7)) { pg8::Gemm g{(const u16*)(ws + WS_H1B), (const u16*)(ws + WS_WGU), M, NGU, DM, DM, 1 << 30, 0L}; pg8::StaticOrder S; S.init(M, NGU, G, (int)blockIdx.x);
        EpiFfn1 E{(const float*)(ws + WS_RSQ), (u16*)(ws + WS_ACT)}; pg8::gemm_phase<EpiFfn1, true>(lds, g, S, E); } SEAM(7);
    const bool fuse9 = (G == (M / 256) * (DM / 256)) && (hi - lo > 1);
    if (IN(8)) { pg8::Gemm g{(const u16*)(ws + WS_ACT), (const u16*)(ws + WS_WD), M, DM, DFF, DFF, 1 << 30, 0L}; pg8::StaticOrder S; S.init(M, DM, G, (int)blockIdx.x);
        if (fuse9) { EpiResNorm E{a.out, a.out, a.g_fin, (float*)(ws + WS_RSQ), (unsigned*)(ws + WS_CNT)}; pg8::gemm_phase<EpiResNorm, false>(lds, g, S, E); }
        else { EpiRes<false> E{a.out, a.out, nullptr, (float*)(ws + WS_RSQ)}; pg8::gemm_phase<EpiRes<false>, false>(lds, g, S, E); } }
    if (!fuse9) { SEAM(8);
    if (IN(9)) { p9_final(a, G); } }
#ifdef PROBE_LIST
    if (lo == 20) p0_prologue(a, lds, G, 1);
    if (lo == 30) p0_prologue(a, lds, G, 2);
    if (lo == 40) p0_prologue(a, lds, G, 4);
    if (lo == 14) p4_outputs(a, lds, G, 1);
    if (lo == 24) p4_outputs(a, lds, G, 2);
    if (lo == 34) p4_outputs(a, lds, G, 2 | 4);
    if (lo == 44) p4_outputs(a, lds, G, 2 | 8);
    if (lo == 54) p4_outputs(a, lds, G, 2 | 16);
    if (lo == 64) p4_outputs(a, lds, G, 2 | 32);
    if (lo == 74) p4_outputs(a, lds, G, 2 | 64);
    if (lo == 18) { pg8::Gemm g{(const u16*)(ws + WS_ACT), (const u16*)(ws + WS_WD), M, DM, DFF, DFF, 1 << 30, 0L}; pg8::StaticOrder S; S.init(M, DM, G, (int)blockIdx.x);
        EpiRes<false> E{(const float*)(ws + WS_GA), (float*)(ws + WS_GA), nullptr, (float*)(ws + WS_OG)}; pg8::gemm_phase<EpiRes<false>, false>(lds, g, S, E); }
    if (lo == 19) { Args b = a; b.out = (float*)(ws + WS_GA); p9_final(b, G); }
#endif
#ifdef PROBE_STOP
    if (lo == 10) p_dump(a, G);
    if (lo == 11 && (PROBE_STOP == 2 || PROBE_STOP == 3)) { for (size_t i = (size_t)blockIdx.x * NTHR + threadIdx.x; i < (size_t)M * DM; i += (size_t)G * NTHR) a.out[i] = ((const float*)(a.ws + WS_GA))[i]; }
#endif
#undef IN
#undef SEAM
}

extern "C" void kernel_launch(void* const* d_in, const int* in_sizes, int n_in, void* d_out, int out_size, void* d_ws, size_t ws_size, hipStream_t stream) {
    static int grid = 0;
    if (grid == 0) {
        if (n_in != 16 || in_sizes[0] != M * DM || out_size != M * DM || ws_size < WS_END) { fprintf(stderr, "kernel_launch: unexpected shapes (n_in %d, in0 %d, out %d, ws %zu); nothing launched\n", n_in, n_in > 0 ? in_sizes[0] : -1, out_size, ws_size); grid = -1; return; }
        int dev = 0, cus = 0, per_cu = 0;
        (void)hipGetDevice(&dev); (void)hipDeviceGetAttribute(&cus, hipDeviceAttributeMultiprocessorCount, dev);
        if (hipFuncSetAttribute((const void*)mega, hipFuncAttributeMaxDynamicSharedMemorySize, LDS_BYTES) != hipSuccess) { fprintf(stderr, "kernel_launch: hipFuncSetAttribute failed\n"); }
        if (hipOccupancyMaxActiveBlocksPerMultiprocessor(&per_cu, (const void*)mega, NTHR, LDS_BYTES) != hipSuccess || per_cu < 1) per_cu = 1;
        (void)hipGetLastError();
        if (cus <= 0) cus = 256;
        grid = cus * per_cu;
    }
    if (grid < 0) return;
#if MK_COOP
    if (hipMemsetAsync((char*)d_ws + WS_BAR, 0, CTL_ZERO, stream) != hipSuccess) { fprintf(stderr, "kernel_launch: hipMemsetAsync of the barrier words failed\n"); return; }
#endif
    Args a{};
    a.x = (const float*)d_in[0]; a.meta = (const float*)d_in[1]; a.g_mix = (const float*)d_in[2]; a.w_in = (const float*)d_in[3]; a.lb_raw = (const float*)d_in[4]; a.g_hn = (const float*)d_in[5];
    a.pool_w = (const float*)d_in[6]; a.pool_scale = (const float*)d_in[7]; a.w_a = (const float*)d_in[8]; a.w_b = (const float*)d_in[9]; a.w_out = (const float*)d_in[10]; a.g_ffn = (const float*)d_in[11];
    a.w_gate = (const float*)d_in[12]; a.w_up = (const float*)d_in[13]; a.w_down = (const float*)d_in[14]; a.g_fin = (const float*)d_in[15];
    a.out = (float*)d_out; a.ws = (unsigned char*)d_ws;
#if MK_COOP
    a.ph_lo = 0; a.ph_hi = NPH;
    void* args[] = {&a};
    const hipError_t e = hipLaunchCooperativeKernel((const void*)mega, dim3(grid), dim3(NTHR), args, LDS_BYTES, stream);
    if (e != hipSuccess) fprintf(stderr, "kernel_launch: cooperative launch failed: %s (grid %d)\n", hipGetErrorString(e), grid);
#else
#ifdef PROBE_STOP
    for (int ph = 0; ph <= PROBE_STOP; ++ph) { a.ph_lo = ph; a.ph_hi = ph + 1; hipLaunchKernelGGL(mega, dim3(grid), dim3(NTHR), LDS_BYTES, stream, a); }
    a.ph_lo = 10; a.ph_hi = 11; hipLaunchKernelGGL(mega, dim3(grid), dim3(NTHR), LDS_BYTES, stream, a);
    a.ph_lo = 11; a.ph_hi = 12; hipLaunchKernelGGL(mega, dim3(grid), dim3(NTHR), LDS_BYTES, stream, a);
#else
#ifdef PROBE_LIST
    { const int lst[] = PROBE_LIST; for (int i = 0; i < (int)(sizeof(lst) / sizeof(int)); ++i) { a.ph_lo = lst[i]; a.ph_hi = lst[i] + 1; hipLaunchKernelGGL(mega, dim3(grid), dim3(NTHR), LDS_BYTES, stream, a); } }
#else
    for (int ph = 0; ph < NPH; ++ph) { a.ph_lo = ph; a.ph_hi = ph + 1; hipLaunchKernelGGL(mega, dim3(grid), dim3(NTHR), LDS_BYTES, stream, a); }
#endif
#endif
#endif
}
```

```cpp
#include <hip/hip_runtime.h>
#include <hip/hip_cooperative_groups.h>
#include <cstdio>
#include <cstdint>
namespace cg = cooperative_groups;

#ifndef MK_COOP
#define MK_COOP 1
#endif

#define LAS __attribute__((address_space(3)))
typedef unsigned short u16;
typedef short bf16x8 __attribute__((ext_vector_type(8)));
typedef float f32x4 __attribute__((ext_vector_type(4)));
typedef unsigned u32x4 __attribute__((ext_vector_type(4)));
typedef unsigned u32x2 __attribute__((ext_vector_type(2)));

typedef __bf16 bf16v2_t __attribute__((ext_vector_type(2)));
typedef float f32v2_t __attribute__((ext_vector_type(2)));
__device__ __forceinline__ unsigned cvt_pk_bf16(float lo, float hi) { const f32v2_t f = {lo, hi}; const bf16v2_t v = __builtin_convertvector(f, bf16v2_t); return __builtin_bit_cast(unsigned, v); }
__device__ __forceinline__ float bf_lo(unsigned w) { return __uint_as_float(w << 16); }
__device__ __forceinline__ float bf_hi(unsigned w) { return __uint_as_float(w & 0xffff0000u); }
__device__ __forceinline__ float bf1(u16 w) { return __uint_as_float((unsigned)w << 16); }
__device__ __forceinline__ unsigned pk_h(float a, float b) { const _Float16 x = (_Float16)a, y = (_Float16)b; return (unsigned)__builtin_bit_cast(unsigned short, x) | ((unsigned)__builtin_bit_cast(unsigned short, y) << 16); }
__device__ __forceinline__ float h2f(u16 w) { return (float)__builtin_bit_cast(_Float16, w); }
__device__ __forceinline__ float sigm(float z) { return __builtin_amdgcn_rcpf(1.0f + __expf(-z)); }

namespace pg8 {
constexpr int BM = 256, BK = 64, HALF = 128, HTB = HALF * BK * 2, STAGE_BYTES = 8 * HTB, NXCD = 8, WGM = 8;
__host__ __device__ __forceinline__ int lds_byte(int r, int c) { const int st = (r >> 4) * 2 + (c >> 5), rr = r & 15, cc = c & 31, ob = rr * 64 + cc * 2; return st * 1024 + (ob ^ (((ob >> 9) & 1) << 5)); }
__host__ __device__ __forceinline__ void stage_rc(int b, int& R, int& C) { const int st = b / 1024, sb = b % 1024, swz = sb ^ (((sb >> 9) & 1) << 5); R = (st >> 1) * 16 + swz / 64; C = (st & 1) * 32 + (swz % 64) / 2; }
__host__ __device__ __forceinline__ int perm32(int rho) { const int n = rho >> 4, i = rho & 15; return 8 * (i >> 2) + 4 * n + (i & 3); }
struct Unit { int pm, pn; };
struct Gemm { const u16* A; const u16* Bt; int M, N, K, lda, ksplit; long a2delta; };
struct StaticOrder {
    int nM, nN, nwg, G, c;
    __host__ __device__ void init(int M, int N, int G_, int c_) { nM = M / BM; nN = N / BM; nwg = nM * nN; G = G_; c = c_; }
    __host__ __device__ bool next(int i, Unit& u) const {
        const long L = (long)i * G + c; if (L >= nwg) return false;
        int wgid = (int)L; { const int q = nwg / NXCD, r = nwg % NXCD, xcd = wgid % NXCD, off = wgid / NXCD; wgid = (xcd < r ? xcd * (q + 1) : r * (q + 1) + (xcd - r) * q) + off; }
        const int nig = WGM * nN, gid = wgid / nig, fm = gid * WGM, gsz = (nM - fm) < WGM ? (nM - fm) : WGM;
        u.pm = fm + ((wgid % nig) % gsz); u.pn = (wgid % nig) / gsz; return true;
    }
};
template <class Epi, bool ALIGN_EPI>
__device__ __forceinline__ void gemm_phase(LAS unsigned char* lds, const Gemm g, const StaticOrder& S, const Epi& E) {
    const int tid = threadIdx.x, wid = __builtin_amdgcn_readfirstlane(tid >> 6), lane = tid & 63, wr = wid >> 2, wc = wid & 3, fr = lane & 15, fq = lane >> 4;
    const int K = g.K, nt = K / BK, lda = g.lda;
    unsigned voffA[2], voffB[2];
#pragma unroll
    for (int i = 0; i < 2; ++i) { int R, C; stage_rc(tid * 16 + i * 8192, R, C); const int Rb = Epi::PERM ? ((R & ~31) + perm32(R & 31)) : R;
        voffA[i] = (unsigned)(R * lda + C) * 2u; voffB[i] = (unsigned)(Rb * K + C) * 2u; }
    const size_t kstep = (size_t)(BK * 2);
    const size_t hstepA = (size_t)HALF * lda * 2, tstepA = 2 * hstepA;
    const size_t hstepB = (size_t)HALF * K * 2, tstepB = 2 * hstepB;
    const unsigned ldsw = (unsigned)wid * 1024u;
    const int aoff = lds_byte(wr * 64 + fr, fq * 8), boff = lds_byte(wc * 32 + fr, fq * 8);
#define PG8_SA(b, h) (((b) * 2 + (h)) * HTB)
#define PG8_SB(b, h) ((4 + (b) * 2 + (h)) * HTB)
#define PG8_STAGE(bufoff, gbase, voff) do { _Pragma("unroll") for (int _i = 0; _i < 2; ++_i) \
        __builtin_amdgcn_global_load_lds((const unsigned*)((const char*)(gbase) + (voff)[_i]), (LAS unsigned*)(lds + (bufoff) + ldsw + _i * 8192), 16, 0, 0); } while (0)
#define PG8_LDA(dst, b, h) do { _Pragma("unroll") for (int m = 0; m < 4; ++m) _Pragma("unroll") for (int k = 0; k < 2; ++k) dst[m][k] = *(const LAS bf16x8*)(lds + PG8_SA(b, h) + aoff + m * 2048 + k * 1024); } while (0)
#define PG8_LDB(dst, b, h) do { _Pragma("unroll") for (int n = 0; n < 2; ++n) _Pragma("unroll") for (int k = 0; k < 2; ++k) dst[n][k] = *(const LAS bf16x8*)(lds + PG8_SB(b, h) + boff + n * 2048 + k * 1024); } while (0)
#define PG8_MMA(ai, bj, At, Bt) do { __builtin_amdgcn_s_setprio(1); _Pragma("unroll") for (int m = 0; m < 4; ++m) _Pragma("unroll") for (int n = 0; n < 2; ++n) _Pragma("unroll") for (int k = 0; k < 2; ++k) \
        acc[ai][bj][m][n] = __builtin_amdgcn_mfma_f32_16x16x32_bf16(Bt[n][k], At[m][k], acc[ai][bj][m][n], 0, 0, 0); __builtin_amdgcn_s_setprio(0); } while (0)
#define PG8_WAIT_V(n) asm volatile("s_waitcnt vmcnt(" #n ")" ::: "memory")
#define PG8_WAIT_L(n) asm volatile("s_waitcnt lgkmcnt(" #n ")" ::: "memory")
#define PG8_BAR __builtin_amdgcn_s_barrier()
#define PG8_SCHED __builtin_amdgcn_sched_barrier(0)
    Unit cur, nxt; int ui = 0;
    if (!S.next(0, cur)) return;
    f32x4 acc[2][2][4][2];
#pragma unroll
    for (int a = 0; a < 2; ++a)
#pragma unroll
        for (int b = 0; b < 2; ++b)
#pragma unroll
            for (int m = 0; m < 4; ++m)
#pragma unroll
                for (int n = 0; n < 2; ++n) acc[a][b][m][n] = (f32x4){0.f, 0.f, 0.f, 0.f};
    bf16x8 At[4][2], B0[2][2], B1[2][2];
    const char* cA = (const char*)g.A + (size_t)cur.pm * tstepA; const char* cB = (const char*)g.Bt + (size_t)cur.pn * tstepB;
    PG8_STAGE(PG8_SB(0, 0), cB, voffB); PG8_STAGE(PG8_SB(0, 1), cB + hstepB, voffB); PG8_STAGE(PG8_SA(0, 0), cA, voffA); PG8_STAGE(PG8_SA(0, 1), cA + hstepA, voffA);
    if (wr == 1) PG8_BAR;
    PG8_WAIT_V(2); PG8_BAR;
    PG8_STAGE(PG8_SB(1, 0), cB + kstep, voffB); PG8_STAGE(PG8_SA(1, 0), cA + kstep, voffA); PG8_STAGE(PG8_SB(1, 1), cB + hstepB + kstep, voffB);
    PG8_WAIT_V(6); PG8_BAR;
    for (;;) {
        const bool has_next = S.next(ui + 1, nxt);
        const char* nA = has_next ? (const char*)g.A + (size_t)nxt.pm * tstepA : cA; const char* nB = has_next ? (const char*)g.Bt + (size_t)nxt.pn * tstepB : cB;
        for (int t = 0; t < nt; t += 2) {
            const bool last = (t == nt - 2);
            if constexpr (Epi::MID) { if (t == g.ksplit) E.mid(acc, cur, wr, wc, fr, fq); }
            const char* a1 = cA + (size_t)(t + 1) * kstep + (t >= g.ksplit ? g.a2delta : 0L);
            const char* a2 = last ? nA : cA + (size_t)(t + 2) * kstep + (t + 2 >= g.ksplit ? g.a2delta : 0L);
            const char* b2 = last ? nB : cB + (size_t)(t + 2) * kstep;
            const char* a3 = a2 + kstep; const char* b3 = b2 + kstep;
            PG8_LDB(B0, 0, 0); PG8_LDB(B1, 0, 1); PG8_SCHED; PG8_LDA(At, 0, 0); PG8_STAGE(PG8_SA(1, 1), a1 + hstepA, voffA);
            PG8_WAIT_V(8); PG8_WAIT_L(0); PG8_BAR; PG8_MMA(0, 0, At, B0); PG8_MMA(0, 1, At, B1); PG8_BAR; PG8_SCHED;
            PG8_LDA(At, 0, 1); PG8_STAGE(PG8_SB(0, 0), b2, voffB); PG8_STAGE(PG8_SB(0, 1), b2 + hstepB, voffB); PG8_STAGE(PG8_SA(0, 0), a2, voffA);
            PG8_WAIT_V(8); PG8_WAIT_L(0); PG8_BAR; PG8_MMA(1, 0, At, B0); PG8_MMA(1, 1, At, B1); PG8_BAR; PG8_SCHED;
            PG8_LDB(B0, 1, 0); PG8_LDB(B1, 1, 1); PG8_SCHED; PG8_LDA(At, 1, 0); PG8_STAGE(PG8_SA(0, 1), a2 + hstepA, voffA);
            PG8_WAIT_V(8); PG8_WAIT_L(0); PG8_BAR; PG8_MMA(0, 0, At, B0); PG8_MMA(0, 1, At, B1); PG8_BAR; PG8_SCHED;
            PG8_LDA(At, 1, 1); PG8_STAGE(PG8_SB(1, 0), b3, voffB); PG8_STAGE(PG8_SB(1, 1), b3 + hstepB, voffB); PG8_STAGE(PG8_SA(1, 0), a3, voffA);
            PG8_WAIT_V(8); PG8_WAIT_L(0); PG8_BAR; PG8_MMA(1, 0, At, B0); PG8_MMA(1, 1, At, B1); PG8_BAR; PG8_SCHED;
        }
        if constexpr (ALIGN_EPI) { if (wr == 0) PG8_BAR; }
        if constexpr (!Epi::AFTER) E(acc, cur, wr, wc, fr, fq);
        if (!has_next) break;
#pragma unroll
        for (int a = 0; a < 2; ++a)
#pragma unroll
            for (int b = 0; b < 2; ++b)
#pragma unroll
                for (int m = 0; m < 4; ++m)
#pragma unroll
                    for (int n = 0; n < 2; ++n) acc[a][b][m][n] = (f32x4){0.f, 0.f, 0.f, 0.f};
        cur = nxt; cA = nA; cB = nB; ++ui;
        if constexpr (ALIGN_EPI) { if (wr == 1) PG8_BAR; }
    }
    PG8_WAIT_V(0);
    if constexpr (!ALIGN_EPI) { if (wr == 0) PG8_BAR; }
    PG8_BAR;
    if constexpr (Epi::AFTER) E.after(acc, cur, wr, wc, fr, fq, lds, wid, lane);
#undef PG8_SA
#undef PG8_SB
#undef PG8_STAGE
#undef PG8_LDA
#undef PG8_LDB
#undef PG8_MMA
#undef PG8_WAIT_V
#undef PG8_WAIT_L
#undef PG8_BAR
#undef PG8_SCHED
}
}

constexpr int NWAVES = 8, NTHR = 512;
constexpr int SEQ = 8192, BATCH = 2, DM = 1024, M = BATCH * SEQ, NMETA = 16, INW = 6656, DFF = 2816, NGU = 2 * DFF, CHK = 64, NCH = SEQ / CHK;
constexpr float EPS = 1e-6f;
constexpr size_t KiB = 1024, MiB = 1u << 20;
constexpr size_t WS_LB = 0, WS_GM = 64 * KiB, WS_VM = 128 * KiB, WS_PLM = 192 * KiB, WS_PWT = 256 * KiB, WS_UM = 512 * KiB, WS_DK = 1 * MiB, WS_RSQ = 2 * MiB;
constexpr size_t WS_WAB = 3 * MiB, WS_WOUT = 6 * MiB, WS_WD = 8 * MiB, WS_WIN = 14 * MiB, WS_WGU = 14 * MiB;
constexpr size_t WS_Q = 28 * MiB, WS_G = 60 * MiB, WS_V = 92 * MiB, WS_OG = 124 * MiB, WS_GA = 156 * MiB, WS_GB = 188 * MiB, WS_PB = 220 * MiB, WS_END = 252 * MiB;
constexpr size_t WS_MG = WS_G, WS_H1B = WS_GB, WS_ACT = WS_Q;
static_assert(WS_WD + (size_t)DM * DFF * 2 <= WS_WIN && WS_WIN + (size_t)INW * DM * 2 <= WS_Q && WS_WGU + (size_t)NGU * DM * 2 <= WS_Q && WS_ACT + (size_t)M * DFF * 2 <= WS_H1B, "ws map");
constexpr int LDS_BYTES = 163840;
constexpr size_t WS_BAR = 16 * KiB, WS_CNT = 32 * KiB, CTL_ZERO = 32 * KiB;

struct Args {
    const float *x, *meta, *g_mix, *w_in, *lb_raw, *g_hn, *pool_w, *pool_scale, *w_a, *w_b, *w_out, *g_ffn, *w_gate, *w_up, *w_down, *g_fin;
    float* out; unsigned char* ws; int ph_lo, ph_hi;
};

#define LDS_WAIT() asm volatile("s_waitcnt lgkmcnt(0)" ::: "memory")
__device__ __forceinline__ float wave_sum(float v) {
#pragma unroll
    for (int o = 1; o < 64; o <<= 1) v += __shfl_xor(v, o);
    return v;
}

__device__ __forceinline__ void tr_item(const float* W, int N, int k0, int n0, u16* WT, int drow0, int dpitch, int dk0, const float* ks, LAS float* scr, int lane) {
#pragma unroll
    for (int i = 0; i < 32; ++i) { const int kk = 2 * i + (lane >> 5); float w = __builtin_nontemporal_load(&W[(size_t)(k0 + kk) * N + n0 + (lane & 31)]); if (ks) w *= ks[k0 + kk]; scr[kk * 33 + (lane & 31)] = w; }
    LDS_WAIT(); asm volatile("" ::: "memory");
    const int c = lane & 7;
#pragma unroll
    for (int j = 0; j < 4; ++j) { const int n = (lane >> 3) + 8 * j; const LAS float* s = scr + (8 * c) * 33 + n;
        u32x4 o; o.x = cvt_pk_bf16(s[0 * 33], s[1 * 33]); o.y = cvt_pk_bf16(s[2 * 33], s[3 * 33]); o.z = cvt_pk_bf16(s[4 * 33], s[5 * 33]); o.w = cvt_pk_bf16(s[6 * 33], s[7 * 33]);
        *(u32x4*)(WT + (size_t)(drow0 + n) * dpitch + dk0 + k0 + 8 * c) = o; }
    LDS_WAIT(); asm volatile("" ::: "memory");
}
__device__ __forceinline__ void rms_row_bf16(const float* xrow, const float* g, u16* orow, int lane) {
    const f32x4* xr = (const f32x4*)xrow + lane; const f32x4* gr = (const f32x4*)g + lane;
    f32x4 v[4]; float s = 0.f;
#pragma unroll
    for (int j = 0; j < 4; ++j) { v[j] = xr[64 * j]; s += (v[j].x * v[j].x + v[j].y * v[j].y) + (v[j].z * v[j].z + v[j].w * v[j].w); }
    const float rstd = rsqrtf(wave_sum(s) * (1.f / DM) + EPS);
    u32x2* o8 = (u32x2*)orow + lane;
#pragma unroll
    for (int j = 0; j < 4; ++j) { const f32x4 gv = gr[64 * j]; u32x2 o; o.x = cvt_pk_bf16(v[j].x * rstd * gv.x, v[j].y * rstd * gv.y); o.y = cvt_pk_bf16(v[j].z * rstd * gv.z, v[j].w * rstd * gv.w); o8[64 * j] = o; }
}

__device__ __forceinline__ void p0_meta(const Args& a, LAS unsigned char* lds, int j, int tid, int wave, int lane) {
    LAS float* nm = (LAS float*)lds;
    LAS float* part = (LAS float*)(lds + 65536);
#pragma unroll
    for (int rr = 0; rr < 2; ++rr) { const int r = 2 * wave + rr; const f32x4* xr = (const f32x4*)(a.meta + (size_t)r * DM) + lane; const f32x4* gr = (const f32x4*)a.g_mix + lane;
        f32x4 v[4]; float s = 0.f;
#pragma unroll
        for (int q = 0; q < 4; ++q) { v[q] = xr[64 * q]; s += (v[q].x * v[q].x + v[q].y * v[q].y) + (v[q].z * v[q].z + v[q].w * v[q].w); }
        const float rstd = rsqrtf(wave_sum(s) * (1.f / DM) + EPS);
#pragma unroll
        for (int q = 0; q < 4; ++q) { const f32x4 gv = gr[64 * q]; *(LAS f32x4*)(nm + r * 1024 + 4 * (lane + 64 * q)) = (f32x4){v[q].x * rstd * gv.x, v[q].y * rstd * gv.y, v[q].z * rstd * gv.z, v[q].w * rstd * gv.w}; }
    }
    __syncthreads();
    const int colbase = j < 16 ? 1024 + 64 * j : (j < 32 ? 2048 + 64 * (j - 16) : 4096 + 64 * (j - 32));
    {
        const int col = colbase + lane; float acc[16];
#pragma unroll
        for (int r = 0; r < 16; ++r) acc[r] = 0.f;
#pragma unroll 4
        for (int k = 128 * wave; k < 128 * wave + 128; k += 4) {
            const float w0 = a.w_in[(size_t)(k + 0) * INW + col], w1 = a.w_in[(size_t)(k + 1) * INW + col], w2 = a.w_in[(size_t)(k + 2) * INW + col], w3 = a.w_in[(size_t)(k + 3) * INW + col];
#pragma unroll
            for (int r = 0; r < 16; ++r) { const f32x4 n4 = *(const LAS f32x4*)(nm + r * 1024 + k); acc[r] += (n4.x * w0 + n4.y * w1) + (n4.z * w2 + n4.w * w3); }
        }
#pragma unroll
        for (int r = 0; r < 16; ++r) part[(wave * 16 + r) * 64 + lane] = acc[r];
    }
    __syncthreads();
#pragma unroll
    for (int o = 0; o < 2; ++o) {
        const int idx = tid + o * NTHR, r = idx >> 6, cl = idx & 63; float z = 0.f;
#pragma unroll
        for (int w = 0; w < 8; ++w) z += part[(w * 16 + r) * 64 + cl];
        const int col = colbase + cl;
        if (col < 2048) { const int c = col - 1024; const float lb = 1.0f / (1.0f + __expf(a.lb_raw[1024 + c] - a.lb_raw[c])); const float f = lb + (1.0f - lb) * sigm(z);
            const _Float16 hv = (_Float16)__logf(f); ((u16*)(a.ws + WS_GM))[r * 1024 + c] = __builtin_bit_cast(unsigned short, hv); }
        else if (col < 3072) { ((u16*)(a.ws + WS_VM))[r * 1024 + (col - 2048)] = (u16)(cvt_pk_bf16(z, 0.f) & 0xffffu); }
        else { ((u16*)(a.ws + WS_PLM))[r * 512 + (col - 4096)] = (u16)(cvt_pk_bf16(z, 0.f) & 0xffffu); }
    }
    __syncthreads();
}

__device__ __forceinline__ void late_weights(const Args& a, LAS unsigned char* lds, int gw, int NGW) {
    const int lane = threadIdx.x & 63, wave = __builtin_amdgcn_readfirstlane(threadIdx.x >> 6);
    LAS float* scr = (LAS float*)(lds + wave * 16384);
    constexpr int I_A = 16 * 32, I_B = 8 * 32, I_O = 16 * 32, I_D = 44 * 32, I_P = 32;
    constexpr int NIT = I_A + I_B + I_O + I_D + I_P;
    for (int it = gw; it < NIT; it += NGW) {
        int r = it;
        if (r < I_A) { tr_item(a.w_a, 1024, 64 * (r / 32), 32 * (r % 32), (u16*)(a.ws + WS_WAB), 32 * (r % 32), 1536, 0, nullptr, scr, lane); continue; } r -= I_A;
        if (r < I_B) { tr_item(a.w_b, 1024, 64 * (r / 32), 32 * (r % 32), (u16*)(a.ws + WS_WAB), 32 * (r % 32), 1536, 1024, nullptr, scr, lane); continue; } r -= I_B;
        if (r < I_O) { tr_item(a.w_out, 1024, 64 * (r / 32), 32 * (r % 32), (u16*)(a.ws + WS_WOUT), 32 * (r % 32), 1024, 0, nullptr, scr, lane); continue; } r -= I_O;
        if (r < I_D) { tr_item(a.w_down, 1024, 64 * (r / 32), 32 * (r % 32), (u16*)(a.ws + WS_WD), 32 * (r % 32), DFF, 0, nullptr, scr, lane); continue; } r -= I_D;
        { const int gi = r >> 3, q = r & 7; tr_item(a.pool_w + (size_t)gi * 16384, 128, 64 * (q >> 2), 32 * (q & 3), (u16*)(a.ws + WS_PWT) + (size_t)gi * 16384, 32 * (q & 3), 128, 0, nullptr, scr, lane); }
    }
}

__device__ __forceinline__ void p0_prologue(const Args& a, LAS unsigned char* lds, int G, int skip = 0) {
    const int tid = threadIdx.x, lane = tid & 63, wave = __builtin_amdgcn_readfirstlane(tid >> 6);
    const bool split = G > 80;
    if ((int)blockIdx.x < 40) { if (!(skip & 4)) p0_meta(a, lds, (int)blockIdx.x, tid, wave, lane); if (split) return; }
    if (blockIdx.x == 40 || (G <= 40 && blockIdx.x == 0)) { for (int c = tid; c < 1024; c += NTHR) ((float*)(a.ws + WS_LB))[c] = 1.0f / (1.0f + __expf(a.lb_raw[1024 + c] - a.lb_raw[c])); }
    LAS float* scr = (LAS float*)(lds + wave * 16384);
    const int gw = ((int)blockIdx.x - (split ? 40 : 0)) * NWAVES + wave, NGW = (G - (split ? 40 : 0)) * NWAVES;
    constexpr int I_IN = 16 * 208;
    for (int it = gw; it < I_IN && !(skip & 1); it += NGW) tr_item(a.w_in, INW, 64 * (it / 208), 32 * (it % 208), (u16*)(a.ws + WS_WIN), 32 * (it % 208), 1024, 0, nullptr, scr, lane);
    if (G != 256) late_weights(a, lds, gw, NGW);
    u16* XN = (u16*)a.out;
    {
        const f32x4* gr = (const f32x4*)a.g_mix + lane; f32x4 gv[4];
#pragma unroll
        for (int j = 0; j < 4; ++j) gv[j] = gr[64 * j];
        for (int m = 4 * gw; m < M && !(skip & 2); m += 4 * NGW) {
            const f32x4* xr = (const f32x4*)(a.x + (size_t)m * DM) + lane; f32x4 v[16]; float ss[4];
#pragma unroll
            for (int j = 0; j < 16; ++j) v[j] = __builtin_nontemporal_load(&xr[64 * j]);
#pragma unroll
            for (int rr = 0; rr < 4; ++rr) { float t = 0.f;
#pragma unroll
                for (int j = 0; j < 4; ++j) { const f32x4 w = v[4 * rr + j]; t += (w.x * w.x + w.y * w.y) + (w.z * w.z + w.w * w.w); }
                ss[rr] = t; }
#pragma unroll
            for (int o = 1; o < 64; o <<= 1) {
#pragma unroll
                for (int rr = 0; rr < 4; ++rr) ss[rr] += __shfl_xor(ss[rr], o); }
            u32x2* o8 = (u32x2*)(XN + (size_t)m * DM) + lane;
#pragma unroll
            for (int j = 0; j < 16; ++j) { const float rs = rsqrtf(ss[j >> 2] * (1.f / DM) + EPS); const f32x4 g4 = gv[j & 3]; u32x2 o; o.x = cvt_pk_bf16(v[j].x * rs * g4.x, v[j].y * rs * g4.y); o.y = cvt_pk_bf16(v[j].z * rs * g4.z, v[j].w * rs * g4.w); o8[64 * j] = o; }
        }
    }
}

struct EpiIn {
    static constexpr bool PERM = true, MID = false, AFTER = false;
    unsigned char* ws;
    __device__ __forceinline__ void mid(f32x4 (&)[2][2][4][2], const pg8::Unit&, int, int, int, int) const {}
    __device__ __forceinline__ void operator()(f32x4 (&acc)[2][2][4][2], const pg8::Unit& u, int wr, int wc, int fr, int fq) const {
        const int colt = u.pn * 256; int type, c0; size_t boff;
        if (colt < 1024) { type = 1; boff = WS_Q; c0 = colt; }
        else if (colt < 2048) { type = 3; boff = WS_G; c0 = colt - 1024; }
        else if (colt < 3072) { type = 0; boff = WS_V; c0 = colt - 2048; }
        else if (colt < 4096) { type = 1; boff = WS_OG; c0 = colt - 3072; }
        else if (colt < 4608) { type = 0; boff = WS_PB; c0 = colt - 4096 + 512; }
        else if (colt < 5632) { type = 2; boff = WS_GA; c0 = colt - 4608; }
        else { type = 2; boff = WS_GB; c0 = colt - 5632; }
        u16* base = (u16*)(ws + boff);
        const int col0 = c0 + wc * 32 + 8 * fq, row0 = u.pm * 256 + wr * 64 + fr;
        const float* LB = (const float*)(ws + WS_LB);
        f32x4 lbv[2][2];
        if (type == 3) {
#pragma unroll
            for (int bj = 0; bj < 2; ++bj) { lbv[bj][0] = *(const f32x4*)(LB + col0 + bj * 128); lbv[bj][1] = *(const f32x4*)(LB + col0 + bj * 128 + 4); }
        } else {
#pragma unroll
            for (int bj = 0; bj < 2; ++bj) { lbv[bj][0] = (f32x4){0.f, 0.f, 0.f, 0.f}; lbv[bj][1] = (f32x4){0.f, 0.f, 0.f, 0.f}; }
        }
#pragma unroll
        for (int ai = 0; ai < 2; ++ai)
#pragma unroll
            for (int m = 0; m < 4; ++m) { u16* rowp = base + (size_t)(row0 + ai * 128 + m * 16) * 1024 + col0;
#pragma unroll
                for (int bj = 0; bj < 2; ++bj) { f32x4 v0 = acc[ai][bj][m][0], v1 = acc[ai][bj][m][1]; u32x4 w;
                    if (type == 3) {
                        const f32x4 l0 = lbv[bj][0], l1 = lbv[bj][1];
#pragma unroll
                        for (int e = 0; e < 4; ++e) { v0[e] = __logf(l0[e] + (1.0f - l0[e]) * sigm(v0[e])); v1[e] = __logf(l1[e] + (1.0f - l1[e]) * sigm(v1[e])); }
                        w.x = pk_h(v0[0], v0[1]); w.y = pk_h(v0[2], v0[3]); w.z = pk_h(v1[0], v1[1]); w.w = pk_h(v1[2], v1[3]);
                    } else {
                        if (type == 1) {
#pragma unroll
                            for (int e = 0; e < 4; ++e) { v0[e] = v0[e] * sigm(v0[e]); v1[e] = v1[e] * sigm(v1[e]); }
                        } else if (type == 2) {
#pragma unroll
                            for (int e = 0; e < 4; ++e) { v0[e] = sigm(v0[e]); v1[e] = sigm(v1[e]); }
                        }
                        w.x = cvt_pk_bf16(v0[0], v0[1]); w.y = cvt_pk_bf16(v0[2], v0[3]); w.z = cvt_pk_bf16(v1[0], v1[1]); w.w = cvt_pk_bf16(v1[2], v1[3]);
                    }
                    __builtin_nontemporal_store(w, (u32x4*)(rowp + bj * 128)); } }
    }
};
struct EpiMerge {
    static constexpr bool PERM = true, MID = true, AFTER = false;
    const u16 *GA, *GB; u16* MG;
    __device__ __forceinline__ void mid(f32x4 (&acc)[2][2][4][2], const pg8::Unit& u, int wr, int wc, int fr, int fq) const {
        int zz = 0; asm volatile("" : "+v"(zz));
        const int col0 = u.pn * 256 + wc * 32 + 8 * fq, row0 = u.pm * 256 + wr * 64 + fr + zz;
#pragma unroll
        for (int ai = 0; ai < 2; ++ai)
#pragma unroll
            for (int m = 0; m < 4; ++m) { const size_t off = (size_t)(row0 + ai * 128 + m * 16) * 1024 + col0;
#pragma unroll
                for (int bj = 0; bj < 2; ++bj) { const u32x4 ga = __builtin_nontemporal_load((const u32x4*)(GA + off + bj * 128)), gb = *(const u32x4*)(GB + off + bj * 128);
#pragma unroll
                    for (int e = 0; e < 2; ++e) { acc[ai][bj][m][0][2 * e] *= bf_lo(ga[e]) * __builtin_amdgcn_rcpf(bf_lo(gb[e])); acc[ai][bj][m][0][2 * e + 1] *= bf_hi(ga[e]) * __builtin_amdgcn_rcpf(bf_hi(gb[e]));
                        acc[ai][bj][m][1][2 * e] *= bf_lo(ga[2 + e]) * __builtin_amdgcn_rcpf(bf_lo(gb[2 + e])); acc[ai][bj][m][1][2 * e + 1] *= bf_hi(ga[2 + e]) * __builtin_amdgcn_rcpf(bf_hi(gb[2 + e])); } }
                asm volatile("" ::: "memory"); }
    }
    __device__ __forceinline__ void operator()(f32x4 (&acc)[2][2][4][2], const pg8::Unit& u, int wr, int wc, int fr, int fq) const {
        const int col0 = u.pn * 256 + wc * 32 + 8 * fq, row0 = u.pm * 256 + wr * 64 + fr;
#pragma unroll
        for (int ai = 0; ai < 2; ++ai)
#pragma unroll
            for (int m = 0; m < 4; ++m) { const size_t off = (size_t)(row0 + ai * 128 + m * 16) * 1024 + col0;
#pragma unroll
                for (int bj = 0; bj < 2; ++bj) { const u32x4 gb = *(const u32x4*)(GB + off + bj * 128);
                    acc[ai][bj][m][0] *= (f32x4){bf_lo(gb[0]), bf_hi(gb[0]), bf_lo(gb[1]), bf_hi(gb[1])}; acc[ai][bj][m][1] *= (f32x4){bf_lo(gb[2]), bf_hi(gb[2]), bf_lo(gb[3]), bf_hi(gb[3])}; } }
#pragma unroll
        for (int ai = 0; ai < 2; ++ai)
#pragma unroll
            for (int m = 0; m < 4; ++m) { const size_t off = (size_t)(row0 + ai * 128 + m * 16) * 1024 + col0;
#pragma unroll
                for (int bj = 0; bj < 2; ++bj) { const f32x4 v0 = acc[ai][bj][m][0], v1 = acc[ai][bj][m][1]; u32x4 w;
                    w.x = cvt_pk_bf16(v0[0], v0[1]); w.y = cvt_pk_bf16(v0[2], v0[3]); w.z = cvt_pk_bf16(v1[0], v1[1]); w.w = cvt_pk_bf16(v1[2], v1[3]);
                    *(u32x4*)(MG + off + bj * 128) = w; } }
    }
};
template <bool WITH_BF16>
struct EpiRes {
    static constexpr bool PERM = false, MID = false, AFTER = false;
    const float* base; float* H; u16* Hb; float* rsq;
    __device__ __forceinline__ void mid(f32x4 (&)[2][2][4][2], const pg8::Unit&, int, int, int, int) const {}
    __device__ __forceinline__ void operator()(f32x4 (&acc)[2][2][4][2], const pg8::Unit& u, int wr, int wc, int fr, int fq) const {
        const int col0 = u.pn * 256 + wc * 32 + 4 * fq, row0 = u.pm * 256 + wr * 64 + fr;
#pragma unroll
        for (int ai = 0; ai < 2; ++ai) {
            f32x4 pre[4][2][2];
#pragma unroll
            for (int m = 0; m < 4; ++m) { const size_t off = (size_t)(row0 + ai * 128 + m * 16) * 1024 + col0;
#pragma unroll
                for (int bj = 0; bj < 2; ++bj)
#pragma unroll
                    for (int n = 0; n < 2; ++n) pre[m][bj][n] = __builtin_nontemporal_load((const f32x4*)(base + off + bj * 128 + n * 16)); }
            asm volatile("" ::: "memory");
#pragma unroll
            for (int m = 0; m < 4; ++m) { const int row = row0 + ai * 128 + m * 16; const size_t off = (size_t)row * 1024 + col0; float s = 0.f;
#pragma unroll
                for (int bj = 0; bj < 2; ++bj)
#pragma unroll
                    for (int n = 0; n < 2; ++n) { const f32x4 hv = pre[m][bj][n] + acc[ai][bj][m][n];
                        *(f32x4*)(H + off + bj * 128 + n * 16) = hv; s += (hv[0] * hv[0] + hv[1] * hv[1]) + (hv[2] * hv[2] + hv[3] * hv[3]);
                        if (WITH_BF16) { u32x2 w; w.x = cvt_pk_bf16(hv[0], hv[1]); w.y = cvt_pk_bf16(hv[2], hv[3]); *(u32x2*)(Hb + off + bj * 128 + n * 16) = w; } }
                s += __shfl_xor(s, 16); s += __shfl_xor(s, 32);
                if (fq == 0) rsq[(size_t)row * 16 + u.pn * 4 + wc] = s; }
            asm volatile("" ::: "memory");
        }
    }
};
struct EpiFfn1 {
    static constexpr bool PERM = true, MID = false, AFTER = false;
    const float* rsq; u16* ACT;
    __device__ __forceinline__ void mid(f32x4 (&)[2][2][4][2], const pg8::Unit&, int, int, int, int) const {}
    __device__ __forceinline__ void operator()(const f32x4 (&acc)[2][2][4][2], const pg8::Unit& u, int wr, int wc, int fr, int fq) const {
        const int col0 = u.pn * 128 + wc * 32 + 8 * fq, row0 = u.pm * 256 + wr * 64 + fr;
        float rstdv[2][4];
#pragma unroll
        for (int ai = 0; ai < 2; ++ai)
#pragma unroll
            for (int m = 0; m < 4; ++m) { const int row = row0 + ai * 128 + m * 16; const f32x4* rp = (const f32x4*)(rsq + (size_t)row * 16);
                const f32x4 r0 = rp[0], r1 = rp[1], r2 = rp[2], r3 = rp[3];
                const float ss = ((r0[0] + r0[1]) + (r0[2] + r0[3])) + ((r1[0] + r1[1]) + (r1[2] + r1[3])) + ((r2[0] + r2[1]) + (r2[2] + r2[3])) + ((r3[0] + r3[1]) + (r3[2] + r3[3]));
                rstdv[ai][m] = rsqrtf(ss * (1.f / DM) + EPS); }
#pragma unroll
        for (int ai = 0; ai < 2; ++ai)
#pragma unroll
            for (int m = 0; m < 4; ++m) { const int row = row0 + ai * 128 + m * 16;
                const float rstd = rstdv[ai][m];
                float o[8];
#pragma unroll
                for (int n = 0; n < 2; ++n)
#pragma unroll
                    for (int e = 0; e < 4; ++e) { const float gt = acc[ai][0][m][n][e] * rstd, up = acc[ai][1][m][n][e] * rstd; o[4 * n + e] = gt * sigm(gt) * up; }
                u32x4 w; w.x = cvt_pk_bf16(o[0], o[1]); w.y = cvt_pk_bf16(o[2], o[3]); w.z = cvt_pk_bf16(o[4], o[5]); w.w = cvt_pk_bf16(o[6], o[7]);
                __builtin_nontemporal_store(w, (u32x4*)(ACT + (size_t)row * DFF + col0)); }
    }
};

struct EpiResNorm {
    static constexpr bool PERM = false, MID = false, AFTER = true;
    const float* base; float* out; const float* gfin; float* slots; unsigned* cnt;
    __device__ __forceinline__ void mid(f32x4 (&)[2][2][4][2], const pg8::Unit&, int, int, int, int) const {}
    __device__ __forceinline__ void operator()(const f32x4 (&)[2][2][4][2], const pg8::Unit&, int, int, int, int) const {}
    __device__ __forceinline__ void after(f32x4 (&acc)[2][2][4][2], const pg8::Unit& u, int wr, int wc, int fr, int fq, LAS unsigned char* lds, int wid, int lane) const {
        LAS float* P = (LAS float*)lds; LAS float* R = (LAS float*)(lds + 4096);
        const int col0 = u.pn * 256 + wc * 32 + 4 * fq;
#pragma unroll
        for (int ai = 0; ai < 2; ++ai)
#pragma unroll
            for (int m = 0; m < 4; ++m) { const int rl = ai * 128 + wr * 64 + m * 16 + fr; const size_t off = (size_t)(u.pm * 256 + rl) * 1024 + col0; float s = 0.f;
#pragma unroll
                for (int bj = 0; bj < 2; ++bj)
#pragma unroll
                    for (int n = 0; n < 2; ++n) { const f32x4 hv = __builtin_nontemporal_load((const f32x4*)(base + off + bj * 128 + n * 16)) + acc[ai][bj][m][n]; acc[ai][bj][m][n] = hv; s += (hv[0] * hv[0] + hv[1] * hv[1]) + (hv[2] * hv[2] + hv[3] * hv[3]); }
                s += __shfl_xor(s, 16); s += __shfl_xor(s, 32);
                if (fq == 0) P[rl * 4 + wc] = s;
                if (m & 1) asm volatile("" ::: "memory"); }
        asm volatile("s_waitcnt lgkmcnt(0)" ::: "memory"); __builtin_amdgcn_s_barrier(); asm volatile("" ::: "memory");
        const int row = wid * 32 + (lane & 31);
        unsigned* slot = (unsigned*)slots + (size_t)(u.pm * 256 + row) * 16;
        if (lane < 32) { const float t = (P[row * 4 + 0] + P[row * 4 + 1]) + (P[row * 4 + 2] + P[row * 4 + 3]);
            __hip_atomic_store(slot + u.pn, __float_as_uint(t), __ATOMIC_RELAXED, __HIP_MEMORY_SCOPE_AGENT); }
        asm volatile("s_waitcnt vmcnt(0)" ::: "memory");
        if (lane == 0) __hip_atomic_fetch_add(cnt + 64 * u.pm, 1u, __ATOMIC_RELAXED, __HIP_MEMORY_SCOPE_AGENT);
        if (wid == 0) { unsigned sp = 0;
            while ((unsigned)__builtin_amdgcn_readfirstlane(__hip_atomic_load(cnt + 64 * u.pm, __ATOMIC_RELAXED, __HIP_MEMORY_SCOPE_AGENT)) < 32u) { __builtin_amdgcn_s_sleep(2); if (++sp > (1u << 20)) break; }
            __builtin_amdgcn_fence(__ATOMIC_ACQUIRE, "agent"); }
        asm volatile("s_waitcnt vmcnt(0) lgkmcnt(0)" ::: "memory"); __builtin_amdgcn_s_barrier(); asm volatile("" ::: "memory");
        if (lane < 32) { float t = 0.f;
#pragma unroll
            for (int k = 0; k < 4; ++k) t += __uint_as_float(__hip_atomic_load(slot + k, __ATOMIC_RELAXED, __HIP_MEMORY_SCOPE_AGENT));
            R[row] = rsqrtf(t * (1.f / DM) + EPS); }
        asm volatile("s_waitcnt lgkmcnt(0)" ::: "memory"); __builtin_amdgcn_s_barrier(); asm volatile("" ::: "memory");
        f32x4 gv[2][2];
#pragma unroll
        for (int bj = 0; bj < 2; ++bj)
#pragma unroll
            for (int n = 0; n < 2; ++n) gv[bj][n] = *(const f32x4*)(gfin + col0 + bj * 128 + n * 16);
#pragma unroll
        for (int ai = 0; ai < 2; ++ai)
#pragma unroll
            for (int m = 0; m < 4; ++m) { const int rl = ai * 128 + wr * 64 + m * 16 + fr; const size_t off = (size_t)(u.pm * 256 + rl) * 1024 + col0; const float rs = R[rl];
#pragma unroll
                for (int bj = 0; bj < 2; ++bj)
#pragma unroll
                    for (int n = 0; n < 2; ++n) *(f32x4*)(out + off + bj * 128 + n * 16) = acc[ai][bj][m][n] * rs * gv[bj][n]; }
    }
};
#define RLX_AGENT __ATOMIC_RELAXED, __HIP_MEMORY_SCOPE_AGENT
#define XB_TMO      128
#define XB_XCNT(j)  (256  + 64 * (j))
#define XB_XSUB(j)  (1280 + 64 * (j))
#define XB_XGEN(j)  (2304 + 64 * (j))
#define XB_TOP      3328
#define XB_TOPGEN   3392
#define XCD_BAR_WORDS 3456
#define XB_SPIN_CAP (1u << 18)

__device__ __forceinline__ unsigned xb_ld(unsigned* p)              { return __hip_atomic_load(p, __ATOMIC_RELAXED, __HIP_MEMORY_SCOPE_AGENT); }
__device__ __forceinline__ unsigned xb_add(unsigned* p, unsigned v) { return __hip_atomic_fetch_add(p, v, __ATOMIC_RELAXED, __HIP_MEMORY_SCOPE_AGENT); }
__device__ __forceinline__ unsigned xb_xcc_id() { return (unsigned)__builtin_amdgcn_s_getreg((3 << 11) | 20) & 0xFu; }
#define XB_SPIN(cond, bar) do { unsigned _sp = 0; while (cond) { __builtin_amdgcn_s_sleep(1); \
    if ((++_sp & 255u) == 0u) { if (xb_ld(&(bar)[XB_TMO])) break; if (_sp > XB_SPIN_CAP) { atomicAdd(&(bar)[XB_TMO], 1u); break; } } } } while (0)

struct XcdBarrier {
    unsigned* bar; unsigned x;
    volatile LAS unsigned* st;
};

__device__ __forceinline__ XcdBarrier xcd_barrier_post(unsigned* bar, volatile LAS unsigned* st) {
    XcdBarrier b; b.bar = bar; b.x = xb_xcc_id(); b.st = st;
    if (threadIdx.x == 0) (void)xb_add(&bar[XB_XCNT(b.x)], 1u);
    return b;
}
__device__ __forceinline__ void xcd_barrier_complete(unsigned* bar, unsigned x, unsigned& nloc, unsigned& nx) {
    const unsigned G = gridDim.x * gridDim.y * gridDim.z;
    unsigned sum, cnt, mine, sp = 0u;
    for (;;) {
        sum = 0u; cnt = 0u; mine = 0u;
#pragma unroll
        for (unsigned j = 0; j < 16; ++j) { const unsigned c = xb_ld(&bar[XB_XCNT(j)]); sum += c; cnt += (c > 0u) ? 1u : 0u; mine = (j == x) ? c : mine; }
        if (sum == G) break;
        __builtin_amdgcn_s_sleep(1);
        if ((++sp & 255u) == 0u) { if (xb_ld(&bar[XB_TMO])) break; if (sp > XB_SPIN_CAP) { atomicAdd(&bar[XB_TMO], 1u); break; } }
    }
    nloc = mine > 0u ? mine : 1u; nx = cnt > 0u ? cnt : 1u;
}

__device__ __forceinline__ void xcd_barrier(const XcdBarrier& b) {
    asm volatile("s_waitcnt vmcnt(0)" ::: "memory");
    __syncthreads();
    if (threadIdx.x == 0) {
        unsigned* bar = b.bar;
        __builtin_amdgcn_s_waitcnt(0);
        unsigned nloc = b.st[0], nx = b.st[1];
        if (nloc == 0u) { xcd_barrier_complete(bar, b.x, nloc, nx); b.st[0] = nloc; b.st[1] = nx; }
        const unsigned old = xb_add(&bar[XB_XSUB(b.x)], 1u);
        const unsigned gen = old / nloc;
        if (old + 1u == (gen + 1u) * nloc) {
            __builtin_amdgcn_fence(__ATOMIC_RELEASE, "agent");
            asm volatile("s_waitcnt vmcnt(0)" ::: "memory");
            const unsigned og = xb_add(&bar[XB_TOP], 1u);
            const unsigned tg = og / nx;
            if (og + 1u == (tg + 1u) * nx) xb_add(&bar[XB_TOPGEN], 1u);
            else XB_SPIN(xb_ld(&bar[XB_TOPGEN]) == tg, bar);
            __builtin_amdgcn_fence(__ATOMIC_ACQUIRE, "agent");
            xb_add(&bar[XB_XGEN(b.x)], 1u);
            asm volatile("s_waitcnt vmcnt(0)" ::: "memory");
        } else {
            XB_SPIN(xb_ld(&bar[XB_XGEN(b.x)]) == gen, bar);
            __builtin_amdgcn_fence(__ATOMIC_ACQUIRE, "agent");
            asm volatile("s_waitcnt vmcnt(0)" ::: "memory");
        }
    }
    __syncthreads();
}

__device__ __forceinline__ void p2_wave(const u16* Gp, const u16* Vp, int nrows, int h, u16* Uout, float* dk, int lane) {
    const int r = lane & 15, q = lane >> 4;
    bf16x8 kf[8][2]; float tot1[8];
#pragma unroll
    for (int kk = 0; kk < 2; ++kk) { const int ks = 1 - kk;
#pragma unroll
        for (int dg = 0; dg < 2; ++dg) {
            int zz = 0; asm volatile("" : "+v"(zz));
            u32x4 wq[4];
#pragma unroll
            for (int p2 = 0; p2 < 2; ++p2) { const int dp = 2 * dg + p2; const int dcol = 32 * dp + 2 * r + zz; unsigned gw[8];
#pragma unroll
                for (int j = 0; j < 8; ++j) { const int s = 32 * ks + 8 * q + j; gw[j] = s < nrows ? *(const unsigned*)(Gp + (size_t)s * 1024 + h * 128 + dcol) : 0u; }
#pragma unroll
                for (int par = 0; par < 2; ++par) { const int dt = 2 * dp + par; float gv[8];
#pragma unroll
                    for (int j = 0; j < 8; ++j) gv[j] = h2f((u16)(par ? (gw[j] >> 16) : (gw[j] & 0xffffu)));
                    float suf[8]; float run = 0.f;
#pragma unroll
                    for (int j = 7; j >= 0; --j) { suf[j] = run; run += gv[j]; }
                    const float T = run, ta = __shfl_xor(T, 16), tb = __shfl_xor(T, 32), tc = __shfl_xor(ta, 32);
                    const float after = ((q ^ 1) > q ? ta : 0.f) + ((q ^ 2) > q ? tb : 0.f) + ((q ^ 3) > q ? tc : 0.f);
                    const float tot = (T + ta) + (tb + tc);
                    float base;
                    if (ks == 1) { tot1[dt] = tot; base = after; } else { base = after + tot1[dt]; if (dk && q == 0) dk[h * 128 + dcol + par] = __expf(tot + tot1[dt]); }
                    float kh[8];
#pragma unroll
                    for (int j = 0; j < 8; ++j) kh[j] = (1.0f - __expf(gv[j])) * __expf(suf[j] + base);
                    u32x4& w = wq[2 * p2 + par];
                    w.x = cvt_pk_bf16(kh[0], kh[1]); w.y = cvt_pk_bf16(kh[2], kh[3]); w.z = cvt_pk_bf16(kh[4], kh[5]); w.w = cvt_pk_bf16(kh[6], kh[7]); } }
            asm volatile("" : "+v"(wq[0].x), "+v"(wq[0].y), "+v"(wq[0].z), "+v"(wq[0].w), "+v"(wq[1].x), "+v"(wq[1].y), "+v"(wq[1].z), "+v"(wq[1].w),
                              "+v"(wq[2].x), "+v"(wq[2].y), "+v"(wq[2].z), "+v"(wq[2].w), "+v"(wq[3].x), "+v"(wq[3].y), "+v"(wq[3].z), "+v"(wq[3].w));
#pragma unroll
            for (int d4 = 0; d4 < 4; ++d4) kf[4 * dg + d4][ks] = __builtin_bit_cast(bf16x8, wq[d4]); } }
#pragma unroll 1
    for (int ep = 0; ep < 4; ++ep) {
        int zz = 0; asm volatile("" : "+v"(zz)); const int ecol = 32 * ep + 2 * r + zz;
        unsigned vw[2][8];
#pragma unroll
        for (int ks = 0; ks < 2; ++ks)
#pragma unroll
            for (int j = 0; j < 8; ++j) { const int s = 32 * ks + 8 * q + j; vw[ks][j] = s < nrows ? *(const unsigned*)(Vp + (size_t)s * 1024 + h * 128 + ecol) : 0u; }
#pragma unroll
        for (int par = 0; par < 2; ++par) {
            bf16x8 vf[2];
#pragma unroll
            for (int ks = 0; ks < 2; ++ks) { u32x4 w;
                if (par == 0) { w.x = (vw[ks][0] & 0xffffu) | (vw[ks][1] << 16); w.y = (vw[ks][2] & 0xffffu) | (vw[ks][3] << 16); w.z = (vw[ks][4] & 0xffffu) | (vw[ks][5] << 16); w.w = (vw[ks][6] & 0xffffu) | (vw[ks][7] << 16); }
                else { w.x = (vw[ks][0] >> 16) | (vw[ks][1] & 0xffff0000u); w.y = (vw[ks][2] >> 16) | (vw[ks][3] & 0xffff0000u); w.z = (vw[ks][4] >> 16) | (vw[ks][5] & 0xffff0000u); w.w = (vw[ks][6] >> 16) | (vw[ks][7] & 0xffff0000u); }
                vf[ks] = __builtin_bit_cast(bf16x8, w); }
            f32x4 acc[8];
#pragma unroll
            for (int dt = 0; dt < 8; ++dt) { acc[dt] = (f32x4){0.f, 0.f, 0.f, 0.f};
#pragma unroll
                for (int ks = 0; ks < 2; ++ks) acc[dt] = __builtin_amdgcn_mfma_f32_16x16x32_bf16(kf[dt][ks], vf[ks], acc[dt], 0, 0, 0); }
#pragma unroll
            for (int dp = 0; dp < 4; ++dp) { u32x4 w; w.x = cvt_pk_bf16(acc[2 * dp][0], acc[2 * dp + 1][0]); w.y = cvt_pk_bf16(acc[2 * dp][1], acc[2 * dp + 1][1]); w.z = cvt_pk_bf16(acc[2 * dp][2], acc[2 * dp + 1][2]); w.w = cvt_pk_bf16(acc[2 * dp][3], acc[2 * dp + 1][3]);
                { const int e = 32 * ep + 2 * r + par;
                  *(u32x4*)(Uout + ((size_t)((e >> 4) * 4 + dp) * 64 + q * 16 + (e & 15)) * 8) = w; } } }
    }
}
__device__ __forceinline__ void p2_states(const Args& a, int G) {
    const int tid = threadIdx.x, lane = tid & 63, wave = __builtin_amdgcn_readfirstlane(tid >> 6);
    const u16* Gb = (const u16*)(a.ws + WS_G); const u16* Vb = (const u16*)(a.ws + WS_V); u16* US = (u16*)a.out; float* DK = (float*)(a.ws + WS_DK);
    for (int it = blockIdx.x; it < BATCH * NCH + 1; it += G) {
        if (it < BATCH * NCH) { const size_t row0 = (size_t)it * CHK;
            p2_wave(Gb + row0 * 1024, Vb + row0 * 1024, CHK, wave, US + ((size_t)it * 8 + wave) * 16384, DK + (size_t)it * 1024, lane); }
        else p2_wave((const u16*)(a.ws + WS_GM), (const u16*)(a.ws + WS_VM), NMETA, wave, (u16*)(a.ws + WS_UM) + (size_t)wave * 16384, nullptr, lane);
    }
}

__device__ __forceinline__ void p3_scan(const Args& a, LAS unsigned char* lds, int G) {
    const int tid = threadIdx.x, lane = tid & 63, wave = __builtin_amdgcn_readfirstlane(tid >> 6);
    {
        LAS float* scr = (LAS float*)(lds + wave * 16384);
        const int gw = (int)blockIdx.x * NWAVES + wave, NGW = G * NWAVES;
        for (int it = gw; it < 2 * 16 * 88; it += NGW) { const int up = it >= 16 * 88, r = up ? it - 16 * 88 : it, kb = r / 88, nb = r % 88, n0 = 32 * nb;
            tr_item(up ? a.w_up : a.w_gate, DFF, 64 * kb, n0, (u16*)(a.ws + WS_WGU), (n0 >> 7) * 256 + (n0 & 127) + (up ? 128 : 0), 1024, 0, a.g_ffn, scr, lane); }
    }
    u16* US = (u16*)a.out; const float* DK = (const float*)(a.ws + WS_DK); const u16* UM = (const u16*)(a.ws + WS_UM);
    for (int idx = blockIdx.x * NTHR + tid; idx < BATCH * 8 * 128 * 64; idx += G * NTHR) {
        const int pr = idx & 8191, h = (idx >> 13) & 7, b = idx >> 16;
        const int d = 32 * ((pr >> 8) & 3) + 8 * ((pr >> 6) & 3) + 2 * (pr & 3);
        const unsigned um = *(const unsigned*)(UM + (size_t)h * 16384 + 2 * pr);
        float s0 = bf_lo(um), s1 = bf_hi(um);
        unsigned* up = (unsigned*)(US + ((size_t)(b * NCH) * 8 + h) * 16384 + 2 * pr);
        const float* dkp = DK + (size_t)(b * NCH) * 1024 + h * 128 + d;
#pragma unroll 1
        for (int c0 = 0; c0 < NCH; c0 += 16) {
            unsigned uu[16]; float dd0[16], dd1[16];
#pragma unroll
            for (int i = 0; i < 16; ++i) { uu[i] = up[(size_t)(c0 + i) * 8 * 8192]; dd0[i] = dkp[(size_t)(c0 + i) * 1024]; dd1[i] = dkp[(size_t)(c0 + i) * 1024 + 1]; }
#pragma unroll
            for (int i = 0; i < 16; ++i) { up[(size_t)(c0 + i) * 8 * 8192] = cvt_pk_bf16(s0, s1); s0 = dd0[i] * s0 + bf_lo(uu[i]); s1 = dd1[i] * s1 + bf_hi(uu[i]); }
        }
    }
}

constexpr int P4_PITCH = 272, P4_MAT = 64 * P4_PITCH  , P4_VPITCH = 136, P4_HS = 4 * P4_MAT  , P4_TOT = 2 * P4_HS  , P4_PLD = P4_TOT + 4096  ;
static_assert(P4_PLD + P4_MAT + 64 <= LDS_BYTES, "LDS map");
__device__ __forceinline__ unsigned ld_pl(const u16* PB, const u16* PLM, int b, int tx, int cofs) {
    return tx >= 0 ? *(const unsigned*)(PB + (size_t)(b * SEQ + tx) * 1024 + 512 + cofs) : *(const unsigned*)(PLM + (size_t)(NMETA + tx) * 512 + cofs);
}
__device__ __forceinline__ void p4_outputs(const Args& a, LAS unsigned char* lds, int G, int skip = 0) {
    (void)skip;
    const int tid = threadIdx.x, lane = tid & 63, wave = __builtin_amdgcn_readfirstlane(tid >> 6);
    const int r = lane & 15, q = lane >> 4;
    u16* Qb = (u16*)(a.ws + WS_Q); const u16* Gb = (const u16*)(a.ws + WS_G); const u16* Vb = (const u16*)(a.ws + WS_V); const u16* OGb = (const u16*)(a.ws + WS_OG);
    u16* PB = (u16*)(a.ws + WS_PB); const u16* PLM = (const u16*)(a.ws + WS_PLM); const u16* PWT = (const u16*)(a.ws + WS_PWT); const u16* US = (const u16*)a.out;
    LAS unsigned char* PLD = lds + P4_PLD;
    for (int item = blockIdx.x; item < BATCH * NCH * 4; item += G) {
        const int hp = item & 3, bc = item >> 2, c = bc & (NCH - 1), b = bc >> 7;
        const size_t row0 = (size_t)b * SEQ + (size_t)c * CHK;
        const int hs = wave >> 2, tq = wave & 3, h = 2 * hp + hs;
        LAS unsigned char* L = lds + hs * P4_HS;
        LAS unsigned char* KT = L, *QT = L + P4_MAT, *QH = L + 2 * P4_MAT, *VT = L + 3 * P4_MAT;
        LAS float* TOT = (LAS float*)(lds + P4_TOT) + hs * 512;
        const int d0 = 2 * lane; const size_t cofs = (size_t)h * 128 + d0;
        unsigned gp[16], qv[16], vv[16];
#pragma unroll
        for (int i = 0; i < 16; ++i) { const size_t o = (row0 + 16 * tq + i) * 1024 + cofs; gp[i] = __builtin_nontemporal_load((const unsigned*)(Gb + o)); qv[i] = __builtin_nontemporal_load((const unsigned*)(Qb + o)); vv[i] = __builtin_nontemporal_load((const unsigned*)(Vb + o)); }
        const int gi = hp, wlen = 2 << gi; const float inv = 1.0f / (float)wlen;
        const int t0 = 8 * wave, pcofs = gi * 128 + 2 * lane, tx0 = c * CHK + t0;
        unsigned pu[23];
#pragma unroll
        for (int j = 1; j < 16; ++j) pu[15 - j] = (j < wlen) ? ld_pl(PB, PLM, b, tx0 - j, pcofs) : 0u;
#pragma unroll
        for (int i = 0; i < 8; ++i) pu[15 + i] = ld_pl(PB, PLM, b, tx0 + i, pcofs);
        bf16x8 wf[4];
#pragma unroll
        for (int kd = 0; kd < 4; ++kd) wf[kd] = *(const bf16x8*)(PWT + (size_t)(gi * 128 + 16 * wave + r) * 128 + 32 * kd + 8 * q);
        float s0 = 0.f, s1 = 0.f;
#pragma unroll
        for (int i = 0; i < 16; ++i) { s0 += h2f((u16)(gp[i] & 0xffffu)); s1 += h2f((u16)(gp[i] >> 16)); }
        TOT[tq * 128 + d0] = s0; TOT[tq * 128 + d0 + 1] = s1;
        __syncthreads();
        {
            float w0 = 0.f, w1 = 0.f;
#pragma unroll
            for (int j = 1; j < 16; ++j) if (j < wlen) { w0 += bf_lo(pu[15 - j]); w1 += bf_hi(pu[15 - j]); }
#pragma unroll
            for (int i = 0; i < 8; ++i) { const float u0 = bf_lo(pu[15 + i]), u1 = bf_hi(pu[15 + i]); w0 += u0; w1 += u1;
                *(LAS unsigned*)(PLD + (t0 + i) * P4_PITCH + 4 * lane) = cvt_pk_bf16(w0 * inv - u0, w1 * inv - u1);
                const unsigned o = wlen == 2 ? pu[15 + i - 1] : (wlen == 4 ? pu[15 + i - 3] : (wlen == 8 ? pu[15 + i - 7] : pu[15 + i - 15]));
                w0 -= bf_lo(o); w1 -= bf_hi(o); }
        }
        float b0 = 0.f, b1 = 0.f;
#pragma unroll
        for (int t2 = 0; t2 < 3; ++t2) if (t2 < tq) { b0 += TOT[t2 * 128 + d0]; b1 += TOT[t2 * 128 + d0 + 1]; }
        const float bm0 = TOT[d0] + TOT[128 + d0], bm1 = TOT[d0 + 1] + TOT[128 + d0 + 1];
#pragma unroll
        for (int i = 0; i < 16; ++i) { const int t = 16 * tq + i; const float g0 = h2f((u16)(gp[i] & 0xffffu)), g1 = h2f((u16)(gp[i] >> 16)); b0 += g0; b1 += g1;
            const unsigned q2 = qv[i], v2 = vv[i];
            const float q0 = bf_lo(q2), q1 = bf_hi(q2), k0 = 1.0f - __expf(g0), k1 = 1.0f - __expf(g1);
            const float eb0 = __expf(b0), eb1 = __expf(b1), em0 = __expf(fminf(b0 - bm0, 80.f)), em1 = __expf(fminf(b1 - bm1, 80.f)), ek0 = __expf(fminf(bm0 - b0, 80.f)), ek1 = __expf(fminf(bm1 - b1, 80.f));
            *(LAS unsigned*)(QT + t * P4_PITCH + d0 * 2) = cvt_pk_bf16(q0 * em0, q1 * em1);
            *(LAS unsigned*)(QH + t * P4_PITCH + d0 * 2) = cvt_pk_bf16(q0 * eb0, q1 * eb1);
            *(LAS unsigned*)(KT + t * P4_PITCH + d0 * 2) = cvt_pk_bf16(k0 * ek0, k1 * ek1);
            *(LAS u16*)(VT + d0 * P4_VPITCH + t * 2) = (u16)(v2 & 0xffffu); *(LAS u16*)(VT + (d0 + 1) * P4_VPITCH + t * 2) = (u16)(v2 >> 16); }
        const u16* Sp = US + ((size_t)bc * 8 + h) * 16384;
        bf16x8 sfr[8][4];
#pragma unroll
        for (int et = 0; et < 8; ++et)
#pragma unroll
            for (int kd = 0; kd < 4; ++kd) sfr[et][kd] = *(const bf16x8*)(Sp + ((size_t)(et * 4 + kd) * 64 + lane) * 8);
        const int tt = tq;
        const size_t orow = (row0 + 16 * tt + r) * 1024 + (size_t)h * 128;
        __syncthreads();
        u32x2 ogv[8];
#pragma unroll
        for (int et = 0; et < 8; ++et) ogv[et] = __builtin_nontemporal_load((const u32x2*)(OGb + orow + 16 * et + 4 * q));
        {
            f32x4 acc[4];
#pragma unroll
            for (int t4 = 0; t4 < 4; ++t4) acc[t4] = (f32x4){0.f, 0.f, 0.f, 0.f};
#pragma unroll
            for (int kd = 0; kd < 4; ++kd)
#pragma unroll
                for (int t4 = 0; t4 < 4; ++t4) { const bf16x8 pfr = *(const LAS bf16x8*)(PLD + (16 * t4 + r) * P4_PITCH + (32 * kd + 8 * q) * 2); acc[t4] = __builtin_amdgcn_mfma_f32_16x16x32_bf16(wf[kd], pfr, acc[t4], 0, 0, 0); }
            const int n0 = gi * 128 + 16 * wave + 4 * q; const f32x4 psc = *(const f32x4*)(a.pool_scale + n0);
#pragma unroll
            for (int t4 = 0; t4 < 4; ++t4) { u32x2 w; w.x = cvt_pk_bf16(acc[t4][0] * psc[0], acc[t4][1] * psc[1]); w.y = cvt_pk_bf16(acc[t4][2] * psc[2], acc[t4][3] * psc[3]);
                *(u32x2*)(PB + (row0 + 16 * t4 + r) * 1024 + n0) = w; }
        }
        bf16x8 qt[4], qh[4];
#pragma unroll
        for (int kd = 0; kd < 4; ++kd) { qt[kd] = *(const LAS bf16x8*)(QT + (16 * tt + r) * P4_PITCH + (32 * kd + 8 * q) * 2); qh[kd] = *(const LAS bf16x8*)(QH + (16 * tt + r) * P4_PITCH + (32 * kd + 8 * q) * 2); }
        f32x4 sc[4];
#pragma unroll
        for (int st = 0; st < 4; ++st) { f32x4 acc = (f32x4){0.f, 0.f, 0.f, 0.f};
            if (st <= tt) {
#pragma unroll
                for (int kd = 0; kd < 4; ++kd) { const bf16x8 kfr = *(const LAS bf16x8*)(KT + (16 * st + r) * P4_PITCH + (32 * kd + 8 * q) * 2); acc = __builtin_amdgcn_mfma_f32_16x16x32_bf16(kfr, qt[kd], acc, 0, 0, 0); }
                if (st == tt) {
#pragma unroll
                    for (int i = 0; i < 4; ++i) if (4 * q + i > r) acc[i] = 0.f; }
            }
            sc[st] = acc; }
        bf16x8 pf[2];
#pragma unroll
        for (int ks = 0; ks < 2; ++ks) { u32x4 w; w.x = cvt_pk_bf16(sc[2 * ks][0], sc[2 * ks][1]); w.y = cvt_pk_bf16(sc[2 * ks][2], sc[2 * ks][3]); w.z = cvt_pk_bf16(sc[2 * ks + 1][0], sc[2 * ks + 1][1]); w.w = cvt_pk_bf16(sc[2 * ks + 1][2], sc[2 * ks + 1][3]);
            pf[ks] = __builtin_bit_cast(bf16x8, w); }
        f32x4 oa[8]; float ss = 0.f;
#pragma unroll
        for (int et = 0; et < 8; ++et) { f32x4 acc = (f32x4){0.f, 0.f, 0.f, 0.f};
#pragma unroll
            for (int kd = 0; kd < 4; ++kd) acc = __builtin_amdgcn_mfma_f32_16x16x32_bf16(sfr[et][kd], qh[kd], acc, 0, 0, 0);
#pragma unroll
            for (int ks = 0; ks < 2; ++ks) if (2 * ks <= tt) {
                const u32x2 lo = *(const LAS u32x2*)(VT + (16 * et + r) * P4_VPITCH + (32 * ks + 4 * q) * 2), hi = *(const LAS u32x2*)(VT + (16 * et + r) * P4_VPITCH + (32 * ks + 16 + 4 * q) * 2);
                const u32x4 w = (u32x4){lo.x, lo.y, hi.x, hi.y};
                acc = __builtin_amdgcn_mfma_f32_16x16x32_bf16(__builtin_bit_cast(bf16x8, w), pf[ks], acc, 0, 0, 0); }
            oa[et] = acc; ss += (acc[0] * acc[0] + acc[1] * acc[1]) + (acc[2] * acc[2] + acc[3] * acc[3]); }
        ss += __shfl_xor(ss, 16); ss += __shfl_xor(ss, 32);
        const float rstd = rsqrtf(ss * (1.f / 128.f) + EPS);
#pragma unroll
        for (int et = 0; et < 8; ++et) { const int e0 = 16 * et + 4 * q; const f32x4 gn = *(const f32x4*)(a.g_hn + e0); const u32x2 og = ogv[et];
            u32x2 w; w.x = cvt_pk_bf16(oa[et][0] * rstd * gn[0] * bf_lo(og.x), oa[et][1] * rstd * gn[1] * bf_hi(og.x)); w.y = cvt_pk_bf16(oa[et][2] * rstd * gn[2] * bf_lo(og.y), oa[et][3] * rstd * gn[3] * bf_hi(og.y));
            *(LAS u32x2*)(QT + (16 * tt + r) * P4_PITCH + e0 * 2) = w; }
        asm volatile("s_waitcnt lgkmcnt(0)" ::: "memory");
#pragma unroll
        for (int i = 0; i < 4; ++i) { const int rr = 16 * tt + 4 * i + (lane >> 4); const u32x4 v = *(const LAS u32x4*)(QT + rr * P4_PITCH + (lane & 15) * 16);
            *(u32x4*)(Qb + (row0 + rr) * 1024 + (size_t)h * 128 + (lane & 15) * 8) = v; }
    }
    __syncthreads();
}

__device__ __forceinline__ void p9_final(const Args& a, int G) {
    const int tid = threadIdx.x, lane = tid & 63, wave = __builtin_amdgcn_readfirstlane(tid >> 6);
    const float* rsq = (const float*)(a.ws + WS_RSQ);
    const f32x4* gr = (const f32x4*)a.g_fin + lane; f32x4 gv[4];
#pragma unroll
    for (int j = 0; j < 4; ++j) gv[j] = gr[64 * j];
    for (int m = 2 * (blockIdx.x * NWAVES + wave); m < M; m += 2 * G * NWAVES) {
        float p = lane < 32 ? rsq[(size_t)m * 16 + lane] : 0.f;
        f32x4* xr = (f32x4*)(a.out + (size_t)m * DM) + lane; f32x4 v[8];
#pragma unroll
        for (int j = 0; j < 8; ++j) v[j] = xr[64 * j];
        p += __shfl_xor(p, 1); p += __shfl_xor(p, 2); p += __shfl_xor(p, 4); p += __shfl_xor(p, 8);
        const float r0 = rsqrtf(__shfl(p, 0) * (1.f / DM) + EPS), r1 = rsqrtf(__shfl(p, 16) * (1.f / DM) + EPS);
#pragma unroll
        for (int j = 0; j < 8; ++j) { const float rs = j < 4 ? r0 : r1; const f32x4 g4 = gv[j & 3]; xr[64 * j] = (f32x4){v[j].x * rs * g4.x, v[j].y * rs * g4.y, v[j].z * rs * g4.z, v[j].w * rs * g4.w}; }
    }
}

#ifdef PROBE_STOP
__device__ __forceinline__ void p_dump(const Args& a, int G) {
    const u16* Qb = (const u16*)(a.ws + WS_Q); const u16* Gb = (const u16*)(a.ws + WS_G); const u16* Vb = (const u16*)(a.ws + WS_V); const u16* OGb = (const u16*)(a.ws + WS_OG);
    const u16* GAb = (const u16*)(a.ws + WS_GA); const u16* GBb = (const u16*)(a.ws + WS_GB); const u16* PB = (const u16*)(a.ws + WS_PB);
    for (size_t i = (size_t)blockIdx.x * NTHR + threadIdx.x; i < (size_t)M * DM; i += (size_t)G * NTHR) {
        float v = 0.f;
        if (PROBE_STOP == 1) v = bf1(Qb[i]) + h2f(Gb[i]) + bf1(Vb[i]) + bf1(OGb[i]) + bf1(GAb[i]) + bf1(GBb[i]) + bf1(PB[i]);
        else if (PROBE_STOP == 2 || PROBE_STOP == 3) { float t = bf1(((const u16*)a.out)[i]) + bf1(((const u16*)a.out)[i + (size_t)M * DM]); if (!(fabsf(t) < 1e30f)) t = 12345.f; ((float*)(a.ws + WS_GA))[i] = t; continue; }
        else if (PROBE_STOP == 4) v = bf1(Qb[i]) + bf1(PB[i]);
        else if (PROBE_STOP == 5) v = bf1(Gb[i]);
        else continue;
        a.out[i] = v;
    }
}
#endif
__device__ __forceinline__ void flat_barrier(unsigned* cnt) {
    asm volatile("s_waitcnt vmcnt(0)" ::: "memory");
    __syncthreads();
    if (threadIdx.x == 0) {
        const unsigned Gn = gridDim.x;
        __builtin_amdgcn_fence(__ATOMIC_RELEASE, "agent");
        asm volatile("s_waitcnt vmcnt(0)" ::: "memory");
        const unsigned old = __hip_atomic_fetch_add(cnt, 1u, __ATOMIC_RELAXED, __HIP_MEMORY_SCOPE_AGENT);
        const unsigned target = (old / Gn + 1u) * Gn; unsigned sp = 0;
        while (__hip_atomic_load(cnt, __ATOMIC_RELAXED, __HIP_MEMORY_SCOPE_AGENT) < target) { __builtin_amdgcn_s_sleep(1); if (++sp > (1u << 22)) break; }
        __builtin_amdgcn_fence(__ATOMIC_ACQUIRE, "agent");
        asm volatile("s_waitcnt vmcnt(0)" ::: "memory");
    }
    __syncthreads();
}
constexpr int NPH = 10;
__global__ void __launch_bounds__(NTHR, 2) mega(Args a) {
    extern __shared__ __attribute__((aligned(16))) unsigned char lds_raw[];
    LAS unsigned char* lds = (LAS unsigned char*)lds_raw;
    cg::grid_group grid = cg::this_grid();
    const int G = gridDim.x, lo = a.ph_lo, hi = a.ph_hi;
    unsigned char* ws = a.ws;
    volatile LAS unsigned* MISC = (volatile LAS unsigned*)(lds + LDS_BYTES - 64);
    if (threadIdx.x < 16) MISC[threadIdx.x] = 0u;
    __syncthreads();
    XcdBarrier bar; bar.bar = (unsigned*)(ws + WS_BAR); bar.x = 0; bar.st = nullptr;
    if (hi - lo > 1) bar = xcd_barrier_post((unsigned*)(ws + WS_BAR), MISC);
    if (hi < 0) grid.sync();
#ifndef PHMASK
#define PHMASK 0x3ff
#endif
#define IN(k) (((PHMASK >> (k)) & 1) && lo <= (k) && (k) < hi)
#ifndef CG_SEAMS
#define CG_SEAMS 0x0
#endif
#define SEAM(k) do { if (IN(k) && IN((k) + 1)) { if ((CG_SEAMS >> (k)) & 1) grid.sync(); else xcd_barrier(bar); } } while (0)
#ifndef PROBE_DUP
#define PROBE_DUP 0
#endif
#ifndef PROBE_XSYNC
#define PROBE_XSYNC 0
#endif
#define DUP(k) (((PROBE_DUP >> (k)) & 1) ? 2 : 1)
    if (IN(0)) { p0_prologue(a, lds, G); } SEAM(0);
#ifdef PROBE_XBAR
    for (int xs = 0; xs < PROBE_XBAR; ++xs) flat_barrier((unsigned*)(ws + WS_BAR + 14 * KiB));
#endif
    if (IN(1)) { pg8::Gemm g{(const u16*)a.out, (const u16*)(ws + WS_WIN), M, INW, DM, DM, 1 << 30, 0L}; pg8::StaticOrder S; S.init(M, INW, G, (int)blockIdx.x);
        EpiIn E{ws}; pg8::gemm_phase<EpiIn, true>(lds, g, S, E);
        if (G == 256 && blockIdx.x >= 128) late_weights(a, lds, ((int)blockIdx.x - 128) * NWAVES + (int)(threadIdx.x >> 6), 128 * NWAVES); }
    SEAM(1);
    if (IN(2)) { p2_states(a, G); } SEAM(2);
    if (IN(3)) { p3_scan(a, lds, G); } SEAM(3);
    if (IN(4)) { p4_outputs(a, lds, G); } SEAM(4);
    if (IN(5)) { pg8::Gemm g{(const u16*)(ws + WS_Q), (const u16*)(ws + WS_WAB), M, DM, 1536, DM, 16, (long)(WS_PB - WS_Q) - 16L * 128L}; pg8::StaticOrder S; S.init(M, DM, G, (int)blockIdx.x);
        EpiMerge E{(const u16*)(ws + WS_GA), (const u16*)(ws + WS_GB), (u16*)(ws + WS_MG)}; pg8::gemm_phase<EpiMerge, false>(lds, g, S, E); } SEAM(5);
    if (IN(6)) { pg8::Gemm g{(const u16*)(ws + WS_MG), (const u16*)(ws + WS_WOUT), M, DM, DM, DM, 1 << 30, 0L}; pg8::StaticOrder S; S.init(M, DM, G, (int)blockIdx.x);
        EpiRes<true> E{a.x, a.out, (u16*)(ws + WS_H1B), (float*)(ws + WS_RSQ)}; pg8::gemm_phase<EpiRes<true>, false>(lds, g, S, E); } SEAM(6);
    if (IN(7)) { pg8::Gemm g{(const u16*)(ws + WS_H1B), (const u16*)(ws + WS_WGU), M, NGU, DM, DM, 1 << 30, 0L}; pg8::StaticOrder S; S.init(M, NGU, G, (int)blockIdx.x);
        EpiFfn1 E{(const float*)(ws + WS_RSQ), (u16*)(ws + WS_ACT)}; pg8::gemm_phase<EpiFfn1, true>(lds, g, S, E); } SEAM(7);
    const bool fuse9 = (G == (M / 256) * (DM / 256)) && (hi - lo > 1);
    if (IN(8)) { pg8::Gemm g{(const u16*)(ws + WS_ACT), (const u16*)(ws + WS_WD), M, DM, DFF, DFF, 1 << 30, 0L}; pg8::StaticOrder S; S.init(M, DM, G, (int)blockIdx.x);
        if (fuse9) { EpiResNorm E{a.out, a.out, a.g_fin, (float*)(ws + WS_RSQ), (unsigned*)(ws + WS_CNT)}; pg8::gemm_phase<EpiResNorm, false>(lds, g, S, E); }
        else { EpiRes<false> E{a.out, a.out, nullptr, (float*)(ws + WS_RSQ)}; pg8::gemm_phase<EpiRes<false>, false>(lds, g, S, E); } }
    if (!fuse9) { SEAM(8);
    if (IN(9)) { p9_final(a, G); } }
#ifdef PROBE_LIST
    if (lo == 20) p0_prologue(a, lds, G, 1);
    if (lo == 30) p0_prologue(a, lds, G, 2);
    if (lo == 40) p0_prologue(a, lds, G, 4);
    if (lo == 14) p4_outputs(a, lds, G, 1);
    if (lo == 24) p4_outputs(a, lds, G, 2);
    if (lo == 34) p4_outputs(a, lds, G, 2 | 4);
    if (lo == 44) p4_outputs(a, lds, G, 2 | 8);
    if (lo == 54) p4_outputs(a, lds, G, 2 | 16);
    if (lo == 64) p4_outputs(a, lds, G, 2 | 32);
    if (lo == 74) p4_outputs(a, lds, G, 2 | 64);
    if (lo == 18) { pg8::Gemm g{(const u16*)(ws + WS_ACT), (const u16*)(ws + WS_WD), M, DM, DFF, DFF, 1 << 30, 0L}; pg8::StaticOrder S; S.init(M, DM, G, (int)blockIdx.x);
        EpiRes<false> E{(const float*)(ws + WS_GA), (float*)(ws + WS_GA), nullptr, (float*)(ws + WS_OG)}; pg8::gemm_phase<EpiRes<false>, false>(lds, g, S, E); }
    if (lo == 19) { Args b = a; b.out = (float*)(ws + WS_GA); p9_final(b, G); }
#endif
#ifdef PROBE_STOP
    if (lo == 10) p_dump(a, G);
    if (lo == 11 && (PROBE_STOP == 2 || PROBE_STOP == 3)) { for (size_t i = (size_t)blockIdx.x * NTHR + threadIdx.x; i < (size_t)M * DM; i += (size_t)G * NTHR) a.out[i] = ((const float*)(a.ws + WS_GA))[i]; }
#endif
#undef IN
#undef SEAM
}

extern "C" void kernel_launch(void* const* d_in, const int* in_sizes, int n_in, void* d_out, int out_size, void* d_ws, size_t ws_size, hipStream_t stream) {
    static int grid = 0;
    if (grid == 0) {
        if (n_in != 16 || in_sizes[0] != M * DM || out_size != M * DM || ws_size < WS_END) { fprintf(stderr, "kernel_launch: unexpected shapes (n_in %d, in0 %d, out %d, ws %zu); nothing launched\n", n_in, n_in > 0 ? in_sizes[0] : -1, out_size, ws_size); grid = -1; return; }
        int dev = 0, cus = 0, per_cu = 0;
        (void)hipGetDevice(&dev); (void)hipDeviceGetAttribute(&cus, hipDeviceAttributeMultiprocessorCount, dev);
        if (hipFuncSetAttribute((const void*)mega, hipFuncAttributeMaxDynamicSharedMemorySize, LDS_BYTES) != hipSuccess) { fprintf(stderr, "kernel_launch: hipFuncSetAttribute failed\n"); }
        if (hipOccupancyMaxActiveBlocksPerMultiprocessor(&per_cu, (const void*)mega, NTHR, LDS_BYTES) != hipSuccess || per_cu < 1) per_cu = 1;
        (void)hipGetLastError();
        if (cus <= 0) cus = 256;
        grid = cus * per_cu;
    }
    if (grid < 0) return;
#if MK_COOP
    if (hipMemsetAsync((char*)d_ws + WS_BAR, 0, CTL_ZERO, stream) != hipSuccess) { fprintf(stderr, "kernel_launch: hipMemsetAsync of the barrier words failed\n"); return; }
#endif
    Args a{};
    a.x = (const float*)d_in[0]; a.meta = (const float*)d_in[1]; a.g_mix = (const float*)d_in[2]; a.w_in = (const float*)d_in[3]; a.lb_raw = (const float*)d_in[4]; a.g_hn = (const float*)d_in[5];
    a.pool_w = (const float*)d_in[6]; a.pool_scale = (const float*)d_in[7]; a.w_a = (const float*)d_in[8]; a.w_b = (const float*)d_in[9]; a.w_out = (const float*)d_in[10]; a.g_ffn = (const float*)d_in[11];
    a.w_gate = (const float*)d_in[12]; a.w_up = (const float*)d_in[13]; a.w_down = (const float*)d_in[14]; a.g_fin = (const float*)d_in[15];
    a.out = (float*)d_out; a.ws = (unsigned char*)d_ws;
#if MK_COOP
    a.ph_lo = 0; a.ph_hi = NPH;
    void* args[] = {&a};
    const hipError_t e = hipLaunchCooperativeKernel((const void*)mega, dim3(grid), dim3(NTHR), args, LDS_BYTES, stream);
    if (e != hipSuccess) fprintf(stderr, "kernel_launch: cooperative launch failed: %s (grid %d)\n", hipGetErrorString(e), grid);
#else
#ifdef PROBE_STOP
    for (int ph = 0; ph <= PROBE_STOP; ++ph) { a.ph_lo = ph; a.ph_hi = ph + 1; hipLaunchKernelGGL(mega, dim3(grid), dim3(NTHR), LDS_BYTES, stream, a); }
    a.ph_lo = 10; a.ph_hi = 11; hipLaunchKernelGGL(mega, dim3(grid), dim3(NTHR), LDS_BYTES, stream, a);
    a.ph_lo = 11; a.ph_hi = 12; hipLaunchKernelGGL(mega, dim3(grid), dim3(NTHR), LDS_BYTES, stream, a);
#else
#ifdef PROBE_LIST
    { const int lst[] = PROBE_LIST; for (int i = 0; i < (int)(sizeof(lst) / sizeof(int)); ++i) { a.ph_lo = lst[i]; a.ph_hi = lst[i] + 1; hipLaunchKernelGGL(mega, dim3(grid), dim3(NTHR), LDS_BYTES, stream, a); } }
#else
    for (int ph = 0; ph < NPH; ++ph) { a.ph_lo = ph; a.ph_hi = ph + 1; hipLaunchKernelGGL(mega, dim3(grid), dim3(NTHR), LDS_BYTES, stream, a); }
#endif
#endif
#endif
}
```

```cpp
#include <hip/hip_runtime.h>
#include <hip/hip_cooperative_groups.h>
#include <cstdio>
#include <cstdint>
namespace cg = cooperative_groups;

#ifndef MK_COOP
#define MK_COOP 1
#endif

#define LAS __attribute__((address_space(3)))
typedef unsigned short u16;
typedef short bf16x8 __attribute__((ext_vector_type(8)));
typedef float f32x4 __attribute__((ext_vector_type(4)));
typedef unsigned u32x4 __attribute__((ext_vector_type(4)));
typedef unsigned u32x2 __attribute__((ext_vector_type(2)));

typedef __bf16 bf16v2_t __attribute__((ext_vector_type(2)));
typedef float f32v2_t __attribute__((ext_vector_type(2)));
__device__ __forceinline__ unsigned cvt_pk_bf16(float lo, float hi) { const f32v2_t f = {lo, hi}; const bf16v2_t v = __builtin_convertvector(f, bf16v2_t); return __builtin_bit_cast(unsigned, v); }
__device__ __forceinline__ float bf_lo(unsigned w) { return __uint_as_float(w << 16); }
__device__ __forceinline__ float bf_hi(unsigned w) { return __uint_as_float(w & 0xffff0000u); }
__device__ __forceinline__ float bf1(u16 w) { return __uint_as_float((unsigned)w << 16); }
__device__ __forceinline__ unsigned pk_h(float a, float b) { const _Float16 x = (_Float16)a, y = (_Float16)b; return (unsigned)__builtin_bit_cast(unsigned short, x) | ((unsigned)__builtin_bit_cast(unsigned short, y) << 16); }
__device__ __forceinline__ float h2f(u16 w) { return (float)__builtin_bit_cast(_Float16, w); }
__device__ __forceinline__ float sigm(float z) { return __builtin_amdgcn_rcpf(1.0f + __expf(-z)); }

namespace pg8 {
constexpr int BM = 256, BK = 64, HALF = 128, HTB = HALF * BK * 2, STAGE_BYTES = 8 * HTB, NXCD = 8, WGM = 8;
__host__ __device__ __forceinline__ int lds_byte(int r, int c) { const int st = (r >> 4) * 2 + (c >> 5), rr = r & 15, cc = c & 31, ob = rr * 64 + cc * 2; return st * 1024 + (ob ^ (((ob >> 9) & 1) << 5)); }
__host__ __device__ __forceinline__ void stage_rc(int b, int& R, int& C) { const int st = b / 1024, sb = b % 1024, swz = sb ^ (((sb >> 9) & 1) << 5); R = (st >> 1) * 16 + swz / 64; C = (st & 1) * 32 + (swz % 64) / 2; }
__host__ __device__ __forceinline__ int perm32(int rho) { const int n = rho >> 4, i = rho & 15; return 8 * (i >> 2) + 4 * n + (i & 3); }
struct Unit { int pm, pn; };
struct Gemm { const u16* A; const u16* Bt; int M, N, K, lda, ksplit; long a2delta; };
struct StaticOrder {
    int nM, nN, nwg, G, c;
    __host__ __device__ void init(int M, int N, int G_, int c_) { nM = M / BM; nN = N / BM; nwg = nM * nN; G = G_; c = c_; }
    __host__ __device__ bool next(int i, Unit& u) const {
        const long L = (long)i * G + c; if (L >= nwg) return false;
        int wgid = (int)L; { const int q = nwg / NXCD, r = nwg % NXCD, xcd = wgid % NXCD, off = wgid / NXCD; wgid = (xcd < r ? xcd * (q + 1) : r * (q + 1) + (xcd - r) * q) + off; }
        const int nig = WGM * nN, gid = wgid / nig, fm = gid * WGM, gsz = (nM - fm) < WGM ? (nM - fm) : WGM;
        u.pm = fm + ((wgid % nig) % gsz); u.pn = (wgid % nig) / gsz; return true;
    }
};
template <class Epi, bool ALIGN_EPI>
__device__ __forceinline__ void gemm_phase(LAS unsigned char* lds, const Gemm g, const StaticOrder& S, const Epi& E) {
    const int tid = threadIdx.x, wid = __builtin_amdgcn_readfirstlane(tid >> 6), lane = tid & 63, wr = wid >> 2, wc = wid & 3, fr = lane & 15, fq = lane >> 4;
    const int K = g.K, nt = K / BK, lda = g.lda;
    unsigned voffA[2], voffB[2];
#pragma unroll
    for (int i = 0; i < 2; ++i) { int R, C; stage_rc(tid * 16 + i * 8192, R, C); const int Rb = Epi::PERM ? ((R & ~31) + perm32(R & 31)) : R;
        voffA[i] = (unsigned)(R * lda + C) * 2u; voffB[i] = (unsigned)(Rb * K + C) * 2u; }
    const size_t kstep = (size_t)(BK * 2);
    const size_t hstepA = (size_t)HALF * lda * 2, tstepA = 2 * hstepA;
    const size_t hstepB = (size_t)HALF * K * 2, tstepB = 2 * hstepB;
    const unsigned ldsw = (unsigned)wid * 1024u;
    const int aoff = lds_byte(wr * 64 + fr, fq * 8), boff = lds_byte(wc * 32 + fr, fq * 8);
#define PG8_SA(b, h) (((b) * 2 + (h)) * HTB)
#define PG8_SB(b, h) ((4 + (b) * 2 + (h)) * HTB)
#define PG8_STAGE(bufoff, gbase, voff) do { _Pragma("unroll") for (int _i = 0; _i < 2; ++_i) \
        __builtin_amdgcn_global_load_lds((const unsigned*)((const char*)(gbase) + (voff)[_i]), (LAS unsigned*)(lds + (bufoff) + ldsw + _i * 8192), 16, 0, 0); } while (0)
#define PG8_LDA(dst, b, h) do { _Pragma("unroll") for (int m = 0; m < 4; ++m) _Pragma("unroll") for (int k = 0; k < 2; ++k) dst[m][k] = *(const LAS bf16x8*)(lds + PG8_SA(b, h) + aoff + m * 2048 + k * 1024); } while (0)
#define PG8_LDB(dst, b, h) do { _Pragma("unroll") for (int n = 0; n < 2; ++n) _Pragma("unroll") for (int k = 0; k < 2; ++k) dst[n][k] = *(const LAS bf16x8*)(lds + PG8_SB(b, h) + boff + n * 2048 + k * 1024); } while (0)
#define PG8_MMA(ai, bj, At, Bt) do { __builtin_amdgcn_s_setprio(1); _Pragma("unroll") for (int m = 0; m < 4; ++m) _Pragma("unroll") for (int n = 0; n < 2; ++n) _Pragma("unroll") for (int k = 0; k < 2; ++k) \
        acc[ai][bj][m][n] = __builtin_amdgcn_mfma_f32_16x16x32_bf16(Bt[n][k], At[m][k], acc[ai][bj][m][n], 0, 0, 0); __builtin_amdgcn_s_setprio(0); } while (0)
#define PG8_WAIT_V(n) asm volatile("s_waitcnt vmcnt(" #n ")" ::: "memory")
#define PG8_WAIT_L(n) asm volatile("s_waitcnt lgkmcnt(" #n ")" ::: "memory")
#define PG8_BAR __builtin_amdgcn_s_barrier()
#define PG8_SCHED __builtin_amdgcn_sched_barrier(0)
    Unit cur, nxt; int ui = 0;
    if (!S.next(0, cur)) return;
    f32x4 acc[2][2][4][2];
#pragma unroll
    for (int a = 0; a < 2; ++a)
#pragma unroll
        for (int b = 0; b < 2; ++b)
#pragma unroll
            for (int m = 0; m < 4; ++m)
#pragma unroll
                for (int n = 0; n < 2; ++n) acc[a][b][m][n] = (f32x4){0.f, 0.f, 0.f, 0.f};
    bf16x8 At[4][2], B0[2][2], B1[2][2];
    const char* cA = (const char*)g.A + (size_t)cur.pm * tstepA; const char* cB = (const char*)g.Bt + (size_t)cur.pn * tstepB;
    PG8_STAGE(PG8_SB(0, 0), cB, voffB); PG8_STAGE(PG8_SB(0, 1), cB + hstepB, voffB); PG8_STAGE(PG8_SA(0, 0), cA, voffA); PG8_STAGE(PG8_SA(0, 1), cA + hstepA, voffA);
    if (wr == 1) PG8_BAR;
    PG8_WAIT_V(2); PG8_BAR;
    PG8_STAGE(PG8_SB(1, 0), cB + kstep, voffB); PG8_STAGE(PG8_SA(1, 0), cA + kstep, voffA); PG8_STAGE(PG8_SB(1, 1), cB + hstepB + kstep, voffB);
    PG8_WAIT_V(6); PG8_BAR;
    for (;;) {
        const bool has_next = S.next(ui + 1, nxt);
        const char* nA = has_next ? (const char*)g.A + (size_t)nxt.pm * tstepA : cA; const char* nB = has_next ? (const char*)g.Bt + (size_t)nxt.pn * tstepB : cB;
        for (int t = 0; t < nt; t += 2) {
            const bool last = (t == nt - 2);
            if constexpr (Epi::MID) { if (t == g.ksplit) E.mid(acc, cur, wr, wc, fr, fq); }
            const char* a1 = cA + (size_t)(t + 1) * kstep + (t >= g.ksplit ? g.a2delta : 0L);
            const char* a2 = last ? nA : cA + (size_t)(t + 2) * kstep + (t + 2 >= g.ksplit ? g.a2delta : 0L);
            const char* b2 = last ? nB : cB + (size_t)(t + 2) * kstep;
            const char* a3 = a2 + kstep; const char* b3 = b2 + kstep;
            PG8_LDB(B0, 0, 0); PG8_LDB(B1, 0, 1); PG8_SCHED; PG8_LDA(At, 0, 0); PG8_STAGE(PG8_SA(1, 1), a1 + hstepA, voffA);
            PG8_WAIT_V(8); PG8_WAIT_L(0); PG8_BAR; PG8_MMA(0, 0, At, B0); PG8_MMA(0, 1, At, B1); PG8_BAR; PG8_SCHED;
            PG8_LDA(At, 0, 1); PG8_STAGE(PG8_SB(0, 0), b2, voffB); PG8_STAGE(PG8_SB(0, 1), b2 + hstepB, voffB); PG8_STAGE(PG8_SA(0, 0), a2, voffA);
            PG8_WAIT_V(8); PG8_WAIT_L(0); PG8_BAR; PG8_MMA(1, 0, At, B0); PG8_MMA(1, 1, At, B1); PG8_BAR; PG8_SCHED;
            PG8_LDB(B0, 1, 0); PG8_LDB(B1, 1, 1); PG8_SCHED; PG8_LDA(At, 1, 0); PG8_STAGE(PG8_SA(0, 1), a2 + hstepA, voffA);
            PG8_WAIT_V(8); PG8_WAIT_L(0); PG8_BAR; PG8_MMA(0, 0, At, B0); PG8_MMA(0, 1, At, B1); PG8_BAR; PG8_SCHED;
            PG8_LDA(At, 1, 1); PG8_STAGE(PG8_SB(1, 0), b3, voffB); PG8_STAGE(PG8_SB(1, 1), b3 + hstepB, voffB); PG8_STAGE(PG8_SA(1, 0), a3, voffA);
            PG8_WAIT_V(8); PG8_WAIT_L(0); PG8_BAR; PG8_MMA(1, 0, At, B0); PG8_MMA(1, 1, At, B1); PG8_BAR; PG8_SCHED;
        }
        if constexpr (ALIGN_EPI) { if (wr == 0) PG8_BAR; }
        if constexpr (!Epi::AFTER) E(acc, cur, wr, wc, fr, fq);
        if (!has_next) break;
#pragma unroll
        for (int a = 0; a < 2; ++a)
#pragma unroll
            for (int b = 0; b < 2; ++b)
#pragma unroll
                for (int m = 0; m < 4; ++m)
#pragma unroll
                    for (int n = 0; n < 2; ++n) acc[a][b][m][n] = (f32x4){0.f, 0.f, 0.f, 0.f};
        cur = nxt; cA = nA; cB = nB; ++ui;
        if constexpr (ALIGN_EPI) { if (wr == 1) PG8_BAR; }
    }
    PG8_WAIT_V(0);
    if constexpr (!ALIGN_EPI) { if (wr == 0) PG8_BAR; }
    PG8_BAR;
    if constexpr (Epi::AFTER) E.after(acc, cur, wr, wc, fr, fq, lds, wid, lane);
#undef PG8_SA
#undef PG8_SB
#undef PG8_STAGE
#undef PG8_LDA
#undef PG8_LDB
#undef PG8_MMA
#undef PG8_WAIT_V
#undef PG8_WAIT_L
#undef PG8_BAR
#undef PG8_SCHED
}
}

constexpr int NWAVES = 8, NTHR = 512;
constexpr int SEQ = 8192, BATCH = 2, DM = 1024, M = BATCH * SEQ, NMETA = 16, INW = 6656, DFF = 2816, NGU = 2 * DFF, CHK = 64, NCH = SEQ / CHK;
constexpr float EPS = 1e-6f;
constexpr size_t KiB = 1024, MiB = 1u << 20;
constexpr size_t WS_LB = 0, WS_GM = 64 * KiB, WS_VM = 128 * KiB, WS_PLM = 192 * KiB, WS_PWT = 256 * KiB, WS_UM = 512 * KiB, WS_DK = 1 * MiB, WS_RSQ = 2 * MiB;
constexpr size_t WS_WAB = 3 * MiB, WS_WOUT = 6 * MiB, WS_WD = 8 * MiB, WS_WIN = 14 * MiB, WS_WGU = 14 * MiB;
constexpr size_t WS_Q = 28 * MiB, WS_G = 60 * MiB, WS_V = 92 * MiB, WS_OG = 124 * MiB, WS_GA = 156 * MiB, WS_GB = 188 * MiB, WS_PB = 220 * MiB, WS_END = 252 * MiB;
constexpr size_t WS_MG = WS_G, WS_H1B = WS_GB, WS_ACT = WS_Q;
static_assert(WS_WD + (size_t)DM * DFF * 2 <= WS_WIN && WS_WIN + (size_t)INW * DM * 2 <= WS_Q && WS_WGU + (size_t)NGU * DM * 2 <= WS_Q && WS_ACT + (size_t)M * DFF * 2 <= WS_H1B, "ws map");
constexpr int LDS_BYTES = 163840;
constexpr size_t WS_BAR = 16 * KiB, WS_CNT = 32 * KiB, CTL_ZERO = 32 * KiB;

struct Args {
    const float *x, *meta, *g_mix, *w_in, *lb_raw, *g_hn, *pool_w, *pool_scale, *w_a, *w_b, *w_out, *g_ffn, *w_gate, *w_up, *w_down, *g_fin;
    float* out; unsigned char* ws; int ph_lo, ph_hi;
};

#define LDS_WAIT() asm volatile("s_waitcnt lgkmcnt(0)" ::: "memory")
__device__ __forceinline__ float wave_sum(float v) {
#pragma unroll
    for (int o = 1; o < 64; o <<= 1) v += __shfl_xor(v, o);
    return v;
}

__device__ __forceinline__ void tr_item(const float* W, int N, int k0, int n0, u16* WT, int drow0, int dpitch, int dk0, const float* ks, LAS float* scr, int lane) {
#pragma unroll
    for (int i = 0; i < 32; ++i) { const int kk = 2 * i + (lane >> 5); float w = __builtin_nontemporal_load(&W[(size_t)(k0 + kk) * N + n0 + (lane & 31)]); if (ks) w *= ks[k0 + kk]; scr[kk * 33 + (lane & 31)] = w; }
    LDS_WAIT(); asm volatile("" ::: "memory");
    const int c = lane & 7;
#pragma unroll
    for (int j = 0; j < 4; ++j) { const int n = (lane >> 3) + 8 * j; const LAS float* s = scr + (8 * c) * 33 + n;
        u32x4 o; o.x = cvt_pk_bf16(s[0 * 33], s[1 * 33]); o.y = cvt_pk_bf16(s[2 * 33], s[3 * 33]); o.z = cvt_pk_bf16(s[4 * 33], s[5 * 33]); o.w = cvt_pk_bf16(s[6 * 33], s[7 * 33]);
        *(u32x4*)(WT + (size_t)(drow0 + n) * dpitch + dk0 + k0 + 8 * c) = o; }
    LDS_WAIT(); asm volatile("" ::: "memory");
}
__device__ __forceinline__ void rms_row_bf16(const float* xrow, const float* g, u16* orow, int lane) {
    const f32x4* xr = (const f32x4*)xrow + lane; const f32x4* gr = (const f32x4*)g + lane;
    f32x4 v[4]; float s = 0.f;
#pragma unroll
    for (int j = 0; j < 4; ++j) { v[j] = xr[64 * j]; s += (v[j].x * v[j].x + v[j].y * v[j].y) + (v[j].z * v[j].z + v[j].w * v[j].w); }
    const float rstd = rsqrtf(wave_sum(s) * (1.f / DM) + EPS);
    u32x2* o8 = (u32x2*)orow + lane;
#pragma unroll
    for (int j = 0; j < 4; ++j) { const f32x4 gv = gr[64 * j]; u32x2 o; o.x = cvt_pk_bf16(v[j].x * rstd * gv.x, v[j].y * rstd * gv.y); o.y = cvt_pk_bf16(v[j].z * rstd * gv.z, v[j].w * rstd * gv.w); o8[64 * j] = o; }
}

__device__ __forceinline__ void p0_meta(const Args& a, LAS unsigned char* lds, int j, int tid, int wave, int lane) {
    LAS float* nm = (LAS float*)lds;
    LAS float* part = (LAS float*)(lds + 65536);
#pragma unroll
    for (int rr = 0; rr < 2; ++rr) { const int r = 2 * wave + rr; const f32x4* xr = (const f32x4*)(a.meta + (size_t)r * DM) + lane; const f32x4* gr = (const f32x4*)a.g_mix + lane;
        f32x4 v[4]; float s = 0.f;
#pragma unroll
        for (int q = 0; q < 4; ++q) { v[q] = xr[64 * q]; s += (v[q].x * v[q].x + v[q].y * v[q].y) + (v[q].z * v[q].z + v[q].w * v[q].w); }
        const float rstd = rsqrtf(wave_sum(s) * (1.f / DM) + EPS);
#pragma unroll
        for (int q = 0; q < 4; ++q) { const f32x4 gv = gr[64 * q]; *(LAS f32x4*)(nm + r * 1024 + 4 * (lane + 64 * q)) = (f32x4){v[q].x * rstd * gv.x, v[q].y * rstd * gv.y, v[q].z * rstd * gv.z, v[q].w * rstd * gv.w}; }
    }
    __syncthreads();
    const int colbase = j < 32 ? 1024 + 32 * j : (j < 64 ? 2048 + 32 * (j - 32) : 4096 + 32 * (j - 64));
    {
        const int col = colbase + (lane & 31), kh = lane >> 5; float acc[16];
#pragma unroll
        for (int r = 0; r < 16; ++r) acc[r] = 0.f;
#pragma unroll 4
        for (int k = 128 * wave + 64 * kh; k < 128 * wave + 64 * kh + 64; k += 4) {
            const float w0 = a.w_in[(size_t)(k + 0) * INW + col], w1 = a.w_in[(size_t)(k + 1) * INW + col], w2 = a.w_in[(size_t)(k + 2) * INW + col], w3 = a.w_in[(size_t)(k + 3) * INW + col];
#pragma unroll
            for (int r = 0; r < 16; ++r) { const f32x4 n4 = *(const LAS f32x4*)(nm + r * 1024 + k); acc[r] += (n4.x * w0 + n4.y * w1) + (n4.z * w2 + n4.w * w3); }
        }
#pragma unroll
        for (int r = 0; r < 16; ++r) part[(wave * 16 + r) * 64 + lane] = acc[r];
    }
    __syncthreads();
    {
        const int r = tid >> 5, cl = tid & 31; float z = 0.f;
#pragma unroll
        for (int w = 0; w < 8; ++w) z += part[(w * 16 + r) * 64 + cl] + part[(w * 16 + r) * 64 + 32 + cl];
        const int col = colbase + cl;
        if (col < 2048) { const int c = col - 1024; const float lb = 1.0f / (1.0f + __expf(a.lb_raw[1024 + c] - a.lb_raw[c])); const float f = lb + (1.0f - lb) * sigm(z);
            const _Float16 hv = (_Float16)__logf(f); ((u16*)(a.ws + WS_GM))[r * 1024 + c] = __builtin_bit_cast(unsigned short, hv); }
        else if (col < 3072) { ((u16*)(a.ws + WS_VM))[r * 1024 + (col - 2048)] = (u16)(cvt_pk_bf16(z, 0.f) & 0xffffu); }
        else { ((u16*)(a.ws + WS_PLM))[r * 512 + (col - 4096)] = (u16)(cvt_pk_bf16(z, 0.f) & 0xffffu); }
    }
    __syncthreads();
}

__device__ __forceinline__ void late_weights(const Args& a, LAS unsigned char* lds, int gw, int NGW) {
    const int lane = threadIdx.x & 63, wave = __builtin_amdgcn_readfirstlane(threadIdx.x >> 6);
    LAS float* scr = (LAS float*)(lds + wave * 16384);
    constexpr int I_A = 16 * 32, I_B = 8 * 32, I_O = 16 * 32, I_D = 44 * 32, I_P = 32;
    constexpr int NIT = I_A + I_B + I_O + I_D + I_P;
    for (int it = gw; it < NIT; it += NGW) {
        int r = it;
        if (r < I_A) { tr_item(a.w_a, 1024, 64 * (r / 32), 32 * (r % 32), (u16*)(a.ws + WS_WAB), 32 * (r % 32), 1536, 0, nullptr, scr, lane); continue; } r -= I_A;
        if (r < I_B) { tr_item(a.w_b, 1024, 64 * (r / 32), 32 * (r % 32), (u16*)(a.ws + WS_WAB), 32 * (r % 32), 1536, 1024, nullptr, scr, lane); continue; } r -= I_B;
        if (r < I_O) { tr_item(a.w_out, 1024, 64 * (r / 32), 32 * (r % 32), (u16*)(a.ws + WS_WOUT), 32 * (r % 32), 1024, 0, nullptr, scr, lane); continue; } r -= I_O;
        if (r < I_D) { tr_item(a.w_down, 1024, 64 * (r / 32), 32 * (r % 32), (u16*)(a.ws + WS_WD), 32 * (r % 32), DFF, 0, nullptr, scr, lane); continue; } r -= I_D;
        { const int gi = r >> 3, q = r & 7; tr_item(a.pool_w + (size_t)gi * 16384, 128, 64 * (q >> 2), 32 * (q & 3), (u16*)(a.ws + WS_PWT) + (size_t)gi * 16384, 32 * (q & 3), 128, 0, nullptr, scr, lane); }
    }
}

__device__ __forceinline__ void p0_prologue(const Args& a, LAS unsigned char* lds, int G, int skip = 0) {
    const int tid = threadIdx.x, lane = tid & 63, wave = __builtin_amdgcn_readfirstlane(tid >> 6);
    const bool split = G > 160;
    if ((int)blockIdx.x < 80) { if (!(skip & 4)) p0_meta(a, lds, (int)blockIdx.x, tid, wave, lane); if (split) return; }
    if (blockIdx.x == 80 || (G <= 80 && blockIdx.x == 0)) { for (int c = tid; c < 1024; c += NTHR) ((float*)(a.ws + WS_LB))[c] = 1.0f / (1.0f + __expf(a.lb_raw[1024 + c] - a.lb_raw[c])); }
    LAS float* scr = (LAS float*)(lds + wave * 16384);
    const int gw = ((int)blockIdx.x - (split ? 80 : 0)) * NWAVES + wave, NGW = (G - (split ? 80 : 0)) * NWAVES;
    constexpr int I_IN = 16 * 208;
    for (int it = gw; it < I_IN && !(skip & 1); it += NGW) tr_item(a.w_in, INW, 64 * (it / 208), 32 * (it % 208), (u16*)(a.ws + WS_WIN), 32 * (it % 208), 1024, 0, nullptr, scr, lane);
    if (G != 256) late_weights(a, lds, gw, NGW);
    u16* XN = (u16*)a.out;
    {
        const f32x4* gr = (const f32x4*)a.g_mix + lane; f32x4 gv[4];
#pragma unroll
        for (int j = 0; j < 4; ++j) gv[j] = gr[64 * j];
        for (int m = 4 * gw; m < M && !(skip & 2); m += 4 * NGW) {
            const f32x4* xr = (const f32x4*)(a.x + (size_t)m * DM) + lane; f32x4 v[16]; float ss[4];
#pragma unroll
            for (int j = 0; j < 16; ++j) v[j] = __builtin_nontemporal_load(&xr[64 * j]);
#pragma unroll
            for (int rr = 0; rr < 4; ++rr) { float t = 0.f;
#pragma unroll
                for (int j = 0; j < 4; ++j) { const f32x4 w = v[4 * rr + j]; t += (w.x * w.x + w.y * w.y) + (w.z * w.z + w.w * w.w); }
                ss[rr] = t; }
#pragma unroll
            for (int o = 1; o < 64; o <<= 1) {
#pragma unroll
                for (int rr = 0; rr < 4; ++rr) ss[rr] += __shfl_xor(ss[rr], o); }
            u32x2* o8 = (u32x2*)(XN + (size_t)m * DM) + lane;
#pragma unroll
            for (int j = 0; j < 16; ++j) { const float rs = rsqrtf(ss[j >> 2] * (1.f / DM) + EPS); const f32x4 g4 = gv[j & 3]; u32x2 o; o.x = cvt_pk_bf16(v[j].x * rs * g4.x, v[j].y * rs * g4.y); o.y = cvt_pk_bf16(v[j].z * rs * g4.z, v[j].w * rs * g4.w); o8[64 * j] = o; }
        }
    }
}

struct EpiIn {
    static constexpr bool PERM = true, MID = false, AFTER = false;
    unsigned char* ws;
    __device__ __forceinline__ void mid(f32x4 (&)[2][2][4][2], const pg8::Unit&, int, int, int, int) const {}
    __device__ __forceinline__ void operator()(f32x4 (&acc)[2][2][4][2], const pg8::Unit& u, int wr, int wc, int fr, int fq) const {
        const int colt = u.pn * 256; int type, c0; size_t boff;
        if (colt < 1024) { type = 1; boff = WS_Q; c0 = colt; }
        else if (colt < 2048) { type = 3; boff = WS_G; c0 = colt - 1024; }
        else if (colt < 3072) { type = 0; boff = WS_V; c0 = colt - 2048; }
        else if (colt < 4096) { type = 1; boff = WS_OG; c0 = colt - 3072; }
        else if (colt < 4608) { type = 0; boff = WS_PB; c0 = colt - 4096 + 512; }
        else if (colt < 5632) { type = 2; boff = WS_GA; c0 = colt - 4608; }
        else { type = 2; boff = WS_GB; c0 = colt - 5632; }
        u16* base = (u16*)(ws + boff);
        const int col0 = c0 + wc * 32 + 8 * fq, row0 = u.pm * 256 + wr * 64 + fr;
        const float* LB = (const float*)(ws + WS_LB);
        f32x4 lbv[2][2];
        if (type == 3) {
#pragma unroll
            for (int bj = 0; bj < 2; ++bj) { lbv[bj][0] = *(const f32x4*)(LB + col0 + bj * 128); lbv[bj][1] = *(const f32x4*)(LB + col0 + bj * 128 + 4); }
        } else {
#pragma unroll
            for (int bj = 0; bj < 2; ++bj) { lbv[bj][0] = (f32x4){0.f, 0.f, 0.f, 0.f}; lbv[bj][1] = (f32x4){0.f, 0.f, 0.f, 0.f}; }
        }
#pragma unroll
        for (int ai = 0; ai < 2; ++ai)
#pragma unroll
            for (int m = 0; m < 4; ++m) { u16* rowp = base + (size_t)(row0 + ai * 128 + m * 16) * 1024 + col0;
#pragma unroll
                for (int bj = 0; bj < 2; ++bj) { f32x4 v0 = acc[ai][bj][m][0], v1 = acc[ai][bj][m][1]; u32x4 w;
                    if (type == 3) {
                        const f32x4 l0 = lbv[bj][0], l1 = lbv[bj][1];
#pragma unroll
                        for (int e = 0; e < 4; ++e) { v0[e] = __logf(l0[e] + (1.0f - l0[e]) * sigm(v0[e])); v1[e] = __logf(l1[e] + (1.0f - l1[e]) * sigm(v1[e])); }
                        w.x = pk_h(v0[0], v0[1]); w.y = pk_h(v0[2], v0[3]); w.z = pk_h(v1[0], v1[1]); w.w = pk_h(v1[2], v1[3]);
                    } else {
                        if (type == 1) {
#pragma unroll
                            for (int e = 0; e < 4; ++e) { v0[e] = v0[e] * sigm(v0[e]); v1[e] = v1[e] * sigm(v1[e]); }
                        } else if (type == 2) {
#pragma unroll
                            for (int e = 0; e < 4; ++e) { v0[e] = sigm(v0[e]); v1[e] = sigm(v1[e]); }
                        }
                        w.x = cvt_pk_bf16(v0[0], v0[1]); w.y = cvt_pk_bf16(v0[2], v0[3]); w.z = cvt_pk_bf16(v1[0], v1[1]); w.w = cvt_pk_bf16(v1[2], v1[3]);
                    }
                    __builtin_nontemporal_store(w, (u32x4*)(rowp + bj * 128)); } }
    }
};
struct EpiMerge {
    static constexpr bool PERM = true, MID = true, AFTER = false;
    const u16 *GA, *GB; u16* MG;
    __device__ __forceinline__ void mid(f32x4 (&acc)[2][2][4][2], const pg8::Unit& u, int wr, int wc, int fr, int fq) const {
        int zz = 0; asm volatile("" : "+v"(zz));
        const int col0 = u.pn * 256 + wc * 32 + 8 * fq, row0 = u.pm * 256 + wr * 64 + fr + zz;
#pragma unroll
        for (int ai = 0; ai < 2; ++ai)
#pragma unroll
            for (int m = 0; m < 4; ++m) { const size_t off = (size_t)(row0 + ai * 128 + m * 16) * 1024 + col0;
#pragma unroll
                for (int bj = 0; bj < 2; ++bj) { const u32x4 ga = __builtin_nontemporal_load((const u32x4*)(GA + off + bj * 128)), gb = *(const u32x4*)(GB + off + bj * 128);
#pragma unroll
                    for (int e = 0; e < 2; ++e) { acc[ai][bj][m][0][2 * e] *= bf_lo(ga[e]) * __builtin_amdgcn_rcpf(bf_lo(gb[e])); acc[ai][bj][m][0][2 * e + 1] *= bf_hi(ga[e]) * __builtin_amdgcn_rcpf(bf_hi(gb[e]));
                        acc[ai][bj][m][1][2 * e] *= bf_lo(ga[2 + e]) * __builtin_amdgcn_rcpf(bf_lo(gb[2 + e])); acc[ai][bj][m][1][2 * e + 1] *= bf_hi(ga[2 + e]) * __builtin_amdgcn_rcpf(bf_hi(gb[2 + e])); } }
                asm volatile("" ::: "memory"); }
    }
    __device__ __forceinline__ void operator()(f32x4 (&acc)[2][2][4][2], const pg8::Unit& u, int wr, int wc, int fr, int fq) const {
        const int col0 = u.pn * 256 + wc * 32 + 8 * fq, row0 = u.pm * 256 + wr * 64 + fr;
#pragma unroll
        for (int ai = 0; ai < 2; ++ai)
#pragma unroll
            for (int m = 0; m < 4; ++m) { const size_t off = (size_t)(row0 + ai * 128 + m * 16) * 1024 + col0;
#pragma unroll
                for (int bj = 0; bj < 2; ++bj) { const u32x4 gb = *(const u32x4*)(GB + off + bj * 128);
                    acc[ai][bj][m][0] *= (f32x4){bf_lo(gb[0]), bf_hi(gb[0]), bf_lo(gb[1]), bf_hi(gb[1])}; acc[ai][bj][m][1] *= (f32x4){bf_lo(gb[2]), bf_hi(gb[2]), bf_lo(gb[3]), bf_hi(gb[3])}; } }
#pragma unroll
        for (int ai = 0; ai < 2; ++ai)
#pragma unroll
            for (int m = 0; m < 4; ++m) { const size_t off = (size_t)(row0 + ai * 128 + m * 16) * 1024 + col0;
#pragma unroll
                for (int bj = 0; bj < 2; ++bj) { const f32x4 v0 = acc[ai][bj][m][0], v1 = acc[ai][bj][m][1]; u32x4 w;
                    w.x = cvt_pk_bf16(v0[0], v0[1]); w.y = cvt_pk_bf16(v0[2], v0[3]); w.z = cvt_pk_bf16(v1[0], v1[1]); w.w = cvt_pk_bf16(v1[2], v1[3]);
                    *(u32x4*)(MG + off + bj * 128) = w; } }
    }
};
template <bool WITH_BF16>
struct EpiRes {
    static constexpr bool PERM = false, MID = false, AFTER = false;
    const float* base; float* H; u16* Hb; float* rsq;
    __device__ __forceinline__ void mid(f32x4 (&)[2][2][4][2], const pg8::Unit&, int, int, int, int) const {}
    __device__ __forceinline__ void operator()(f32x4 (&acc)[2][2][4][2], const pg8::Unit& u, int wr, int wc, int fr, int fq) const {
        const int col0 = u.pn * 256 + wc * 32 + 4 * fq, row0 = u.pm * 256 + wr * 64 + fr;
#pragma unroll
        for (int ai = 0; ai < 2; ++ai) {
            f32x4 pre[4][2][2];
#pragma unroll
            for (int m = 0; m < 4; ++m) { const size_t off = (size_t)(row0 + ai * 128 + m * 16) * 1024 + col0;
#pragma unroll
                for (int bj = 0; bj < 2; ++bj)
#pragma unroll
                    for (int n = 0; n < 2; ++n) pre[m][bj][n] = __builtin_nontemporal_load((const f32x4*)(base + off + bj * 128 + n * 16)); }
            asm volatile("" ::: "memory");
#pragma unroll
            for (int m = 0; m < 4; ++m) { const int row = row0 + ai * 128 + m * 16; const size_t off = (size_t)row * 1024 + col0; float s = 0.f;
#pragma unroll
                for (int bj = 0; bj < 2; ++bj)
#pragma unroll
                    for (int n = 0; n < 2; ++n) { const f32x4 hv = pre[m][bj][n] + acc[ai][bj][m][n];
                        *(f32x4*)(H + off + bj * 128 + n * 16) = hv; s += (hv[0] * hv[0] + hv[1] * hv[1]) + (hv[2] * hv[2] + hv[3] * hv[3]);
                        if (WITH_BF16) { u32x2 w; w.x = cvt_pk_bf16(hv[0], hv[1]); w.y = cvt_pk_bf16(hv[2], hv[3]); *(u32x2*)(Hb + off + bj * 128 + n * 16) = w; } }
                s += __shfl_xor(s, 16); s += __shfl_xor(s, 32);
                if (fq == 0) rsq[(size_t)row * 16 + u.pn * 4 + wc] = s; }
            asm volatile("" ::: "memory");
        }
    }
};
struct EpiFfn1 {
    static constexpr bool PERM = true, MID = false, AFTER = false;
    const float* rsq; u16* ACT;
    __device__ __forceinline__ void mid(f32x4 (&)[2][2][4][2], const pg8::Unit&, int, int, int, int) const {}
    __device__ __forceinline__ void operator()(const f32x4 (&acc)[2][2][4][2], const pg8::Unit& u, int wr, int wc, int fr, int fq) const {
        const int col0 = u.pn * 128 + wc * 32 + 8 * fq, row0 = u.pm * 256 + wr * 64 + fr;
        float rstdv[2][4];
#pragma unroll
        for (int ai = 0; ai < 2; ++ai)
#pragma unroll
            for (int m = 0; m < 4; ++m) { const int row = row0 + ai * 128 + m * 16; const f32x4* rp = (const f32x4*)(rsq + (size_t)row * 16);
                const f32x4 r0 = rp[0], r1 = rp[1], r2 = rp[2], r3 = rp[3];
                const float ss = ((r0[0] + r0[1]) + (r0[2] + r0[3])) + ((r1[0] + r1[1]) + (r1[2] + r1[3])) + ((r2[0] + r2[1]) + (r2[2] + r2[3])) + ((r3[0] + r3[1]) + (r3[2] + r3[3]));
                rstdv[ai][m] = rsqrtf(ss * (1.f / DM) + EPS); }
#pragma unroll
        for (int ai = 0; ai < 2; ++ai)
#pragma unroll
            for (int m = 0; m < 4; ++m) { const int row = row0 + ai * 128 + m * 16;
                const float rstd = rstdv[ai][m];
                float o[8];
#pragma unroll
                for (int n = 0; n < 2; ++n)
#pragma unroll
                    for (int e = 0; e < 4; ++e) { const float gt = acc[ai][0][m][n][e] * rstd, up = acc[ai][1][m][n][e] * rstd; o[4 * n + e] = gt * sigm(gt) * up; }
                u32x4 w; w.x = cvt_pk_bf16(o[0], o[1]); w.y = cvt_pk_bf16(o[2], o[3]); w.z = cvt_pk_bf16(o[4], o[5]); w.w = cvt_pk_bf16(o[6], o[7]);
                __builtin_nontemporal_store(w, (u32x4*)(ACT + (size_t)row * DFF + col0)); }
    }
};

struct EpiResNorm {
    static constexpr bool PERM = false, MID = false, AFTER = true;
    const float* base; float* out; const float* gfin; float* slots; unsigned* cnt;
    __device__ __forceinline__ void mid(f32x4 (&)[2][2][4][2], const pg8::Unit&, int, int, int, int) const {}
    __device__ __forceinline__ void operator()(const f32x4 (&)[2][2][4][2], const pg8::Unit&, int, int, int, int) const {}
    __device__ __forceinline__ void after(f32x4 (&acc)[2][2][4][2], const pg8::Unit& u, int wr, int wc, int fr, int fq, LAS unsigned char* lds, int wid, int lane) const {
        LAS float* P = (LAS float*)lds; LAS float* R = (LAS float*)(lds + 4096);
        const int col0 = u.pn * 256 + wc * 32 + 4 * fq;
#pragma unroll
        for (int ai = 0; ai < 2; ++ai)
#pragma unroll
            for (int m = 0; m < 4; ++m) { const int rl = ai * 128 + wr * 64 + m * 16 + fr; const size_t off = (size_t)(u.pm * 256 + rl) * 1024 + col0; float s = 0.f;
#pragma unroll
                for (int bj = 0; bj < 2; ++bj)
#pragma unroll
                    for (int n = 0; n < 2; ++n) { const f32x4 hv = __builtin_nontemporal_load((const f32x4*)(base + off + bj * 128 + n * 16)) + acc[ai][bj][m][n]; acc[ai][bj][m][n] = hv; s += (hv[0] * hv[0] + hv[1] * hv[1]) + (hv[2] * hv[2] + hv[3] * hv[3]); }
                s += __shfl_xor(s, 16); s += __shfl_xor(s, 32);
                if (fq == 0) P[rl * 4 + wc] = s;
                if (m & 1) asm volatile("" ::: "memory"); }
        asm volatile("s_waitcnt lgkmcnt(0)" ::: "memory"); __builtin_amdgcn_s_barrier(); asm volatile("" ::: "memory");
        const int row = wid * 32 + (lane & 31);
        unsigned* slot = (unsigned*)slots + (size_t)(u.pm * 256 + row) * 16;
        if (lane < 32) { const float t = (P[row * 4 + 0] + P[row * 4 + 1]) + (P[row * 4 + 2] + P[row * 4 + 3]);
            __hip_atomic_store(slot + u.pn, __float_as_uint(t), __ATOMIC_RELAXED, __HIP_MEMORY_SCOPE_AGENT); }
        asm volatile("s_waitcnt vmcnt(0)" ::: "memory");
        if (lane == 0) __hip_atomic_fetch_add(cnt + 64 * u.pm, 1u, __ATOMIC_RELAXED, __HIP_MEMORY_SCOPE_AGENT);
        if (wid == 0) { unsigned sp = 0;
            while ((unsigned)__builtin_amdgcn_readfirstlane(__hip_atomic_load(cnt + 64 * u.pm, __ATOMIC_RELAXED, __HIP_MEMORY_SCOPE_AGENT)) < 32u) { __builtin_amdgcn_s_sleep(2); if (++sp > (1u << 20)) break; }
            __builtin_amdgcn_fence(__ATOMIC_ACQUIRE, "agent"); }
        asm volatile("s_waitcnt vmcnt(0) lgkmcnt(0)" ::: "memory"); __builtin_amdgcn_s_barrier(); asm volatile("" ::: "memory");
        if (lane < 32) { float t = 0.f;
#pragma unroll
            for (int k = 0; k < 4; ++k) t += __uint_as_float(__hip_atomic_load(slot + k, __ATOMIC_RELAXED, __HIP_MEMORY_SCOPE_AGENT));
            R[row] = rsqrtf(t * (1.f / DM) + EPS); }
        asm volatile("s_waitcnt lgkmcnt(0)" ::: "memory"); __builtin_amdgcn_s_barrier(); asm volatile("" ::: "memory");
        f32x4 gv[2][2];
#pragma unroll
        for (int bj = 0; bj < 2; ++bj)
#pragma unroll
            for (int n = 0; n < 2; ++n) gv[bj][n] = *(const f32x4*)(gfin + col0 + bj * 128 + n * 16);
#pragma unroll
        for (int ai = 0; ai < 2; ++ai)
#pragma unroll
            for (int m = 0; m < 4; ++m) { const int rl = ai * 128 + wr * 64 + m * 16 + fr; const size_t off = (size_t)(u.pm * 256 + rl) * 1024 + col0; const float rs = R[rl];
#pragma unroll
                for (int bj = 0; bj < 2; ++bj)
#pragma unroll
                    for (int n = 0; n < 2; ++n) *(f32x4*)(out + off + bj * 128 + n * 16) = acc[ai][bj][m][n] * rs * gv[bj][n]; }
    }
};
#define RLX_AGENT __ATOMIC_RELAXED, __HIP_MEMORY_SCOPE_AGENT
#define XB_TMO      128
#define XB_XCNT(j)  (256  + 64 * (j))
#define XB_XSUB(j)  (1280 + 64 * (j))
#define XB_XGEN(j)  (2304 + 64 * (j))
#define XB_TOP      3328
#define XB_TOPGEN   3392
#define XCD_BAR_WORDS 3456
#define XB_SPIN_CAP (1u << 18)

__device__ __forceinline__ unsigned xb_ld(unsigned* p)              { return __hip_atomic_load(p, __ATOMIC_RELAXED, __HIP_MEMORY_SCOPE_AGENT); }
__device__ __forceinline__ unsigned xb_add(unsigned* p, unsigned v) { return __hip_atomic_fetch_add(p, v, __ATOMIC_RELAXED, __HIP_MEMORY_SCOPE_AGENT); }
__device__ __forceinline__ unsigned xb_xcc_id() { return (unsigned)__builtin_amdgcn_s_getreg((3 << 11) | 20) & 0xFu; }
#define XB_SPIN(cond, bar) do { unsigned _sp = 0; while (cond) { __builtin_amdgcn_s_sleep(1); \
    if ((++_sp & 255u) == 0u) { if (xb_ld(&(bar)[XB_TMO])) break; if (_sp > XB_SPIN_CAP) { atomicAdd(&(bar)[XB_TMO], 1u); break; } } } } while (0)

struct XcdBarrier {
    unsigned* bar; unsigned x;
    volatile LAS unsigned* st;
};

__device__ __forceinline__ XcdBarrier xcd_barrier_post(unsigned* bar, volatile LAS unsigned* st) {
    XcdBarrier b; b.bar = bar; b.x = xb_xcc_id(); b.st = st;
    if (threadIdx.x == 0) (void)xb_add(&bar[XB_XCNT(b.x)], 1u);
    return b;
}
__device__ __forceinline__ void xcd_barrier_complete(unsigned* bar, unsigned x, unsigned& nloc, unsigned& nx) {
    const unsigned G = gridDim.x * gridDim.y * gridDim.z;
    unsigned sum, cnt, mine, sp = 0u;
    for (;;) {
        sum = 0u; cnt = 0u; mine = 0u;
#pragma unroll
        for (unsigned j = 0; j < 16; ++j) { const unsigned c = xb_ld(&bar[XB_XCNT(j)]); sum += c; cnt += (c > 0u) ? 1u : 0u; mine = (j == x) ? c : mine; }
        if (sum == G) break;
        __builtin_amdgcn_s_sleep(1);
        if ((++sp & 255u) == 0u) { if (xb_ld(&bar[XB_TMO])) break; if (sp > XB_SPIN_CAP) { atomicAdd(&bar[XB_TMO], 1u); break; } }
    }
    nloc = mine > 0u ? mine : 1u; nx = cnt > 0u ? cnt : 1u;
}

__device__ __forceinline__ void xcd_barrier(const XcdBarrier& b) {
    asm volatile("s_waitcnt vmcnt(0)" ::: "memory");
    __syncthreads();
    if (threadIdx.x == 0) {
        unsigned* bar = b.bar;
        __builtin_amdgcn_s_waitcnt(0);
        unsigned nloc = b.st[0], nx = b.st[1];
        if (nloc == 0u) { xcd_barrier_complete(bar, b.x, nloc, nx); b.st[0] = nloc; b.st[1] = nx; }
        const unsigned old = xb_add(&bar[XB_XSUB(b.x)], 1u);
        const unsigned gen = old / nloc;
        if (old + 1u == (gen + 1u) * nloc) {
            __builtin_amdgcn_fence(__ATOMIC_RELEASE, "agent");
            asm volatile("s_waitcnt vmcnt(0)" ::: "memory");
            const unsigned og = xb_add(&bar[XB_TOP], 1u);
            const unsigned tg = og / nx;
            if (og + 1u == (tg + 1u) * nx) xb_add(&bar[XB_TOPGEN], 1u);
            else XB_SPIN(xb_ld(&bar[XB_TOPGEN]) == tg, bar);
            __builtin_amdgcn_fence(__ATOMIC_ACQUIRE, "agent");
            xb_add(&bar[XB_XGEN(b.x)], 1u);
            asm volatile("s_waitcnt vmcnt(0)" ::: "memory");
        } else {
            XB_SPIN(xb_ld(&bar[XB_XGEN(b.x)]) == gen, bar);
            __builtin_amdgcn_fence(__ATOMIC_ACQUIRE, "agent");
            asm volatile("s_waitcnt vmcnt(0)" ::: "memory");
        }
    }
    __syncthreads();
}

__device__ __forceinline__ void p2_wave(const u16* Gp, const u16* Vp, int nrows, int h, u16* Uout, float* dk, int lane) {
    const int r = lane & 15, q = lane >> 4;
    bf16x8 kf[8][2]; float tot1[8];
#pragma unroll
    for (int kk = 0; kk < 2; ++kk) { const int ks = 1 - kk;
#pragma unroll
        for (int dg = 0; dg < 2; ++dg) {
            int zz = 0; asm volatile("" : "+v"(zz));
            u32x4 wq[4];
#pragma unroll
            for (int p2 = 0; p2 < 2; ++p2) { const int dp = 2 * dg + p2; const int dcol = 32 * dp + 2 * r + zz; unsigned gw[8];
#pragma unroll
                for (int j = 0; j < 8; ++j) { const int s = 32 * ks + 8 * q + j; gw[j] = s < nrows ? *(const unsigned*)(Gp + (size_t)s * 1024 + h * 128 + dcol) : 0u; }
#pragma unroll
                for (int par = 0; par < 2; ++par) { const int dt = 2 * dp + par; float gv[8];
#pragma unroll
                    for (int j = 0; j < 8; ++j) gv[j] = h2f((u16)(par ? (gw[j] >> 16) : (gw[j] & 0xffffu)));
                    float suf[8]; float run = 0.f;
#pragma unroll
                    for (int j = 7; j >= 0; --j) { suf[j] = run; run += gv[j]; }
                    const float T = run, ta = __shfl_xor(T, 16), tb = __shfl_xor(T, 32), tc = __shfl_xor(ta, 32);
                    const float after = ((q ^ 1) > q ? ta : 0.f) + ((q ^ 2) > q ? tb : 0.f) + ((q ^ 3) > q ? tc : 0.f);
                    const float tot = (T + ta) + (tb + tc);
                    float base;
                    if (ks == 1) { tot1[dt] = tot; base = after; } else { base = after + tot1[dt]; if (dk && q == 0) dk[h * 128 + dcol + par] = __expf(tot + tot1[dt]); }
                    float kh[8];
#pragma unroll
                    for (int j = 0; j < 8; ++j) kh[j] = (1.0f - __expf(gv[j])) * __expf(suf[j] + base);
                    u32x4& w = wq[2 * p2 + par];
                    w.x = cvt_pk_bf16(kh[0], kh[1]); w.y = cvt_pk_bf16(kh[2], kh[3]); w.z = cvt_pk_bf16(kh[4], kh[5]); w.w = cvt_pk_bf16(kh[6], kh[7]); } }
            asm volatile("" : "+v"(wq[0].x), "+v"(wq[0].y), "+v"(wq[0].z), "+v"(wq[0].w), "+v"(wq[1].x), "+v"(wq[1].y), "+v"(wq[1].z), "+v"(wq[1].w),
                              "+v"(wq[2].x), "+v"(wq[2].y), "+v"(wq[2].z), "+v"(wq[2].w), "+v"(wq[3].x), "+v"(wq[3].y), "+v"(wq[3].z), "+v"(wq[3].w));
#pragma unroll
            for (int d4 = 0; d4 < 4; ++d4) kf[4 * dg + d4][ks] = __builtin_bit_cast(bf16x8, wq[d4]); } }
#pragma unroll 1
    for (int ep = 0; ep < 4; ++ep) {
        int zz = 0; asm volatile("" : "+v"(zz)); const int ecol = 32 * ep + 2 * r + zz;
        unsigned vw[2][8];
#pragma unroll
        for (int ks = 0; ks < 2; ++ks)
#pragma unroll
            for (int j = 0; j < 8; ++j) { const int s = 32 * ks + 8 * q + j; vw[ks][j] = s < nrows ? *(const unsigned*)(Vp + (size_t)s * 1024 + h * 128 + ecol) : 0u; }
#pragma unroll
        for (int par = 0; par < 2; ++par) {
            bf16x8 vf[2];
#pragma unroll
            for (int ks = 0; ks < 2; ++ks) { u32x4 w;
                if (par == 0) { w.x = (vw[ks][0] & 0xffffu) | (vw[ks][1] << 16); w.y = (vw[ks][2] & 0xffffu) | (vw[ks][3] << 16); w.z = (vw[ks][4] & 0xffffu) | (vw[ks][5] << 16); w.w = (vw[ks][6] & 0xffffu) | (vw[ks][7] << 16); }
                else { w.x = (vw[ks][0] >> 16) | (vw[ks][1] & 0xffff0000u); w.y = (vw[ks][2] >> 16) | (vw[ks][3] & 0xffff0000u); w.z = (vw[ks][4] >> 16) | (vw[ks][5] & 0xffff0000u); w.w = (vw[ks][6] >> 16) | (vw[ks][7] & 0xffff0000u); }
                vf[ks] = __builtin_bit_cast(bf16x8, w); }
            f32x4 acc[8];
#pragma unroll
            for (int dt = 0; dt < 8; ++dt) { acc[dt] = (f32x4){0.f, 0.f, 0.f, 0.f};
#pragma unroll
                for (int ks = 0; ks < 2; ++ks) acc[dt] = __builtin_amdgcn_mfma_f32_16x16x32_bf16(kf[dt][ks], vf[ks], acc[dt], 0, 0, 0); }
#pragma unroll
            for (int dp = 0; dp < 4; ++dp) { u32x4 w; w.x = cvt_pk_bf16(acc[2 * dp][0], acc[2 * dp + 1][0]); w.y = cvt_pk_bf16(acc[2 * dp][1], acc[2 * dp + 1][1]); w.z = cvt_pk_bf16(acc[2 * dp][2], acc[2 * dp + 1][2]); w.w = cvt_pk_bf16(acc[2 * dp][3], acc[2 * dp + 1][3]);
                { const int e = 32 * ep + 2 * r + par;
                  *(u32x4*)(Uout + ((size_t)((e >> 4) * 4 + dp) * 64 + q * 16 + (e & 15)) * 8) = w; } } }
    }
}
__device__ __forceinline__ void p2_states(const Args& a, int G) {
    const int tid = threadIdx.x, lane = tid & 63, wave = __builtin_amdgcn_readfirstlane(tid >> 6);
    const u16* Gb = (const u16*)(a.ws + WS_G); const u16* Vb = (const u16*)(a.ws + WS_V); u16* US = (u16*)a.out; float* DK = (float*)(a.ws + WS_DK);
    for (int it = blockIdx.x; it < BATCH * NCH + (G == 256 ? 0 : 1); it += G) {
        if (it < BATCH * NCH) { const size_t row0 = (size_t)it * CHK;
            p2_wave(Gb + row0 * 1024, Vb + row0 * 1024, CHK, wave, US + ((size_t)it * 8 + wave) * 16384, DK + (size_t)it * 1024, lane); }
        else p2_wave((const u16*)(a.ws + WS_GM), (const u16*)(a.ws + WS_VM), NMETA, wave, (u16*)(a.ws + WS_UM) + (size_t)wave * 16384, nullptr, lane);
    }
}

__device__ __forceinline__ void p3_scan(const Args& a, LAS unsigned char* lds, int G) {
    const int tid = threadIdx.x, lane = tid & 63, wave = __builtin_amdgcn_readfirstlane(tid >> 6);
    {
        LAS float* scr = (LAS float*)(lds + wave * 16384);
        const int gw = (int)blockIdx.x * NWAVES + wave, NGW = G * NWAVES;
        for (int it = gw; it < 2 * 16 * 88; it += NGW) { const int up = it >= 16 * 88, r = up ? it - 16 * 88 : it, kb = r / 88, nb = r % 88, n0 = 32 * nb;
            tr_item(up ? a.w_up : a.w_gate, DFF, 64 * kb, n0, (u16*)(a.ws + WS_WGU), (n0 >> 7) * 256 + (n0 & 127) + (up ? 128 : 0), 1024, 0, a.g_ffn, scr, lane); }
    }
    u16* US = (u16*)a.out; const float* DK = (const float*)(a.ws + WS_DK); const u16* UM = (const u16*)(a.ws + WS_UM);
    for (int idx = blockIdx.x * NTHR + tid; idx < BATCH * 8 * 128 * 64; idx += G * NTHR) {
        const int pr = idx & 8191, h = (idx >> 13) & 7, b = idx >> 16;
        const int d = 32 * ((pr >> 8) & 3) + 8 * ((pr >> 6) & 3) + 2 * (pr & 3);
        const unsigned um = *(const unsigned*)(UM + (size_t)h * 16384 + 2 * pr);
        float s0 = bf_lo(um), s1 = bf_hi(um);
        unsigned* up = (unsigned*)(US + ((size_t)(b * NCH) * 8 + h) * 16384 + 2 * pr);
        const float* dkp = DK + (size_t)(b * NCH) * 1024 + h * 128 + d;
#pragma unroll 1
        for (int c0 = 0; c0 < NCH; c0 += 16) {
            unsigned uu[16]; float dd0[16], dd1[16];
#pragma unroll
            for (int i = 0; i < 16; ++i) { uu[i] = up[(size_t)(c0 + i) * 8 * 8192]; dd0[i] = dkp[(size_t)(c0 + i) * 1024]; dd1[i] = dkp[(size_t)(c0 + i) * 1024 + 1]; }
#pragma unroll
            for (int i = 0; i < 16; ++i) { up[(size_t)(c0 + i) * 8 * 8192] = cvt_pk_bf16(s0, s1); s0 = dd0[i] * s0 + bf_lo(uu[i]); s1 = dd1[i] * s1 + bf_hi(uu[i]); }
        }
    }
}

constexpr int P4_PITCH = 272, P4_MAT = 64 * P4_PITCH  , P4_VPITCH = 136, P4_HS = 4 * P4_MAT  , P4_TOT = 2 * P4_HS  , P4_PLD = P4_TOT + 4096  ;
static_assert(P4_PLD + P4_MAT + 64 <= LDS_BYTES, "LDS map");
__device__ __forceinline__ unsigned ld_pl(const u16* PB, const u16* PLM, int b, int tx, int cofs) {
    return tx >= 0 ? *(const unsigned*)(PB + (size_t)(b * SEQ + tx) * 1024 + 512 + cofs) : *(const unsigned*)(PLM + (size_t)(NMETA + tx) * 512 + cofs);
}
__device__ __forceinline__ void p4_outputs(const Args& a, LAS unsigned char* lds, int G, int skip = 0) {
    (void)skip;
    const int tid = threadIdx.x, lane = tid & 63, wave = __builtin_amdgcn_readfirstlane(tid >> 6);
    const int r = lane & 15, q = lane >> 4;
    u16* Qb = (u16*)(a.ws + WS_Q); const u16* Gb = (const u16*)(a.ws + WS_G); const u16* Vb = (const u16*)(a.ws + WS_V); const u16* OGb = (const u16*)(a.ws + WS_OG);
    u16* PB = (u16*)(a.ws + WS_PB); const u16* PLM = (const u16*)(a.ws + WS_PLM); const u16* PWT = (const u16*)(a.ws + WS_PWT); const u16* US = (const u16*)a.out;
    LAS unsigned char* PLD = lds + P4_PLD;
    for (int item = blockIdx.x; item < BATCH * NCH * 4; item += G) {
        const int hp = item & 3, bc = item >> 2, c = bc & (NCH - 1), b = bc >> 7;
        const size_t row0 = (size_t)b * SEQ + (size_t)c * CHK;
        const int hs = wave >> 2, tq = wave & 3, h = 2 * hp + hs;
        LAS unsigned char* L = lds + hs * P4_HS;
        LAS unsigned char* KT = L, *QT = L + P4_MAT, *QH = L + 2 * P4_MAT, *VT = L + 3 * P4_MAT;
        LAS float* TOT = (LAS float*)(lds + P4_TOT) + hs * 512;
        const int d0 = 2 * lane; const size_t cofs = (size_t)h * 128 + d0;
        unsigned gp[16], qv[16], vv[16];
#pragma unroll
        for (int i = 0; i < 16; ++i) { const size_t o = (row0 + 16 * tq + i) * 1024 + cofs; gp[i] = __builtin_nontemporal_load((const unsigned*)(Gb + o)); qv[i] = __builtin_nontemporal_load((const unsigned*)(Qb + o)); vv[i] = __builtin_nontemporal_load((const unsigned*)(Vb + o)); }
        const int gi = hp, wlen = 2 << gi; const float inv = 1.0f / (float)wlen;
        const int t0 = 8 * wave, pcofs = gi * 128 + 2 * lane, tx0 = c * CHK + t0;
        unsigned pu[23];
#pragma unroll
        for (int j = 1; j < 16; ++j) pu[15 - j] = (j < wlen) ? ld_pl(PB, PLM, b, tx0 - j, pcofs) : 0u;
#pragma unroll
        for (int i = 0; i < 8; ++i) pu[15 + i] = ld_pl(PB, PLM, b, tx0 + i, pcofs);
        bf16x8 wf[4];
#pragma unroll
        for (int kd = 0; kd < 4; ++kd) wf[kd] = *(const bf16x8*)(PWT + (size_t)(gi * 128 + 16 * wave + r) * 128 + 32 * kd + 8 * q);
        float s0 = 0.f, s1 = 0.f;
#pragma unroll
        for (int i = 0; i < 16; ++i) { s0 += h2f((u16)(gp[i] & 0xffffu)); s1 += h2f((u16)(gp[i] >> 16)); }
        TOT[tq * 128 + d0] = s0; TOT[tq * 128 + d0 + 1] = s1;
        __syncthreads();
        {
            float w0 = 0.f, w1 = 0.f;
#pragma unroll
            for (int j = 1; j < 16; ++j) if (j < wlen) { w0 += bf_lo(pu[15 - j]); w1 += bf_hi(pu[15 - j]); }
#pragma unroll
            for (int i = 0; i < 8; ++i) { const float u0 = bf_lo(pu[15 + i]), u1 = bf_hi(pu[15 + i]); w0 += u0; w1 += u1;
                *(LAS unsigned*)(PLD + (t0 + i) * P4_PITCH + 4 * lane) = cvt_pk_bf16(w0 * inv - u0, w1 * inv - u1);
                const unsigned o = wlen == 2 ? pu[15 + i - 1] : (wlen == 4 ? pu[15 + i - 3] : (wlen == 8 ? pu[15 + i - 7] : pu[15 + i - 15]));
                w0 -= bf_lo(o); w1 -= bf_hi(o); }
        }
        float b0 = 0.f, b1 = 0.f;
#pragma unroll
        for (int t2 = 0; t2 < 3; ++t2) if (t2 < tq) { b0 += TOT[t2 * 128 + d0]; b1 += TOT[t2 * 128 + d0 + 1]; }
        const float bm0 = TOT[d0] + TOT[128 + d0], bm1 = TOT[d0 + 1] + TOT[128 + d0 + 1];
#pragma unroll
        for (int i = 0; i < 16; ++i) { const int t = 16 * tq + i; const float g0 = h2f((u16)(gp[i] & 0xffffu)), g1 = h2f((u16)(gp[i] >> 16)); b0 += g0; b1 += g1;
            const unsigned q2 = qv[i], v2 = vv[i];
            const float q0 = bf_lo(q2), q1 = bf_hi(q2), k0 = 1.0f - __expf(g0), k1 = 1.0f - __expf(g1);
            const float eb0 = __expf(b0), eb1 = __expf(b1), em0 = __expf(fminf(b0 - bm0, 80.f)), em1 = __expf(fminf(b1 - bm1, 80.f)), ek0 = __expf(fminf(bm0 - b0, 80.f)), ek1 = __expf(fminf(bm1 - b1, 80.f));
            *(LAS unsigned*)(QT + t * P4_PITCH + d0 * 2) = cvt_pk_bf16(q0 * em0, q1 * em1);
            *(LAS unsigned*)(QH + t * P4_PITCH + d0 * 2) = cvt_pk_bf16(q0 * eb0, q1 * eb1);
            *(LAS unsigned*)(KT + t * P4_PITCH + d0 * 2) = cvt_pk_bf16(k0 * ek0, k1 * ek1);
            *(LAS u16*)(VT + d0 * P4_VPITCH + t * 2) = (u16)(v2 & 0xffffu); *(LAS u16*)(VT + (d0 + 1) * P4_VPITCH + t * 2) = (u16)(v2 >> 16); }
        const u16* Sp = US + ((size_t)bc * 8 + h) * 16384;
        bf16x8 sfr[8][4];
#pragma unroll
        for (int et = 0; et < 8; ++et)
#pragma unroll
            for (int kd = 0; kd < 4; ++kd) sfr[et][kd] = *(const bf16x8*)(Sp + ((size_t)(et * 4 + kd) * 64 + lane) * 8);
        const int tt = tq;
        const size_t orow = (row0 + 16 * tt + r) * 1024 + (size_t)h * 128;
        __syncthreads();
        u32x2 ogv[8];
#pragma unroll
        for (int et = 0; et < 8; ++et) ogv[et] = __builtin_nontemporal_load((const u32x2*)(OGb + orow + 16 * et + 4 * q));
        {
            f32x4 acc[4];
#pragma unroll
            for (int t4 = 0; t4 < 4; ++t4) acc[t4] = (f32x4){0.f, 0.f, 0.f, 0.f};
#pragma unroll
            for (int kd = 0; kd < 4; ++kd)
#pragma unroll
                for (int t4 = 0; t4 < 4; ++t4) { const bf16x8 pfr = *(const LAS bf16x8*)(PLD + (16 * t4 + r) * P4_PITCH + (32 * kd + 8 * q) * 2); acc[t4] = __builtin_amdgcn_mfma_f32_16x16x32_bf16(wf[kd], pfr, acc[t4], 0, 0, 0); }
            const int n0 = gi * 128 + 16 * wave + 4 * q; const f32x4 psc = *(const f32x4*)(a.pool_scale + n0);
#pragma unroll
            for (int t4 = 0; t4 < 4; ++t4) { u32x2 w; w.x = cvt_pk_bf16(acc[t4][0] * psc[0], acc[t4][1] * psc[1]); w.y = cvt_pk_bf16(acc[t4][2] * psc[2], acc[t4][3] * psc[3]);
                *(u32x2*)(PB + (row0 + 16 * t4 + r) * 1024 + n0) = w; }
        }
        bf16x8 qt[4], qh[4];
#pragma unroll
        for (int kd = 0; kd < 4; ++kd) { qt[kd] = *(const LAS bf16x8*)(QT + (16 * tt + r) * P4_PITCH + (32 * kd + 8 * q) * 2); qh[kd] = *(const LAS bf16x8*)(QH + (16 * tt + r) * P4_PITCH + (32 * kd + 8 * q) * 2); }
        f32x4 sc[4];
#pragma unroll
        for (int st = 0; st < 4; ++st) { f32x4 acc = (f32x4){0.f, 0.f, 0.f, 0.f};
            if (st <= tt) {
#pragma unroll
                for (int kd = 0; kd < 4; ++kd) { const bf16x8 kfr = *(const LAS bf16x8*)(KT + (16 * st + r) * P4_PITCH + (32 * kd + 8 * q) * 2); acc = __builtin_amdgcn_mfma_f32_16x16x32_bf16(kfr, qt[kd], acc, 0, 0, 0); }
                if (st == tt) {
#pragma unroll
                    for (int i = 0; i < 4; ++i) if (4 * q + i > r) acc[i] = 0.f; }
            }
            sc[st] = acc; }
        bf16x8 pf[2];
#pragma unroll
        for (int ks = 0; ks < 2; ++ks) { u32x4 w; w.x = cvt_pk_bf16(sc[2 * ks][0], sc[2 * ks][1]); w.y = cvt_pk_bf16(sc[2 * ks][2], sc[2 * ks][3]); w.z = cvt_pk_bf16(sc[2 * ks + 1][0], sc[2 * ks + 1][1]); w.w = cvt_pk_bf16(sc[2 * ks + 1][2], sc[2 * ks + 1][3]);
            pf[ks] = __builtin_bit_cast(bf16x8, w); }
        f32x4 oa[8]; float ss = 0.f;
#pragma unroll
        for (int et = 0; et < 8; ++et) { f32x4 acc = (f32x4){0.f, 0.f, 0.f, 0.f};
#pragma unroll
            for (int kd = 0; kd < 4; ++kd) acc = __builtin_amdgcn_mfma_f32_16x16x32_bf16(sfr[et][kd], qh[kd], acc, 0, 0, 0);
#pragma unroll
            for (int ks = 0; ks < 2; ++ks) if (2 * ks <= tt) {
                const u32x2 lo = *(const LAS u32x2*)(VT + (16 * et + r) * P4_VPITCH + (32 * ks + 4 * q) * 2), hi = *(const LAS u32x2*)(VT + (16 * et + r) * P4_VPITCH + (32 * ks + 16 + 4 * q) * 2);
                const u32x4 w = (u32x4){lo.x, lo.y, hi.x, hi.y};
                acc = __builtin_amdgcn_mfma_f32_16x16x32_bf16(__builtin_bit_cast(bf16x8, w), pf[ks], acc, 0, 0, 0); }
            oa[et] = acc; ss += (acc[0] * acc[0] + acc[1] * acc[1]) + (acc[2] * acc[2] + acc[3] * acc[3]); }
        ss += __shfl_xor(ss, 16); ss += __shfl_xor(ss, 32);
        const float rstd = rsqrtf(ss * (1.f / 128.f) + EPS);
#pragma unroll
        for (int et = 0; et < 8; ++et) { const int e0 = 16 * et + 4 * q; const f32x4 gn = *(const f32x4*)(a.g_hn + e0); const u32x2 og = ogv[et];
            u32x2 w; w.x = cvt_pk_bf16(oa[et][0] * rstd * gn[0] * bf_lo(og.x), oa[et][1] * rstd * gn[1] * bf_hi(og.x)); w.y = cvt_pk_bf16(oa[et][2] * rstd * gn[2] * bf_lo(og.y), oa[et][3] * rstd * gn[3] * bf_hi(og.y));
            *(LAS u32x2*)(QT + (16 * tt + r) * P4_PITCH + e0 * 2) = w; }
        asm volatile("s_waitcnt lgkmcnt(0)" ::: "memory");
#pragma unroll
        for (int i = 0; i < 4; ++i) { const int rr = 16 * tt + 4 * i + (lane >> 4); const u32x4 v = *(const LAS u32x4*)(QT + rr * P4_PITCH + (lane & 15) * 16);
            *(u32x4*)(Qb + (row0 + rr) * 1024 + (size_t)h * 128 + (lane & 15) * 8) = v; }
    }
    __syncthreads();
}

__device__ __forceinline__ void p9_final(const Args& a, int G) {
    const int tid = threadIdx.x, lane = tid & 63, wave = __builtin_amdgcn_readfirstlane(tid >> 6);
    const float* rsq = (const float*)(a.ws + WS_RSQ);
    const f32x4* gr = (const f32x4*)a.g_fin + lane; f32x4 gv[4];
#pragma unroll
    for (int j = 0; j < 4; ++j) gv[j] = gr[64 * j];
    for (int m = 2 * (blockIdx.x * NWAVES + wave); m < M; m += 2 * G * NWAVES) {
        float p = lane < 32 ? rsq[(size_t)m * 16 + lane] : 0.f;
        f32x4* xr = (f32x4*)(a.out + (size_t)m * DM) + lane; f32x4 v[8];
#pragma unroll
        for (int j = 0; j < 8; ++j) v[j] = xr[64 * j];
        p += __shfl_xor(p, 1); p += __shfl_xor(p, 2); p += __shfl_xor(p, 4); p += __shfl_xor(p, 8);
        const float r0 = rsqrtf(__shfl(p, 0) * (1.f / DM) + EPS), r1 = rsqrtf(__shfl(p, 16) * (1.f / DM) + EPS);
#pragma unroll
        for (int j = 0; j < 8; ++j) { const float rs = j < 4 ? r0 : r1; const f32x4 g4 = gv[j & 3]; xr[64 * j] = (f32x4){v[j].x * rs * g4.x, v[j].y * rs * g4.y, v[j].z * rs * g4.z, v[j].w * rs * g4.w}; }
    }
}

#ifdef PROBE_STOP
__device__ __forceinline__ void p_dump(const Args& a, int G) {
    const u16* Qb = (const u16*)(a.ws + WS_Q); const u16* Gb = (const u16*)(a.ws + WS_G); const u16* Vb = (const u16*)(a.ws + WS_V); const u16* OGb = (const u16*)(a.ws + WS_OG);
    const u16* GAb = (const u16*)(a.ws + WS_GA); const u16* GBb = (const u16*)(a.ws + WS_GB); const u16* PB = (const u16*)(a.ws + WS_PB);
    for (size_t i = (size_t)blockIdx.x * NTHR + threadIdx.x; i < (size_t)M * DM; i += (size_t)G * NTHR) {
        float v = 0.f;
        if (PROBE_STOP == 1) v = bf1(Qb[i]) + h2f(Gb[i]) + bf1(Vb[i]) + bf1(OGb[i]) + bf1(GAb[i]) + bf1(GBb[i]) + bf1(PB[i]);
        else if (PROBE_STOP == 2 || PROBE_STOP == 3) { float t = bf1(((const u16*)a.out)[i]) + bf1(((const u16*)a.out)[i + (size_t)M * DM]); if (!(fabsf(t) < 1e30f)) t = 12345.f; ((float*)(a.ws + WS_GA))[i] = t; continue; }
        else if (PROBE_STOP == 4) v = bf1(Qb[i]) + bf1(PB[i]);
        else if (PROBE_STOP == 5) v = bf1(Gb[i]);
        else continue;
        a.out[i] = v;
    }
}
#endif
__device__ __forceinline__ void flat_barrier(unsigned* cnt) {
    asm volatile("s_waitcnt vmcnt(0)" ::: "memory");
    __syncthreads();
    if (threadIdx.x == 0) {
        const unsigned Gn = gridDim.x;
        __builtin_amdgcn_fence(__ATOMIC_RELEASE, "agent");
        asm volatile("s_waitcnt vmcnt(0)" ::: "memory");
        const unsigned old = __hip_atomic_fetch_add(cnt, 1u, __ATOMIC_RELAXED, __HIP_MEMORY_SCOPE_AGENT);
        const unsigned target = (old / Gn + 1u) * Gn; unsigned sp = 0;
        while (__hip_atomic_load(cnt, __ATOMIC_RELAXED, __HIP_MEMORY_SCOPE_AGENT) < target) { __builtin_amdgcn_s_sleep(1); if (++sp > (1u << 22)) break; }
        __builtin_amdgcn_fence(__ATOMIC_ACQUIRE, "agent");
        asm volatile("s_waitcnt vmcnt(0)" ::: "memory");
    }
    __syncthreads();
}
constexpr int NPH = 10;
__global__ void __launch_bounds__(NTHR, 2) mega(Args a) {
    extern __shared__ __attribute__((aligned(16))) unsigned char lds_raw[];
    LAS unsigned char* lds = (LAS unsigned char*)lds_raw;
    cg::grid_group grid = cg::this_grid();
    const int G = gridDim.x, lo = a.ph_lo, hi = a.ph_hi;
    unsigned char* ws = a.ws;
    volatile LAS unsigned* MISC = (volatile LAS unsigned*)(lds + LDS_BYTES - 64);
    if (threadIdx.x < 16) MISC[threadIdx.x] = 0u;
    __syncthreads();
    XcdBarrier bar; bar.bar = (unsigned*)(ws + WS_BAR); bar.x = 0; bar.st = nullptr;
    if (hi - lo > 1) bar = xcd_barrier_post((unsigned*)(ws + WS_BAR), MISC);
    if (hi < 0) grid.sync();
#ifndef PHMASK
#define PHMASK 0x3ff
#endif
#define IN(k) (((PHMASK >> (k)) & 1) && lo <= (k) && (k) < hi)
#ifndef CG_SEAMS
#define CG_SEAMS 0x0
#endif
#define SEAM(k) do { if (IN(k) && IN((k) + 1)) { if ((CG_SEAMS >> (k)) & 1) grid.sync(); else xcd_barrier(bar); } } while (0)
#ifndef PROBE_DUP
#define PROBE_DUP 0
#endif
#ifndef PROBE_XSYNC
#define PROBE_XSYNC 0
#endif
#define DUP(k) (((PROBE_DUP >> (k)) & 1) ? 2 : 1)
    if (IN(0)) { p0_prologue(a, lds, G); } SEAM(0);
#ifdef PROBE_XBAR
    for (int xs = 0; xs < PROBE_XBAR; ++xs) flat_barrier((unsigned*)(ws + WS_BAR + 14 * KiB));
#endif
    if (IN(1)) { pg8::Gemm g{(const u16*)a.out, (const u16*)(ws + WS_WIN), M, INW, DM, DM, 1 << 30, 0L}; pg8::StaticOrder S; S.init(M, INW, G, (int)blockIdx.x);
        EpiIn E{ws}; pg8::gemm_phase<EpiIn, true>(lds, g, S, E);
        if (G == 256 && blockIdx.x == 255) p2_wave((const u16*)(ws + WS_GM), (const u16*)(ws + WS_VM), NMETA, (int)(threadIdx.x >> 6), (u16*)(ws + WS_UM) + (size_t)(threadIdx.x >> 6) * 16384, nullptr, (int)(threadIdx.x & 63));
        else if (G == 256 && blockIdx.x >= 128) late_weights(a, lds, ((int)blockIdx.x - 128) * NWAVES + (int)(threadIdx.x >> 6), 127 * NWAVES); }
    SEAM(1);
    if (IN(2)) { p2_states(a, G); } SEAM(2);
    if (IN(3)) { p3_scan(a, lds, G); } SEAM(3);
    if (IN(4)) { p4_outputs(a, lds, G); } SEAM(4);
    if (IN(5)) { pg8::Gemm g{(const u16*)(ws + WS_Q), (const u16*)(ws + WS_WAB), M, DM, 1536, DM, 16, (long)(WS_PB - WS_Q) - 16L * 128L}; pg8::StaticOrder S; S.init(M, DM, G, (int)blockIdx.x);
        EpiMerge E{(const u16*)(ws + WS_GA), (const u16*)(ws + WS_GB), (u16*)(ws + WS_MG)}; pg8::gemm_phase<EpiMerge, false>(lds, g, S, E); } SEAM(5);
    if (IN(6)) { pg8::Gemm g{(const u16*)(ws + WS_MG), (const u16*)(ws + WS_WOUT), M, DM, DM, DM, 1 << 30, 0L}; pg8::StaticOrder S; S.init(M, DM, G, (int)blockIdx.x);
        EpiRes<true> E{a.x, a.out, (u16*)(ws + WS_H1B), (float*)(ws + WS_RSQ)}; pg8::gemm_phase<EpiRes<true>, false>(lds, g, S, E); } SEAM(6);
    if (IN(7)) { pg8::Gemm g{(const u16*)(ws + WS_H1B), (const u16*)(ws + WS_WGU), M, NGU, DM, DM, 1 << 30, 0L}; pg8::StaticOrder S; S.init(M, NGU, G, (int)blockIdx.x);
        EpiFfn1 E{(const float*)(ws + WS_RSQ), (u16*)(ws + WS_ACT)}; pg8::gemm_phase<EpiFfn1, true>(lds, g, S, E); } SEAM(7);
    const bool fuse9 = (G == (M / 256) * (DM / 256)) && (hi - lo > 1);
    if (IN(8)) { pg8::Gemm g{(const u16*)(ws + WS_ACT), (const u16*)(ws + WS_WD), M, DM, DFF, DFF, 1 << 30, 0L}; pg8::StaticOrder S; S.init(M, DM, G, (int)blockIdx.x);
        if (fuse9) { EpiResNorm E{a.out, a.out, a.g_fin, (float*)(ws + WS_RSQ), (unsigned*)(ws + WS_CNT)}; pg8::gemm_phase<EpiResNorm, false>(lds, g, S, E); }
        else { EpiRes<false> E{a.out, a.out, nullptr, (float*)(ws + WS_RSQ)}; pg8::gemm_phase<EpiRes<false>, false>(lds, g, S, E); } }
    if (!fuse9) { SEAM(8);
    if (IN(9)) { p9_final(a, G); } }
#ifdef PROBE_LIST
    if (lo == 20) p0_prologue(a, lds, G, 1);
    if (lo == 30) p0_prologue(a, lds, G, 2);
    if (lo == 40) p0_prologue(a, lds, G, 4);
    if (lo == 14) p4_outputs(a, lds, G, 1);
    if (lo == 24) p4_outputs(a, lds, G, 2);
    if (lo == 34) p4_outputs(a, lds, G, 2 | 4);
    if (lo == 44) p4_outputs(a, lds, G, 2 | 8);
    if (lo == 54) p4_outputs(a, lds, G, 2 | 16);
    if (lo == 64) p4_outputs(a, lds, G, 2 | 32);
    if (lo == 74) p4_outputs(a, lds, G, 2 | 64);
    if (lo == 18) { pg8::Gemm g{(const u16*)(ws + WS_ACT), (const u16*)(ws + WS_WD), M, DM, DFF, DFF, 1 << 30, 0L}; pg8::StaticOrder S; S.init(M, DM, G, (int)blockIdx.x);
        EpiRes<false> E{(const float*)(ws + WS_GA), (float*)(ws + WS_GA), nullptr, (float*)(ws + WS_OG)}; pg8::gemm_phase<EpiRes<false>, false>(lds, g, S, E); }
    if (lo == 19) { Args b = a; b.out = (float*)(ws + WS_GA); p9_final(b, G); }
#endif
#ifdef PROBE_STOP
    if (lo == 10) p_dump(a, G);
    if (lo == 11 && (PROBE_STOP == 2 || PROBE_STOP == 3)) { for (size_t i = (size_t)blockIdx.x * NTHR + threadIdx.x; i < (size_t)M * DM; i += (size_t)G * NTHR) a.out[i] = ((const float*)(a.ws + WS_GA))[i]; }
#endif
#undef IN
#undef SEAM
}

extern "C" void kernel_launch(void* const* d_in, const int* in_sizes, int n_in, void* d_out, int out_size, void* d_ws, size_t ws_size, hipStream_t stream) {
    static int grid = 0;
    if (grid == 0) {
        if (n_in != 16 || in_sizes[0] != M * DM || out_size != M * DM || ws_size < WS_END) { fprintf(stderr, "kernel_launch: unexpected shapes (n_in %d, in0 %d, out %d, ws %zu); nothing launched\n", n_in, n_in > 0 ? in_sizes[0] : -1, out_size, ws_size); grid = -1; return; }
        int dev = 0, cus = 0, per_cu = 0;
        (void)hipGetDevice(&dev); (void)hipDeviceGetAttribute(&cus, hipDeviceAttributeMultiprocessorCount, dev);
        if (hipFuncSetAttribute((const void*)mega, hipFuncAttributeMaxDynamicSharedMemorySize, LDS_BYTES) != hipSuccess) { fprintf(stderr, "kernel_launch: hipFuncSetAttribute failed\n"); }
        if (hipOccupancyMaxActiveBlocksPerMultiprocessor(&per_cu, (const void*)mega, NTHR, LDS_BYTES) != hipSuccess || per_cu < 1) per_cu = 1;
        (void)hipGetLastError();
        if (cus <= 0) cus = 256;
        grid = cus * per_cu;
    }
    if (grid < 0) return;
#if MK_COOP
    if (hipMemsetAsync((char*)d_ws + WS_BAR, 0, CTL_ZERO, stream) != hipSuccess) { fprintf(stderr, "kernel_launch: hipMemsetAsync of the barrier words failed\n"); return; }
#endif
    Args a{};
    a.x = (const float*)d_in[0]; a.meta = (const float*)d_in[1]; a.g_mix = (const float*)d_in[2]; a.w_in = (const float*)d_in[3]; a.lb_raw = (const float*)d_in[4]; a.g_hn = (const float*)d_in[5];
    a.pool_w = (const float*)d_in[6]; a.pool_scale = (const float*)d_in[7]; a.w_a = (const float*)d_in[8]; a.w_b = (const float*)d_in[9]; a.w_out = (const float*)d_in[10]; a.g_ffn = (const float*)d_in[11];
    a.w_gate = (const float*)d_in[12]; a.w_up = (const float*)d_in[13]; a.w_down = (const float*)d_in[14]; a.g_fin = (const float*)d_in[15];
    a.out = (float*)d_out; a.ws = (unsigned char*)d_ws;
#if MK_COOP
    a.ph_lo = 0; a.ph_hi = NPH;
    void* args[] = {&a};
    const hipError_t e = hipLaunchCooperativeKernel((const void*)mega, dim3(grid), dim3(NTHR), args, LDS_BYTES, stream);
    if (e != hipSuccess) fprintf(stderr, "kernel_launch: cooperative launch failed: %s (grid %d)\n", hipGetErrorString(e), grid);
#else
#ifdef PROBE_STOP
    for (int ph = 0; ph <= PROBE_STOP; ++ph) { a.ph_lo = ph; a.ph_hi = ph + 1; hipLaunchKernelGGL(mega, dim3(grid), dim3(NTHR), LDS_BYTES, stream, a); }
    a.ph_lo = 10; a.ph_hi = 11; hipLaunchKernelGGL(mega, dim3(grid), dim3(NTHR), LDS_BYTES, stream, a);
    a.ph_lo = 11; a.ph_hi = 12; hipLaunchKernelGGL(mega, dim3(grid), dim3(NTHR), LDS_BYTES, stream, a);
#else
#ifdef PROBE_LIST
    { const int lst[] = PROBE_LIST; for (int i = 0; i < (int)(sizeof(lst) / sizeof(int)); ++i) { a.ph_lo = lst[i]; a.ph_hi = lst[i] + 1; hipLaunchKernelGGL(mega, dim3(grid), dim3(NTHR), LDS_BYTES, stream, a); } }
#else
    for (int ph = 0; ph < NPH; ++ph) { a.ph_lo = ph; a.ph_hi = ph + 1; hipLaunchKernelGGL(mega, dim3(grid), dim3(NTHR), LDS_BYTES, stream, a); }
#endif
#endif
#endif
}
```

```cpp
#include <hip/hip_runtime.h>
#include <hip/hip_cooperative_groups.h>
#include <cstdio>
#include <cstdint>
namespace cg = cooperative_groups;

#ifndef MK_COOP
#define MK_COOP 1
#endif

#define LAS __attribute__((address_space(3)))
typedef unsigned short u16;
typedef short bf16x8 __attribute__((ext_vector_type(8)));
typedef float f32x4 __attribute__((ext_vector_type(4)));
typedef unsigned u32x4 __attribute__((ext_vector_type(4)));
typedef unsigned u32x2 __attribute__((ext_vector_type(2)));

typedef __bf16 bf16v2_t __attribute__((ext_vector_type(2)));
typedef float f32v2_t __attribute__((ext_vector_type(2)));
__device__ __forceinline__ unsigned cvt_pk_bf16(float lo, float hi) { const f32v2_t f = {lo, hi}; const bf16v2_t v = __builtin_convertvector(f, bf16v2_t); return __builtin_bit_cast(unsigned, v); }
__device__ __forceinline__ float bf_lo(unsigned w) { return __uint_as_float(w << 16); }
__device__ __forceinline__ float bf_hi(unsigned w) { return __uint_as_float(w & 0xffff0000u); }
__device__ __forceinline__ float bf1(u16 w) { return __uint_as_float((unsigned)w << 16); }
__device__ __forceinline__ unsigned pk_h(float a, float b) { const _Float16 x = (_Float16)a, y = (_Float16)b; return (unsigned)__builtin_bit_cast(unsigned short, x) | ((unsigned)__builtin_bit_cast(unsigned short, y) << 16); }
__device__ __forceinline__ float h2f(u16 w) { return (float)__builtin_bit_cast(_Float16, w); }
__device__ __forceinline__ float sigm(float z) { return __builtin_amdgcn_rcpf(1.0f + __expf(-z)); }

namespace pg8 {
constexpr int BM = 256, BK = 64, HALF = 128, HTB = HALF * BK * 2, STAGE_BYTES = 8 * HTB, NXCD = 8, WGM = 8;
__host__ __device__ __forceinline__ int lds_byte(int r, int c) { const int st = (r >> 4) * 2 + (c >> 5), rr = r & 15, cc = c & 31, ob = rr * 64 + cc * 2; return st * 1024 + (ob ^ (((ob >> 9) & 1) << 5)); }
__host__ __device__ __forceinline__ void stage_rc(int b, int& R, int& C) { const int st = b / 1024, sb = b % 1024, swz = sb ^ (((sb >> 9) & 1) << 5); R = (st >> 1) * 16 + swz / 64; C = (st & 1) * 32 + (swz % 64) / 2; }
__host__ __device__ __forceinline__ int perm32(int rho) { const int n = rho >> 4, i = rho & 15; return 8 * (i >> 2) + 4 * n + (i & 3); }
struct Unit { int pm, pn; };
struct Gemm { const u16* A; const u16* Bt; int M, N, K, lda, ksplit; long a2delta; };
struct StaticOrder {
    int nM, nN, nwg, G, c;
    __host__ __device__ void init(int M, int N, int G_, int c_) { nM = M / BM; nN = N / BM; nwg = nM * nN; G = G_; c = c_; }
    __host__ __device__ bool next(int i, Unit& u) const {
        const long L = (long)i * G + c; if (L >= nwg) return false;
        int wgid = (int)L; { const int q = nwg / NXCD, r = nwg % NXCD, xcd = wgid % NXCD, off = wgid / NXCD; wgid = (xcd < r ? xcd * (q + 1) : r * (q + 1) + (xcd - r) * q) + off; }
        const int nig = WGM * nN, gid = wgid / nig, fm = gid * WGM, gsz = (nM - fm) < WGM ? (nM - fm) : WGM;
        u.pm = fm + ((wgid % nig) % gsz); u.pn = (wgid % nig) / gsz; return true;
    }
};
template <class Epi, bool ALIGN_EPI>
__device__ __forceinline__ void gemm_phase(LAS unsigned char* lds, const Gemm g, const StaticOrder& S, const Epi& E) {
    const int tid = threadIdx.x, wid = __builtin_amdgcn_readfirstlane(tid >> 6), lane = tid & 63, wr = wid >> 2, wc = wid & 3, fr = lane & 15, fq = lane >> 4;
    const int K = g.K, nt = K / BK, lda = g.lda;
    unsigned voffA[2], voffB[2];
#pragma unroll
    for (int i = 0; i < 2; ++i) { int R, C; stage_rc(tid * 16 + i * 8192, R, C); const int Rb = Epi::PERM ? ((R & ~31) + perm32(R & 31)) : R;
        voffA[i] = (unsigned)(R * lda + C) * 2u; voffB[i] = (unsigned)(Rb * K + C) * 2u; }
    const size_t kstep = (size_t)(BK * 2);
    const size_t hstepA = (size_t)HALF * lda * 2, tstepA = 2 * hstepA;
    const size_t hstepB = (size_t)HALF * K * 2, tstepB = 2 * hstepB;
    const unsigned ldsw = (unsigned)wid * 1024u;
    const int aoff = lds_byte(wr * 64 + fr, fq * 8), boff = lds_byte(wc * 32 + fr, fq * 8);
#define PG8_SA(b, h) (((b) * 2 + (h)) * HTB)
#define PG8_SB(b, h) ((4 + (b) * 2 + (h)) * HTB)
#define PG8_STAGE(bufoff, gbase, voff) do { _Pragma("unroll") for (int _i = 0; _i < 2; ++_i) \
        __builtin_amdgcn_global_load_lds((const unsigned*)((const char*)(gbase) + (voff)[_i]), (LAS unsigned*)(lds + (bufoff) + ldsw + _i * 8192), 16, 0, 0); } while (0)
#define PG8_LDA(dst, b, h) do { _Pragma("unroll") for (int m = 0; m < 4; ++m) _Pragma("unroll") for (int k = 0; k < 2; ++k) dst[m][k] = *(const LAS bf16x8*)(lds + PG8_SA(b, h) + aoff + m * 2048 + k * 1024); } while (0)
#define PG8_LDB(dst, b, h) do { _Pragma("unroll") for (int n = 0; n < 2; ++n) _Pragma("unroll") for (int k = 0; k < 2; ++k) dst[n][k] = *(const LAS bf16x8*)(lds + PG8_SB(b, h) + boff + n * 2048 + k * 1024); } while (0)
#define PG8_MMA(ai, bj, At, Bt) do { __builtin_amdgcn_s_setprio(1); _Pragma("unroll") for (int m = 0; m < 4; ++m) _Pragma("unroll") for (int n = 0; n < 2; ++n) _Pragma("unroll") for (int k = 0; k < 2; ++k) \
        acc[ai][bj][m][n] = __builtin_amdgcn_mfma_f32_16x16x32_bf16(Bt[n][k], At[m][k], acc[ai][bj][m][n], 0, 0, 0); __builtin_amdgcn_s_setprio(0); } while (0)
#define PG8_WAIT_V(n) asm volatile("s_waitcnt vmcnt(" #n ")" ::: "memory")
#define PG8_WAIT_L(n) asm volatile("s_waitcnt lgkmcnt(" #n ")" ::: "memory")
#define PG8_BAR __builtin_amdgcn_s_barrier()
#define PG8_SCHED __builtin_amdgcn_sched_barrier(0)
    Unit cur, nxt; int ui = 0;
    if (!S.next(0, cur)) return;
    f32x4 acc[2][2][4][2];
#pragma unroll
    for (int a = 0; a < 2; ++a)
#pragma unroll
        for (int b = 0; b < 2; ++b)
#pragma unroll
            for (int m = 0; m < 4; ++m)
#pragma unroll
                for (int n = 0; n < 2; ++n) acc[a][b][m][n] = (f32x4){0.f, 0.f, 0.f, 0.f};
    bf16x8 At[4][2], B0[2][2], B1[2][2];
    const char* cA = (const char*)g.A + (size_t)cur.pm * tstepA; const char* cB = (const char*)g.Bt + (size_t)cur.pn * tstepB;
    PG8_STAGE(PG8_SB(0, 0), cB, voffB); PG8_STAGE(PG8_SB(0, 1), cB + hstepB, voffB); PG8_STAGE(PG8_SA(0, 0), cA, voffA); PG8_STAGE(PG8_SA(0, 1), cA + hstepA, voffA);
    if (wr == 1) PG8_BAR;
    PG8_WAIT_V(2); PG8_BAR;
    PG8_STAGE(PG8_SB(1, 0), cB + kstep, voffB); PG8_STAGE(PG8_SA(1, 0), cA + kstep, voffA); PG8_STAGE(PG8_SB(1, 1), cB + hstepB + kstep, voffB);
    PG8_WAIT_V(6); PG8_BAR;
    for (;;) {
        const bool has_next = S.next(ui + 1, nxt);
        const char* nA = has_next ? (const char*)g.A + (size_t)nxt.pm * tstepA : cA; const char* nB = has_next ? (const char*)g.Bt + (size_t)nxt.pn * tstepB : cB;
        for (int t = 0; t < nt; t += 2) {
            const bool last = (t == nt - 2);
            if constexpr (Epi::MID) { if (t == g.ksplit) E.mid(acc, cur, wr, wc, fr, fq); }
            const char* a1 = cA + (size_t)(t + 1) * kstep + (t >= g.ksplit ? g.a2delta : 0L);
            const char* a2 = last ? nA : cA + (size_t)(t + 2) * kstep + (t + 2 >= g.ksplit ? g.a2delta : 0L);
            const char* b2 = last ? nB : cB + (size_t)(t + 2) * kstep;
            const char* a3 = a2 + kstep; const char* b3 = b2 + kstep;
            PG8_LDB(B0, 0, 0); PG8_LDB(B1, 0, 1); PG8_SCHED; PG8_LDA(At, 0, 0); PG8_STAGE(PG8_SA(1, 1), a1 + hstepA, voffA);
            PG8_WAIT_V(8); PG8_WAIT_L(0); PG8_BAR; PG8_MMA(0, 0, At, B0); PG8_MMA(0, 1, At, B1); PG8_BAR; PG8_SCHED;
            PG8_LDA(At, 0, 1); PG8_STAGE(PG8_SB(0, 0), b2, voffB); PG8_STAGE(PG8_SB(0, 1), b2 + hstepB, voffB); PG8_STAGE(PG8_SA(0, 0), a2, voffA);
            PG8_WAIT_V(8); PG8_WAIT_L(0); PG8_BAR; PG8_MMA(1, 0, At, B0); PG8_MMA(1, 1, At, B1); PG8_BAR; PG8_SCHED;
            PG8_LDB(B0, 1, 0); PG8_LDB(B1, 1, 1); PG8_SCHED; PG8_LDA(At, 1, 0); PG8_STAGE(PG8_SA(0, 1), a2 + hstepA, voffA);
            PG8_WAIT_V(8); PG8_WAIT_L(0); PG8_BAR; PG8_MMA(0, 0, At, B0); PG8_MMA(0, 1, At, B1); PG8_BAR; PG8_SCHED;
            PG8_LDA(At, 1, 1); PG8_STAGE(PG8_SB(1, 0), b3, voffB); PG8_STAGE(PG8_SB(1, 1), b3 + hstepB, voffB); PG8_STAGE(PG8_SA(1, 0), a3, voffA);
            PG8_WAIT_V(8); PG8_WAIT_L(0); PG8_BAR; PG8_MMA(1, 0, At, B0); PG8_MMA(1, 1, At, B1); PG8_BAR; PG8_SCHED;
        }
        if constexpr (ALIGN_EPI) { if (wr == 0) PG8_BAR; }
        if constexpr (!Epi::AFTER) E(acc, cur, wr, wc, fr, fq);
        if (!has_next) break;
#pragma unroll
        for (int a = 0; a < 2; ++a)
#pragma unroll
            for (int b = 0; b < 2; ++b)
#pragma unroll
                for (int m = 0; m < 4; ++m)
#pragma unroll
                    for (int n = 0; n < 2; ++n) acc[a][b][m][n] = (f32x4){0.f, 0.f, 0.f, 0.f};
        cur = nxt; cA = nA; cB = nB; ++ui;
        if constexpr (ALIGN_EPI) { if (wr == 1) PG8_BAR; }
    }
    PG8_WAIT_V(0);
    if constexpr (!ALIGN_EPI) { if (wr == 0) PG8_BAR; }
    PG8_BAR;
    if constexpr (Epi::AFTER) E.after(acc, cur, wr, wc, fr, fq, lds, wid, lane);
#undef PG8_SA
#undef PG8_SB
#undef PG8_STAGE
#undef PG8_LDA
#undef PG8_LDB
#undef PG8_MMA
#undef PG8_WAIT_V
#undef PG8_WAIT_L
#undef PG8_BAR
#undef PG8_SCHED
}
}

constexpr int NWAVES = 8, NTHR = 512;
constexpr int SEQ = 8192, BATCH = 2, DM = 1024, M = BATCH * SEQ, NMETA = 16, INW = 6656, DFF = 2816, NGU = 2 * DFF, CHK = 64, NCH = SEQ / CHK;
constexpr float EPS = 1e-6f;
constexpr size_t KiB = 1024, MiB = 1u << 20;
constexpr size_t WS_LB = 0, WS_GM = 64 * KiB, WS_VM = 128 * KiB, WS_PLM = 192 * KiB, WS_PWT = 256 * KiB, WS_UM = 512 * KiB, WS_DK = 1 * MiB, WS_RSQ = 2 * MiB;
constexpr size_t WS_WAB = 3 * MiB, WS_WOUT = 6 * MiB, WS_WD = 8 * MiB, WS_WIN = 14 * MiB, WS_WGU = 14 * MiB;
constexpr size_t WS_Q = 28 * MiB, WS_G = 60 * MiB, WS_V = 92 * MiB, WS_OG = 124 * MiB, WS_GA = 156 * MiB, WS_GB = 188 * MiB, WS_PB = 220 * MiB, WS_END = 252 * MiB;
constexpr size_t WS_MG = WS_G, WS_H1B = WS_GB, WS_ACT = WS_Q;
static_assert(WS_WD + (size_t)DM * DFF * 2 <= WS_WIN && WS_WIN + (size_t)INW * DM * 2 <= WS_Q && WS_WGU + (size_t)NGU * DM * 2 <= WS_Q && WS_ACT + (size_t)M * DFF * 2 <= WS_H1B, "ws map");
constexpr int LDS_BYTES = 163840;
constexpr size_t WS_BAR = 16 * KiB, WS_CNT = 32 * KiB, CTL_ZERO = 32 * KiB;

struct Args {
    const float *x, *meta, *g_mix, *w_in, *lb_raw, *g_hn, *pool_w, *pool_scale, *w_a, *w_b, *w_out, *g_ffn, *w_gate, *w_up, *w_down, *g_fin;
    float* out; unsigned char* ws; int ph_lo, ph_hi;
};

#define LDS_WAIT() asm volatile("s_waitcnt lgkmcnt(0)" ::: "memory")
__device__ __forceinline__ float wave_sum(float v) {
#pragma unroll
    for (int o = 1; o < 64; o <<= 1) v += __shfl_xor(v, o);
    return v;
}

__device__ __forceinline__ void tr_item(const float* W, int N, int k0, int n0, u16* WT, int drow0, int dpitch, int dk0, const float* ks, LAS float* scr, int lane) {
#pragma unroll
    for (int i = 0; i < 32; ++i) { const int kk = 2 * i + (lane >> 5); float w = __builtin_nontemporal_load(&W[(size_t)(k0 + kk) * N + n0 + (lane & 31)]); if (ks) w *= ks[k0 + kk]; scr[kk * 33 + (lane & 31)] = w; }
    LDS_WAIT(); asm volatile("" ::: "memory");
    const int c = lane & 7;
#pragma unroll
    for (int j = 0; j < 4; ++j) { const int n = (lane >> 3) + 8 * j; const LAS float* s = scr + (8 * c) * 33 + n;
        u32x4 o; o.x = cvt_pk_bf16(s[0 * 33], s[1 * 33]); o.y = cvt_pk_bf16(s[2 * 33], s[3 * 33]); o.z = cvt_pk_bf16(s[4 * 33], s[5 * 33]); o.w = cvt_pk_bf16(s[6 * 33], s[7 * 33]);
        *(u32x4*)(WT + (size_t)(drow0 + n) * dpitch + dk0 + k0 + 8 * c) = o; }
    LDS_WAIT(); asm volatile("" ::: "memory");
}
__device__ __forceinline__ void rms_row_bf16(const float* xrow, const float* g, u16* orow, int lane) {
    const f32x4* xr = (const f32x4*)xrow + lane; const f32x4* gr = (const f32x4*)g + lane;
    f32x4 v[4]; float s = 0.f;
#pragma unroll
    for (int j = 0; j < 4; ++j) { v[j] = xr[64 * j]; s += (v[j].x * v[j].x + v[j].y * v[j].y) + (v[j].z * v[j].z + v[j].w * v[j].w); }
    const float rstd = rsqrtf(wave_sum(s) * (1.f / DM) + EPS);
    u32x2* o8 = (u32x2*)orow + lane;
#pragma unroll
    for (int j = 0; j < 4; ++j) { const f32x4 gv = gr[64 * j]; u32x2 o; o.x = cvt_pk_bf16(v[j].x * rstd * gv.x, v[j].y * rstd * gv.y); o.y = cvt_pk_bf16(v[j].z * rstd * gv.z, v[j].w * rstd * gv.w); o8[64 * j] = o; }
}

__device__ __forceinline__ void p0_meta(const Args& a, LAS unsigned char* lds, int j, int tid, int wave, int lane) {
    LAS float* nm = (LAS float*)lds;
    LAS float* part = (LAS float*)(lds + 65536);
#pragma unroll
    for (int rr = 0; rr < 2; ++rr) { const int r = 2 * wave + rr; const f32x4* xr = (const f32x4*)(a.meta + (size_t)r * DM) + lane; const f32x4* gr = (const f32x4*)a.g_mix + lane;
        f32x4 v[4]; float s = 0.f;
#pragma unroll
        for (int q = 0; q < 4; ++q) { v[q] = xr[64 * q]; s += (v[q].x * v[q].x + v[q].y * v[q].y) + (v[q].z * v[q].z + v[q].w * v[q].w); }
        const float rstd = rsqrtf(wave_sum(s) * (1.f / DM) + EPS);
#pragma unroll
        for (int q = 0; q < 4; ++q) { const f32x4 gv = gr[64 * q]; *(LAS f32x4*)(nm + r * 1024 + 4 * (lane + 64 * q)) = (f32x4){v[q].x * rstd * gv.x, v[q].y * rstd * gv.y, v[q].z * rstd * gv.z, v[q].w * rstd * gv.w}; }
    }
    __syncthreads();
    const int colbase = j < 32 ? 1024 + 32 * j : (j < 64 ? 2048 + 32 * (j - 32) : 4096 + 32 * (j - 64));
    {
        const int col = colbase + (lane & 31), kh = lane >> 5; float acc[16];
#pragma unroll
        for (int r = 0; r < 16; ++r) acc[r] = 0.f;
#pragma unroll 4
        for (int k = 128 * wave + 64 * kh; k < 128 * wave + 64 * kh + 64; k += 4) {
            const float w0 = a.w_in[(size_t)(k + 0) * INW + col], w1 = a.w_in[(size_t)(k + 1) * INW + col], w2 = a.w_in[(size_t)(k + 2) * INW + col], w3 = a.w_in[(size_t)(k + 3) * INW + col];
#pragma unroll
            for (int r = 0; r < 16; ++r) { const f32x4 n4 = *(const LAS f32x4*)(nm + r * 1024 + k); acc[r] += (n4.x * w0 + n4.y * w1) + (n4.z * w2 + n4.w * w3); }
        }
#pragma unroll
        for (int r = 0; r < 16; ++r) part[(wave * 16 + r) * 64 + lane] = acc[r];
    }
    __syncthreads();
    {
        const int r = tid >> 5, cl = tid & 31; float z = 0.f;
#pragma unroll
        for (int w = 0; w < 8; ++w) z += part[(w * 16 + r) * 64 + cl] + part[(w * 16 + r) * 64 + 32 + cl];
        const int col = colbase + cl;
        if (col < 2048) { const int c = col - 1024; const float lb = 1.0f / (1.0f + __expf(a.lb_raw[1024 + c] - a.lb_raw[c])); const float f = lb + (1.0f - lb) * sigm(z);
            const _Float16 hv = (_Float16)__logf(f); ((u16*)(a.ws + WS_GM))[r * 1024 + c] = __builtin_bit_cast(unsigned short, hv); }
        else if (col < 3072) { ((u16*)(a.ws + WS_VM))[r * 1024 + (col - 2048)] = (u16)(cvt_pk_bf16(z, 0.f) & 0xffffu); }
        else { ((u16*)(a.ws + WS_PLM))[r * 512 + (col - 4096)] = (u16)(cvt_pk_bf16(z, 0.f) & 0xffffu); }
    }
    __syncthreads();
}

__device__ __forceinline__ void late_weights(const Args& a, LAS unsigned char* lds, int gw, int NGW) {
    const int lane = threadIdx.x & 63, wave = __builtin_amdgcn_readfirstlane(threadIdx.x >> 6);
    LAS float* scr = (LAS float*)(lds + wave * 16384);
    constexpr int I_A = 16 * 32, I_B = 8 * 32, I_O = 16 * 32, I_D = 44 * 32, I_P = 32;
    constexpr int NIT = I_A + I_B + I_O + I_D + I_P;
    for (int it = gw; it < NIT; it += NGW) {
        int r = it;
        if (r < I_A) { tr_item(a.w_a, 1024, 64 * (r / 32), 32 * (r % 32), (u16*)(a.ws + WS_WAB), 32 * (r % 32), 1536, 0, nullptr, scr, lane); continue; } r -= I_A;
        if (r < I_B) { tr_item(a.w_b, 1024, 64 * (r / 32), 32 * (r % 32), (u16*)(a.ws + WS_WAB), 32 * (r % 32), 1536, 1024, nullptr, scr, lane); continue; } r -= I_B;
        if (r < I_O) { tr_item(a.w_out, 1024, 64 * (r / 32), 32 * (r % 32), (u16*)(a.ws + WS_WOUT), 32 * (r % 32), 1024, 0, nullptr, scr, lane); continue; } r -= I_O;
        if (r < I_D) { tr_item(a.w_down, 1024, 64 * (r / 32), 32 * (r % 32), (u16*)(a.ws + WS_WD), 32 * (r % 32), DFF, 0, nullptr, scr, lane); continue; } r -= I_D;
        { const int gi = r >> 3, q = r & 7; tr_item(a.pool_w + (size_t)gi * 16384, 128, 64 * (q >> 2), 32 * (q & 3), (u16*)(a.ws + WS_PWT) + (size_t)gi * 16384, 32 * (q & 3), 128, 0, nullptr, scr, lane); }
    }
}

__device__ __forceinline__ void p0_prologue(const Args& a, LAS unsigned char* lds, int G, int skip = 0) {
    const int tid = threadIdx.x, lane = tid & 63, wave = __builtin_amdgcn_readfirstlane(tid >> 6);
    const bool split = G > 160;
    if ((int)blockIdx.x < 80) { if (!(skip & 4)) p0_meta(a, lds, (int)blockIdx.x, tid, wave, lane); if (split) return; }
    if (blockIdx.x == 80 || (G <= 80 && blockIdx.x == 0)) { for (int c = tid; c < 1024; c += NTHR) ((float*)(a.ws + WS_LB))[c] = 1.0f / (1.0f + __expf(a.lb_raw[1024 + c] - a.lb_raw[c])); }
    LAS float* scr = (LAS float*)(lds + wave * 16384);
    const int gw = ((int)blockIdx.x - (split ? 80 : 0)) * NWAVES + wave, NGW = (G - (split ? 80 : 0)) * NWAVES;
    constexpr int I_IN = 16 * 208;
    for (int it = gw; it < I_IN && !(skip & 1); it += NGW) tr_item(a.w_in, INW, 64 * (it / 208), 32 * (it % 208), (u16*)(a.ws + WS_WIN), 32 * (it % 208), 1024, 0, nullptr, scr, lane);
    if (G != 256) late_weights(a, lds, gw, NGW);
    u16* XN = (u16*)a.out;
    {
        const f32x4* gr = (const f32x4*)a.g_mix + lane; f32x4 gv[4];
#pragma unroll
        for (int j = 0; j < 4; ++j) gv[j] = gr[64 * j];
        for (int m = 4 * gw; m < M && !(skip & 2); m += 4 * NGW) {
            const f32x4* xr = (const f32x4*)(a.x + (size_t)m * DM) + lane; f32x4 v[16]; float ss[4];
#pragma unroll
            for (int j = 0; j < 16; ++j) v[j] = __builtin_nontemporal_load(&xr[64 * j]);
#pragma unroll
            for (int rr = 0; rr < 4; ++rr) { float t = 0.f;
#pragma unroll
                for (int j = 0; j < 4; ++j) { const f32x4 w = v[4 * rr + j]; t += (w.x * w.x + w.y * w.y) + (w.z * w.z + w.w * w.w); }
                ss[rr] = t; }
#pragma unroll
            for (int o = 1; o < 64; o <<= 1) {
#pragma unroll
                for (int rr = 0; rr < 4; ++rr) ss[rr] += __shfl_xor(ss[rr], o); }
            u32x2* o8 = (u32x2*)(XN + (size_t)m * DM) + lane;
#pragma unroll
            for (int j = 0; j < 16; ++j) { const float rs = rsqrtf(ss[j >> 2] * (1.f / DM) + EPS); const f32x4 g4 = gv[j & 3]; u32x2 o; o.x = cvt_pk_bf16(v[j].x * rs * g4.x, v[j].y * rs * g4.y); o.y = cvt_pk_bf16(v[j].z * rs * g4.z, v[j].w * rs * g4.w); o8[64 * j] = o; }
        }
    }
}

struct EpiIn {
    static constexpr bool PERM = true, MID = false, AFTER = false;
    unsigned char* ws;
    __device__ __forceinline__ void mid(f32x4 (&)[2][2][4][2], const pg8::Unit&, int, int, int, int) const {}
    __device__ __forceinline__ void operator()(f32x4 (&acc)[2][2][4][2], const pg8::Unit& u, int wr, int wc, int fr, int fq) const {
        const int colt = u.pn * 256; int type, c0; size_t boff;
        if (colt < 1024) { type = 1; boff = WS_Q; c0 = colt; }
        else if (colt < 2048) { type = 3; boff = WS_G; c0 = colt - 1024; }
        else if (colt < 3072) { type = 0; boff = WS_V; c0 = colt - 2048; }
        else if (colt < 4096) { type = 1; boff = WS_OG; c0 = colt - 3072; }
        else if (colt < 4608) { type = 0; boff = WS_PB; c0 = colt - 4096 + 512; }
        else if (colt < 5632) { type = 2; boff = WS_GA; c0 = colt - 4608; }
        else { type = 2; boff = WS_GB; c0 = colt - 5632; }
        u16* base = (u16*)(ws + boff);
        const int col0 = c0 + wc * 32 + 8 * fq, row0 = u.pm * 256 + wr * 64 + fr;
        const float* LB = (const float*)(ws + WS_LB);
        f32x4 lbv[2][2];
        if (type == 3) {
#pragma unroll
            for (int bj = 0; bj < 2; ++bj) { lbv[bj][0] = *(const f32x4*)(LB + col0 + bj * 128); lbv[bj][1] = *(const f32x4*)(LB + col0 + bj * 128 + 4); }
        } else {
#pragma unroll
            for (int bj = 0; bj < 2; ++bj) { lbv[bj][0] = (f32x4){0.f, 0.f, 0.f, 0.f}; lbv[bj][1] = (f32x4){0.f, 0.f, 0.f, 0.f}; }
        }
#pragma unroll
        for (int ai = 0; ai < 2; ++ai)
#pragma unroll
            for (int m = 0; m < 4; ++m) { u16* rowp = base + (size_t)(row0 + ai * 128 + m * 16) * 1024 + col0;
#pragma unroll
                for (int bj = 0; bj < 2; ++bj) { f32x4 v0 = acc[ai][bj][m][0], v1 = acc[ai][bj][m][1]; u32x4 w;
                    if (type == 3) {
                        const f32x4 l0 = lbv[bj][0], l1 = lbv[bj][1];
#pragma unroll
                        for (int e = 0; e < 4; ++e) { v0[e] = __logf(l0[e] + (1.0f - l0[e]) * sigm(v0[e])); v1[e] = __logf(l1[e] + (1.0f - l1[e]) * sigm(v1[e])); }
                        w.x = pk_h(v0[0], v0[1]); w.y = pk_h(v0[2], v0[3]); w.z = pk_h(v1[0], v1[1]); w.w = pk_h(v1[2], v1[3]);
                    } else {
                        if (type == 1) {
#pragma unroll
                            for (int e = 0; e < 4; ++e) { v0[e] = v0[e] * sigm(v0[e]); v1[e] = v1[e] * sigm(v1[e]); }
                        } else if (type == 2) {
#pragma unroll
                            for (int e = 0; e < 4; ++e) { v0[e] = sigm(v0[e]); v1[e] = sigm(v1[e]); }
                        }
                        w.x = cvt_pk_bf16(v0[0], v0[1]); w.y = cvt_pk_bf16(v0[2], v0[3]); w.z = cvt_pk_bf16(v1[0], v1[1]); w.w = cvt_pk_bf16(v1[2], v1[3]);
                    }
                    __builtin_nontemporal_store(w, (u32x4*)(rowp + bj * 128)); } }
    }
};
struct EpiMerge {
    static constexpr bool PERM = true, MID = true, AFTER = false;
    const u16 *GA, *GB; u16* MG;
    __device__ __forceinline__ void mid(f32x4 (&acc)[2][2][4][2], const pg8::Unit& u, int wr, int wc, int fr, int fq) const {
        int zz = 0; asm volatile("" : "+v"(zz));
        const int col0 = u.pn * 256 + wc * 32 + 8 * fq, row0 = u.pm * 256 + wr * 64 + fr + zz;
#pragma unroll
        for (int ai = 0; ai < 2; ++ai)
#pragma unroll
            for (int m = 0; m < 4; ++m) { const size_t off = (size_t)(row0 + ai * 128 + m * 16) * 1024 + col0;
#pragma unroll
                for (int bj = 0; bj < 2; ++bj) { const u32x4 ga = __builtin_nontemporal_load((const u32x4*)(GA + off + bj * 128)), gb = *(const u32x4*)(GB + off + bj * 128);
#pragma unroll
                    for (int e = 0; e < 2; ++e) { acc[ai][bj][m][0][2 * e] *= bf_lo(ga[e]) * __builtin_amdgcn_rcpf(bf_lo(gb[e])); acc[ai][bj][m][0][2 * e + 1] *= bf_hi(ga[e]) * __builtin_amdgcn_rcpf(bf_hi(gb[e]));
                        acc[ai][bj][m][1][2 * e] *= bf_lo(ga[2 + e]) * __builtin_amdgcn_rcpf(bf_lo(gb[2 + e])); acc[ai][bj][m][1][2 * e + 1] *= bf_hi(ga[2 + e]) * __builtin_amdgcn_rcpf(bf_hi(gb[2 + e])); } }
                asm volatile("" ::: "memory"); }
    }
    __device__ __forceinline__ void operator()(f32x4 (&acc)[2][2][4][2], const pg8::Unit& u, int wr, int wc, int fr, int fq) const {
        const int col0 = u.pn * 256 + wc * 32 + 8 * fq, row0 = u.pm * 256 + wr * 64 + fr;
#pragma unroll
        for (int ai = 0; ai < 2; ++ai)
#pragma unroll
            for (int m = 0; m < 4; ++m) { const size_t off = (size_t)(row0 + ai * 128 + m * 16) * 1024 + col0;
#pragma unroll
                for (int bj = 0; bj < 2; ++bj) { const u32x4 gb = *(const u32x4*)(GB + off + bj * 128);
                    acc[ai][bj][m][0] *= (f32x4){bf_lo(gb[0]), bf_hi(gb[0]), bf_lo(gb[1]), bf_hi(gb[1])}; acc[ai][bj][m][1] *= (f32x4){bf_lo(gb[2]), bf_hi(gb[2]), bf_lo(gb[3]), bf_hi(gb[3])}; } }
#pragma unroll
        for (int ai = 0; ai < 2; ++ai)
#pragma unroll
            for (int m = 0; m < 4; ++m) { const size_t off = (size_t)(row0 + ai * 128 + m * 16) * 1024 + col0;
#pragma unroll
                for (int bj = 0; bj < 2; ++bj) { const f32x4 v0 = acc[ai][bj][m][0], v1 = acc[ai][bj][m][1]; u32x4 w;
                    w.x = cvt_pk_bf16(v0[0], v0[1]); w.y = cvt_pk_bf16(v0[2], v0[3]); w.z = cvt_pk_bf16(v1[0], v1[1]); w.w = cvt_pk_bf16(v1[2], v1[3]);
                    *(u32x4*)(MG + off + bj * 128) = w; } }
    }
};
template <bool WITH_BF16>
struct EpiRes {
    static constexpr bool PERM = false, MID = false, AFTER = false;
    const float* base; float* H; u16* Hb; float* rsq;
    __device__ __forceinline__ void mid(f32x4 (&)[2][2][4][2], const pg8::Unit&, int, int, int, int) const {}
    __device__ __forceinline__ void operator()(f32x4 (&acc)[2][2][4][2], const pg8::Unit& u, int wr, int wc, int fr, int fq) const {
        const int col0 = u.pn * 256 + wc * 32 + 4 * fq, row0 = u.pm * 256 + wr * 64 + fr;
#pragma unroll
        for (int ai = 0; ai < 2; ++ai) {
            f32x4 pre[4][2][2];
#pragma unroll
            for (int m = 0; m < 4; ++m) { const size_t off = (size_t)(row0 + ai * 128 + m * 16) * 1024 + col0;
#pragma unroll
                for (int bj = 0; bj < 2; ++bj)
#pragma unroll
                    for (int n = 0; n < 2; ++n) pre[m][bj][n] = __builtin_nontemporal_load((const f32x4*)(base + off + bj * 128 + n * 16)); }
            asm volatile("" ::: "memory");
#pragma unroll
            for (int m = 0; m < 4; ++m) { const int row = row0 + ai * 128 + m * 16; const size_t off = (size_t)row * 1024 + col0; float s = 0.f;
#pragma unroll
                for (int bj = 0; bj < 2; ++bj)
#pragma unroll
                    for (int n = 0; n < 2; ++n) { const f32x4 hv = pre[m][bj][n] + acc[ai][bj][m][n];
                        if (H) *(f32x4*)(H + off + bj * 128 + n * 16) = hv;
                        s += (hv[0] * hv[0] + hv[1] * hv[1]) + (hv[2] * hv[2] + hv[3] * hv[3]);
                        if (WITH_BF16) { u32x2 w; w.x = cvt_pk_bf16(hv[0], hv[1]); w.y = cvt_pk_bf16(hv[2], hv[3]); *(u32x2*)(Hb + off + bj * 128 + n * 16) = w; } }
                s += __shfl_xor(s, 16); s += __shfl_xor(s, 32);
                if (fq == 0) rsq[(size_t)row * 16 + u.pn * 4 + wc] = s; }
            asm volatile("" ::: "memory");
        }
    }
};
struct EpiFfn1 {
    static constexpr bool PERM = true, MID = false, AFTER = false;
    const float* rsq; u16* ACT;
    __device__ __forceinline__ void mid(f32x4 (&)[2][2][4][2], const pg8::Unit&, int, int, int, int) const {}
    __device__ __forceinline__ void operator()(const f32x4 (&acc)[2][2][4][2], const pg8::Unit& u, int wr, int wc, int fr, int fq) const {
        const int col0 = u.pn * 128 + wc * 32 + 8 * fq, row0 = u.pm * 256 + wr * 64 + fr;
        float rstdv[2][4];
#pragma unroll
        for (int ai = 0; ai < 2; ++ai)
#pragma unroll
            for (int m = 0; m < 4; ++m) { const int row = row0 + ai * 128 + m * 16; const f32x4* rp = (const f32x4*)(rsq + (size_t)row * 16);
                const f32x4 r0 = rp[0], r1 = rp[1], r2 = rp[2], r3 = rp[3];
                const float ss = ((r0[0] + r0[1]) + (r0[2] + r0[3])) + ((r1[0] + r1[1]) + (r1[2] + r1[3])) + ((r2[0] + r2[1]) + (r2[2] + r2[3])) + ((r3[0] + r3[1]) + (r3[2] + r3[3]));
                rstdv[ai][m] = rsqrtf(ss * (1.f / DM) + EPS); }
#pragma unroll
        for (int ai = 0; ai < 2; ++ai)
#pragma unroll
            for (int m = 0; m < 4; ++m) { const int row = row0 + ai * 128 + m * 16;
                const float rstd = rstdv[ai][m];
                float o[8];
#pragma unroll
                for (int n = 0; n < 2; ++n)
#pragma unroll
                    for (int e = 0; e < 4; ++e) { const float gt = acc[ai][0][m][n][e] * rstd, up = acc[ai][1][m][n][e] * rstd; o[4 * n + e] = gt * sigm(gt) * up; }
                u32x4 w; w.x = cvt_pk_bf16(o[0], o[1]); w.y = cvt_pk_bf16(o[2], o[3]); w.z = cvt_pk_bf16(o[4], o[5]); w.w = cvt_pk_bf16(o[6], o[7]);
                __builtin_nontemporal_store(w, (u32x4*)(ACT + (size_t)row * DFF + col0)); }
    }
};

struct EpiResNorm {
    static constexpr bool PERM = false, MID = false, AFTER = true;
    const u16* base; float* out; const float* gfin; float* slots; unsigned* cnt;
    __device__ __forceinline__ void mid(f32x4 (&)[2][2][4][2], const pg8::Unit&, int, int, int, int) const {}
    __device__ __forceinline__ void operator()(const f32x4 (&)[2][2][4][2], const pg8::Unit&, int, int, int, int) const {}
    __device__ __forceinline__ void after(f32x4 (&acc)[2][2][4][2], const pg8::Unit& u, int wr, int wc, int fr, int fq, LAS unsigned char* lds, int wid, int lane) const {
        LAS float* P = (LAS float*)lds; LAS float* R = (LAS float*)(lds + 4096);
        const int col0 = u.pn * 256 + wc * 32 + 4 * fq;
#pragma unroll
        for (int ai = 0; ai < 2; ++ai)
#pragma unroll
            for (int m = 0; m < 4; ++m) { const int rl = ai * 128 + wr * 64 + m * 16 + fr; const size_t off = (size_t)(u.pm * 256 + rl) * 1024 + col0; float s = 0.f;
#pragma unroll
                for (int bj = 0; bj < 2; ++bj)
#pragma unroll
                    for (int n = 0; n < 2; ++n) { const u32x2 hb = __builtin_nontemporal_load((const u32x2*)(base + off + bj * 128 + n * 16));
                        const f32x4 hv = (f32x4){bf_lo(hb.x), bf_hi(hb.x), bf_lo(hb.y), bf_hi(hb.y)} + acc[ai][bj][m][n]; acc[ai][bj][m][n] = hv; s += (hv[0] * hv[0] + hv[1] * hv[1]) + (hv[2] * hv[2] + hv[3] * hv[3]); }
                s += __shfl_xor(s, 16); s += __shfl_xor(s, 32);
                if (fq == 0) P[rl * 4 + wc] = s;
                if (m & 1) asm volatile("" ::: "memory"); }
        asm volatile("s_waitcnt lgkmcnt(0)" ::: "memory"); __builtin_amdgcn_s_barrier(); asm volatile("" ::: "memory");
        const int row = wid * 32 + (lane & 31);
        unsigned* slot = (unsigned*)slots + (size_t)(u.pm * 256 + row) * 16;
        if (lane < 32) { const float t = (P[row * 4 + 0] + P[row * 4 + 1]) + (P[row * 4 + 2] + P[row * 4 + 3]);
            __hip_atomic_store(slot + u.pn, __float_as_uint(t), __ATOMIC_RELAXED, __HIP_MEMORY_SCOPE_AGENT); }
        asm volatile("s_waitcnt vmcnt(0)" ::: "memory");
        if (lane == 0) __hip_atomic_fetch_add(cnt + 64 * u.pm, 1u, __ATOMIC_RELAXED, __HIP_MEMORY_SCOPE_AGENT);
        if (wid == 0) { unsigned sp = 0;
            while ((unsigned)__builtin_amdgcn_readfirstlane(__hip_atomic_load(cnt + 64 * u.pm, __ATOMIC_RELAXED, __HIP_MEMORY_SCOPE_AGENT)) < 32u) { __builtin_amdgcn_s_sleep(2); if (++sp > (1u << 20)) break; }
            __builtin_amdgcn_fence(__ATOMIC_ACQUIRE, "agent"); }
        asm volatile("s_waitcnt vmcnt(0) lgkmcnt(0)" ::: "memory"); __builtin_amdgcn_s_barrier(); asm volatile("" ::: "memory");
        if (lane < 32) { float t = 0.f;
#pragma unroll
            for (int k = 0; k < 4; ++k) t += __uint_as_float(__hip_atomic_load(slot + k, __ATOMIC_RELAXED, __HIP_MEMORY_SCOPE_AGENT));
            R[row] = rsqrtf(t * (1.f / DM) + EPS); }
        asm volatile("s_waitcnt lgkmcnt(0)" ::: "memory"); __builtin_amdgcn_s_barrier(); asm volatile("" ::: "memory");
        f32x4 gv[2][2];
#pragma unroll
        for (int bj = 0; bj < 2; ++bj)
#pragma unroll
            for (int n = 0; n < 2; ++n) gv[bj][n] = *(const f32x4*)(gfin + col0 + bj * 128 + n * 16);
#pragma unroll
        for (int ai = 0; ai < 2; ++ai)
#pragma unroll
            for (int m = 0; m < 4; ++m) { const int rl = ai * 128 + wr * 64 + m * 16 + fr; const size_t off = (size_t)(u.pm * 256 + rl) * 1024 + col0; const float rs = R[rl];
#pragma unroll
                for (int bj = 0; bj < 2; ++bj)
#pragma unroll
                    for (int n = 0; n < 2; ++n) *(f32x4*)(out + off + bj * 128 + n * 16) = acc[ai][bj][m][n] * rs * gv[bj][n]; }
    }
};
#define RLX_AGENT __ATOMIC_RELAXED, __HIP_MEMORY_SCOPE_AGENT
#define XB_TMO      128
#define XB_XCNT(j)  (256  + 64 * (j))
#define XB_XSUB(j)  (1280 + 64 * (j))
#define XB_XGEN(j)  (2304 + 64 * (j))
#define XB_TOP      3328
#define XB_TOPGEN   3392
#define XCD_BAR_WORDS 3456
#define XB_SPIN_CAP (1u << 18)

__device__ __forceinline__ unsigned xb_ld(unsigned* p)              { return __hip_atomic_load(p, __ATOMIC_RELAXED, __HIP_MEMORY_SCOPE_AGENT); }
__device__ __forceinline__ unsigned xb_add(unsigned* p, unsigned v) { return __hip_atomic_fetch_add(p, v, __ATOMIC_RELAXED, __HIP_MEMORY_SCOPE_AGENT); }
__device__ __forceinline__ unsigned xb_xcc_id() { return (unsigned)__builtin_amdgcn_s_getreg((3 << 11) | 20) & 0xFu; }
#define XB_SPIN(cond, bar) do { unsigned _sp = 0; while (cond) { __builtin_amdgcn_s_sleep(1); \
    if ((++_sp & 255u) == 0u) { if (xb_ld(&(bar)[XB_TMO])) break; if (_sp > XB_SPIN_CAP) { atomicAdd(&(bar)[XB_TMO], 1u); break; } } } } while (0)

struct XcdBarrier {
    unsigned* bar; unsigned x;
    volatile LAS unsigned* st;
};

__device__ __forceinline__ XcdBarrier xcd_barrier_post(unsigned* bar, volatile LAS unsigned* st) {
    XcdBarrier b; b.bar = bar; b.x = xb_xcc_id(); b.st = st;
    if (threadIdx.x == 0) (void)xb_add(&bar[XB_XCNT(b.x)], 1u);
    return b;
}
__device__ __forceinline__ void xcd_barrier_complete(unsigned* bar, unsigned x, unsigned& nloc, unsigned& nx) {
    const unsigned G = gridDim.x * gridDim.y * gridDim.z;
    unsigned sum, cnt, mine, sp = 0u;
    for (;;) {
        sum = 0u; cnt = 0u; mine = 0u;
#pragma unroll
        for (unsigned j = 0; j < 16; ++j) { const unsigned c = xb_ld(&bar[XB_XCNT(j)]); sum += c; cnt += (c > 0u) ? 1u : 0u; mine = (j == x) ? c : mine; }
        if (sum == G) break;
        __builtin_amdgcn_s_sleep(1);
        if ((++sp & 255u) == 0u) { if (xb_ld(&bar[XB_TMO])) break; if (sp > XB_SPIN_CAP) { atomicAdd(&bar[XB_TMO], 1u); break; } }
    }
    nloc = mine > 0u ? mine : 1u; nx = cnt > 0u ? cnt : 1u;
}

__device__ __forceinline__ void xcd_barrier(const XcdBarrier& b) {
    asm volatile("s_waitcnt vmcnt(0)" ::: "memory");
    __syncthreads();
    if (threadIdx.x == 0) {
        unsigned* bar = b.bar;
        __builtin_amdgcn_s_waitcnt(0);
        unsigned nloc = b.st[0], nx = b.st[1];
        if (nloc == 0u) { xcd_barrier_complete(bar, b.x, nloc, nx); b.st[0] = nloc; b.st[1] = nx; }
        const unsigned old = xb_add(&bar[XB_XSUB(b.x)], 1u);
        const unsigned gen = old / nloc;
        if (old + 1u == (gen + 1u) * nloc) {
            __builtin_amdgcn_fence(__ATOMIC_RELEASE, "agent");
            asm volatile("s_waitcnt vmcnt(0)" ::: "memory");
            const unsigned og = xb_add(&bar[XB_TOP], 1u);
            const unsigned tg = og / nx;
            if (og + 1u == (tg + 1u) * nx) xb_add(&bar[XB_TOPGEN], 1u);
            else XB_SPIN(xb_ld(&bar[XB_TOPGEN]) == tg, bar);
            __builtin_amdgcn_fence(__ATOMIC_ACQUIRE, "agent");
            xb_add(&bar[XB_XGEN(b.x)], 1u);
            asm volatile("s_waitcnt vmcnt(0)" ::: "memory");
        } else {
            XB_SPIN(xb_ld(&bar[XB_XGEN(b.x)]) == gen, bar);
            __builtin_amdgcn_fence(__ATOMIC_ACQUIRE, "agent");
            asm volatile("s_waitcnt vmcnt(0)" ::: "memory");
        }
    }
    __syncthreads();
}

__device__ __forceinline__ void p2_wave(const u16* Gp, const u16* Vp, int nrows, int h, u16* Uout, float* dk, int lane) {
    const int r = lane & 15, q = lane >> 4;
    bf16x8 kf[8][2]; float tot1[8];
#pragma unroll
    for (int kk = 0; kk < 2; ++kk) { const int ks = 1 - kk;
#pragma unroll
        for (int dg = 0; dg < 2; ++dg) {
            int zz = 0; asm volatile("" : "+v"(zz));
            u32x4 wq[4];
#pragma unroll
            for (int p2 = 0; p2 < 2; ++p2) { const int dp = 2 * dg + p2; const int dcol = 32 * dp + 2 * r + zz; unsigned gw[8];
#pragma unroll
                for (int j = 0; j < 8; ++j) { const int s = 32 * ks + 8 * q + j; gw[j] = s < nrows ? *(const unsigned*)(Gp + (size_t)s * 1024 + h * 128 + dcol) : 0u; }
#pragma unroll
                for (int par = 0; par < 2; ++par) { const int dt = 2 * dp + par; float gv[8];
#pragma unroll
                    for (int j = 0; j < 8; ++j) gv[j] = h2f((u16)(par ? (gw[j] >> 16) : (gw[j] & 0xffffu)));
                    float suf[8]; float run = 0.f;
#pragma unroll
                    for (int j = 7; j >= 0; --j) { suf[j] = run; run += gv[j]; }
                    const float T = run, ta = __shfl_xor(T, 16), tb = __shfl_xor(T, 32), tc = __shfl_xor(ta, 32);
                    const float after = ((q ^ 1) > q ? ta : 0.f) + ((q ^ 2) > q ? tb : 0.f) + ((q ^ 3) > q ? tc : 0.f);
                    const float tot = (T + ta) + (tb + tc);
                    float base;
                    if (ks == 1) { tot1[dt] = tot; base = after; } else { base = after + tot1[dt]; if (dk && q == 0) dk[h * 128 + dcol + par] = __expf(tot + tot1[dt]); }
                    float kh[8];
#pragma unroll
                    for (int j = 0; j < 8; ++j) kh[j] = (1.0f - __expf(gv[j])) * __expf(suf[j] + base);
                    u32x4& w = wq[2 * p2 + par];
                    w.x = cvt_pk_bf16(kh[0], kh[1]); w.y = cvt_pk_bf16(kh[2], kh[3]); w.z = cvt_pk_bf16(kh[4], kh[5]); w.w = cvt_pk_bf16(kh[6], kh[7]); } }
            asm volatile("" : "+v"(wq[0].x), "+v"(wq[0].y), "+v"(wq[0].z), "+v"(wq[0].w), "+v"(wq[1].x), "+v"(wq[1].y), "+v"(wq[1].z), "+v"(wq[1].w),
                              "+v"(wq[2].x), "+v"(wq[2].y), "+v"(wq[2].z), "+v"(wq[2].w), "+v"(wq[3].x), "+v"(wq[3].y), "+v"(wq[3].z), "+v"(wq[3].w));
#pragma unroll
            for (int d4 = 0; d4 < 4; ++d4) kf[4 * dg + d4][ks] = __builtin_bit_cast(bf16x8, wq[d4]); } }
#pragma unroll 1
    for (int ep = 0; ep < 4; ++ep) {
        int zz = 0; asm volatile("" : "+v"(zz)); const int ecol = 32 * ep + 2 * r + zz;
        unsigned vw[2][8];
#pragma unroll
        for (int ks = 0; ks < 2; ++ks)
#pragma unroll
            for (int j = 0; j < 8; ++j) { const int s = 32 * ks + 8 * q + j; vw[ks][j] = s < nrows ? *(const unsigned*)(Vp + (size_t)s * 1024 + h * 128 + ecol) : 0u; }
#pragma unroll
        for (int par = 0; par < 2; ++par) {
            bf16x8 vf[2];
#pragma unroll
            for (int ks = 0; ks < 2; ++ks) { u32x4 w;
                if (par == 0) { w.x = (vw[ks][0] & 0xffffu) | (vw[ks][1] << 16); w.y = (vw[ks][2] & 0xffffu) | (vw[ks][3] << 16); w.z = (vw[ks][4] & 0xffffu) | (vw[ks][5] << 16); w.w = (vw[ks][6] & 0xffffu) | (vw[ks][7] << 16); }
                else { w.x = (vw[ks][0] >> 16) | (vw[ks][1] & 0xffff0000u); w.y = (vw[ks][2] >> 16) | (vw[ks][3] & 0xffff0000u); w.z = (vw[ks][4] >> 16) | (vw[ks][5] & 0xffff0000u); w.w = (vw[ks][6] >> 16) | (vw[ks][7] & 0xffff0000u); }
                vf[ks] = __builtin_bit_cast(bf16x8, w); }
            f32x4 acc[8];
#pragma unroll
            for (int dt = 0; dt < 8; ++dt) { acc[dt] = (f32x4){0.f, 0.f, 0.f, 0.f};
#pragma unroll
                for (int ks = 0; ks < 2; ++ks) acc[dt] = __builtin_amdgcn_mfma_f32_16x16x32_bf16(kf[dt][ks], vf[ks], acc[dt], 0, 0, 0); }
#pragma unroll
            for (int dp = 0; dp < 4; ++dp) { u32x4 w; w.x = cvt_pk_bf16(acc[2 * dp][0], acc[2 * dp + 1][0]); w.y = cvt_pk_bf16(acc[2 * dp][1], acc[2 * dp + 1][1]); w.z = cvt_pk_bf16(acc[2 * dp][2], acc[2 * dp + 1][2]); w.w = cvt_pk_bf16(acc[2 * dp][3], acc[2 * dp + 1][3]);
                { const int e = 32 * ep + 2 * r + par;
                  *(u32x4*)(Uout + ((size_t)((e >> 4) * 4 + dp) * 64 + q * 16 + (e & 15)) * 8) = w; } } }
    }
}
__device__ __forceinline__ void p2_states(const Args& a, int G) {
    const int tid = threadIdx.x, lane = tid & 63, wave = __builtin_amdgcn_readfirstlane(tid >> 6);
    const u16* Gb = (const u16*)(a.ws + WS_G); const u16* Vb = (const u16*)(a.ws + WS_V); u16* US = (u16*)a.out; float* DK = (float*)(a.ws + WS_DK);
    for (int it = blockIdx.x; it < BATCH * NCH + (G == 256 ? 0 : 1); it += G) {
        if (it < BATCH * NCH) { const size_t row0 = (size_t)it * CHK;
            p2_wave(Gb + row0 * 1024, Vb + row0 * 1024, CHK, wave, US + ((size_t)it * 8 + wave) * 16384, DK + (size_t)it * 1024, lane); }
        else p2_wave((const u16*)(a.ws + WS_GM), (const u16*)(a.ws + WS_VM), NMETA, wave, (u16*)(a.ws + WS_UM) + (size_t)wave * 16384, nullptr, lane);
    }
}

__device__ __forceinline__ void p3_scan(const Args& a, LAS unsigned char* lds, int G) {
    const int tid = threadIdx.x, lane = tid & 63, wave = __builtin_amdgcn_readfirstlane(tid >> 6);
    {
        LAS float* scr = (LAS float*)(lds + wave * 16384);
        const int gw = (int)blockIdx.x * NWAVES + wave, NGW = G * NWAVES;
        for (int it = gw; it < 2 * 16 * 88; it += NGW) { const int up = it >= 16 * 88, r = up ? it - 16 * 88 : it, kb = r / 88, nb = r % 88, n0 = 32 * nb;
            tr_item(up ? a.w_up : a.w_gate, DFF, 64 * kb, n0, (u16*)(a.ws + WS_WGU), (n0 >> 7) * 256 + (n0 & 127) + (up ? 128 : 0), 1024, 0, a.g_ffn, scr, lane); }
    }
    u16* US = (u16*)a.out; const float* DK = (const float*)(a.ws + WS_DK); const u16* UM = (const u16*)(a.ws + WS_UM);
    for (int idx = blockIdx.x * NTHR + tid; idx < BATCH * 8 * 128 * 64; idx += G * NTHR) {
        const int pr = idx & 8191, h = (idx >> 13) & 7, b = idx >> 16;
        const int d = 32 * ((pr >> 8) & 3) + 8 * ((pr >> 6) & 3) + 2 * (pr & 3);
        const unsigned um = *(const unsigned*)(UM + (size_t)h * 16384 + 2 * pr);
        float s0 = bf_lo(um), s1 = bf_hi(um);
        unsigned* up = (unsigned*)(US + ((size_t)(b * NCH) * 8 + h) * 16384 + 2 * pr);
        const float* dkp = DK + (size_t)(b * NCH) * 1024 + h * 128 + d;
#pragma unroll 1
        for (int c0 = 0; c0 < NCH; c0 += 16) {
            unsigned uu[16]; float dd0[16], dd1[16];
#pragma unroll
            for (int i = 0; i < 16; ++i) { uu[i] = up[(size_t)(c0 + i) * 8 * 8192]; dd0[i] = dkp[(size_t)(c0 + i) * 1024]; dd1[i] = dkp[(size_t)(c0 + i) * 1024 + 1]; }
#pragma unroll
            for (int i = 0; i < 16; ++i) { up[(size_t)(c0 + i) * 8 * 8192] = cvt_pk_bf16(s0, s1); s0 = dd0[i] * s0 + bf_lo(uu[i]); s1 = dd1[i] * s1 + bf_hi(uu[i]); }
        }
    }
}

constexpr int P4_PITCH = 272, P4_MAT = 64 * P4_PITCH  , P4_VPITCH = 136, P4_HS = 4 * P4_MAT  , P4_TOT = 2 * P4_HS  , P4_PLD = P4_TOT + 4096  ;
static_assert(P4_PLD + P4_MAT + 64 <= LDS_BYTES, "LDS map");
__device__ __forceinline__ unsigned ld_pl(const u16* PB, const u16* PLM, int b, int tx, int cofs) {
    return tx >= 0 ? *(const unsigned*)(PB + (size_t)(b * SEQ + tx) * 1024 + 512 + cofs) : *(const unsigned*)(PLM + (size_t)(NMETA + tx) * 512 + cofs);
}
__device__ __forceinline__ void p4_outputs(const Args& a, LAS unsigned char* lds, int G, int skip = 0) {
    (void)skip;
    const int tid = threadIdx.x, lane = tid & 63, wave = __builtin_amdgcn_readfirstlane(tid >> 6);
    const int r = lane & 15, q = lane >> 4;
    u16* Qb = (u16*)(a.ws + WS_Q); const u16* Gb = (const u16*)(a.ws + WS_G); const u16* Vb = (const u16*)(a.ws + WS_V); const u16* OGb = (const u16*)(a.ws + WS_OG);
    u16* PB = (u16*)(a.ws + WS_PB); const u16* PLM = (const u16*)(a.ws + WS_PLM); const u16* PWT = (const u16*)(a.ws + WS_PWT); const u16* US = (const u16*)a.out;
    LAS unsigned char* PLD = lds + P4_PLD;
    for (int item = blockIdx.x; item < BATCH * NCH * 4; item += G) {
        const int hp = item & 3, bc = item >> 2, c = bc & (NCH - 1), b = bc >> 7;
        const size_t row0 = (size_t)b * SEQ + (size_t)c * CHK;
        const int hs = wave >> 2, tq = wave & 3, h = 2 * hp + hs;
        LAS unsigned char* L = lds + hs * P4_HS;
        LAS unsigned char* KT = L, *QT = L + P4_MAT, *QH = L + 2 * P4_MAT, *VT = L + 3 * P4_MAT;
        LAS float* TOT = (LAS float*)(lds + P4_TOT) + hs * 512;
        const int d0 = 2 * lane; const size_t cofs = (size_t)h * 128 + d0;
        unsigned gp[16], qv[16], vv[16];
#pragma unroll
        for (int i = 0; i < 16; ++i) { const size_t o = (row0 + 16 * tq + i) * 1024 + cofs; gp[i] = __builtin_nontemporal_load((const unsigned*)(Gb + o)); qv[i] = __builtin_nontemporal_load((const unsigned*)(Qb + o)); vv[i] = __builtin_nontemporal_load((const unsigned*)(Vb + o)); }
        const int gi = hp, wlen = 2 << gi; const float inv = 1.0f / (float)wlen;
        const int t0 = 8 * wave, pcofs = gi * 128 + 2 * lane, tx0 = c * CHK + t0;
        unsigned pu[23];
#pragma unroll
        for (int j = 1; j < 16; ++j) pu[15 - j] = (j < wlen) ? ld_pl(PB, PLM, b, tx0 - j, pcofs) : 0u;
#pragma unroll
        for (int i = 0; i < 8; ++i) pu[15 + i] = ld_pl(PB, PLM, b, tx0 + i, pcofs);
        bf16x8 wf[4];
#pragma unroll
        for (int kd = 0; kd < 4; ++kd) wf[kd] = *(const bf16x8*)(PWT + (size_t)(gi * 128 + 16 * wave + r) * 128 + 32 * kd + 8 * q);
        float s0 = 0.f, s1 = 0.f;
#pragma unroll
        for (int i = 0; i < 16; ++i) { s0 += h2f((u16)(gp[i] & 0xffffu)); s1 += h2f((u16)(gp[i] >> 16)); }
        TOT[tq * 128 + d0] = s0; TOT[tq * 128 + d0 + 1] = s1;
        __syncthreads();
        {
            float w0 = 0.f, w1 = 0.f;
#pragma unroll
            for (int j = 1; j < 16; ++j) if (j < wlen) { w0 += bf_lo(pu[15 - j]); w1 += bf_hi(pu[15 - j]); }
#pragma unroll
            for (int i = 0; i < 8; ++i) { const float u0 = bf_lo(pu[15 + i]), u1 = bf_hi(pu[15 + i]); w0 += u0; w1 += u1;
                *(LAS unsigned*)(PLD + (t0 + i) * P4_PITCH + 4 * lane) = cvt_pk_bf16(w0 * inv - u0, w1 * inv - u1);
                const unsigned o = wlen == 2 ? pu[15 + i - 1] : (wlen == 4 ? pu[15 + i - 3] : (wlen == 8 ? pu[15 + i - 7] : pu[15 + i - 15]));
                w0 -= bf_lo(o); w1 -= bf_hi(o); }
        }
        float b0 = 0.f, b1 = 0.f;
#pragma unroll
        for (int t2 = 0; t2 < 3; ++t2) if (t2 < tq) { b0 += TOT[t2 * 128 + d0]; b1 += TOT[t2 * 128 + d0 + 1]; }
        const float bm0 = TOT[d0] + TOT[128 + d0], bm1 = TOT[d0 + 1] + TOT[128 + d0 + 1];
#pragma unroll
        for (int i = 0; i < 16; ++i) { const int t = 16 * tq + i; const float g0 = h2f((u16)(gp[i] & 0xffffu)), g1 = h2f((u16)(gp[i] >> 16)); b0 += g0; b1 += g1;
            const unsigned q2 = qv[i], v2 = vv[i];
            const float q0 = bf_lo(q2), q1 = bf_hi(q2), k0 = 1.0f - __expf(g0), k1 = 1.0f - __expf(g1);
            const float eb0 = __expf(b0), eb1 = __expf(b1), em0 = __expf(fminf(b0 - bm0, 80.f)), em1 = __expf(fminf(b1 - bm1, 80.f)), ek0 = __expf(fminf(bm0 - b0, 80.f)), ek1 = __expf(fminf(bm1 - b1, 80.f));
            *(LAS unsigned*)(QT + t * P4_PITCH + d0 * 2) = cvt_pk_bf16(q0 * em0, q1 * em1);
            *(LAS unsigned*)(QH + t * P4_PITCH + d0 * 2) = cvt_pk_bf16(q0 * eb0, q1 * eb1);
            *(LAS unsigned*)(KT + t * P4_PITCH + d0 * 2) = cvt_pk_bf16(k0 * ek0, k1 * ek1);
            *(LAS u16*)(VT + d0 * P4_VPITCH + t * 2) = (u16)(v2 & 0xffffu); *(LAS u16*)(VT + (d0 + 1) * P4_VPITCH + t * 2) = (u16)(v2 >> 16); }
        const u16* Sp = US + ((size_t)bc * 8 + h) * 16384;
        bf16x8 sfr[8][4];
#pragma unroll
        for (int et = 0; et < 8; ++et)
#pragma unroll
            for (int kd = 0; kd < 4; ++kd) sfr[et][kd] = *(const bf16x8*)(Sp + ((size_t)(et * 4 + kd) * 64 + lane) * 8);
        const int tt = tq;
        const size_t orow = (row0 + 16 * tt + r) * 1024 + (size_t)h * 128;
        __syncthreads();
        u32x2 ogv[8];
#pragma unroll
        for (int et = 0; et < 8; ++et) ogv[et] = __builtin_nontemporal_load((const u32x2*)(OGb + orow + 16 * et + 4 * q));
        {
            f32x4 acc[4];
#pragma unroll
            for (int t4 = 0; t4 < 4; ++t4) acc[t4] = (f32x4){0.f, 0.f, 0.f, 0.f};
#pragma unroll
            for (int kd = 0; kd < 4; ++kd)
#pragma unroll
                for (int t4 = 0; t4 < 4; ++t4) { const bf16x8 pfr = *(const LAS bf16x8*)(PLD + (16 * t4 + r) * P4_PITCH + (32 * kd + 8 * q) * 2); acc[t4] = __builtin_amdgcn_mfma_f32_16x16x32_bf16(wf[kd], pfr, acc[t4], 0, 0, 0); }
            const int n0 = gi * 128 + 16 * wave + 4 * q; const f32x4 psc = *(const f32x4*)(a.pool_scale + n0);
#pragma unroll
            for (int t4 = 0; t4 < 4; ++t4) { u32x2 w; w.x = cvt_pk_bf16(acc[t4][0] * psc[0], acc[t4][1] * psc[1]); w.y = cvt_pk_bf16(acc[t4][2] * psc[2], acc[t4][3] * psc[3]);
                *(u32x2*)(PB + (row0 + 16 * t4 + r) * 1024 + n0) = w; }
        }
        bf16x8 qt[4], qh[4];
#pragma unroll
        for (int kd = 0; kd < 4; ++kd) { qt[kd] = *(const LAS bf16x8*)(QT + (16 * tt + r) * P4_PITCH + (32 * kd + 8 * q) * 2); qh[kd] = *(const LAS bf16x8*)(QH + (16 * tt + r) * P4_PITCH + (32 * kd + 8 * q) * 2); }
        f32x4 sc[4];
#pragma unroll
        for (int st = 0; st < 4; ++st) { f32x4 acc = (f32x4){0.f, 0.f, 0.f, 0.f};
            if (st <= tt) {
#pragma unroll
                for (int kd = 0; kd < 4; ++kd) { const bf16x8 kfr = *(const LAS bf16x8*)(KT + (16 * st + r) * P4_PITCH + (32 * kd + 8 * q) * 2); acc = __builtin_amdgcn_mfma_f32_16x16x32_bf16(kfr, qt[kd], acc, 0, 0, 0); }
                if (st == tt) {
#pragma unroll
                    for (int i = 0; i < 4; ++i) if (4 * q + i > r) acc[i] = 0.f; }
            }
            sc[st] = acc; }
        bf16x8 pf[2];
#pragma unroll
        for (int ks = 0; ks < 2; ++ks) { u32x4 w; w.x = cvt_pk_bf16(sc[2 * ks][0], sc[2 * ks][1]); w.y = cvt_pk_bf16(sc[2 * ks][2], sc[2 * ks][3]); w.z = cvt_pk_bf16(sc[2 * ks + 1][0], sc[2 * ks + 1][1]); w.w = cvt_pk_bf16(sc[2 * ks + 1][2], sc[2 * ks + 1][3]);
            pf[ks] = __builtin_bit_cast(bf16x8, w); }
        f32x4 oa[8]; float ss = 0.f;
#pragma unroll
        for (int et = 0; et < 8; ++et) { f32x4 acc = (f32x4){0.f, 0.f, 0.f, 0.f};
#pragma unroll
            for (int kd = 0; kd < 4; ++kd) acc = __builtin_amdgcn_mfma_f32_16x16x32_bf16(sfr[et][kd], qh[kd], acc, 0, 0, 0);
#pragma unroll
            for (int ks = 0; ks < 2; ++ks) if (2 * ks <= tt) {
                const u32x2 lo = *(const LAS u32x2*)(VT + (16 * et + r) * P4_VPITCH + (32 * ks + 4 * q) * 2), hi = *(const LAS u32x2*)(VT + (16 * et + r) * P4_VPITCH + (32 * ks + 16 + 4 * q) * 2);
                const u32x4 w = (u32x4){lo.x, lo.y, hi.x, hi.y};
                acc = __builtin_amdgcn_mfma_f32_16x16x32_bf16(__builtin_bit_cast(bf16x8, w), pf[ks], acc, 0, 0, 0); }
            oa[et] = acc; ss += (acc[0] * acc[0] + acc[1] * acc[1]) + (acc[2] * acc[2] + acc[3] * acc[3]); }
        ss += __shfl_xor(ss, 16); ss += __shfl_xor(ss, 32);
        const float rstd = rsqrtf(ss * (1.f / 128.f) + EPS);
#pragma unroll
        for (int et = 0; et < 8; ++et) { const int e0 = 16 * et + 4 * q; const f32x4 gn = *(const f32x4*)(a.g_hn + e0); const u32x2 og = ogv[et];
            u32x2 w; w.x = cvt_pk_bf16(oa[et][0] * rstd * gn[0] * bf_lo(og.x), oa[et][1] * rstd * gn[1] * bf_hi(og.x)); w.y = cvt_pk_bf16(oa[et][2] * rstd * gn[2] * bf_lo(og.y), oa[et][3] * rstd * gn[3] * bf_hi(og.y));
            *(LAS u32x2*)(QT + (16 * tt + r) * P4_PITCH + e0 * 2) = w; }
        asm volatile("s_waitcnt lgkmcnt(0)" ::: "memory");
#pragma unroll
        for (int i = 0; i < 4; ++i) { const int rr = 16 * tt + 4 * i + (lane >> 4); const u32x4 v = *(const LAS u32x4*)(QT + rr * P4_PITCH + (lane & 15) * 16);
            *(u32x4*)(Qb + (row0 + rr) * 1024 + (size_t)h * 128 + (lane & 15) * 8) = v; }
    }
    __syncthreads();
}

__device__ __forceinline__ void p9_final(const Args& a, int G) {
    const int tid = threadIdx.x, lane = tid & 63, wave = __builtin_amdgcn_readfirstlane(tid >> 6);
    const float* rsq = (const float*)(a.ws + WS_RSQ);
    const f32x4* gr = (const f32x4*)a.g_fin + lane; f32x4 gv[4];
#pragma unroll
    for (int j = 0; j < 4; ++j) gv[j] = gr[64 * j];
    for (int m = 2 * (blockIdx.x * NWAVES + wave); m < M; m += 2 * G * NWAVES) {
        float p = lane < 32 ? rsq[(size_t)m * 16 + lane] : 0.f;
        f32x4* xr = (f32x4*)(a.out + (size_t)m * DM) + lane; f32x4 v[8];
#pragma unroll
        for (int j = 0; j < 8; ++j) v[j] = xr[64 * j];
        p += __shfl_xor(p, 1); p += __shfl_xor(p, 2); p += __shfl_xor(p, 4); p += __shfl_xor(p, 8);
        const float r0 = rsqrtf(__shfl(p, 0) * (1.f / DM) + EPS), r1 = rsqrtf(__shfl(p, 16) * (1.f / DM) + EPS);
#pragma unroll
        for (int j = 0; j < 8; ++j) { const float rs = j < 4 ? r0 : r1; const f32x4 g4 = gv[j & 3]; xr[64 * j] = (f32x4){v[j].x * rs * g4.x, v[j].y * rs * g4.y, v[j].z * rs * g4.z, v[j].w * rs * g4.w}; }
    }
}

#ifdef PROBE_STOP
__device__ __forceinline__ void p_dump(const Args& a, int G) {
    const u16* Qb = (const u16*)(a.ws + WS_Q); const u16* Gb = (const u16*)(a.ws + WS_G); const u16* Vb = (const u16*)(a.ws + WS_V); const u16* OGb = (const u16*)(a.ws + WS_OG);
    const u16* GAb = (const u16*)(a.ws + WS_GA); const u16* GBb = (const u16*)(a.ws + WS_GB); const u16* PB = (const u16*)(a.ws + WS_PB);
    for (size_t i = (size_t)blockIdx.x * NTHR + threadIdx.x; i < (size_t)M * DM; i += (size_t)G * NTHR) {
        float v = 0.f;
        if (PROBE_STOP == 1) v = bf1(Qb[i]) + h2f(Gb[i]) + bf1(Vb[i]) + bf1(OGb[i]) + bf1(GAb[i]) + bf1(GBb[i]) + bf1(PB[i]);
        else if (PROBE_STOP == 2 || PROBE_STOP == 3) { float t = bf1(((const u16*)a.out)[i]) + bf1(((const u16*)a.out)[i + (size_t)M * DM]); if (!(fabsf(t) < 1e30f)) t = 12345.f; ((float*)(a.ws + WS_GA))[i] = t; continue; }
        else if (PROBE_STOP == 4) v = bf1(Qb[i]) + bf1(PB[i]);
        else if (PROBE_STOP == 5) v = bf1(Gb[i]);
        else continue;
        a.out[i] = v;
    }
}
#endif
__device__ __forceinline__ void flat_barrier(unsigned* cnt) {
    asm volatile("s_waitcnt vmcnt(0)" ::: "memory");
    __syncthreads();
    if (threadIdx.x == 0) {
        const unsigned Gn = gridDim.x;
        __builtin_amdgcn_fence(__ATOMIC_RELEASE, "agent");
        asm volatile("s_waitcnt vmcnt(0)" ::: "memory");
        const unsigned old = __hip_atomic_fetch_add(cnt, 1u, __ATOMIC_RELAXED, __HIP_MEMORY_SCOPE_AGENT);
        const unsigned target = (old / Gn + 1u) * Gn; unsigned sp = 0;
        while (__hip_atomic_load(cnt, __ATOMIC_RELAXED, __HIP_MEMORY_SCOPE_AGENT) < target) { __builtin_amdgcn_s_sleep(1); if (++sp > (1u << 22)) break; }
        __builtin_amdgcn_fence(__ATOMIC_ACQUIRE, "agent");
        asm volatile("s_waitcnt vmcnt(0)" ::: "memory");
    }
    __syncthreads();
}
constexpr int NPH = 10;
__global__ void __launch_bounds__(NTHR, 2) mega(Args a) {
    extern __shared__ __attribute__((aligned(16))) unsigned char lds_raw[];
    LAS unsigned char* lds = (LAS unsigned char*)lds_raw;
    cg::grid_group grid = cg::this_grid();
    const int G = gridDim.x, lo = a.ph_lo, hi = a.ph_hi;
    unsigned char* ws = a.ws;
    volatile LAS unsigned* MISC = (volatile LAS unsigned*)(lds + LDS_BYTES - 64);
    if (threadIdx.x < 16) MISC[threadIdx.x] = 0u;
    __syncthreads();
    XcdBarrier bar; bar.bar = (unsigned*)(ws + WS_BAR); bar.x = 0; bar.st = nullptr;
    if (hi - lo > 1) bar = xcd_barrier_post((unsigned*)(ws + WS_BAR), MISC);
    if (hi < 0) grid.sync();
#ifndef PHMASK
#define PHMASK 0x3ff
#endif
#define IN(k) (((PHMASK >> (k)) & 1) && lo <= (k) && (k) < hi)
#ifndef CG_SEAMS
#define CG_SEAMS 0x0
#endif
#define SEAM(k) do { if (IN(k) && IN((k) + 1)) { if ((CG_SEAMS >> (k)) & 1) grid.sync(); else xcd_barrier(bar); } } while (0)
#ifndef PROBE_DUP
#define PROBE_DUP 0
#endif
#ifndef PROBE_XSYNC
#define PROBE_XSYNC 0
#endif
#define DUP(k) (((PROBE_DUP >> (k)) & 1) ? 2 : 1)
    if (IN(0)) { p0_prologue(a, lds, G); } SEAM(0);
#ifdef PROBE_XBAR
    for (int xs = 0; xs < PROBE_XBAR; ++xs) flat_barrier((unsigned*)(ws + WS_BAR + 14 * KiB));
#endif
    if (IN(1)) { pg8::Gemm g{(const u16*)a.out, (const u16*)(ws + WS_WIN), M, INW, DM, DM, 1 << 30, 0L}; pg8::StaticOrder S; S.init(M, INW, G, (int)blockIdx.x);
        EpiIn E{ws}; pg8::gemm_phase<EpiIn, true>(lds, g, S, E);
        if (G == 256 && blockIdx.x == 255) p2_wave((const u16*)(ws + WS_GM), (const u16*)(ws + WS_VM), NMETA, (int)(threadIdx.x >> 6), (u16*)(ws + WS_UM) + (size_t)(threadIdx.x >> 6) * 16384, nullptr, (int)(threadIdx.x & 63));
        else if (G == 256 && blockIdx.x >= 128) late_weights(a, lds, ((int)blockIdx.x - 128) * NWAVES + (int)(threadIdx.x >> 6), 127 * NWAVES); }
    SEAM(1);
    if (IN(2)) { p2_states(a, G); } SEAM(2);
    if (IN(3)) { p3_scan(a, lds, G); } SEAM(3);
    if (IN(4)) { p4_outputs(a, lds, G); } SEAM(4);
    if (IN(5)) { pg8::Gemm g{(const u16*)(ws + WS_Q), (const u16*)(ws + WS_WAB), M, DM, 1536, DM, 16, (long)(WS_PB - WS_Q) - 16L * 128L}; pg8::StaticOrder S; S.init(M, DM, G, (int)blockIdx.x);
        EpiMerge E{(const u16*)(ws + WS_GA), (const u16*)(ws + WS_GB), (u16*)(ws + WS_MG)}; pg8::gemm_phase<EpiMerge, false>(lds, g, S, E); } SEAM(5);
    if (IN(6)) { pg8::Gemm g{(const u16*)(ws + WS_MG), (const u16*)(ws + WS_WOUT), M, DM, DM, DM, 1 << 30, 0L}; pg8::StaticOrder S; S.init(M, DM, G, (int)blockIdx.x);
        const bool fuse9_ = (G == (M / 256) * (DM / 256)) && (hi - lo > 1);
        EpiRes<true> E{a.x, fuse9_ ? nullptr : a.out, (u16*)(ws + WS_H1B), (float*)(ws + WS_RSQ)}; pg8::gemm_phase<EpiRes<true>, false>(lds, g, S, E); } SEAM(6);
    if (IN(7)) { pg8::Gemm g{(const u16*)(ws + WS_H1B), (const u16*)(ws + WS_WGU), M, NGU, DM, DM, 1 << 30, 0L}; pg8::StaticOrder S; S.init(M, NGU, G, (int)blockIdx.x);
        EpiFfn1 E{(const float*)(ws + WS_RSQ), (u16*)(ws + WS_ACT)}; pg8::gemm_phase<EpiFfn1, true>(lds, g, S, E); } SEAM(7);
    const bool fuse9 = (G == (M / 256) * (DM / 256)) && (hi - lo > 1);
    if (IN(8)) { pg8::Gemm g{(const u16*)(ws + WS_ACT), (const u16*)(ws + WS_WD), M, DM, DFF, DFF, 1 << 30, 0L}; pg8::StaticOrder S; S.init(M, DM, G, (int)blockIdx.x);
        if (fuse9) { EpiResNorm E{(const u16*)(ws + WS_H1B), a.out, a.g_fin, (float*)(ws + WS_RSQ), (unsigned*)(ws + WS_CNT)}; pg8::gemm_phase<EpiResNorm, false>(lds, g, S, E); }
        else { EpiRes<false> E{a.out, a.out, nullptr, (float*)(ws + WS_RSQ)}; pg8::gemm_phase<EpiRes<false>, false>(lds, g, S, E); } }
    if (!fuse9) { SEAM(8);
    if (IN(9)) { p9_final(a, G); } }
#ifdef PROBE_LIST
    if (lo == 20) p0_prologue(a, lds, G, 1);
    if (lo == 30) p0_prologue(a, lds, G, 2);
    if (lo == 40) p0_prologue(a, lds, G, 4);
    if (lo == 14) p4_outputs(a, lds, G, 1);
    if (lo == 24) p4_outputs(a, lds, G, 2);
    if (lo == 34) p4_outputs(a, lds, G, 2 | 4);
    if (lo == 44) p4_outputs(a, lds, G, 2 | 8);
    if (lo == 54) p4_outputs(a, lds, G, 2 | 16);
    if (lo == 64) p4_outputs(a, lds, G, 2 | 32);
    if (lo == 74) p4_outputs(a, lds, G, 2 | 64);
    if (lo == 18) { pg8::Gemm g{(const u16*)(ws + WS_ACT), (const u16*)(ws + WS_WD), M, DM, DFF, DFF, 1 << 30, 0L}; pg8::StaticOrder S; S.init(M, DM, G, (int)blockIdx.x);
        EpiRes<false> E{(const float*)(ws + WS_GA), (float*)(ws + WS_GA), nullptr, (float*)(ws + WS_OG)}; pg8::gemm_phase<EpiRes<false>, false>(lds, g, S, E); }
    if (lo == 19) { Args b = a; b.out = (float*)(ws + WS_GA); p9_final(b, G); }
#endif
#ifdef PROBE_STOP
    if (lo == 10) p_dump(a, G);
    if (lo == 11 && (PROBE_STOP == 2 || PROBE_STOP == 3)) { for (size_t i = (size_t)blockIdx.x * NTHR + threadIdx.x; i < (size_t)M * DM; i += (size_t)G * NTHR) a.out[i] = ((const float*)(a.ws + WS_GA))[i]; }
#endif
#undef IN
#undef SEAM
}

extern "C" void kernel_launch(void* const* d_in, const int* in_sizes, int n_in, void* d_out, int out_size, void* d_ws, size_t ws_size, hipStream_t stream) {
    static int grid = 0;
    if (grid == 0) {
        if (n_in != 16 || in_sizes[0] != M * DM || out_size != M * DM || ws_size < WS_END) { fprintf(stderr, "kernel_launch: unexpected shapes (n_in %d, in0 %d, out %d, ws %zu); nothing launched\n", n_in, n_in > 0 ? in_sizes[0] : -1, out_size, ws_size); grid = -1; return; }
        int dev = 0, cus = 0, per_cu = 0;
        (void)hipGetDevice(&dev); (void)hipDeviceGetAttribute(&cus, hipDeviceAttributeMultiprocessorCount, dev);
        if (hipFuncSetAttribute((const void*)mega, hipFuncAttributeMaxDynamicSharedMemorySize, LDS_BYTES) != hipSuccess) { fprintf(stderr, "kernel_launch: hipFuncSetAttribute failed\n"); }
        if (hipOccupancyMaxActiveBlocksPerMultiprocessor(&per_cu, (const void*)mega, NTHR, LDS_BYTES) != hipSuccess || per_cu < 1) per_cu = 1;
        (void)hipGetLastError();
        if (cus <= 0) cus = 256;
        grid = cus * per_cu;
    }
    if (grid < 0) return;
#if MK_COOP
    if (hipMemsetAsync((char*)d_ws + WS_BAR, 0, CTL_ZERO, stream) != hipSuccess) { fprintf(stderr, "kernel_launch: hipMemsetAsync of the barrier words failed\n"); return; }
#endif
    Args a{};
    a.x = (const float*)d_in[0]; a.meta = (const float*)d_in[1]; a.g_mix = (const float*)d_in[2]; a.w_in = (const float*)d_in[3]; a.lb_raw = (const float*)d_in[4]; a.g_hn = (const float*)d_in[5];
    a.pool_w = (const float*)d_in[6]; a.pool_scale = (const float*)d_in[7]; a.w_a = (const float*)d_in[8]; a.w_b = (const float*)d_in[9]; a.w_out = (const float*)d_in[10]; a.g_ffn = (const float*)d_in[11];
    a.w_gate = (const float*)d_in[12]; a.w_up = (const float*)d_in[13]; a.w_down = (const float*)d_in[14]; a.g_fin = (const float*)d_in[15];
    a.out = (float*)d_out; a.ws = (unsigned char*)d_ws;
#if MK_COOP
    a.ph_lo = 0; a.ph_hi = NPH;
    void* args[] = {&a};
    const hipError_t e = hipLaunchCooperativeKernel((const void*)mega, dim3(grid), dim3(NTHR), args, LDS_BYTES, stream);
    if (e != hipSuccess) fprintf(stderr, "kernel_launch: cooperative launch failed: %s (grid %d)\n", hipGetErrorString(e), grid);
#else
#ifdef PROBE_STOP
    for (int ph = 0; ph <= PROBE_STOP; ++ph) { a.ph_lo = ph; a.ph_hi = ph + 1; hipLaunchKernelGGL(mega, dim3(grid), dim3(NTHR), LDS_BYTES, stream, a); }
    a.ph_lo = 10; a.ph_hi = 11; hipLaunchKernelGGL(mega, dim3(grid), dim3(NTHR), LDS_BYTES, stream, a);
    a.ph_lo = 11; a.ph_hi = 12; hipLaunchKernelGGL(mega, dim3(grid), dim3(NTHR), LDS_BYTES, stream, a);
#else
#ifdef PROBE_LIST
    { const int lst[] = PROBE_LIST; for (int i = 0; i < (int)(sizeof(lst) / sizeof(int)); ++i) { a.ph_lo = lst[i]; a.ph_hi = lst[i] + 1; hipLaunchKernelGGL(mega, dim3(grid), dim3(NTHR), LDS_BYTES, stream, a); } }
#else
    for (int ph = 0; ph < NPH; ++ph) { a.ph_lo = ph; a.ph_hi = ph + 1; hipLaunchKernelGGL(mega, dim3(grid), dim3(NTHR), LDS_BYTES, stream, a); }
#endif
#endif
#endif
}
```

```cpp
#include <hip/hip_runtime.h>
#include <hip/hip_cooperative_groups.h>
#include <cstdio>
#include <cstdint>
namespace cg = cooperative_groups;

#ifndef MK_COOP
#define MK_COOP 1
#endif

#define LAS __attribute__((address_space(3)))
typedef unsigned short u16;
typedef short bf16x8 __attribute__((ext_vector_type(8)));
typedef float f32x4 __attribute__((ext_vector_type(4)));
typedef unsigned u32x4 __attribute__((ext_vector_type(4)));
typedef unsigned u32x2 __attribute__((ext_vector_type(2)));

typedef __bf16 bf16v2_t __attribute__((ext_vector_type(2)));
typedef float f32v2_t __attribute__((ext_vector_type(2)));
__device__ __forceinline__ unsigned cvt_pk_bf16(float lo, float hi) { const f32v2_t f = {lo, hi}; const bf16v2_t v = __builtin_convertvector(f, bf16v2_t); return __builtin_bit_cast(unsigned, v); }
__device__ __forceinline__ float bf_lo(unsigned w) { return __uint_as_float(w << 16); }
__device__ __forceinline__ float bf_hi(unsigned w) { return __uint_as_float(w & 0xffff0000u); }
__device__ __forceinline__ float bf1(u16 w) { return __uint_as_float((unsigned)w << 16); }
__device__ __forceinline__ unsigned pk_h(float a, float b) { const _Float16 x = (_Float16)a, y = (_Float16)b; return (unsigned)__builtin_bit_cast(unsigned short, x) | ((unsigned)__builtin_bit_cast(unsigned short, y) << 16); }
__device__ __forceinline__ float h2f(u16 w) { return (float)__builtin_bit_cast(_Float16, w); }
__device__ __forceinline__ float sigm(float z) { return __builtin_amdgcn_rcpf(1.0f + __expf(-z)); }

namespace pg8 {
constexpr int BM = 256, BK = 64, HALF = 128, HTB = HALF * BK * 2, STAGE_BYTES = 8 * HTB, NXCD = 8, WGM = 8;
__host__ __device__ __forceinline__ int lds_byte(int r, int c) { const int st = (r >> 4) * 2 + (c >> 5), rr = r & 15, cc = c & 31, ob = rr * 64 + cc * 2; return st * 1024 + (ob ^ (((ob >> 9) & 1) << 5)); }
__host__ __device__ __forceinline__ void stage_rc(int b, int& R, int& C) { const int st = b / 1024, sb = b % 1024, swz = sb ^ (((sb >> 9) & 1) << 5); R = (st >> 1) * 16 + swz / 64; C = (st & 1) * 32 + (swz % 64) / 2; }
__host__ __device__ __forceinline__ int perm32(int rho) { const int n = rho >> 4, i = rho & 15; return 8 * (i >> 2) + 4 * n + (i & 3); }
struct Unit { int pm, pn; };
struct Gemm { const u16* A; const u16* Bt; int M, N, K, lda, ksplit; long a2delta; };
struct StaticOrder {
    int nM, nN, nwg, G, c;
    __host__ __device__ void init(int M, int N, int G_, int c_) { nM = M / BM; nN = N / BM; nwg = nM * nN; G = G_; c = c_; }
    __host__ __device__ bool next(int i, Unit& u) const {
        const long L = (long)i * G + c; if (L >= nwg) return false;
        int wgid = (int)L; { const int q = nwg / NXCD, r = nwg % NXCD, xcd = wgid % NXCD, off = wgid / NXCD; wgid = (xcd < r ? xcd * (q + 1) : r * (q + 1) + (xcd - r) * q) + off; }
        const int nig = WGM * nN, gid = wgid / nig, fm = gid * WGM, gsz = (nM - fm) < WGM ? (nM - fm) : WGM;
        u.pm = fm + ((wgid % nig) % gsz); u.pn = (wgid % nig) / gsz; return true;
    }
};
template <class Epi, bool ALIGN_EPI>
__device__ __forceinline__ void gemm_phase(LAS unsigned char* lds, const Gemm g, const StaticOrder& S, const Epi& E) {
    const int tid = threadIdx.x, wid = __builtin_amdgcn_readfirstlane(tid >> 6), lane = tid & 63, wr = wid >> 2, wc = wid & 3, fr = lane & 15, fq = lane >> 4;
    const int K = g.K, nt = K / BK, lda = g.lda;
    unsigned voffA[2], voffB[2];
#pragma unroll
    for (int i = 0; i < 2; ++i) { int R, C; stage_rc(tid * 16 + i * 8192, R, C); const int Rb = Epi::PERM ? ((R & ~31) + perm32(R & 31)) : R;
        voffA[i] = (unsigned)(R * lda + C) * 2u; voffB[i] = (unsigned)(Rb * K + C) * 2u; }
    const size_t kstep = (size_t)(BK * 2);
    const size_t hstepA = (size_t)HALF * lda * 2, tstepA = 2 * hstepA;
    const size_t hstepB = (size_t)HALF * K * 2, tstepB = 2 * hstepB;
    const unsigned ldsw = (unsigned)wid * 1024u;
    const int aoff = lds_byte(wr * 64 + fr, fq * 8), boff = lds_byte(wc * 32 + fr, fq * 8);
#define PG8_SA(b, h) (((b) * 2 + (h)) * HTB)
#define PG8_SB(b, h) ((4 + (b) * 2 + (h)) * HTB)
#define PG8_STAGE(bufoff, gbase, voff) do { _Pragma("unroll") for (int _i = 0; _i < 2; ++_i) \
        __builtin_amdgcn_global_load_lds((const unsigned*)((const char*)(gbase) + (voff)[_i]), (LAS unsigned*)(lds + (bufoff) + ldsw + _i * 8192), 16, 0, 0); } while (0)
#define PG8_LDA(dst, b, h) do { _Pragma("unroll") for (int m = 0; m < 4; ++m) _Pragma("unroll") for (int k = 0; k < 2; ++k) dst[m][k] = *(const LAS bf16x8*)(lds + PG8_SA(b, h) + aoff + m * 2048 + k * 1024); } while (0)
#define PG8_LDB(dst, b, h) do { _Pragma("unroll") for (int n = 0; n < 2; ++n) _Pragma("unroll") for (int k = 0; k < 2; ++k) dst[n][k] = *(const LAS bf16x8*)(lds + PG8_SB(b, h) + boff + n * 2048 + k * 1024); } while (0)
#define PG8_MMA(ai, bj, At, Bt) do { __builtin_amdgcn_s_setprio(1); _Pragma("unroll") for (int m = 0; m < 4; ++m) _Pragma("unroll") for (int n = 0; n < 2; ++n) _Pragma("unroll") for (int k = 0; k < 2; ++k) \
        acc[ai][bj][m][n] = __builtin_amdgcn_mfma_f32_16x16x32_bf16(Bt[n][k], At[m][k], acc[ai][bj][m][n], 0, 0, 0); __builtin_amdgcn_s_setprio(0); } while (0)
#define PG8_WAIT_V(n) asm volatile("s_waitcnt vmcnt(" #n ")" ::: "memory")
#define PG8_WAIT_L(n) asm volatile("s_waitcnt lgkmcnt(" #n ")" ::: "memory")
#define PG8_BAR __builtin_amdgcn_s_barrier()
#define PG8_SCHED __builtin_amdgcn_sched_barrier(0)
    Unit cur, nxt; int ui = 0;
    if (!S.next(0, cur)) return;
    f32x4 acc[2][2][4][2];
#pragma unroll
    for (int a = 0; a < 2; ++a)
#pragma unroll
        for (int b = 0; b < 2; ++b)
#pragma unroll
            for (int m = 0; m < 4; ++m)
#pragma unroll
                for (int n = 0; n < 2; ++n) acc[a][b][m][n] = (f32x4){0.f, 0.f, 0.f, 0.f};
    bf16x8 At[4][2], B0[2][2], B1[2][2];
    const char* cA = (const char*)g.A + (size_t)cur.pm * tstepA; const char* cB = (const char*)g.Bt + (size_t)cur.pn * tstepB;
    PG8_STAGE(PG8_SB(0, 0), cB, voffB); PG8_STAGE(PG8_SB(0, 1), cB + hstepB, voffB); PG8_STAGE(PG8_SA(0, 0), cA, voffA); PG8_STAGE(PG8_SA(0, 1), cA + hstepA, voffA);
    if (wr == 1) PG8_BAR;
    PG8_WAIT_V(2); PG8_BAR;
    PG8_STAGE(PG8_SB(1, 0), cB + kstep, voffB); PG8_STAGE(PG8_SA(1, 0), cA + kstep, voffA); PG8_STAGE(PG8_SB(1, 1), cB + hstepB + kstep, voffB);
    PG8_WAIT_V(6); PG8_BAR;
    for (;;) {
        const bool has_next = S.next(ui + 1, nxt);
        const char* nA = has_next ? (const char*)g.A + (size_t)nxt.pm * tstepA : cA; const char* nB = has_next ? (const char*)g.Bt + (size_t)nxt.pn * tstepB : cB;
        for (int t = 0; t < nt; t += 2) {
            const bool last = (t == nt - 2);
            if constexpr (Epi::MID) { if (t == g.ksplit) E.mid(acc, cur, wr, wc, fr, fq); }
            const char* a1 = cA + (size_t)(t + 1) * kstep + (t >= g.ksplit ? g.a2delta : 0L);
            const char* a2 = last ? nA : cA + (size_t)(t + 2) * kstep + (t + 2 >= g.ksplit ? g.a2delta : 0L);
            const char* b2 = last ? nB : cB + (size_t)(t + 2) * kstep;
            const char* a3 = a2 + kstep; const char* b3 = b2 + kstep;
            PG8_LDB(B0, 0, 0); PG8_LDB(B1, 0, 1); PG8_SCHED; PG8_LDA(At, 0, 0); PG8_STAGE(PG8_SA(1, 1), a1 + hstepA, voffA);
            PG8_WAIT_V(8); PG8_WAIT_L(0); PG8_BAR; PG8_MMA(0, 0, At, B0); PG8_MMA(0, 1, At, B1); PG8_BAR; PG8_SCHED;
            PG8_LDA(At, 0, 1); PG8_STAGE(PG8_SB(0, 0), b2, voffB); PG8_STAGE(PG8_SB(0, 1), b2 + hstepB, voffB); PG8_STAGE(PG8_SA(0, 0), a2, voffA);
            PG8_WAIT_V(8); PG8_WAIT_L(0); PG8_BAR; PG8_MMA(1, 0, At, B0); PG8_MMA(1, 1, At, B1); PG8_BAR; PG8_SCHED;
            PG8_LDB(B0, 1, 0); PG8_LDB(B1, 1, 1); PG8_SCHED; PG8_LDA(At, 1, 0); PG8_STAGE(PG8_SA(0, 1), a2 + hstepA, voffA);
            PG8_WAIT_V(8); PG8_WAIT_L(0); PG8_BAR; PG8_MMA(0, 0, At, B0); PG8_MMA(0, 1, At, B1); PG8_BAR; PG8_SCHED;
            PG8_LDA(At, 1, 1); PG8_STAGE(PG8_SB(1, 0), b3, voffB); PG8_STAGE(PG8_SB(1, 1), b3 + hstepB, voffB); PG8_STAGE(PG8_SA(1, 0), a3, voffA);
            PG8_WAIT_V(8); PG8_WAIT_L(0); PG8_BAR; PG8_MMA(1, 0, At, B0); PG8_MMA(1, 1, At, B1); PG8_BAR; PG8_SCHED;
        }
        if constexpr (ALIGN_EPI) { if (wr == 0) PG8_BAR; }
        if constexpr (!Epi::AFTER) E(acc, cur, wr, wc, fr, fq);
        if (!has_next) break;
#pragma unroll
        for (int a = 0; a < 2; ++a)
#pragma unroll
            for (int b = 0; b < 2; ++b)
#pragma unroll
                for (int m = 0; m < 4; ++m)
#pragma unroll
                    for (int n = 0; n < 2; ++n) acc[a][b][m][n] = (f32x4){0.f, 0.f, 0.f, 0.f};
        cur = nxt; cA = nA; cB = nB; ++ui;
        if constexpr (ALIGN_EPI) { if (wr == 1) PG8_BAR; }
    }
    PG8_WAIT_V(0);
    if constexpr (!ALIGN_EPI) { if (wr == 0) PG8_BAR; }
    PG8_BAR;
    if constexpr (Epi::AFTER) E.after(acc, cur, wr, wc, fr, fq, lds, wid, lane);
#undef PG8_SA
#undef PG8_SB
#undef PG8_STAGE
#undef PG8_LDA
#undef PG8_LDB
#undef PG8_MMA
#undef PG8_WAIT_V
#undef PG8_WAIT_L
#undef PG8_BAR
#undef PG8_SCHED
}
}

constexpr int NWAVES = 8, NTHR = 512;
constexpr int SEQ = 8192, BATCH = 2, DM = 1024, M = BATCH * SEQ, NMETA = 16, INW = 6656, DFF = 2816, NGU = 2 * DFF, CHK = 64, NCH = SEQ / CHK;
constexpr float EPS = 1e-6f;
constexpr size_t KiB = 1024, MiB = 1u << 20;
constexpr size_t WS_LB = 0, WS_GM = 64 * KiB, WS_VM = 128 * KiB, WS_PLM = 192 * KiB, WS_PWT = 256 * KiB, WS_UM = 512 * KiB, WS_DK = 1 * MiB, WS_RSQ = 2 * MiB;
constexpr size_t WS_WAB = 3 * MiB, WS_WOUT = 6 * MiB, WS_WD = 8 * MiB, WS_WIN = 14 * MiB, WS_WGU = 14 * MiB;
constexpr size_t WS_Q = 28 * MiB, WS_G = 60 * MiB, WS_V = 92 * MiB, WS_OG = 124 * MiB, WS_GA = 156 * MiB, WS_GB = 188 * MiB, WS_PB = 220 * MiB, WS_END = 252 * MiB;
constexpr size_t WS_MG = WS_G, WS_H1B = WS_GB, WS_ACT = WS_Q;
static_assert(WS_WD + (size_t)DM * DFF * 2 <= WS_WIN && WS_WIN + (size_t)INW * DM * 2 <= WS_Q && WS_WGU + (size_t)NGU * DM * 2 <= WS_Q && WS_ACT + (size_t)M * DFF * 2 <= WS_H1B, "ws map");
constexpr int LDS_BYTES = 163840;
constexpr size_t WS_BAR = 16 * KiB, WS_CNT = 32 * KiB, CTL_ZERO = 32 * KiB;

struct Args {
    const float *x, *meta, *g_mix, *w_in, *lb_raw, *g_hn, *pool_w, *pool_scale, *w_a, *w_b, *w_out, *g_ffn, *w_gate, *w_up, *w_down, *g_fin;
    float* out; unsigned char* ws; int ph_lo, ph_hi;
};

#define LDS_WAIT() asm volatile("s_waitcnt lgkmcnt(0)" ::: "memory")
__device__ __forceinline__ float wave_sum(float v) {
#pragma unroll
    for (int o = 1; o < 64; o <<= 1) v += __shfl_xor(v, o);
    return v;
}

__device__ __forceinline__ void tr_item(const float* W, int N, int k0, int n0, u16* WT, int drow0, int dpitch, int dk0, const float* ks, LAS float* scr, int lane) {
    f32x4 wv[8];
#pragma unroll
    for (int i = 0; i < 8; ++i) wv[i] = __builtin_nontemporal_load((const f32x4*)(W + (size_t)(k0 + 8 * i + (lane >> 3)) * N + n0 + 4 * (lane & 7)));
#pragma unroll
    for (int i = 0; i < 8; ++i) { const int kk = 8 * i + (lane >> 3); f32x4 w = wv[i]; if (ks) w *= ks[k0 + kk];
        LAS float* d = scr + kk * 33 + 4 * (lane & 7); d[0] = w.x; d[1] = w.y; d[2] = w.z; d[3] = w.w; }
    LDS_WAIT(); asm volatile("" ::: "memory");
    const int c = lane & 7;
#pragma unroll
    for (int j = 0; j < 4; ++j) { const int n = (lane >> 3) + 8 * j; const LAS float* s = scr + (8 * c) * 33 + n;
        u32x4 o; o.x = cvt_pk_bf16(s[0 * 33], s[1 * 33]); o.y = cvt_pk_bf16(s[2 * 33], s[3 * 33]); o.z = cvt_pk_bf16(s[4 * 33], s[5 * 33]); o.w = cvt_pk_bf16(s[6 * 33], s[7 * 33]);
        *(u32x4*)(WT + (size_t)(drow0 + n) * dpitch + dk0 + k0 + 8 * c) = o; }
    LDS_WAIT(); asm volatile("" ::: "memory");
}
__device__ __forceinline__ void rms_row_bf16(const float* xrow, const float* g, u16* orow, int lane) {
    const f32x4* xr = (const f32x4*)xrow + lane; const f32x4* gr = (const f32x4*)g + lane;
    f32x4 v[4]; float s = 0.f;
#pragma unroll
    for (int j = 0; j < 4; ++j) { v[j] = xr[64 * j]; s += (v[j].x * v[j].x + v[j].y * v[j].y) + (v[j].z * v[j].z + v[j].w * v[j].w); }
    const float rstd = rsqrtf(wave_sum(s) * (1.f / DM) + EPS);
    u32x2* o8 = (u32x2*)orow + lane;
#pragma unroll
    for (int j = 0; j < 4; ++j) { const f32x4 gv = gr[64 * j]; u32x2 o; o.x = cvt_pk_bf16(v[j].x * rstd * gv.x, v[j].y * rstd * gv.y); o.y = cvt_pk_bf16(v[j].z * rstd * gv.z, v[j].w * rstd * gv.w); o8[64 * j] = o; }
}

__device__ __forceinline__ void p0_meta(const Args& a, LAS unsigned char* lds, int j, int tid, int wave, int lane) {
    LAS float* nm = (LAS float*)lds;
    LAS float* part = (LAS float*)(lds + 65536);
#pragma unroll
    for (int rr = 0; rr < 2; ++rr) { const int r = 2 * wave + rr; const f32x4* xr = (const f32x4*)(a.meta + (size_t)r * DM) + lane; const f32x4* gr = (const f32x4*)a.g_mix + lane;
        f32x4 v[4]; float s = 0.f;
#pragma unroll
        for (int q = 0; q < 4; ++q) { v[q] = xr[64 * q]; s += (v[q].x * v[q].x + v[q].y * v[q].y) + (v[q].z * v[q].z + v[q].w * v[q].w); }
        const float rstd = rsqrtf(wave_sum(s) * (1.f / DM) + EPS);
#pragma unroll
        for (int q = 0; q < 4; ++q) { const f32x4 gv = gr[64 * q]; *(LAS f32x4*)(nm + r * 1024 + 4 * (lane + 64 * q)) = (f32x4){v[q].x * rstd * gv.x, v[q].y * rstd * gv.y, v[q].z * rstd * gv.z, v[q].w * rstd * gv.w}; }
    }
    __syncthreads();
    const int colbase = j < 32 ? 1024 + 32 * j : (j < 64 ? 2048 + 32 * (j - 32) : 4096 + 32 * (j - 64));
    {
        const int col = colbase + (lane & 31), kh = lane >> 5; float acc[16];
#pragma unroll
        for (int r = 0; r < 16; ++r) acc[r] = 0.f;
#pragma unroll 4
        for (int k = 128 * wave + 64 * kh; k < 128 * wave + 64 * kh + 64; k += 4) {
            const float w0 = a.w_in[(size_t)(k + 0) * INW + col], w1 = a.w_in[(size_t)(k + 1) * INW + col], w2 = a.w_in[(size_t)(k + 2) * INW + col], w3 = a.w_in[(size_t)(k + 3) * INW + col];
#pragma unroll
            for (int r = 0; r < 16; ++r) { const f32x4 n4 = *(const LAS f32x4*)(nm + r * 1024 + k); acc[r] += (n4.x * w0 + n4.y * w1) + (n4.z * w2 + n4.w * w3); }
        }
#pragma unroll
        for (int r = 0; r < 16; ++r) part[(wave * 16 + r) * 64 + lane] = acc[r];
    }
    __syncthreads();
    {
        const int r = tid >> 5, cl = tid & 31; float z = 0.f;
#pragma unroll
        for (int w = 0; w < 8; ++w) z += part[(w * 16 + r) * 64 + cl] + part[(w * 16 + r) * 64 + 32 + cl];
        const int col = colbase + cl;
        if (col < 2048) { const int c = col - 1024; const float lb = 1.0f / (1.0f + __expf(a.lb_raw[1024 + c] - a.lb_raw[c])); const float f = lb + (1.0f - lb) * sigm(z);
            const _Float16 hv = (_Float16)__logf(f); ((u16*)(a.ws + WS_GM))[r * 1024 + c] = __builtin_bit_cast(unsigned short, hv); }
        else if (col < 3072) { ((u16*)(a.ws + WS_VM))[r * 1024 + (col - 2048)] = (u16)(cvt_pk_bf16(z, 0.f) & 0xffffu); }
        else { ((u16*)(a.ws + WS_PLM))[r * 512 + (col - 4096)] = (u16)(cvt_pk_bf16(z, 0.f) & 0xffffu); }
    }
    __syncthreads();
}

__device__ __forceinline__ void late_weights(const Args& a, LAS unsigned char* lds, int gw, int NGW) {
    const int lane = threadIdx.x & 63, wave = __builtin_amdgcn_readfirstlane(threadIdx.x >> 6);
    LAS float* scr = (LAS float*)(lds + wave * 16384);
    constexpr int I_A = 16 * 32, I_B = 8 * 32, I_O = 16 * 32, I_D = 44 * 32, I_P = 32;
    constexpr int NIT = I_A + I_B + I_O + I_D + I_P;
    for (int it = gw; it < NIT; it += NGW) {
        int r = it;
        if (r < I_A) { tr_item(a.w_a, 1024, 64 * (r / 32), 32 * (r % 32), (u16*)(a.ws + WS_WAB), 32 * (r % 32), 1536, 0, nullptr, scr, lane); continue; } r -= I_A;
        if (r < I_B) { tr_item(a.w_b, 1024, 64 * (r / 32), 32 * (r % 32), (u16*)(a.ws + WS_WAB), 32 * (r % 32), 1536, 1024, nullptr, scr, lane); continue; } r -= I_B;
        if (r < I_O) { tr_item(a.w_out, 1024, 64 * (r / 32), 32 * (r % 32), (u16*)(a.ws + WS_WOUT), 32 * (r % 32), 1024, 0, nullptr, scr, lane); continue; } r -= I_O;
        if (r < I_D) { tr_item(a.w_down, 1024, 64 * (r / 32), 32 * (r % 32), (u16*)(a.ws + WS_WD), 32 * (r % 32), DFF, 0, nullptr, scr, lane); continue; } r -= I_D;
        { const int gi = r >> 3, q = r & 7; tr_item(a.pool_w + (size_t)gi * 16384, 128, 64 * (q >> 2), 32 * (q & 3), (u16*)(a.ws + WS_PWT) + (size_t)gi * 16384, 32 * (q & 3), 128, 0, nullptr, scr, lane); }
    }
}

__device__ __forceinline__ void p0_prologue(const Args& a, LAS unsigned char* lds, int G, int skip = 0) {
    const int tid = threadIdx.x, lane = tid & 63, wave = __builtin_amdgcn_readfirstlane(tid >> 6);
    const bool split = G > 160;
    if ((int)blockIdx.x < 80) { if (!(skip & 4)) p0_meta(a, lds, (int)blockIdx.x, tid, wave, lane); if (split) return; }
    if (blockIdx.x == 80 || (G <= 80 && blockIdx.x == 0)) { for (int c = tid; c < 1024; c += NTHR) ((float*)(a.ws + WS_LB))[c] = 1.0f / (1.0f + __expf(a.lb_raw[1024 + c] - a.lb_raw[c])); }
    LAS float* scr = (LAS float*)(lds + wave * 16384);
    const int gw = ((int)blockIdx.x - (split ? 80 : 0)) * NWAVES + wave, NGW = (G - (split ? 80 : 0)) * NWAVES;
    constexpr int I_IN = 16 * 208;
    for (int it = gw; it < I_IN && !(skip & 1); it += NGW) tr_item(a.w_in, INW, 64 * (it / 208), 32 * (it % 208), (u16*)(a.ws + WS_WIN), 32 * (it % 208), 1024, 0, nullptr, scr, lane);
    if (G != 256) late_weights(a, lds, gw, NGW);
    u16* XN = (u16*)a.out;
    {
        const f32x4* gr = (const f32x4*)a.g_mix + lane; f32x4 gv[4];
#pragma unroll
        for (int j = 0; j < 4; ++j) gv[j] = gr[64 * j];
        for (int m = 4 * gw; m < M && !(skip & 2); m += 4 * NGW) {
            const f32x4* xr = (const f32x4*)(a.x + (size_t)m * DM) + lane; f32x4 v[16]; float ss[4];
#pragma unroll
            for (int j = 0; j < 16; ++j) v[j] = __builtin_nontemporal_load(&xr[64 * j]);
#pragma unroll
            for (int rr = 0; rr < 4; ++rr) { float t = 0.f;
#pragma unroll
                for (int j = 0; j < 4; ++j) { const f32x4 w = v[4 * rr + j]; t += (w.x * w.x + w.y * w.y) + (w.z * w.z + w.w * w.w); }
                ss[rr] = t; }
#pragma unroll
            for (int o = 1; o < 64; o <<= 1) {
#pragma unroll
                for (int rr = 0; rr < 4; ++rr) ss[rr] += __shfl_xor(ss[rr], o); }
            u32x2* o8 = (u32x2*)(XN + (size_t)m * DM) + lane;
#pragma unroll
            for (int j = 0; j < 16; ++j) { const float rs = rsqrtf(ss[j >> 2] * (1.f / DM) + EPS); const f32x4 g4 = gv[j & 3]; u32x2 o; o.x = cvt_pk_bf16(v[j].x * rs * g4.x, v[j].y * rs * g4.y); o.y = cvt_pk_bf16(v[j].z * rs * g4.z, v[j].w * rs * g4.w); o8[64 * j] = o; }
        }
    }
}

struct EpiIn {
    static constexpr bool PERM = true, MID = false, AFTER = false;
    unsigned char* ws;
    __device__ __forceinline__ void mid(f32x4 (&)[2][2][4][2], const pg8::Unit&, int, int, int, int) const {}
    __device__ __forceinline__ void operator()(f32x4 (&acc)[2][2][4][2], const pg8::Unit& u, int wr, int wc, int fr, int fq) const {
        const int colt = u.pn * 256; int type, c0; size_t boff;
        if (colt < 1024) { type = 1; boff = WS_Q; c0 = colt; }
        else if (colt < 2048) { type = 3; boff = WS_G; c0 = colt - 1024; }
        else if (colt < 3072) { type = 0; boff = WS_V; c0 = colt - 2048; }
        else if (colt < 4096) { type = 1; boff = WS_OG; c0 = colt - 3072; }
        else if (colt < 4608) { type = 0; boff = WS_PB; c0 = colt - 4096 + 512; }
        else if (colt < 5632) { type = 2; boff = WS_GA; c0 = colt - 4608; }
        else { type = 2; boff = WS_GB; c0 = colt - 5632; }
        u16* base = (u16*)(ws + boff);
        const int col0 = c0 + wc * 32 + 8 * fq, row0 = u.pm * 256 + wr * 64 + fr;
        const float* LB = (const float*)(ws + WS_LB);
        f32x4 lbv[2][2];
        if (type == 3) {
#pragma unroll
            for (int bj = 0; bj < 2; ++bj) { lbv[bj][0] = *(const f32x4*)(LB + col0 + bj * 128); lbv[bj][1] = *(const f32x4*)(LB + col0 + bj * 128 + 4); }
        } else {
#pragma unroll
            for (int bj = 0; bj < 2; ++bj) { lbv[bj][0] = (f32x4){0.f, 0.f, 0.f, 0.f}; lbv[bj][1] = (f32x4){0.f, 0.f, 0.f, 0.f}; }
        }
#pragma unroll
        for (int ai = 0; ai < 2; ++ai)
#pragma unroll
            for (int m = 0; m < 4; ++m) { u16* rowp = base + (size_t)(row0 + ai * 128 + m * 16) * 1024 + col0;
#pragma unroll
                for (int bj = 0; bj < 2; ++bj) { f32x4 v0 = acc[ai][bj][m][0], v1 = acc[ai][bj][m][1]; u32x4 w;
                    if (type == 3) {
                        const f32x4 l0 = lbv[bj][0], l1 = lbv[bj][1];
#pragma unroll
                        for (int e = 0; e < 4; ++e) { v0[e] = __logf(l0[e] + (1.0f - l0[e]) * sigm(v0[e])); v1[e] = __logf(l1[e] + (1.0f - l1[e]) * sigm(v1[e])); }
                        w.x = pk_h(v0[0], v0[1]); w.y = pk_h(v0[2], v0[3]); w.z = pk_h(v1[0], v1[1]); w.w = pk_h(v1[2], v1[3]);
                    } else {
                        if (type == 1) {
#pragma unroll
                            for (int e = 0; e < 4; ++e) { v0[e] = v0[e] * sigm(v0[e]); v1[e] = v1[e] * sigm(v1[e]); }
                        } else if (type == 2) {
#pragma unroll
                            for (int e = 0; e < 4; ++e) { v0[e] = sigm(v0[e]); v1[e] = sigm(v1[e]); }
                        }
                        w.x = cvt_pk_bf16(v0[0], v0[1]); w.y = cvt_pk_bf16(v0[2], v0[3]); w.z = cvt_pk_bf16(v1[0], v1[1]); w.w = cvt_pk_bf16(v1[2], v1[3]);
                    }
                    __builtin_nontemporal_store(w, (u32x4*)(rowp + bj * 128)); } }
    }
};
struct EpiMerge {
    static constexpr bool PERM = true, MID = true, AFTER = false;
    const u16 *GA, *GB; u16* MG;
    __device__ __forceinline__ void mid(f32x4 (&acc)[2][2][4][2], const pg8::Unit& u, int wr, int wc, int fr, int fq) const {
        int zz = 0; asm volatile("" : "+v"(zz));
        const int col0 = u.pn * 256 + wc * 32 + 8 * fq, row0 = u.pm * 256 + wr * 64 + fr + zz;
#pragma unroll
        for (int ai = 0; ai < 2; ++ai)
#pragma unroll
            for (int m = 0; m < 4; ++m) { const size_t off = (size_t)(row0 + ai * 128 + m * 16) * 1024 + col0;
#pragma unroll
                for (int bj = 0; bj < 2; ++bj) { const u32x4 ga = __builtin_nontemporal_load((const u32x4*)(GA + off + bj * 128)), gb = *(const u32x4*)(GB + off + bj * 128);
#pragma unroll
                    for (int e = 0; e < 2; ++e) { acc[ai][bj][m][0][2 * e] *= bf_lo(ga[e]) * __builtin_amdgcn_rcpf(bf_lo(gb[e])); acc[ai][bj][m][0][2 * e + 1] *= bf_hi(ga[e]) * __builtin_amdgcn_rcpf(bf_hi(gb[e]));
                        acc[ai][bj][m][1][2 * e] *= bf_lo(ga[2 + e]) * __builtin_amdgcn_rcpf(bf_lo(gb[2 + e])); acc[ai][bj][m][1][2 * e + 1] *= bf_hi(ga[2 + e]) * __builtin_amdgcn_rcpf(bf_hi(gb[2 + e])); } }
                asm volatile("" ::: "memory"); }
    }
    __device__ __forceinline__ void operator()(f32x4 (&acc)[2][2][4][2], const pg8::Unit& u, int wr, int wc, int fr, int fq) const {
        const int col0 = u.pn * 256 + wc * 32 + 8 * fq, row0 = u.pm * 256 + wr * 64 + fr;
#pragma unroll
        for (int ai = 0; ai < 2; ++ai)
#pragma unroll
            for (int m = 0; m < 4; ++m) { const size_t off = (size_t)(row0 + ai * 128 + m * 16) * 1024 + col0;
#pragma unroll
                for (int bj = 0; bj < 2; ++bj) { const u32x4 gb = *(const u32x4*)(GB + off + bj * 128);
                    acc[ai][bj][m][0] *= (f32x4){bf_lo(gb[0]), bf_hi(gb[0]), bf_lo(gb[1]), bf_hi(gb[1])}; acc[ai][bj][m][1] *= (f32x4){bf_lo(gb[2]), bf_hi(gb[2]), bf_lo(gb[3]), bf_hi(gb[3])}; } }
#pragma unroll
        for (int ai = 0; ai < 2; ++ai)
#pragma unroll
            for (int m = 0; m < 4; ++m) { const size_t off = (size_t)(row0 + ai * 128 + m * 16) * 1024 + col0;
#pragma unroll
                for (int bj = 0; bj < 2; ++bj) { const f32x4 v0 = acc[ai][bj][m][0], v1 = acc[ai][bj][m][1]; u32x4 w;
                    w.x = cvt_pk_bf16(v0[0], v0[1]); w.y = cvt_pk_bf16(v0[2], v0[3]); w.z = cvt_pk_bf16(v1[0], v1[1]); w.w = cvt_pk_bf16(v1[2], v1[3]);
                    *(u32x4*)(MG + off + bj * 128) = w; } }
    }
};
template <bool WITH_BF16>
struct EpiRes {
    static constexpr bool PERM = false, MID = false, AFTER = false;
    const float* base; float* H; u16* Hb; float* rsq;
    __device__ __forceinline__ void mid(f32x4 (&)[2][2][4][2], const pg8::Unit&, int, int, int, int) const {}
    __device__ __forceinline__ void operator()(f32x4 (&acc)[2][2][4][2], const pg8::Unit& u, int wr, int wc, int fr, int fq) const {
        const int col0 = u.pn * 256 + wc * 32 + 4 * fq, row0 = u.pm * 256 + wr * 64 + fr;
#pragma unroll
        for (int ai = 0; ai < 2; ++ai) {
            f32x4 pre[4][2][2];
#pragma unroll
            for (int m = 0; m < 4; ++m) { const size_t off = (size_t)(row0 + ai * 128 + m * 16) * 1024 + col0;
#pragma unroll
                for (int bj = 0; bj < 2; ++bj)
#pragma unroll
                    for (int n = 0; n < 2; ++n) pre[m][bj][n] = __builtin_nontemporal_load((const f32x4*)(base + off + bj * 128 + n * 16)); }
            asm volatile("" ::: "memory");
#pragma unroll
            for (int m = 0; m < 4; ++m) { const int row = row0 + ai * 128 + m * 16; const size_t off = (size_t)row * 1024 + col0; float s = 0.f;
#pragma unroll
                for (int bj = 0; bj < 2; ++bj)
#pragma unroll
                    for (int n = 0; n < 2; ++n) { const f32x4 hv = pre[m][bj][n] + acc[ai][bj][m][n];
                        if (H) *(f32x4*)(H + off + bj * 128 + n * 16) = hv;
                        s += (hv[0] * hv[0] + hv[1] * hv[1]) + (hv[2] * hv[2] + hv[3] * hv[3]);
                        if (WITH_BF16) { u32x2 w; w.x = cvt_pk_bf16(hv[0], hv[1]); w.y = cvt_pk_bf16(hv[2], hv[3]); *(u32x2*)(Hb + off + bj * 128 + n * 16) = w; } }
                s += __shfl_xor(s, 16); s += __shfl_xor(s, 32);
                if (fq == 0) rsq[(size_t)row * 16 + u.pn * 4 + wc] = s; }
            asm volatile("" ::: "memory");
        }
    }
};
struct EpiFfn1 {
    static constexpr bool PERM = true, MID = false, AFTER = false;
    const float* rsq; u16* ACT;
    __device__ __forceinline__ void mid(f32x4 (&)[2][2][4][2], const pg8::Unit&, int, int, int, int) const {}
    __device__ __forceinline__ void operator()(const f32x4 (&acc)[2][2][4][2], const pg8::Unit& u, int wr, int wc, int fr, int fq) const {
        const int col0 = u.pn * 128 + wc * 32 + 8 * fq, row0 = u.pm * 256 + wr * 64 + fr;
        float rstdv[2][4];
#pragma unroll
        for (int ai = 0; ai < 2; ++ai)
#pragma unroll
            for (int m = 0; m < 4; ++m) { const int row = row0 + ai * 128 + m * 16; const f32x4* rp = (const f32x4*)(rsq + (size_t)row * 16);
                const f32x4 r0 = rp[0], r1 = rp[1], r2 = rp[2], r3 = rp[3];
                const float ss = ((r0[0] + r0[1]) + (r0[2] + r0[3])) + ((r1[0] + r1[1]) + (r1[2] + r1[3])) + ((r2[0] + r2[1]) + (r2[2] + r2[3])) + ((r3[0] + r3[1]) + (r3[2] + r3[3]));
                rstdv[ai][m] = rsqrtf(ss * (1.f / DM) + EPS); }
#pragma unroll
        for (int ai = 0; ai < 2; ++ai)
#pragma unroll
            for (int m = 0; m < 4; ++m) { const int row = row0 + ai * 128 + m * 16;
                const float rstd = rstdv[ai][m];
                float o[8];
#pragma unroll
                for (int n = 0; n < 2; ++n)
#pragma unroll
                    for (int e = 0; e < 4; ++e) { const float gt = acc[ai][0][m][n][e] * rstd, up = acc[ai][1][m][n][e] * rstd; o[4 * n + e] = gt * sigm(gt) * up; }
                u32x4 w; w.x = cvt_pk_bf16(o[0], o[1]); w.y = cvt_pk_bf16(o[2], o[3]); w.z = cvt_pk_bf16(o[4], o[5]); w.w = cvt_pk_bf16(o[6], o[7]);
                __builtin_nontemporal_store(w, (u32x4*)(ACT + (size_t)row * DFF + col0)); }
    }
};

struct EpiResNorm {
    static constexpr bool PERM = false, MID = false, AFTER = true;
    const u16* base; float* out; const float* gfin; float* slots; unsigned* cnt;
    __device__ __forceinline__ void mid(f32x4 (&)[2][2][4][2], const pg8::Unit&, int, int, int, int) const {}
    __device__ __forceinline__ void operator()(const f32x4 (&)[2][2][4][2], const pg8::Unit&, int, int, int, int) const {}
    __device__ __forceinline__ void after(f32x4 (&acc)[2][2][4][2], const pg8::Unit& u, int wr, int wc, int fr, int fq, LAS unsigned char* lds, int wid, int lane) const {
        LAS float* P = (LAS float*)lds; LAS float* R = (LAS float*)(lds + 4096);
        const int col0 = u.pn * 256 + wc * 32 + 4 * fq;
#pragma unroll
        for (int ai = 0; ai < 2; ++ai)
#pragma unroll
            for (int m = 0; m < 4; ++m) { const int rl = ai * 128 + wr * 64 + m * 16 + fr; const size_t off = (size_t)(u.pm * 256 + rl) * 1024 + col0; float s = 0.f;
#pragma unroll
                for (int bj = 0; bj < 2; ++bj)
#pragma unroll
                    for (int n = 0; n < 2; ++n) { const u32x2 hb = __builtin_nontemporal_load((const u32x2*)(base + off + bj * 128 + n * 16));
                        const f32x4 hv = (f32x4){bf_lo(hb.x), bf_hi(hb.x), bf_lo(hb.y), bf_hi(hb.y)} + acc[ai][bj][m][n]; acc[ai][bj][m][n] = hv; s += (hv[0] * hv[0] + hv[1] * hv[1]) + (hv[2] * hv[2] + hv[3] * hv[3]); }
                s += __shfl_xor(s, 16); s += __shfl_xor(s, 32);
                if (fq == 0) P[rl * 4 + wc] = s;
                if (m & 1) asm volatile("" ::: "memory"); }
        asm volatile("s_waitcnt lgkmcnt(0)" ::: "memory"); __builtin_amdgcn_s_barrier(); asm volatile("" ::: "memory");
        const int row = wid * 32 + (lane & 31);
        unsigned* slot = (unsigned*)slots + (size_t)(u.pm * 256 + row) * 16;
        if (lane < 32) { const float t = (P[row * 4 + 0] + P[row * 4 + 1]) + (P[row * 4 + 2] + P[row * 4 + 3]);
            __hip_atomic_store(slot + u.pn, __float_as_uint(t), __ATOMIC_RELAXED, __HIP_MEMORY_SCOPE_AGENT); }
        asm volatile("s_waitcnt vmcnt(0)" ::: "memory");
        if (lane == 0) __hip_atomic_fetch_add(cnt + 64 * u.pm, 1u, __ATOMIC_RELAXED, __HIP_MEMORY_SCOPE_AGENT);
        if (wid == 0) { unsigned sp = 0;
            while ((unsigned)__builtin_amdgcn_readfirstlane(__hip_atomic_load(cnt + 64 * u.pm, __ATOMIC_RELAXED, __HIP_MEMORY_SCOPE_AGENT)) < 32u) { __builtin_amdgcn_s_sleep(2); if (++sp > (1u << 20)) break; }
            __builtin_amdgcn_fence(__ATOMIC_ACQUIRE, "agent"); }
        asm volatile("s_waitcnt vmcnt(0) lgkmcnt(0)" ::: "memory"); __builtin_amdgcn_s_barrier(); asm volatile("" ::: "memory");
        if (lane < 32) { float t = 0.f;
#pragma unroll
            for (int k = 0; k < 4; ++k) t += __uint_as_float(__hip_atomic_load(slot + k, __ATOMIC_RELAXED, __HIP_MEMORY_SCOPE_AGENT));
            R[row] = rsqrtf(t * (1.f / DM) + EPS); }
        asm volatile("s_waitcnt lgkmcnt(0)" ::: "memory"); __builtin_amdgcn_s_barrier(); asm volatile("" ::: "memory");
        f32x4 gv[2][2];
#pragma unroll
        for (int bj = 0; bj < 2; ++bj)
#pragma unroll
            for (int n = 0; n < 2; ++n) gv[bj][n] = *(const f32x4*)(gfin + col0 + bj * 128 + n * 16);
#pragma unroll
        for (int ai = 0; ai < 2; ++ai)
#pragma unroll
            for (int m = 0; m < 4; ++m) { const int rl = ai * 128 + wr * 64 + m * 16 + fr; const size_t off = (size_t)(u.pm * 256 + rl) * 1024 + col0; const float rs = R[rl];
#pragma unroll
                for (int bj = 0; bj < 2; ++bj)
#pragma unroll
                    for (int n = 0; n < 2; ++n) *(f32x4*)(out + off + bj * 128 + n * 16) = acc[ai][bj][m][n] * rs * gv[bj][n]; }
    }
};
#define RLX_AGENT __ATOMIC_RELAXED, __HIP_MEMORY_SCOPE_AGENT
#define XB_TMO      128
#define XB_XCNT(j)  (256  + 64 * (j))
#define XB_XSUB(j)  (1280 + 64 * (j))
#define XB_XGEN(j)  (2304 + 64 * (j))
#define XB_TOP      3328
#define XB_TOPGEN   3392
#define XCD_BAR_WORDS 3456
#define XB_SPIN_CAP (1u << 18)

__device__ __forceinline__ unsigned xb_ld(unsigned* p)              { return __hip_atomic_load(p, __ATOMIC_RELAXED, __HIP_MEMORY_SCOPE_AGENT); }
__device__ __forceinline__ unsigned xb_add(unsigned* p, unsigned v) { return __hip_atomic_fetch_add(p, v, __ATOMIC_RELAXED, __HIP_MEMORY_SCOPE_AGENT); }
__device__ __forceinline__ unsigned xb_xcc_id() { return (unsigned)__builtin_amdgcn_s_getreg((3 << 11) | 20) & 0xFu; }
#define XB_SPIN(cond, bar) do { unsigned _sp = 0; while (cond) { __builtin_amdgcn_s_sleep(1); \
    if ((++_sp & 255u) == 0u) { if (xb_ld(&(bar)[XB_TMO])) break; if (_sp > XB_SPIN_CAP) { atomicAdd(&(bar)[XB_TMO], 1u); break; } } } } while (0)

struct XcdBarrier {
    unsigned* bar; unsigned x;
    volatile LAS unsigned* st;
};

__device__ __forceinline__ XcdBarrier xcd_barrier_post(unsigned* bar, volatile LAS unsigned* st) {
    XcdBarrier b; b.bar = bar; b.x = xb_xcc_id(); b.st = st;
    if (threadIdx.x == 0) (void)xb_add(&bar[XB_XCNT(b.x)], 1u);
    return b;
}
__device__ __forceinline__ void xcd_barrier_complete(unsigned* bar, unsigned x, unsigned& nloc, unsigned& nx) {
    const unsigned G = gridDim.x * gridDim.y * gridDim.z;
    unsigned sum, cnt, mine, sp = 0u;
    for (;;) {
        sum = 0u; cnt = 0u; mine = 0u;
#pragma unroll
        for (unsigned j = 0; j < 16; ++j) { const unsigned c = xb_ld(&bar[XB_XCNT(j)]); sum += c; cnt += (c > 0u) ? 1u : 0u; mine = (j == x) ? c : mine; }
        if (sum == G) break;
        __builtin_amdgcn_s_sleep(1);
        if ((++sp & 255u) == 0u) { if (xb_ld(&bar[XB_TMO])) break; if (sp > XB_SPIN_CAP) { atomicAdd(&bar[XB_TMO], 1u); break; } }
    }
    nloc = mine > 0u ? mine : 1u; nx = cnt > 0u ? cnt : 1u;
}

__device__ __forceinline__ void xcd_barrier(const XcdBarrier& b) {
    asm volatile("s_waitcnt vmcnt(0)" ::: "memory");
    __syncthreads();
    if (threadIdx.x == 0) {
        unsigned* bar = b.bar;
        __builtin_amdgcn_s_waitcnt(0);
        unsigned nloc = b.st[0], nx = b.st[1];
        if (nloc == 0u) { xcd_barrier_complete(bar, b.x, nloc, nx); b.st[0] = nloc; b.st[1] = nx; }
        const unsigned old = xb_add(&bar[XB_XSUB(b.x)], 1u);
        const unsigned gen = old / nloc;
        if (old + 1u == (gen + 1u) * nloc) {
            __builtin_amdgcn_fence(__ATOMIC_RELEASE, "agent");
            asm volatile("s_waitcnt vmcnt(0)" ::: "memory");
            const unsigned og = xb_add(&bar[XB_TOP], 1u);
            const unsigned tg = og / nx;
            if (og + 1u == (tg + 1u) * nx) xb_add(&bar[XB_TOPGEN], 1u);
            else XB_SPIN(xb_ld(&bar[XB_TOPGEN]) == tg, bar);
            __builtin_amdgcn_fence(__ATOMIC_ACQUIRE, "agent");
            xb_add(&bar[XB_XGEN(b.x)], 1u);
            asm volatile("s_waitcnt vmcnt(0)" ::: "memory");
        } else {
            XB_SPIN(xb_ld(&bar[XB_XGEN(b.x)]) == gen, bar);
            __builtin_amdgcn_fence(__ATOMIC_ACQUIRE, "agent");
            asm volatile("s_waitcnt vmcnt(0)" ::: "memory");
        }
    }
    __syncthreads();
}

__device__ __forceinline__ void p2_wave(const u16* Gp, const u16* Vp, int nrows, int h, u16* Uout, float* dk, int lane) {
    const int r = lane & 15, q = lane >> 4;
    bf16x8 kf[8][2]; float tot1[8];
#pragma unroll
    for (int kk = 0; kk < 2; ++kk) { const int ks = 1 - kk;
#pragma unroll
        for (int dg = 0; dg < 2; ++dg) {
            int zz = 0; asm volatile("" : "+v"(zz));
            u32x4 wq[4];
#pragma unroll
            for (int p2 = 0; p2 < 2; ++p2) { const int dp = 2 * dg + p2; const int dcol = 32 * dp + 2 * r + zz; unsigned gw[8];
#pragma unroll
                for (int j = 0; j < 8; ++j) { const int s = 32 * ks + 8 * q + j; gw[j] = s < nrows ? *(const unsigned*)(Gp + (size_t)s * 1024 + h * 128 + dcol) : 0u; }
#pragma unroll
                for (int par = 0; par < 2; ++par) { const int dt = 2 * dp + par; float gv[8];
#pragma unroll
                    for (int j = 0; j < 8; ++j) gv[j] = h2f((u16)(par ? (gw[j] >> 16) : (gw[j] & 0xffffu)));
                    float suf[8]; float run = 0.f;
#pragma unroll
                    for (int j = 7; j >= 0; --j) { suf[j] = run; run += gv[j]; }
                    const float T = run, ta = __shfl_xor(T, 16), tb = __shfl_xor(T, 32), tc = __shfl_xor(ta, 32);
                    const float after = ((q ^ 1) > q ? ta : 0.f) + ((q ^ 2) > q ? tb : 0.f) + ((q ^ 3) > q ? tc : 0.f);
                    const float tot = (T + ta) + (tb + tc);
                    float base;
                    if (ks == 1) { tot1[dt] = tot; base = after; } else { base = after + tot1[dt]; if (dk && q == 0) dk[h * 128 + dcol + par] = __expf(tot + tot1[dt]); }
                    float kh[8];
#pragma unroll
                    for (int j = 0; j < 8; ++j) kh[j] = (1.0f - __expf(gv[j])) * __expf(suf[j] + base);
                    u32x4& w = wq[2 * p2 + par];
                    w.x = cvt_pk_bf16(kh[0], kh[1]); w.y = cvt_pk_bf16(kh[2], kh[3]); w.z = cvt_pk_bf16(kh[4], kh[5]); w.w = cvt_pk_bf16(kh[6], kh[7]); } }
            asm volatile("" : "+v"(wq[0].x), "+v"(wq[0].y), "+v"(wq[0].z), "+v"(wq[0].w), "+v"(wq[1].x), "+v"(wq[1].y), "+v"(wq[1].z), "+v"(wq[1].w),
                              "+v"(wq[2].x), "+v"(wq[2].y), "+v"(wq[2].z), "+v"(wq[2].w), "+v"(wq[3].x), "+v"(wq[3].y), "+v"(wq[3].z), "+v"(wq[3].w));
#pragma unroll
            for (int d4 = 0; d4 < 4; ++d4) kf[4 * dg + d4][ks] = __builtin_bit_cast(bf16x8, wq[d4]); } }
#pragma unroll 1
    for (int ep = 0; ep < 4; ++ep) {
        int zz = 0; asm volatile("" : "+v"(zz)); const int ecol = 32 * ep + 2 * r + zz;
        unsigned vw[2][8];
#pragma unroll
        for (int ks = 0; ks < 2; ++ks)
#pragma unroll
            for (int j = 0; j < 8; ++j) { const int s = 32 * ks + 8 * q + j; vw[ks][j] = s < nrows ? *(const unsigned*)(Vp + (size_t)s * 1024 + h * 128 + ecol) : 0u; }
#pragma unroll
        for (int par = 0; par < 2; ++par) {
            bf16x8 vf[2];
#pragma unroll
            for (int ks = 0; ks < 2; ++ks) { u32x4 w;
                if (par == 0) { w.x = (vw[ks][0] & 0xffffu) | (vw[ks][1] << 16); w.y = (vw[ks][2] & 0xffffu) | (vw[ks][3] << 16); w.z = (vw[ks][4] & 0xffffu) | (vw[ks][5] << 16); w.w = (vw[ks][6] & 0xffffu) | (vw[ks][7] << 16); }
                else { w.x = (vw[ks][0] >> 16) | (vw[ks][1] & 0xffff0000u); w.y = (vw[ks][2] >> 16) | (vw[ks][3] & 0xffff0000u); w.z = (vw[ks][4] >> 16) | (vw[ks][5] & 0xffff0000u); w.w = (vw[ks][6] >> 16) | (vw[ks][7] & 0xffff0000u); }
                vf[ks] = __builtin_bit_cast(bf16x8, w); }
            f32x4 acc[8];
#pragma unroll
            for (int dt = 0; dt < 8; ++dt) { acc[dt] = (f32x4){0.f, 0.f, 0.f, 0.f};
#pragma unroll
                for (int ks = 0; ks < 2; ++ks) acc[dt] = __builtin_amdgcn_mfma_f32_16x16x32_bf16(kf[dt][ks], vf[ks], acc[dt], 0, 0, 0); }
#pragma unroll
            for (int dp = 0; dp < 4; ++dp) { u32x4 w; w.x = cvt_pk_bf16(acc[2 * dp][0], acc[2 * dp + 1][0]); w.y = cvt_pk_bf16(acc[2 * dp][1], acc[2 * dp + 1][1]); w.z = cvt_pk_bf16(acc[2 * dp][2], acc[2 * dp + 1][2]); w.w = cvt_pk_bf16(acc[2 * dp][3], acc[2 * dp + 1][3]);
                { const int e = 32 * ep + 2 * r + par;
                  *(u32x4*)(Uout + ((size_t)((e >> 4) * 4 + dp) * 64 + q * 16 + (e & 15)) * 8) = w; } } }
    }
}
__device__ __forceinline__ void p2_states(const Args& a, int G) {
    const int tid = threadIdx.x, lane = tid & 63, wave = __builtin_amdgcn_readfirstlane(tid >> 6);
    const u16* Gb = (const u16*)(a.ws + WS_G); const u16* Vb = (const u16*)(a.ws + WS_V); u16* US = (u16*)a.out; float* DK = (float*)(a.ws + WS_DK);
    for (int it = blockIdx.x; it < BATCH * NCH + (G == 256 ? 0 : 1); it += G) {
        if (it < BATCH * NCH) { const size_t row0 = (size_t)it * CHK;
            p2_wave(Gb + row0 * 1024, Vb + row0 * 1024, CHK, wave, US + ((size_t)it * 8 + wave) * 16384, DK + (size_t)it * 1024, lane); }
        else p2_wave((const u16*)(a.ws + WS_GM), (const u16*)(a.ws + WS_VM), NMETA, wave, (u16*)(a.ws + WS_UM) + (size_t)wave * 16384, nullptr, lane);
    }
}

__device__ __forceinline__ void p3_scan(const Args& a, LAS unsigned char* lds, int G) {
    const int tid = threadIdx.x, lane = tid & 63, wave = __builtin_amdgcn_readfirstlane(tid >> 6);
    {
        LAS float* scr = (LAS float*)(lds + wave * 16384);
        const int gw = (int)blockIdx.x * NWAVES + wave, NGW = G * NWAVES;
        for (int it = gw; it < 2 * 16 * 88; it += NGW) { const int up = it >= 16 * 88, r = up ? it - 16 * 88 : it, kb = r / 88, nb = r % 88, n0 = 32 * nb;
            tr_item(up ? a.w_up : a.w_gate, DFF, 64 * kb, n0, (u16*)(a.ws + WS_WGU), (n0 >> 7) * 256 + (n0 & 127) + (up ? 128 : 0), 1024, 0, a.g_ffn, scr, lane); }
    }
    u16* US = (u16*)a.out; const float* DK = (const float*)(a.ws + WS_DK); const u16* UM = (const u16*)(a.ws + WS_UM);
    for (int idx = blockIdx.x * NTHR + tid; idx < BATCH * 8 * 128 * 64; idx += G * NTHR) {
        const int pr = idx & 8191, h = (idx >> 13) & 7, b = idx >> 16;
        const int d = 32 * ((pr >> 8) & 3) + 8 * ((pr >> 6) & 3) + 2 * (pr & 3);
        const unsigned um = *(const unsigned*)(UM + (size_t)h * 16384 + 2 * pr);
        float s0 = bf_lo(um), s1 = bf_hi(um);
        unsigned* up = (unsigned*)(US + ((size_t)(b * NCH) * 8 + h) * 16384 + 2 * pr);
        const float* dkp = DK + (size_t)(b * NCH) * 1024 + h * 128 + d;
#pragma unroll 1
        for (int c0 = 0; c0 < NCH; c0 += 16) {
            unsigned uu[16]; float dd0[16], dd1[16];
#pragma unroll
            for (int i = 0; i < 16; ++i) { uu[i] = up[(size_t)(c0 + i) * 8 * 8192]; const f32v2_t dk2 = *(const f32v2_t*)(dkp + (size_t)(c0 + i) * 1024); dd0[i] = dk2[0]; dd1[i] = dk2[1]; }
#pragma unroll
            for (int i = 0; i < 16; ++i) { up[(size_t)(c0 + i) * 8 * 8192] = cvt_pk_bf16(s0, s1); s0 = dd0[i] * s0 + bf_lo(uu[i]); s1 = dd1[i] * s1 + bf_hi(uu[i]); }
        }
    }
}

constexpr int P4_PITCH = 272, P4_MAT = 64 * P4_PITCH  , P4_VPITCH = 136, P4_HS = 4 * P4_MAT  , P4_TOT = 2 * P4_HS  , P4_PLD = P4_TOT + 4096  ;
static_assert(P4_PLD + P4_MAT + 64 <= LDS_BYTES, "LDS map");
__device__ __forceinline__ unsigned ld_pl(const u16* PB, const u16* PLM, int b, int tx, int cofs) {
    return tx >= 0 ? *(const unsigned*)(PB + (size_t)(b * SEQ + tx) * 1024 + 512 + cofs) : *(const unsigned*)(PLM + (size_t)(NMETA + tx) * 512 + cofs);
}
__device__ __forceinline__ void p4_outputs(const Args& a, LAS unsigned char* lds, int G, int skip = 0) {
    (void)skip;
    const int tid = threadIdx.x, lane = tid & 63, wave = __builtin_amdgcn_readfirstlane(tid >> 6);
    const int r = lane & 15, q = lane >> 4;
    u16* Qb = (u16*)(a.ws + WS_Q); const u16* Gb = (const u16*)(a.ws + WS_G); const u16* Vb = (const u16*)(a.ws + WS_V); const u16* OGb = (const u16*)(a.ws + WS_OG);
    u16* PB = (u16*)(a.ws + WS_PB); const u16* PLM = (const u16*)(a.ws + WS_PLM); const u16* PWT = (const u16*)(a.ws + WS_PWT); const u16* US = (const u16*)a.out;
    LAS unsigned char* PLD = lds + P4_PLD;
    for (int item = blockIdx.x; item < BATCH * NCH * 4; item += G) {
        const int hp = item & 3, bc = item >> 2, c = bc & (NCH - 1), b = bc >> 7;
        const size_t row0 = (size_t)b * SEQ + (size_t)c * CHK;
        const int hs = wave >> 2, tq = wave & 3, h = 2 * hp + hs;
        LAS unsigned char* L = lds + hs * P4_HS;
        LAS unsigned char* KT = L, *QT = L + P4_MAT, *QH = L + 2 * P4_MAT, *VT = L + 3 * P4_MAT;
        LAS float* TOT = (LAS float*)(lds + P4_TOT) + hs * 512;
        const int d0 = 2 * lane; const size_t cofs = (size_t)h * 128 + d0;
        unsigned gp[16], qv[16], vv[16];
#pragma unroll
        for (int i = 0; i < 16; ++i) { const size_t o = (row0 + 16 * tq + i) * 1024 + cofs; gp[i] = __builtin_nontemporal_load((const unsigned*)(Gb + o)); qv[i] = __builtin_nontemporal_load((const unsigned*)(Qb + o)); vv[i] = __builtin_nontemporal_load((const unsigned*)(Vb + o)); }
        const int gi = hp, wlen = 2 << gi; const float inv = 1.0f / (float)wlen;
        const int t0 = 8 * wave, pcofs = gi * 128 + 2 * lane, tx0 = c * CHK + t0;
        unsigned pu[23];
#pragma unroll
        for (int j = 1; j < 16; ++j) pu[15 - j] = (j < wlen) ? ld_pl(PB, PLM, b, tx0 - j, pcofs) : 0u;
#pragma unroll
        for (int i = 0; i < 8; ++i) pu[15 + i] = ld_pl(PB, PLM, b, tx0 + i, pcofs);
        bf16x8 wf[4];
#pragma unroll
        for (int kd = 0; kd < 4; ++kd) wf[kd] = *(const bf16x8*)(PWT + (size_t)(gi * 128 + 16 * wave + r) * 128 + 32 * kd + 8 * q);
        float s0 = 0.f, s1 = 0.f;
#pragma unroll
        for (int i = 0; i < 16; ++i) { s0 += h2f((u16)(gp[i] & 0xffffu)); s1 += h2f((u16)(gp[i] >> 16)); }
        TOT[tq * 128 + d0] = s0; TOT[tq * 128 + d0 + 1] = s1;
        __syncthreads();
        {
            float w0 = 0.f, w1 = 0.f;
#pragma unroll
            for (int j = 1; j < 16; ++j) if (j < wlen) { w0 += bf_lo(pu[15 - j]); w1 += bf_hi(pu[15 - j]); }
#pragma unroll
            for (int i = 0; i < 8; ++i) { const float u0 = bf_lo(pu[15 + i]), u1 = bf_hi(pu[15 + i]); w0 += u0; w1 += u1;
                *(LAS unsigned*)(PLD + (t0 + i) * P4_PITCH + 4 * lane) = cvt_pk_bf16(w0 * inv - u0, w1 * inv - u1);
                const unsigned o = wlen == 2 ? pu[15 + i - 1] : (wlen == 4 ? pu[15 + i - 3] : (wlen == 8 ? pu[15 + i - 7] : pu[15 + i - 15]));
                w0 -= bf_lo(o); w1 -= bf_hi(o); }
        }
        float b0 = 0.f, b1 = 0.f;
#pragma unroll
        for (int t2 = 0; t2 < 3; ++t2) if (t2 < tq) { b0 += TOT[t2 * 128 + d0]; b1 += TOT[t2 * 128 + d0 + 1]; }
        const float bm0 = TOT[d0] + TOT[128 + d0], bm1 = TOT[d0 + 1] + TOT[128 + d0 + 1];
#pragma unroll
        for (int i = 0; i < 16; ++i) { const int t = 16 * tq + i; const float g0 = h2f((u16)(gp[i] & 0xffffu)), g1 = h2f((u16)(gp[i] >> 16)); b0 += g0; b1 += g1;
            const unsigned q2 = qv[i], v2 = vv[i];
            const float q0 = bf_lo(q2), q1 = bf_hi(q2), k0 = 1.0f - __expf(g0), k1 = 1.0f - __expf(g1);
            const float eb0 = __expf(b0), eb1 = __expf(b1), em0 = __expf(fminf(b0 - bm0, 80.f)), em1 = __expf(fminf(b1 - bm1, 80.f)), ek0 = __expf(fminf(bm0 - b0, 80.f)), ek1 = __expf(fminf(bm1 - b1, 80.f));
            *(LAS unsigned*)(QT + t * P4_PITCH + d0 * 2) = cvt_pk_bf16(q0 * em0, q1 * em1);
            *(LAS unsigned*)(QH + t * P4_PITCH + d0 * 2) = cvt_pk_bf16(q0 * eb0, q1 * eb1);
            *(LAS unsigned*)(KT + t * P4_PITCH + d0 * 2) = cvt_pk_bf16(k0 * ek0, k1 * ek1);
            *(LAS u16*)(VT + d0 * P4_VPITCH + t * 2) = (u16)(v2 & 0xffffu); *(LAS u16*)(VT + (d0 + 1) * P4_VPITCH + t * 2) = (u16)(v2 >> 16); }
        const u16* Sp = US + ((size_t)bc * 8 + h) * 16384;
        bf16x8 sfr[8][4];
#pragma unroll
        for (int et = 0; et < 8; ++et)
#pragma unroll
            for (int kd = 0; kd < 4; ++kd) sfr[et][kd] = *(const bf16x8*)(Sp + ((size_t)(et * 4 + kd) * 64 + lane) * 8);
        const int tt = tq;
        const size_t orow = (row0 + 16 * tt + r) * 1024 + (size_t)h * 128;
        __syncthreads();
        u32x2 ogv[8];
#pragma unroll
        for (int et = 0; et < 8; ++et) ogv[et] = __builtin_nontemporal_load((const u32x2*)(OGb + orow + 16 * et + 4 * q));
        {
            f32x4 acc[4];
#pragma unroll
            for (int t4 = 0; t4 < 4; ++t4) acc[t4] = (f32x4){0.f, 0.f, 0.f, 0.f};
#pragma unroll
            for (int kd = 0; kd < 4; ++kd)
#pragma unroll
                for (int t4 = 0; t4 < 4; ++t4) { const bf16x8 pfr = *(const LAS bf16x8*)(PLD + (16 * t4 + r) * P4_PITCH + (32 * kd + 8 * q) * 2); acc[t4] = __builtin_amdgcn_mfma_f32_16x16x32_bf16(wf[kd], pfr, acc[t4], 0, 0, 0); }
            const int n0 = gi * 128 + 16 * wave + 4 * q; const f32x4 psc = *(const f32x4*)(a.pool_scale + n0);
#pragma unroll
            for (int t4 = 0; t4 < 4; ++t4) { u32x2 w; w.x = cvt_pk_bf16(acc[t4][0] * psc[0], acc[t4][1] * psc[1]); w.y = cvt_pk_bf16(acc[t4][2] * psc[2], acc[t4][3] * psc[3]);
                *(u32x2*)(PB + (row0 + 16 * t4 + r) * 1024 + n0) = w; }
        }
        bf16x8 qt[4], qh[4];
#pragma unroll
        for (int kd = 0; kd < 4; ++kd) { qt[kd] = *(const LAS bf16x8*)(QT + (16 * tt + r) * P4_PITCH + (32 * kd + 8 * q) * 2); qh[kd] = *(const LAS bf16x8*)(QH + (16 * tt + r) * P4_PITCH + (32 * kd + 8 * q) * 2); }
        f32x4 sc[4];
#pragma unroll
        for (int st = 0; st < 4; ++st) { f32x4 acc = (f32x4){0.f, 0.f, 0.f, 0.f};
            if (st <= tt) {
#pragma unroll
                for (int kd = 0; kd < 4; ++kd) { const bf16x8 kfr = *(const LAS bf16x8*)(KT + (16 * st + r) * P4_PITCH + (32 * kd + 8 * q) * 2); acc = __builtin_amdgcn_mfma_f32_16x16x32_bf16(kfr, qt[kd], acc, 0, 0, 0); }
                if (st == tt) {
#pragma unroll
                    for (int i = 0; i < 4; ++i) if (4 * q + i > r) acc[i] = 0.f; }
            }
            sc[st] = acc; }
        bf16x8 pf[2];
#pragma unroll
        for (int ks = 0; ks < 2; ++ks) { u32x4 w; w.x = cvt_pk_bf16(sc[2 * ks][0], sc[2 * ks][1]); w.y = cvt_pk_bf16(sc[2 * ks][2], sc[2 * ks][3]); w.z = cvt_pk_bf16(sc[2 * ks + 1][0], sc[2 * ks + 1][1]); w.w = cvt_pk_bf16(sc[2 * ks + 1][2], sc[2 * ks + 1][3]);
            pf[ks] = __builtin_bit_cast(bf16x8, w); }
        f32x4 oa[8]; float ss = 0.f;
#pragma unroll
        for (int et = 0; et < 8; ++et) { f32x4 acc = (f32x4){0.f, 0.f, 0.f, 0.f};
#pragma unroll
            for (int kd = 0; kd < 4; ++kd) acc = __builtin_amdgcn_mfma_f32_16x16x32_bf16(sfr[et][kd], qh[kd], acc, 0, 0, 0);
#pragma unroll
            for (int ks = 0; ks < 2; ++ks) if (2 * ks <= tt) {
                const u32x2 lo = *(const LAS u32x2*)(VT + (16 * et + r) * P4_VPITCH + (32 * ks + 4 * q) * 2), hi = *(const LAS u32x2*)(VT + (16 * et + r) * P4_VPITCH + (32 * ks + 16 + 4 * q) * 2);
                const u32x4 w = (u32x4){lo.x, lo.y, hi.x, hi.y};
                acc = __builtin_amdgcn_mfma_f32_16x16x32_bf16(__builtin_bit_cast(bf16x8, w), pf[ks], acc, 0, 0, 0); }
            oa[et] = acc; ss += (acc[0] * acc[0] + acc[1] * acc[1]) + (acc[2] * acc[2] + acc[3] * acc[3]); }
        ss += __shfl_xor(ss, 16); ss += __shfl_xor(ss, 32);
        const float rstd = rsqrtf(ss * (1.f / 128.f) + EPS);
#pragma unroll
        for (int et = 0; et < 8; ++et) { const int e0 = 16 * et + 4 * q; const f32x4 gn = *(const f32x4*)(a.g_hn + e0); const u32x2 og = ogv[et];
            u32x2 w; w.x = cvt_pk_bf16(oa[et][0] * rstd * gn[0] * bf_lo(og.x), oa[et][1] * rstd * gn[1] * bf_hi(og.x)); w.y = cvt_pk_bf16(oa[et][2] * rstd * gn[2] * bf_lo(og.y), oa[et][3] * rstd * gn[3] * bf_hi(og.y));
            *(LAS u32x2*)(QT + (16 * tt + r) * P4_PITCH + e0 * 2) = w; }
        asm volatile("s_waitcnt lgkmcnt(0)" ::: "memory");
#pragma unroll
        for (int i = 0; i < 4; ++i) { const int rr = 16 * tt + 4 * i + (lane >> 4); const u32x4 v = *(const LAS u32x4*)(QT + rr * P4_PITCH + (lane & 15) * 16);
            *(u32x4*)(Qb + (row0 + rr) * 1024 + (size_t)h * 128 + (lane & 15) * 8) = v; }
    }
    __syncthreads();
}

__device__ __forceinline__ void p9_final(const Args& a, int G) {
    const int tid = threadIdx.x, lane = tid & 63, wave = __builtin_amdgcn_readfirstlane(tid >> 6);
    const float* rsq = (const float*)(a.ws + WS_RSQ);
    const f32x4* gr = (const f32x4*)a.g_fin + lane; f32x4 gv[4];
#pragma unroll
    for (int j = 0; j < 4; ++j) gv[j] = gr[64 * j];
    for (int m = 2 * (blockIdx.x * NWAVES + wave); m < M; m += 2 * G * NWAVES) {
        float p = lane < 32 ? rsq[(size_t)m * 16 + lane] : 0.f;
        f32x4* xr = (f32x4*)(a.out + (size_t)m * DM) + lane; f32x4 v[8];
#pragma unroll
        for (int j = 0; j < 8; ++j) v[j] = xr[64 * j];
        p += __shfl_xor(p, 1); p += __shfl_xor(p, 2); p += __shfl_xor(p, 4); p += __shfl_xor(p, 8);
        const float r0 = rsqrtf(__shfl(p, 0) * (1.f / DM) + EPS), r1 = rsqrtf(__shfl(p, 16) * (1.f / DM) + EPS);
#pragma unroll
        for (int j = 0; j < 8; ++j) { const float rs = j < 4 ? r0 : r1; const f32x4 g4 = gv[j & 3]; xr[64 * j] = (f32x4){v[j].x * rs * g4.x, v[j].y * rs * g4.y, v[j].z * rs * g4.z, v[j].w * rs * g4.w}; }
    }
}

#ifdef PROBE_STOP
__device__ __forceinline__ void p_dump(const Args& a, int G) {
    const u16* Qb = (const u16*)(a.ws + WS_Q); const u16* Gb = (const u16*)(a.ws + WS_G); const u16* Vb = (const u16*)(a.ws + WS_V); const u16* OGb = (const u16*)(a.ws + WS_OG);
    const u16* GAb = (const u16*)(a.ws + WS_GA); const u16* GBb = (const u16*)(a.ws + WS_GB); const u16* PB = (const u16*)(a.ws + WS_PB);
    for (size_t i = (size_t)blockIdx.x * NTHR + threadIdx.x; i < (size_t)M * DM; i += (size_t)G * NTHR) {
        float v = 0.f;
        if (PROBE_STOP == 1) v = bf1(Qb[i]) + h2f(Gb[i]) + bf1(Vb[i]) + bf1(OGb[i]) + bf1(GAb[i]) + bf1(GBb[i]) + bf1(PB[i]);
        else if (PROBE_STOP == 2 || PROBE_STOP == 3) { float t = bf1(((const u16*)a.out)[i]) + bf1(((const u16*)a.out)[i + (size_t)M * DM]); if (!(fabsf(t) < 1e30f)) t = 12345.f; ((float*)(a.ws + WS_GA))[i] = t; continue; }
        else if (PROBE_STOP == 4) v = bf1(Qb[i]) + bf1(PB[i]);
        else if (PROBE_STOP == 5) v = bf1(Gb[i]);
        else continue;
        a.out[i] = v;
    }
}
#endif
__device__ __forceinline__ void flat_barrier(unsigned* cnt) {
    asm volatile("s_waitcnt vmcnt(0)" ::: "memory");
    __syncthreads();
    if (threadIdx.x == 0) {
        const unsigned Gn = gridDim.x;
        __builtin_amdgcn_fence(__ATOMIC_RELEASE, "agent");
        asm volatile("s_waitcnt vmcnt(0)" ::: "memory");
        const unsigned old = __hip_atomic_fetch_add(cnt, 1u, __ATOMIC_RELAXED, __HIP_MEMORY_SCOPE_AGENT);
        const unsigned target = (old / Gn + 1u) * Gn; unsigned sp = 0;
        while (__hip_atomic_load(cnt, __ATOMIC_RELAXED, __HIP_MEMORY_SCOPE_AGENT) < target) { __builtin_amdgcn_s_sleep(1); if (++sp > (1u << 22)) break; }
        __builtin_amdgcn_fence(__ATOMIC_ACQUIRE, "agent");
        asm volatile("s_waitcnt vmcnt(0)" ::: "memory");
    }
    __syncthreads();
}
constexpr int NPH = 10;
__global__ void __launch_bounds__(NTHR, 2) mega(Args a) {
    extern __shared__ __attribute__((aligned(16))) unsigned char lds_raw[];
    LAS unsigned char* lds = (LAS unsigned char*)lds_raw;
    cg::grid_group grid = cg::this_grid();
    const int G = gridDim.x, lo = a.ph_lo, hi = a.ph_hi;
    unsigned char* ws = a.ws;
    volatile LAS unsigned* MISC = (volatile LAS unsigned*)(lds + LDS_BYTES - 64);
    if (threadIdx.x < 16) MISC[threadIdx.x] = 0u;
    __syncthreads();
    XcdBarrier bar; bar.bar = (unsigned*)(ws + WS_BAR); bar.x = 0; bar.st = nullptr;
    if (hi - lo > 1) bar = xcd_barrier_post((unsigned*)(ws + WS_BAR), MISC);
    if (hi < 0) grid.sync();
#ifndef PHMASK
#define PHMASK 0x3ff
#endif
#define IN(k) (((PHMASK >> (k)) & 1) && lo <= (k) && (k) < hi)
#ifndef CG_SEAMS
#define CG_SEAMS 0x0
#endif
#define SEAM(k) do { if (IN(k) && IN((k) + 1)) { if ((CG_SEAMS >> (k)) & 1) grid.sync(); else xcd_barrier(bar); } } while (0)
#ifndef PROBE_DUP
#define PROBE_DUP 0
#endif
#ifndef PROBE_XSYNC
#define PROBE_XSYNC 0
#endif
#define DUP(k) (((PROBE_DUP >> (k)) & 1) ? 2 : 1)
    if (IN(0)) { p0_prologue(a, lds, G); } SEAM(0);
#ifdef PROBE_XBAR
    for (int xs = 0; xs < PROBE_XBAR; ++xs) flat_barrier((unsigned*)(ws + WS_BAR + 14 * KiB));
#endif
    if (IN(1)) { pg8::Gemm g{(const u16*)a.out, (const u16*)(ws + WS_WIN), M, INW, DM, DM, 1 << 30, 0L}; pg8::StaticOrder S; S.init(M, INW, G, (int)blockIdx.x);
        EpiIn E{ws}; pg8::gemm_phase<EpiIn, true>(lds, g, S, E);
        if (G == 256 && blockIdx.x == 255) p2_wave((const u16*)(ws + WS_GM), (const u16*)(ws + WS_VM), NMETA, (int)(threadIdx.x >> 6), (u16*)(ws + WS_UM) + (size_t)(threadIdx.x >> 6) * 16384, nullptr, (int)(threadIdx.x & 63));
        else if (G == 256 && blockIdx.x >= 128) late_weights(a, lds, ((int)blockIdx.x - 128) * NWAVES + (int)(threadIdx.x >> 6), 127 * NWAVES); }
    SEAM(1);
    if (IN(2)) { p2_states(a, G); } SEAM(2);
    if (IN(3)) { p3_scan(a, lds, G); } SEAM(3);
    if (IN(4)) { p4_outputs(a, lds, G); } SEAM(4);
    if (IN(5)) { pg8::Gemm g{(const u16*)(ws + WS_Q), (const u16*)(ws + WS_WAB), M, DM, 1536, DM, 16, (long)(WS_PB - WS_Q) - 16L * 128L}; pg8::StaticOrder S; S.init(M, DM, G, (int)blockIdx.x);
        EpiMerge E{(const u16*)(ws + WS_GA), (const u16*)(ws + WS_GB), (u16*)(ws + WS_MG)}; pg8::gemm_phase<EpiMerge, false>(lds, g, S, E); } SEAM(5);
    if (IN(6)) { pg8::Gemm g{(const u16*)(ws + WS_MG), (const u16*)(ws + WS_WOUT), M, DM, DM, DM, 1 << 30, 0L}; pg8::StaticOrder S; S.init(M, DM, G, (int)blockIdx.x);
        const bool fuse9_ = (G == (M / 256) * (DM / 256)) && (hi - lo > 1);
        EpiRes<true> E{a.x, fuse9_ ? nullptr : a.out, (u16*)(ws + WS_H1B), (float*)(ws + WS_RSQ)}; pg8::gemm_phase<EpiRes<true>, false>(lds, g, S, E); } SEAM(6);
    if (IN(7)) { pg8::Gemm g{(const u16*)(ws + WS_H1B), (const u16*)(ws + WS_WGU), M, NGU, DM, DM, 1 << 30, 0L}; pg8::StaticOrder S; S.init(M, NGU, G, (int)blockIdx.x);
        EpiFfn1 E{(const float*)(ws + WS_RSQ), (u16*)(ws + WS_ACT)}; pg8::gemm_phase<EpiFfn1, true>(lds, g, S, E); } SEAM(7);
    const bool fuse9 = (G == (M / 256) * (DM / 256)) && (hi - lo > 1);
    if (IN(8)) { pg8::Gemm g{(const u16*)(ws + WS_ACT), (const u16*)(ws + WS_WD), M, DM, DFF, DFF, 1 << 30, 0L}; pg8::StaticOrder S; S.init(M, DM, G, (int)blockIdx.x);
        if (fuse9) { EpiResNorm E{(const u16*)(ws + WS_H1B), a.out, a.g_fin, (float*)(ws + WS_RSQ), (unsigned*)(ws + WS_CNT)}; pg8::gemm_phase<EpiResNorm, false>(lds, g, S, E); }
        else { EpiRes<false> E{a.out, a.out, nullptr, (float*)(ws + WS_RSQ)}; pg8::gemm_phase<EpiRes<false>, false>(lds, g, S, E); } }
    if (!fuse9) { SEAM(8);
    if (IN(9)) { p9_final(a, G); } }
#ifdef PROBE_LIST
    if (lo == 20) p0_prologue(a, lds, G, 1);
    if (lo == 30) p0_prologue(a, lds, G, 2);
    if (lo == 40) p0_prologue(a, lds, G, 4);
    if (lo == 14) p4_outputs(a, lds, G, 1);
    if (lo == 24) p4_outputs(a, lds, G, 2);
    if (lo == 34) p4_outputs(a, lds, G, 2 | 4);
    if (lo == 44) p4_outputs(a, lds, G, 2 | 8);
    if (lo == 54) p4_outputs(a, lds, G, 2 | 16);
    if (lo == 64) p4_outputs(a, lds, G, 2 | 32);
    if (lo == 74) p4_outputs(a, lds, G, 2 | 64);
    if (lo == 18) { pg8::Gemm g{(const u16*)(ws + WS_ACT), (const u16*)(ws + WS_WD), M, DM, DFF, DFF, 1 << 30, 0L}; pg8::StaticOrder S; S.init(M, DM, G, (int)blockIdx.x);
        EpiRes<false> E{(const float*)(ws + WS_GA), (float*)(ws + WS_GA), nullptr, (float*)(ws + WS_OG)}; pg8::gemm_phase<EpiRes<false>, false>(lds, g, S, E); }
    if (lo == 19) { Args b = a; b.out = (float*)(ws + WS_GA); p9_final(b, G); }
#endif
#ifdef PROBE_STOP
    if (lo == 10) p_dump(a, G);
    if (lo == 11 && (PROBE_STOP == 2 || PROBE_STOP == 3)) { for (size_t i = (size_t)blockIdx.x * NTHR + threadIdx.x; i < (size_t)M * DM; i += (size_t)G * NTHR) a.out[i] = ((const float*)(a.ws + WS_GA))[i]; }
#endif
#undef IN
#undef SEAM
}

extern "C" void kernel_launch(void* const* d_in, const int* in_sizes, int n_in, void* d_out, int out_size, void* d_ws, size_t ws_size, hipStream_t stream) {
    static int grid = 0;
    if (grid == 0) {
        if (n_in != 16 || in_sizes[0] != M * DM || out_size != M * DM || ws_size < WS_END) { fprintf(stderr, "kernel_launch: unexpected shapes (n_in %d, in0 %d, out %d, ws %zu); nothing launched\n", n_in, n_in > 0 ? in_sizes[0] : -1, out_size, ws_size); grid = -1; return; }
        int dev = 0, cus = 0, per_cu = 0;
        (void)hipGetDevice(&dev); (void)hipDeviceGetAttribute(&cus, hipDeviceAttributeMultiprocessorCount, dev);
        if (hipFuncSetAttribute((const void*)mega, hipFuncAttributeMaxDynamicSharedMemorySize, LDS_BYTES) != hipSuccess) { fprintf(stderr, "kernel_launch: hipFuncSetAttribute failed\n"); }
        if (hipOccupancyMaxActiveBlocksPerMultiprocessor(&per_cu, (const void*)mega, NTHR, LDS_BYTES) != hipSuccess || per_cu < 1) per_cu = 1;
        (void)hipGetLastError();
        if (cus <= 0) cus = 256;
        grid = cus * per_cu;
    }
    if (grid < 0) return;
#if MK_COOP
    if (hipMemsetAsync((char*)d_ws + WS_BAR, 0, CTL_ZERO, stream) != hipSuccess) { fprintf(stderr, "kernel_launch: hipMemsetAsync of the barrier words failed\n"); return; }
#endif
    Args a{};
    a.x = (const float*)d_in[0]; a.meta = (const float*)d_in[1]; a.g_mix = (const float*)d_in[2]; a.w_in = (const float*)d_in[3]; a.lb_raw = (const float*)d_in[4]; a.g_hn = (const float*)d_in[5];
    a.pool_w = (const float*)d_in[6]; a.pool_scale = (const float*)d_in[7]; a.w_a = (const float*)d_in[8]; a.w_b = (const float*)d_in[9]; a.w_out = (const float*)d_in[10]; a.g_ffn = (const float*)d_in[11];
    a.w_gate = (const float*)d_in[12]; a.w_up = (const float*)d_in[13]; a.w_down = (const float*)d_in[14]; a.g_fin = (const float*)d_in[15];
    a.out = (float*)d_out; a.ws = (unsigned char*)d_ws;
#if MK_COOP
    a.ph_lo = 0; a.ph_hi = NPH;
    void* args[] = {&a};
    const hipError_t e = hipLaunchCooperativeKernel((const void*)mega, dim3(grid), dim3(NTHR), args, LDS_BYTES, stream);
    if (e != hipSuccess) fprintf(stderr, "kernel_launch: cooperative launch failed: %s (grid %d)\n", hipGetErrorString(e), grid);
#else
#ifdef PROBE_STOP
    for (int ph = 0; ph <= PROBE_STOP; ++ph) { a.ph_lo = ph; a.ph_hi = ph + 1; hipLaunchKernelGGL(mega, dim3(grid), dim3(NTHR), LDS_BYTES, stream, a); }
    a.ph_lo = 10; a.ph_hi = 11; hipLaunchKernelGGL(mega, dim3(grid), dim3(NTHR), LDS_BYTES, stream, a);
    a.ph_lo = 11; a.ph_hi = 12; hipLaunchKernelGGL(mega, dim3(grid), dim3(NTHR), LDS_BYTES, stream, a);
#else
#ifdef PROBE_LIST
    { const int lst[] = PROBE_LIST; for (int i = 0; i < (int)(sizeof(lst) / sizeof(int)); ++i) { a.ph_lo = lst[i]; a.ph_hi = lst[i] + 1; hipLaunchKernelGGL(mega, dim3(grid), dim3(NTHR), LDS_BYTES, stream, a); } }
#else
    for (int ph = 0; ph < NPH; ++ph) { a.ph_lo = ph; a.ph_hi = ph + 1; hipLaunchKernelGGL(mega, dim3(grid), dim3(NTHR), LDS_BYTES, stream, a); }
#endif
#endif
#endif
}
```

```cpp
#include <hip/hip_runtime.h>
#include <hip/hip_cooperative_groups.h>
#include <cstdio>
#include <cstdint>
namespace cg = cooperative_groups;

#ifndef MK_COOP
#define MK_COOP 1
#endif

#define LAS __attribute__((address_space(3)))
typedef unsigned short u16;
typedef short bf16x8 __attribute__((ext_vector_type(8)));
typedef float f32x4 __attribute__((ext_vector_type(4)));
typedef unsigned u32x4 __attribute__((ext_vector_type(4)));
typedef unsigned u32x2 __attribute__((ext_vector_type(2)));

typedef __bf16 bf16v2_t __attribute__((ext_vector_type(2)));
typedef float f32v2_t __attribute__((ext_vector_type(2)));
__device__ __forceinline__ unsigned cvt_pk_bf16(float lo, float hi) { const f32v2_t f = {lo, hi}; const bf16v2_t v = __builtin_convertvector(f, bf16v2_t); return __builtin_bit_cast(unsigned, v); }
__device__ __forceinline__ float bf_lo(unsigned w) { return __uint_as_float(w << 16); }
__device__ __forceinline__ float bf_hi(unsigned w) { return __uint_as_float(w & 0xffff0000u); }
__device__ __forceinline__ float bf1(u16 w) { return __uint_as_float((unsigned)w << 16); }
__device__ __forceinline__ unsigned pk_h(float a, float b) { const _Float16 x = (_Float16)a, y = (_Float16)b; return (unsigned)__builtin_bit_cast(unsigned short, x) | ((unsigned)__builtin_bit_cast(unsigned short, y) << 16); }
__device__ __forceinline__ float h2f(u16 w) { return (float)__builtin_bit_cast(_Float16, w); }
__device__ __forceinline__ float sigm(float z) { return __builtin_amdgcn_rcpf(1.0f + __expf(-z)); }

namespace pg8 {
constexpr int BM = 256, BK = 64, HALF = 128, HTB = HALF * BK * 2, STAGE_BYTES = 8 * HTB, NXCD = 8, WGM = 8;
__host__ __device__ __forceinline__ int lds_byte(int r, int c) { const int st = (r >> 4) * 2 + (c >> 5), rr = r & 15, cc = c & 31, ob = rr * 64 + cc * 2; return st * 1024 + (ob ^ (((ob >> 9) & 1) << 5)); }
__host__ __device__ __forceinline__ void stage_rc(int b, int& R, int& C) { const int st = b / 1024, sb = b % 1024, swz = sb ^ (((sb >> 9) & 1) << 5); R = (st >> 1) * 16 + swz / 64; C = (st & 1) * 32 + (swz % 64) / 2; }
__host__ __device__ __forceinline__ int perm32(int rho) { const int n = rho >> 4, i = rho & 15; return 8 * (i >> 2) + 4 * n + (i & 3); }
struct Unit { int pm, pn; };
struct Gemm { const u16* A; const u16* Bt; int M, N, K, lda, ksplit; long a2delta; };
struct StaticOrder {
    int nM, nN, nwg, G, c;
    __host__ __device__ void init(int M, int N, int G_, int c_) { nM = M / BM; nN = N / BM; nwg = nM * nN; G = G_; c = c_; }
    __host__ __device__ bool next(int i, Unit& u) const {
        const long L = (long)i * G + c; if (L >= nwg) return false;
        int wgid = (int)L; { const int q = nwg / NXCD, r = nwg % NXCD, xcd = wgid % NXCD, off = wgid / NXCD; wgid = (xcd < r ? xcd * (q + 1) : r * (q + 1) + (xcd - r) * q) + off; }
        const int nig = WGM * nN, gid = wgid / nig, fm = gid * WGM, gsz = (nM - fm) < WGM ? (nM - fm) : WGM;
        u.pm = fm + ((wgid % nig) % gsz); u.pn = (wgid % nig) / gsz; return true;
    }
};
template <class Epi, bool ALIGN_EPI>
__device__ __forceinline__ void gemm_phase(LAS unsigned char* lds, const Gemm g, const StaticOrder& S, const Epi& E) {
    const int tid = threadIdx.x, wid = __builtin_amdgcn_readfirstlane(tid >> 6), lane = tid & 63, wr = wid >> 2, wc = wid & 3, fr = lane & 15, fq = lane >> 4;
    const int K = g.K, nt = K / BK, lda = g.lda;
    unsigned voffA[2], voffB[2];
#pragma unroll
    for (int i = 0; i < 2; ++i) { int R, C; stage_rc(tid * 16 + i * 8192, R, C); const int Rb = Epi::PERM ? ((R & ~31) + perm32(R & 31)) : R;
        voffA[i] = (unsigned)(R * lda + C) * 2u; voffB[i] = (unsigned)(Rb * K + C) * 2u; }
    const size_t kstep = (size_t)(BK * 2);
    const size_t hstepA = (size_t)HALF * lda * 2, tstepA = 2 * hstepA;
    const size_t hstepB = (size_t)HALF * K * 2, tstepB = 2 * hstepB;
    const unsigned ldsw = (unsigned)wid * 1024u;
    const int aoff = lds_byte(wr * 64 + fr, fq * 8), boff = lds_byte(wc * 32 + fr, fq * 8);
#define PG8_SA(b, h) (((b) * 2 + (h)) * HTB)
#define PG8_SB(b, h) ((4 + (b) * 2 + (h)) * HTB)
#define PG8_STAGE(bufoff, gbase, voff) do { _Pragma("unroll") for (int _i = 0; _i < 2; ++_i) \
        __builtin_amdgcn_global_load_lds((const unsigned*)((const char*)(gbase) + (voff)[_i]), (LAS unsigned*)(lds + (bufoff) + ldsw + _i * 8192), 16, 0, 0); } while (0)
#define PG8_LDA(dst, b, h) do { _Pragma("unroll") for (int m = 0; m < 4; ++m) _Pragma("unroll") for (int k = 0; k < 2; ++k) dst[m][k] = *(const LAS bf16x8*)(lds + PG8_SA(b, h) + aoff + m * 2048 + k * 1024); } while (0)
#define PG8_LDB(dst, b, h) do { _Pragma("unroll") for (int n = 0; n < 2; ++n) _Pragma("unroll") for (int k = 0; k < 2; ++k) dst[n][k] = *(const LAS bf16x8*)(lds + PG8_SB(b, h) + boff + n * 2048 + k * 1024); } while (0)
#define PG8_MMA(ai, bj, At, Bt) do { __builtin_amdgcn_s_setprio(1); _Pragma("unroll") for (int m = 0; m < 4; ++m) _Pragma("unroll") for (int n = 0; n < 2; ++n) _Pragma("unroll") for (int k = 0; k < 2; ++k) \
        acc[ai][bj][m][n] = __builtin_amdgcn_mfma_f32_16x16x32_bf16(Bt[n][k], At[m][k], acc[ai][bj][m][n], 0, 0, 0); __builtin_amdgcn_s_setprio(0); } while (0)
#define PG8_WAIT_V(n) asm volatile("s_waitcnt vmcnt(" #n ")" ::: "memory")
#define PG8_WAIT_L(n) asm volatile("s_waitcnt lgkmcnt(" #n ")" ::: "memory")
#define PG8_BAR __builtin_amdgcn_s_barrier()
#define PG8_SCHED __builtin_amdgcn_sched_barrier(0)
    Unit cur, nxt; int ui = 0;
    if (!S.next(0, cur)) return;
    f32x4 acc[2][2][4][2];
#pragma unroll
    for (int a = 0; a < 2; ++a)
#pragma unroll
        for (int b = 0; b < 2; ++b)
#pragma unroll
            for (int m = 0; m < 4; ++m)
#pragma unroll
                for (int n = 0; n < 2; ++n) acc[a][b][m][n] = (f32x4){0.f, 0.f, 0.f, 0.f};
    bf16x8 At[4][2], B0[2][2], B1[2][2];
    const char* cA = (const char*)g.A + (size_t)cur.pm * tstepA; const char* cB = (const char*)g.Bt + (size_t)cur.pn * tstepB;
    PG8_STAGE(PG8_SB(0, 0), cB, voffB); PG8_STAGE(PG8_SB(0, 1), cB + hstepB, voffB); PG8_STAGE(PG8_SA(0, 0), cA, voffA); PG8_STAGE(PG8_SA(0, 1), cA + hstepA, voffA);
    if (wr == 1) PG8_BAR;
    PG8_WAIT_V(2); PG8_BAR;
    PG8_STAGE(PG8_SB(1, 0), cB + kstep, voffB); PG8_STAGE(PG8_SA(1, 0), cA + kstep, voffA); PG8_STAGE(PG8_SB(1, 1), cB + hstepB + kstep, voffB);
    PG8_WAIT_V(6); PG8_BAR;
    for (;;) {
        const bool has_next = S.next(ui + 1, nxt);
        const char* nA = has_next ? (const char*)g.A + (size_t)nxt.pm * tstepA : cA; const char* nB = has_next ? (const char*)g.Bt + (size_t)nxt.pn * tstepB : cB;
        for (int t = 0; t < nt; t += 2) {
            const bool last = (t == nt - 2);
            if constexpr (Epi::MID) { if (t == g.ksplit) E.mid(acc, cur, wr, wc, fr, fq); }
            const char* a1 = cA + (size_t)(t + 1) * kstep + (t >= g.ksplit ? g.a2delta : 0L);
            const char* a2 = last ? nA : cA + (size_t)(t + 2) * kstep + (t + 2 >= g.ksplit ? g.a2delta : 0L);
            const char* b2 = last ? nB : cB + (size_t)(t + 2) * kstep;
            const char* a3 = a2 + kstep; const char* b3 = b2 + kstep;
            PG8_LDB(B0, 0, 0); PG8_LDB(B1, 0, 1); PG8_SCHED; PG8_LDA(At, 0, 0); PG8_STAGE(PG8_SA(1, 1), a1 + hstepA, voffA);
            PG8_WAIT_V(8); PG8_WAIT_L(0); PG8_BAR; PG8_MMA(0, 0, At, B0); PG8_MMA(0, 1, At, B1); PG8_BAR; PG8_SCHED;
            PG8_LDA(At, 0, 1); PG8_STAGE(PG8_SB(0, 0), b2, voffB); PG8_STAGE(PG8_SB(0, 1), b2 + hstepB, voffB); PG8_STAGE(PG8_SA(0, 0), a2, voffA);
            PG8_WAIT_V(8); PG8_WAIT_L(0); PG8_BAR; PG8_MMA(1, 0, At, B0); PG8_MMA(1, 1, At, B1); PG8_BAR; PG8_SCHED;
            PG8_LDB(B0, 1, 0); PG8_LDB(B1, 1, 1); PG8_SCHED; PG8_LDA(At, 1, 0); PG8_STAGE(PG8_SA(0, 1), a2 + hstepA, voffA);
            PG8_WAIT_V(8); PG8_WAIT_L(0); PG8_BAR; PG8_MMA(0, 0, At, B0); PG8_MMA(0, 1, At, B1); PG8_BAR; PG8_SCHED;
            PG8_LDA(At, 1, 1); PG8_STAGE(PG8_SB(1, 0), b3, voffB); PG8_STAGE(PG8_SB(1, 1), b3 + hstepB, voffB); PG8_STAGE(PG8_SA(1, 0), a3, voffA);
            PG8_WAIT_V(8); PG8_WAIT_L(0); PG8_BAR; PG8_MMA(1, 0, At, B0); PG8_MMA(1, 1, At, B1); PG8_BAR; PG8_SCHED;
        }
        if constexpr (ALIGN_EPI) { if (wr == 0) PG8_BAR; }
        if constexpr (!Epi::AFTER) E(acc, cur, wr, wc, fr, fq);
        if (!has_next) break;
#pragma unroll
        for (int a = 0; a < 2; ++a)
#pragma unroll
            for (int b = 0; b < 2; ++b)
#pragma unroll
                for (int m = 0; m < 4; ++m)
#pragma unroll
                    for (int n = 0; n < 2; ++n) acc[a][b][m][n] = (f32x4){0.f, 0.f, 0.f, 0.f};
        cur = nxt; cA = nA; cB = nB; ++ui;
        if constexpr (ALIGN_EPI) { if (wr == 1) PG8_BAR; }
    }
    PG8_WAIT_V(0);
    if constexpr (!ALIGN_EPI) { if (wr == 0) PG8_BAR; }
    PG8_BAR;
    if constexpr (Epi::AFTER) E.after(acc, cur, wr, wc, fr, fq, lds, wid, lane);
#undef PG8_SA
#undef PG8_SB
#undef PG8_STAGE
#undef PG8_LDA
#undef PG8_LDB
#undef PG8_MMA
#undef PG8_WAIT_V
#undef PG8_WAIT_L
#undef PG8_BAR
#undef PG8_SCHED
}
}

constexpr int NWAVES = 8, NTHR = 512;
constexpr int SEQ = 8192, BATCH = 2, DM = 1024, M = BATCH * SEQ, NMETA = 16, INW = 6656, DFF = 2816, NGU = 2 * DFF, CHK = 64, NCH = SEQ / CHK;
constexpr float EPS = 1e-6f;
constexpr size_t KiB = 1024, MiB = 1u << 20;
constexpr size_t WS_LB = 0, WS_GM = 64 * KiB, WS_VM = 128 * KiB, WS_PLM = 192 * KiB, WS_PWT = 256 * KiB, WS_UM = 512 * KiB, WS_DK = 1 * MiB, WS_RSQ = 2 * MiB;
constexpr size_t WS_WAB = 3 * MiB, WS_WOUT = 6 * MiB, WS_WD = 8 * MiB, WS_WIN = 14 * MiB, WS_WGU = 14 * MiB;
constexpr size_t WS_Q = 28 * MiB, WS_G = 60 * MiB, WS_V = 92 * MiB, WS_OG = 124 * MiB, WS_GA = 156 * MiB, WS_GB = 188 * MiB, WS_PB = 220 * MiB, WS_END = 252 * MiB;
constexpr size_t WS_MG = WS_G, WS_H1B = WS_GB, WS_ACT = WS_Q;
static_assert(WS_WD + (size_t)DM * DFF * 2 <= WS_WIN && WS_WIN + (size_t)INW * DM * 2 <= WS_Q && WS_WGU + (size_t)NGU * DM * 2 <= WS_Q && WS_ACT + (size_t)M * DFF * 2 <= WS_H1B, "ws map");
constexpr int LDS_BYTES = 163840;
constexpr size_t WS_BAR = 16 * KiB, WS_CNT = 32 * KiB, CTL_ZERO = 32 * KiB;

struct Args {
    const float *x, *meta, *g_mix, *w_in, *lb_raw, *g_hn, *pool_w, *pool_scale, *w_a, *w_b, *w_out, *g_ffn, *w_gate, *w_up, *w_down, *g_fin;
    float* out; unsigned char* ws; int ph_lo, ph_hi;
};

#define LDS_WAIT() asm volatile("s_waitcnt lgkmcnt(0)" ::: "memory")
__device__ __forceinline__ float wave_sum(float v) {
#pragma unroll
    for (int o = 1; o < 64; o <<= 1) v += __shfl_xor(v, o);
    return v;
}

__device__ __forceinline__ void tr_item(const float* W, int N, int k0, int n0, u16* WT, int drow0, int dpitch, int dk0, const float* ks, LAS float* scr, int lane) {
    f32x4 wv[8];
#pragma unroll
    for (int i = 0; i < 8; ++i) wv[i] = __builtin_nontemporal_load((const f32x4*)(W + (size_t)(k0 + 8 * i + (lane >> 3)) * N + n0 + 4 * (lane & 7)));
#pragma unroll
    for (int i = 0; i < 8; ++i) { const int kk = 8 * i + (lane >> 3); f32x4 w = wv[i]; if (ks) w *= ks[k0 + kk];
        LAS float* d = scr + kk * 33 + 4 * (lane & 7); d[0] = w.x; d[1] = w.y; d[2] = w.z; d[3] = w.w; }
    LDS_WAIT(); asm volatile("" ::: "memory");
    const int c = lane & 7;
#pragma unroll
    for (int j = 0; j < 4; ++j) { const int n = (lane >> 3) + 8 * j; const LAS float* s = scr + (8 * c) * 33 + n;
        u32x4 o; o.x = cvt_pk_bf16(s[0 * 33], s[1 * 33]); o.y = cvt_pk_bf16(s[2 * 33], s[3 * 33]); o.z = cvt_pk_bf16(s[4 * 33], s[5 * 33]); o.w = cvt_pk_bf16(s[6 * 33], s[7 * 33]);
        *(u32x4*)(WT + (size_t)(drow0 + n) * dpitch + dk0 + k0 + 8 * c) = o; }
    LDS_WAIT(); asm volatile("" ::: "memory");
}
__device__ __forceinline__ void rms_row_bf16(const float* xrow, const float* g, u16* orow, int lane) {
    const f32x4* xr = (const f32x4*)xrow + lane; const f32x4* gr = (const f32x4*)g + lane;
    f32x4 v[4]; float s = 0.f;
#pragma unroll
    for (int j = 0; j < 4; ++j) { v[j] = xr[64 * j]; s += (v[j].x * v[j].x + v[j].y * v[j].y) + (v[j].z * v[j].z + v[j].w * v[j].w); }
    const float rstd = rsqrtf(wave_sum(s) * (1.f / DM) + EPS);
    u32x2* o8 = (u32x2*)orow + lane;
#pragma unroll
    for (int j = 0; j < 4; ++j) { const f32x4 gv = gr[64 * j]; u32x2 o; o.x = cvt_pk_bf16(v[j].x * rstd * gv.x, v[j].y * rstd * gv.y); o.y = cvt_pk_bf16(v[j].z * rstd * gv.z, v[j].w * rstd * gv.w); o8[64 * j] = o; }
}

__device__ __forceinline__ void p0_meta(const Args& a, LAS unsigned char* lds, int j, int tid, int wave, int lane) {
    LAS float* nm = (LAS float*)lds;
    LAS float* part = (LAS float*)(lds + 65536);
#pragma unroll
    for (int rr = 0; rr < 2; ++rr) { const int r = 2 * wave + rr; const f32x4* xr = (const f32x4*)(a.meta + (size_t)r * DM) + lane; const f32x4* gr = (const f32x4*)a.g_mix + lane;
        f32x4 v[4]; float s = 0.f;
#pragma unroll
        for (int q = 0; q < 4; ++q) { v[q] = xr[64 * q]; s += (v[q].x * v[q].x + v[q].y * v[q].y) + (v[q].z * v[q].z + v[q].w * v[q].w); }
        const float rstd = rsqrtf(wave_sum(s) * (1.f / DM) + EPS);
#pragma unroll
        for (int q = 0; q < 4; ++q) { const f32x4 gv = gr[64 * q]; *(LAS f32x4*)(nm + r * 1024 + 4 * (lane + 64 * q)) = (f32x4){v[q].x * rstd * gv.x, v[q].y * rstd * gv.y, v[q].z * rstd * gv.z, v[q].w * rstd * gv.w}; }
    }
    __syncthreads();
    const int colbase = j < 32 ? 1024 + 32 * j : (j < 64 ? 2048 + 32 * (j - 32) : 4096 + 32 * (j - 64));
    {
        const int col = colbase + (lane & 31), kh = lane >> 5; float acc[16];
#pragma unroll
        for (int r = 0; r < 16; ++r) acc[r] = 0.f;
#pragma unroll 4
        for (int k = 128 * wave + 64 * kh; k < 128 * wave + 64 * kh + 64; k += 4) {
            const float w0 = a.w_in[(size_t)(k + 0) * INW + col], w1 = a.w_in[(size_t)(k + 1) * INW + col], w2 = a.w_in[(size_t)(k + 2) * INW + col], w3 = a.w_in[(size_t)(k + 3) * INW + col];
#pragma unroll
            for (int r = 0; r < 16; ++r) { const f32x4 n4 = *(const LAS f32x4*)(nm + r * 1024 + k); acc[r] += (n4.x * w0 + n4.y * w1) + (n4.z * w2 + n4.w * w3); }
        }
#pragma unroll
        for (int r = 0; r < 16; ++r) part[(wave * 16 + r) * 64 + lane] = acc[r];
    }
    __syncthreads();
    {
        const int r = tid >> 5, cl = tid & 31; float z = 0.f;
#pragma unroll
        for (int w = 0; w < 8; ++w) z += part[(w * 16 + r) * 64 + cl] + part[(w * 16 + r) * 64 + 32 + cl];
        const int col = colbase + cl;
        if (col < 2048) { const int c = col - 1024; const float lb = 1.0f / (1.0f + __expf(a.lb_raw[1024 + c] - a.lb_raw[c])); const float f = lb + (1.0f - lb) * sigm(z);
            const _Float16 hv = (_Float16)__logf(f); ((u16*)(a.ws + WS_GM))[r * 1024 + c] = __builtin_bit_cast(unsigned short, hv); }
        else if (col < 3072) { ((u16*)(a.ws + WS_VM))[r * 1024 + (col - 2048)] = (u16)(cvt_pk_bf16(z, 0.f) & 0xffffu); }
        else { ((u16*)(a.ws + WS_PLM))[r * 512 + (col - 4096)] = (u16)(cvt_pk_bf16(z, 0.f) & 0xffffu); }
    }
    __syncthreads();
}

__device__ __forceinline__ void late_weights(const Args& a, LAS unsigned char* lds, int gw, int NGW) {
    const int lane = threadIdx.x & 63, wave = __builtin_amdgcn_readfirstlane(threadIdx.x >> 6);
    LAS float* scr = (LAS float*)(lds + wave * 16384);
    constexpr int I_A = 16 * 32, I_B = 8 * 32, I_O = 16 * 32, I_D = 44 * 32, I_P = 32;
    constexpr int NIT = I_A + I_B + I_O + I_D + I_P;
    for (int it = gw; it < NIT; it += NGW) {
        int r = it;
        if (r < I_A) { tr_item(a.w_a, 1024, 64 * (r / 32), 32 * (r % 32), (u16*)(a.ws + WS_WAB), 32 * (r % 32), 1536, 0, nullptr, scr, lane); continue; } r -= I_A;
        if (r < I_B) { tr_item(a.w_b, 1024, 64 * (r / 32), 32 * (r % 32), (u16*)(a.ws + WS_WAB), 32 * (r % 32), 1536, 1024, nullptr, scr, lane); continue; } r -= I_B;
        if (r < I_O) { tr_item(a.w_out, 1024, 64 * (r / 32), 32 * (r % 32), (u16*)(a.ws + WS_WOUT), 32 * (r % 32), 1024, 0, nullptr, scr, lane); continue; } r -= I_O;
        if (r < I_D) { tr_item(a.w_down, 1024, 64 * (r / 32), 32 * (r % 32), (u16*)(a.ws + WS_WD), 32 * (r % 32), DFF, 0, nullptr, scr, lane); continue; } r -= I_D;
        { const int gi = r >> 3, q = r & 7; tr_item(a.pool_w + (size_t)gi * 16384, 128, 64 * (q >> 2), 32 * (q & 3), (u16*)(a.ws + WS_PWT) + (size_t)gi * 16384, 32 * (q & 3), 128, 0, nullptr, scr, lane); }
    }
}

__device__ __forceinline__ void p0_prologue(const Args& a, LAS unsigned char* lds, int G, int skip = 0) {
    const int tid = threadIdx.x, lane = tid & 63, wave = __builtin_amdgcn_readfirstlane(tid >> 6);
    const bool split = G > 160;
    if (!(skip & 4)) for (int j = (int)blockIdx.x; j < 80; j += G) p0_meta(a, lds, j, tid, wave, lane);
    if (split && (int)blockIdx.x < 80) return;
    if (blockIdx.x == 80 || (G <= 80 && blockIdx.x == 0)) { for (int c = tid; c < 1024; c += NTHR) ((float*)(a.ws + WS_LB))[c] = 1.0f / (1.0f + __expf(a.lb_raw[1024 + c] - a.lb_raw[c])); }
    LAS float* scr = (LAS float*)(lds + wave * 16384);
    const int gw = ((int)blockIdx.x - (split ? 80 : 0)) * NWAVES + wave, NGW = (G - (split ? 80 : 0)) * NWAVES;
    constexpr int I_IN = 16 * 208;
    for (int it = gw; it < I_IN && !(skip & 1); it += NGW) tr_item(a.w_in, INW, 64 * (it / 208), 32 * (it % 208), (u16*)(a.ws + WS_WIN), 32 * (it % 208), 1024, 0, nullptr, scr, lane);
    if (G != 256) late_weights(a, lds, gw, NGW);
    u16* XN = (u16*)a.out;
    {
        const f32x4* gr = (const f32x4*)a.g_mix + lane; f32x4 gv[4];
#pragma unroll
        for (int j = 0; j < 4; ++j) gv[j] = gr[64 * j];
        for (int m = 4 * gw; m < M && !(skip & 2); m += 4 * NGW) {
            const f32x4* xr = (const f32x4*)(a.x + (size_t)m * DM) + lane; f32x4 v[16]; float ss[4];
#pragma unroll
            for (int j = 0; j < 16; ++j) v[j] = __builtin_nontemporal_load(&xr[64 * j]);
#pragma unroll
            for (int rr = 0; rr < 4; ++rr) { float t = 0.f;
#pragma unroll
                for (int j = 0; j < 4; ++j) { const f32x4 w = v[4 * rr + j]; t += (w.x * w.x + w.y * w.y) + (w.z * w.z + w.w * w.w); }
                ss[rr] = t; }
#pragma unroll
            for (int o = 1; o < 64; o <<= 1) {
#pragma unroll
                for (int rr = 0; rr < 4; ++rr) ss[rr] += __shfl_xor(ss[rr], o); }
            u32x2* o8 = (u32x2*)(XN + (size_t)m * DM) + lane;
#pragma unroll
            for (int j = 0; j < 16; ++j) { const float rs = rsqrtf(ss[j >> 2] * (1.f / DM) + EPS); const f32x4 g4 = gv[j & 3]; u32x2 o; o.x = cvt_pk_bf16(v[j].x * rs * g4.x, v[j].y * rs * g4.y); o.y = cvt_pk_bf16(v[j].z * rs * g4.z, v[j].w * rs * g4.w); o8[64 * j] = o; }
        }
    }
}

struct EpiIn {
    static constexpr bool PERM = true, MID = false, AFTER = false;
    unsigned char* ws;
    __device__ __forceinline__ void mid(f32x4 (&)[2][2][4][2], const pg8::Unit&, int, int, int, int) const {}
    __device__ __forceinline__ void operator()(f32x4 (&acc)[2][2][4][2], const pg8::Unit& u, int wr, int wc, int fr, int fq) const {
        const int colt = u.pn * 256; int type, c0; size_t boff;
        if (colt < 1024) { type = 1; boff = WS_Q; c0 = colt; }
        else if (colt < 2048) { type = 3; boff = WS_G; c0 = colt - 1024; }
        else if (colt < 3072) { type = 0; boff = WS_V; c0 = colt - 2048; }
        else if (colt < 4096) { type = 1; boff = WS_OG; c0 = colt - 3072; }
        else if (colt < 4608) { type = 0; boff = WS_PB; c0 = colt - 4096 + 512; }
        else if (colt < 5632) { type = 2; boff = WS_GA; c0 = colt - 4608; }
        else { type = 2; boff = WS_GB; c0 = colt - 5632; }
        u16* base = (u16*)(ws + boff);
        const int col0 = c0 + wc * 32 + 8 * fq, row0 = u.pm * 256 + wr * 64 + fr;
        const float* LB = (const float*)(ws + WS_LB);
        f32x4 lbv[2][2];
        if (type == 3) {
#pragma unroll
            for (int bj = 0; bj < 2; ++bj) { lbv[bj][0] = *(const f32x4*)(LB + col0 + bj * 128); lbv[bj][1] = *(const f32x4*)(LB + col0 + bj * 128 + 4); }
        } else {
#pragma unroll
            for (int bj = 0; bj < 2; ++bj) { lbv[bj][0] = (f32x4){0.f, 0.f, 0.f, 0.f}; lbv[bj][1] = (f32x4){0.f, 0.f, 0.f, 0.f}; }
        }
#pragma unroll
        for (int ai = 0; ai < 2; ++ai)
#pragma unroll
            for (int m = 0; m < 4; ++m) { u16* rowp = base + (size_t)(row0 + ai * 128 + m * 16) * 1024 + col0;
#pragma unroll
                for (int bj = 0; bj < 2; ++bj) { f32x4 v0 = acc[ai][bj][m][0], v1 = acc[ai][bj][m][1]; u32x4 w;
                    if (type == 3) {
                        const f32x4 l0 = lbv[bj][0], l1 = lbv[bj][1];
#pragma unroll
                        for (int e = 0; e < 4; ++e) { v0[e] = __logf(l0[e] + (1.0f - l0[e]) * sigm(v0[e])); v1[e] = __logf(l1[e] + (1.0f - l1[e]) * sigm(v1[e])); }
                        w.x = pk_h(v0[0], v0[1]); w.y = pk_h(v0[2], v0[3]); w.z = pk_h(v1[0], v1[1]); w.w = pk_h(v1[2], v1[3]);
                    } else {
                        if (type == 1) {
#pragma unroll
                            for (int e = 0; e < 4; ++e) { v0[e] = v0[e] * sigm(v0[e]); v1[e] = v1[e] * sigm(v1[e]); }
                        } else if (type == 2) {
#pragma unroll
                            for (int e = 0; e < 4; ++e) { v0[e] = sigm(v0[e]); v1[e] = sigm(v1[e]); }
                        }
                        w.x = cvt_pk_bf16(v0[0], v0[1]); w.y = cvt_pk_bf16(v0[2], v0[3]); w.z = cvt_pk_bf16(v1[0], v1[1]); w.w = cvt_pk_bf16(v1[2], v1[3]);
                    }
                    __builtin_nontemporal_store(w, (u32x4*)(rowp + bj * 128)); } }
    }
};
struct EpiMerge {
    static constexpr bool PERM = true, MID = true, AFTER = false;
    const u16 *GA, *GB; u16* MG;
    __device__ __forceinline__ void mid(f32x4 (&acc)[2][2][4][2], const pg8::Unit& u, int wr, int wc, int fr, int fq) const {
        int zz = 0; asm volatile("" : "+v"(zz));
        const int col0 = u.pn * 256 + wc * 32 + 8 * fq, row0 = u.pm * 256 + wr * 64 + fr + zz;
#pragma unroll
        for (int ai = 0; ai < 2; ++ai)
#pragma unroll
            for (int m = 0; m < 4; ++m) { const size_t off = (size_t)(row0 + ai * 128 + m * 16) * 1024 + col0;
#pragma unroll
                for (int bj = 0; bj < 2; ++bj) { const u32x4 ga = __builtin_nontemporal_load((const u32x4*)(GA + off + bj * 128)), gb = *(const u32x4*)(GB + off + bj * 128);
#pragma unroll
                    for (int e = 0; e < 2; ++e) { acc[ai][bj][m][0][2 * e] *= bf_lo(ga[e]) * __builtin_amdgcn_rcpf(bf_lo(gb[e])); acc[ai][bj][m][0][2 * e + 1] *= bf_hi(ga[e]) * __builtin_amdgcn_rcpf(bf_hi(gb[e]));
                        acc[ai][bj][m][1][2 * e] *= bf_lo(ga[2 + e]) * __builtin_amdgcn_rcpf(bf_lo(gb[2 + e])); acc[ai][bj][m][1][2 * e + 1] *= bf_hi(ga[2 + e]) * __builtin_amdgcn_rcpf(bf_hi(gb[2 + e])); } }
                asm volatile("" ::: "memory"); }
    }
    __device__ __forceinline__ void operator()(f32x4 (&acc)[2][2][4][2], const pg8::Unit& u, int wr, int wc, int fr, int fq) const {
        const int col0 = u.pn * 256 + wc * 32 + 8 * fq, row0 = u.pm * 256 + wr * 64 + fr;
#pragma unroll
        for (int ai = 0; ai < 2; ++ai)
#pragma unroll
            for (int m = 0; m < 4; ++m) { const size_t off = (size_t)(row0 + ai * 128 + m * 16) * 1024 + col0;
#pragma unroll
                for (int bj = 0; bj < 2; ++bj) { const u32x4 gb = *(const u32x4*)(GB + off + bj * 128);
                    acc[ai][bj][m][0] *= (f32x4){bf_lo(gb[0]), bf_hi(gb[0]), bf_lo(gb[1]), bf_hi(gb[1])}; acc[ai][bj][m][1] *= (f32x4){bf_lo(gb[2]), bf_hi(gb[2]), bf_lo(gb[3]), bf_hi(gb[3])}; } }
#pragma unroll
        for (int ai = 0; ai < 2; ++ai)
#pragma unroll
            for (int m = 0; m < 4; ++m) { const size_t off = (size_t)(row0 + ai * 128 + m * 16) * 1024 + col0;
#pragma unroll
                for (int bj = 0; bj < 2; ++bj) { const f32x4 v0 = acc[ai][bj][m][0], v1 = acc[ai][bj][m][1]; u32x4 w;
                    w.x = cvt_pk_bf16(v0[0], v0[1]); w.y = cvt_pk_bf16(v0[2], v0[3]); w.z = cvt_pk_bf16(v1[0], v1[1]); w.w = cvt_pk_bf16(v1[2], v1[3]);
                    *(u32x4*)(MG + off + bj * 128) = w; } }
    }
};
template <bool WITH_BF16>
struct EpiRes {
    static constexpr bool PERM = false, MID = false, AFTER = false;
    const float* base; float* H; u16* Hb; float* rsq;
    __device__ __forceinline__ void mid(f32x4 (&)[2][2][4][2], const pg8::Unit&, int, int, int, int) const {}
    __device__ __forceinline__ void operator()(f32x4 (&acc)[2][2][4][2], const pg8::Unit& u, int wr, int wc, int fr, int fq) const {
        const int col0 = u.pn * 256 + wc * 32 + 4 * fq, row0 = u.pm * 256 + wr * 64 + fr;
#pragma unroll
        for (int ai = 0; ai < 2; ++ai) {
            f32x4 pre[4][2][2];
#pragma unroll
            for (int m = 0; m < 4; ++m) { const size_t off = (size_t)(row0 + ai * 128 + m * 16) * 1024 + col0;
#pragma unroll
                for (int bj = 0; bj < 2; ++bj)
#pragma unroll
                    for (int n = 0; n < 2; ++n) pre[m][bj][n] = __builtin_nontemporal_load((const f32x4*)(base + off + bj * 128 + n * 16)); }
            asm volatile("" ::: "memory");
#pragma unroll
            for (int m = 0; m < 4; ++m) { const int row = row0 + ai * 128 + m * 16; const size_t off = (size_t)row * 1024 + col0; float s = 0.f;
#pragma unroll
                for (int bj = 0; bj < 2; ++bj)
#pragma unroll
                    for (int n = 0; n < 2; ++n) { const f32x4 hv = pre[m][bj][n] + acc[ai][bj][m][n];
                        if (H) *(f32x4*)(H + off + bj * 128 + n * 16) = hv;
                        s += (hv[0] * hv[0] + hv[1] * hv[1]) + (hv[2] * hv[2] + hv[3] * hv[3]);
                        if (WITH_BF16) { u32x2 w; w.x = cvt_pk_bf16(hv[0], hv[1]); w.y = cvt_pk_bf16(hv[2], hv[3]); *(u32x2*)(Hb + off + bj * 128 + n * 16) = w; } }
                s += __shfl_xor(s, 16); s += __shfl_xor(s, 32);
                if (fq == 0) rsq[(size_t)row * 16 + u.pn * 4 + wc] = s; }
            asm volatile("" ::: "memory");
        }
    }
};
struct EpiFfn1 {
    static constexpr bool PERM = true, MID = false, AFTER = false;
    const float* rsq; u16* ACT;
    __device__ __forceinline__ void mid(f32x4 (&)[2][2][4][2], const pg8::Unit&, int, int, int, int) const {}
    __device__ __forceinline__ void operator()(const f32x4 (&acc)[2][2][4][2], const pg8::Unit& u, int wr, int wc, int fr, int fq) const {
        const int col0 = u.pn * 128 + wc * 32 + 8 * fq, row0 = u.pm * 256 + wr * 64 + fr;
        float rstdv[2][4];
#pragma unroll
        for (int ai = 0; ai < 2; ++ai)
#pragma unroll
            for (int m = 0; m < 4; ++m) { const int row = row0 + ai * 128 + m * 16; const f32x4* rp = (const f32x4*)(rsq + (size_t)row * 16);
                const f32x4 r0 = rp[0], r1 = rp[1], r2 = rp[2], r3 = rp[3];
                const float ss = ((r0[0] + r0[1]) + (r0[2] + r0[3])) + ((r1[0] + r1[1]) + (r1[2] + r1[3])) + ((r2[0] + r2[1]) + (r2[2] + r2[3])) + ((r3[0] + r3[1]) + (r3[2] + r3[3]));
                rstdv[ai][m] = rsqrtf(ss * (1.f / DM) + EPS); }
#pragma unroll
        for (int ai = 0; ai < 2; ++ai)
#pragma unroll
            for (int m = 0; m < 4; ++m) { const int row = row0 + ai * 128 + m * 16;
                const float rstd = rstdv[ai][m];
                float o[8];
#pragma unroll
                for (int n = 0; n < 2; ++n)
#pragma unroll
                    for (int e = 0; e < 4; ++e) { const float gt = acc[ai][0][m][n][e] * rstd, up = acc[ai][1][m][n][e] * rstd; o[4 * n + e] = gt * sigm(gt) * up; }
                u32x4 w; w.x = cvt_pk_bf16(o[0], o[1]); w.y = cvt_pk_bf16(o[2], o[3]); w.z = cvt_pk_bf16(o[4], o[5]); w.w = cvt_pk_bf16(o[6], o[7]);
                __builtin_nontemporal_store(w, (u32x4*)(ACT + (size_t)row * DFF + col0)); }
    }
};

struct EpiResNorm {
    static constexpr bool PERM = false, MID = false, AFTER = true;
    const u16* base; float* out; const float* gfin; float* slots; unsigned* cnt;
    __device__ __forceinline__ void mid(f32x4 (&)[2][2][4][2], const pg8::Unit&, int, int, int, int) const {}
    __device__ __forceinline__ void operator()(const f32x4 (&)[2][2][4][2], const pg8::Unit&, int, int, int, int) const {}
    __device__ __forceinline__ void after(f32x4 (&acc)[2][2][4][2], const pg8::Unit& u, int wr, int wc, int fr, int fq, LAS unsigned char* lds, int wid, int lane) const {
        LAS float* P = (LAS float*)lds; LAS float* R = (LAS float*)(lds + 4096);
        const int col0 = u.pn * 256 + wc * 32 + 4 * fq;
#pragma unroll
        for (int ai = 0; ai < 2; ++ai)
#pragma unroll
            for (int m = 0; m < 4; ++m) { const int rl = ai * 128 + wr * 64 + m * 16 + fr; const size_t off = (size_t)(u.pm * 256 + rl) * 1024 + col0; float s = 0.f;
#pragma unroll
                for (int bj = 0; bj < 2; ++bj)
#pragma unroll
                    for (int n = 0; n < 2; ++n) { const u32x2 hb = __builtin_nontemporal_load((const u32x2*)(base + off + bj * 128 + n * 16));
                        const f32x4 hv = (f32x4){bf_lo(hb.x), bf_hi(hb.x), bf_lo(hb.y), bf_hi(hb.y)} + acc[ai][bj][m][n]; acc[ai][bj][m][n] = hv; s += (hv[0] * hv[0] + hv[1] * hv[1]) + (hv[2] * hv[2] + hv[3] * hv[3]); }
                s += __shfl_xor(s, 16); s += __shfl_xor(s, 32);
                if (fq == 0) P[rl * 4 + wc] = s;
                if (m & 1) asm volatile("" ::: "memory"); }
        asm volatile("s_waitcnt lgkmcnt(0)" ::: "memory"); __builtin_amdgcn_s_barrier(); asm volatile("" ::: "memory");
        const int row = wid * 32 + (lane & 31);
        unsigned* slot = (unsigned*)slots + (size_t)(u.pm * 256 + row) * 16;
        if (lane < 32) { const float t = (P[row * 4 + 0] + P[row * 4 + 1]) + (P[row * 4 + 2] + P[row * 4 + 3]);
            __hip_atomic_store(slot + u.pn, __float_as_uint(t), __ATOMIC_RELAXED, __HIP_MEMORY_SCOPE_AGENT); }
        asm volatile("s_waitcnt vmcnt(0)" ::: "memory");
        if (lane == 0) __hip_atomic_fetch_add(cnt + 64 * u.pm, 1u, __ATOMIC_RELAXED, __HIP_MEMORY_SCOPE_AGENT);
        if (wid == 0) { unsigned sp = 0;
            while ((unsigned)__builtin_amdgcn_readfirstlane(__hip_atomic_load(cnt + 64 * u.pm, __ATOMIC_RELAXED, __HIP_MEMORY_SCOPE_AGENT)) < 32u) { __builtin_amdgcn_s_sleep(2); if (++sp > (1u << 20)) break; }
            __builtin_amdgcn_fence(__ATOMIC_ACQUIRE, "agent"); }
        asm volatile("s_waitcnt vmcnt(0) lgkmcnt(0)" ::: "memory"); __builtin_amdgcn_s_barrier(); asm volatile("" ::: "memory");
        if (lane < 32) { float t = 0.f;
#pragma unroll
            for (int k = 0; k < 4; ++k) t += __uint_as_float(__hip_atomic_load(slot + k, __ATOMIC_RELAXED, __HIP_MEMORY_SCOPE_AGENT));
            R[row] = rsqrtf(t * (1.f / DM) + EPS); }
        asm volatile("s_waitcnt lgkmcnt(0)" ::: "memory"); __builtin_amdgcn_s_barrier(); asm volatile("" ::: "memory");
        f32x4 gv[2][2];
#pragma unroll
        for (int bj = 0; bj < 2; ++bj)
#pragma unroll
            for (int n = 0; n < 2; ++n) gv[bj][n] = *(const f32x4*)(gfin + col0 + bj * 128 + n * 16);
#pragma unroll
        for (int ai = 0; ai < 2; ++ai)
#pragma unroll
            for (int m = 0; m < 4; ++m) { const int rl = ai * 128 + wr * 64 + m * 16 + fr; const size_t off = (size_t)(u.pm * 256 + rl) * 1024 + col0; const float rs = R[rl];
#pragma unroll
                for (int bj = 0; bj < 2; ++bj)
#pragma unroll
                    for (int n = 0; n < 2; ++n) *(f32x4*)(out + off + bj * 128 + n * 16) = acc[ai][bj][m][n] * rs * gv[bj][n]; }
    }
};
#define RLX_AGENT __ATOMIC_RELAXED, __HIP_MEMORY_SCOPE_AGENT
#define XB_TMO      128
#define XB_XCNT(j)  (256  + 64 * (j))
#define XB_XSUB(j)  (1280 + 64 * (j))
#define XB_XGEN(j)  (2304 + 64 * (j))
#define XB_TOP      3328
#define XB_TOPGEN   3392
#define XCD_BAR_WORDS 3456
#define XB_SPIN_CAP (1u << 18)

__device__ __forceinline__ unsigned xb_ld(unsigned* p)              { return __hip_atomic_load(p, __ATOMIC_RELAXED, __HIP_MEMORY_SCOPE_AGENT); }
__device__ __forceinline__ unsigned xb_add(unsigned* p, unsigned v) { return __hip_atomic_fetch_add(p, v, __ATOMIC_RELAXED, __HIP_MEMORY_SCOPE_AGENT); }
__device__ __forceinline__ unsigned xb_xcc_id() { return (unsigned)__builtin_amdgcn_s_getreg((3 << 11) | 20) & 0xFu; }
#define XB_SPIN(cond, bar) do { unsigned _sp = 0; while (cond) { __builtin_amdgcn_s_sleep(1); \
    if ((++_sp & 255u) == 0u) { if (xb_ld(&(bar)[XB_TMO])) break; if (_sp > XB_SPIN_CAP) { atomicAdd(&(bar)[XB_TMO], 1u); break; } } } } while (0)

struct XcdBarrier {
    unsigned* bar; unsigned x;
    volatile LAS unsigned* st;
};

__device__ __forceinline__ XcdBarrier xcd_barrier_post(unsigned* bar, volatile LAS unsigned* st) {
    XcdBarrier b; b.bar = bar; b.x = xb_xcc_id(); b.st = st;
    if (threadIdx.x == 0) (void)xb_add(&bar[XB_XCNT(b.x)], 1u);
    return b;
}
__device__ __forceinline__ void xcd_barrier_complete(unsigned* bar, unsigned x, unsigned& nloc, unsigned& nx) {
    const unsigned G = gridDim.x * gridDim.y * gridDim.z;
    unsigned sum, cnt, mine, sp = 0u;
    for (;;) {
        sum = 0u; cnt = 0u; mine = 0u;
#pragma unroll
        for (unsigned j = 0; j < 16; ++j) { const unsigned c = xb_ld(&bar[XB_XCNT(j)]); sum += c; cnt += (c > 0u) ? 1u : 0u; mine = (j == x) ? c : mine; }
        if (sum == G) break;
        __builtin_amdgcn_s_sleep(1);
        if ((++sp & 255u) == 0u) { if (xb_ld(&bar[XB_TMO])) break; if (sp > XB_SPIN_CAP) { atomicAdd(&bar[XB_TMO], 1u); break; } }
    }
    nloc = mine > 0u ? mine : 1u; nx = cnt > 0u ? cnt : 1u;
}

__device__ __forceinline__ void xcd_barrier(const XcdBarrier& b) {
    asm volatile("s_waitcnt vmcnt(0)" ::: "memory");
    __syncthreads();
    if (threadIdx.x == 0) {
        unsigned* bar = b.bar;
        __builtin_amdgcn_s_waitcnt(0);
        unsigned nloc = b.st[0], nx = b.st[1];
        if (nloc == 0u) { xcd_barrier_complete(bar, b.x, nloc, nx); b.st[0] = nloc; b.st[1] = nx; }
        const unsigned old = xb_add(&bar[XB_XSUB(b.x)], 1u);
        const unsigned gen = old / nloc;
        if (old + 1u == (gen + 1u) * nloc) {
            __builtin_amdgcn_fence(__ATOMIC_RELEASE, "agent");
            asm volatile("s_waitcnt vmcnt(0)" ::: "memory");
            const unsigned og = xb_add(&bar[XB_TOP], 1u);
            const unsigned tg = og / nx;
            if (og + 1u == (tg + 1u) * nx) xb_add(&bar[XB_TOPGEN], 1u);
            else XB_SPIN(xb_ld(&bar[XB_TOPGEN]) == tg, bar);
            __builtin_amdgcn_fence(__ATOMIC_ACQUIRE, "agent");
            xb_add(&bar[XB_XGEN(b.x)], 1u);
            asm volatile("s_waitcnt vmcnt(0)" ::: "memory");
        } else {
            XB_SPIN(xb_ld(&bar[XB_XGEN(b.x)]) == gen, bar);
            __builtin_amdgcn_fence(__ATOMIC_ACQUIRE, "agent");
            asm volatile("s_waitcnt vmcnt(0)" ::: "memory");
        }
    }
    __syncthreads();
}

__device__ __forceinline__ void p2_wave(const u16* Gp, const u16* Vp, int nrows, int h, u16* Uout, float* dk, int lane) {
    const int r = lane & 15, q = lane >> 4;
    bf16x8 kf[8][2]; float tot1[8];
#pragma unroll
    for (int kk = 0; kk < 2; ++kk) { const int ks = 1 - kk;
#pragma unroll
        for (int dg = 0; dg < 2; ++dg) {
            int zz = 0; asm volatile("" : "+v"(zz));
            u32x4 wq[4];
#pragma unroll
            for (int p2 = 0; p2 < 2; ++p2) { const int dp = 2 * dg + p2; const int dcol = 32 * dp + 2 * r + zz; unsigned gw[8];
#pragma unroll
                for (int j = 0; j < 8; ++j) { const int s = 32 * ks + 8 * q + j; gw[j] = s < nrows ? *(const unsigned*)(Gp + (size_t)s * 1024 + h * 128 + dcol) : 0u; }
#pragma unroll
                for (int par = 0; par < 2; ++par) { const int dt = 2 * dp + par; float gv[8];
#pragma unroll
                    for (int j = 0; j < 8; ++j) gv[j] = h2f((u16)(par ? (gw[j] >> 16) : (gw[j] & 0xffffu)));
                    float suf[8]; float run = 0.f;
#pragma unroll
                    for (int j = 7; j >= 0; --j) { suf[j] = run; run += gv[j]; }
                    const float T = run, ta = __shfl_xor(T, 16), tb = __shfl_xor(T, 32), tc = __shfl_xor(ta, 32);
                    const float after = ((q ^ 1) > q ? ta : 0.f) + ((q ^ 2) > q ? tb : 0.f) + ((q ^ 3) > q ? tc : 0.f);
                    const float tot = (T + ta) + (tb + tc);
                    float base;
                    if (ks == 1) { tot1[dt] = tot; base = after; } else { base = after + tot1[dt]; if (dk && q == 0) dk[h * 128 + dcol + par] = __expf(tot + tot1[dt]); }
                    float kh[8];
#pragma unroll
                    for (int j = 0; j < 8; ++j) kh[j] = (1.0f - __expf(gv[j])) * __expf(suf[j] + base);
                    u32x4& w = wq[2 * p2 + par];
                    w.x = cvt_pk_bf16(kh[0], kh[1]); w.y = cvt_pk_bf16(kh[2], kh[3]); w.z = cvt_pk_bf16(kh[4], kh[5]); w.w = cvt_pk_bf16(kh[6], kh[7]); } }
            asm volatile("" : "+v"(wq[0].x), "+v"(wq[0].y), "+v"(wq[0].z), "+v"(wq[0].w), "+v"(wq[1].x), "+v"(wq[1].y), "+v"(wq[1].z), "+v"(wq[1].w),
                              "+v"(wq[2].x), "+v"(wq[2].y), "+v"(wq[2].z), "+v"(wq[2].w), "+v"(wq[3].x), "+v"(wq[3].y), "+v"(wq[3].z), "+v"(wq[3].w));
#pragma unroll
            for (int d4 = 0; d4 < 4; ++d4) kf[4 * dg + d4][ks] = __builtin_bit_cast(bf16x8, wq[d4]); } }
#pragma unroll 1
    for (int ep = 0; ep < 4; ++ep) {
        int zz = 0; asm volatile("" : "+v"(zz)); const int ecol = 32 * ep + 2 * r + zz;
        unsigned vw[2][8];
#pragma unroll
        for (int ks = 0; ks < 2; ++ks)
#pragma unroll
            for (int j = 0; j < 8; ++j) { const int s = 32 * ks + 8 * q + j; vw[ks][j] = s < nrows ? *(const unsigned*)(Vp + (size_t)s * 1024 + h * 128 + ecol) : 0u; }
#pragma unroll
        for (int par = 0; par < 2; ++par) {
            bf16x8 vf[2];
#pragma unroll
            for (int ks = 0; ks < 2; ++ks) { u32x4 w;
                if (par == 0) { w.x = (vw[ks][0] & 0xffffu) | (vw[ks][1] << 16); w.y = (vw[ks][2] & 0xffffu) | (vw[ks][3] << 16); w.z = (vw[ks][4] & 0xffffu) | (vw[ks][5] << 16); w.w = (vw[ks][6] & 0xffffu) | (vw[ks][7] << 16); }
                else { w.x = (vw[ks][0] >> 16) | (vw[ks][1] & 0xffff0000u); w.y = (vw[ks][2] >> 16) | (vw[ks][3] & 0xffff0000u); w.z = (vw[ks][4] >> 16) | (vw[ks][5] & 0xffff0000u); w.w = (vw[ks][6] >> 16) | (vw[ks][7] & 0xffff0000u); }
                vf[ks] = __builtin_bit_cast(bf16x8, w); }
            f32x4 acc[8];
#pragma unroll
            for (int dt = 0; dt < 8; ++dt) { acc[dt] = (f32x4){0.f, 0.f, 0.f, 0.f};
#pragma unroll
                for (int ks = 0; ks < 2; ++ks) acc[dt] = __builtin_amdgcn_mfma_f32_16x16x32_bf16(kf[dt][ks], vf[ks], acc[dt], 0, 0, 0); }
#pragma unroll
            for (int dp = 0; dp < 4; ++dp) { u32x4 w; w.x = cvt_pk_bf16(acc[2 * dp][0], acc[2 * dp + 1][0]); w.y = cvt_pk_bf16(acc[2 * dp][1], acc[2 * dp + 1][1]); w.z = cvt_pk_bf16(acc[2 * dp][2], acc[2 * dp + 1][2]); w.w = cvt_pk_bf16(acc[2 * dp][3], acc[2 * dp + 1][3]);
                { const int e = 32 * ep + 2 * r + par;
                  *(u32x4*)(Uout + ((size_t)((e >> 4) * 4 + dp) * 64 + q * 16 + (e & 15)) * 8) = w; } } }
    }
}
__device__ __forceinline__ void p2_states(const Args& a, int G) {
    const int tid = threadIdx.x, lane = tid & 63, wave = __builtin_amdgcn_readfirstlane(tid >> 6);
    const u16* Gb = (const u16*)(a.ws + WS_G); const u16* Vb = (const u16*)(a.ws + WS_V); u16* US = (u16*)a.out; float* DK = (float*)(a.ws + WS_DK);
    for (int it = blockIdx.x; it < BATCH * NCH + (G == 256 ? 0 : 1); it += G) {
        if (it < BATCH * NCH) { const size_t row0 = (size_t)it * CHK;
            p2_wave(Gb + row0 * 1024, Vb + row0 * 1024, CHK, wave, US + ((size_t)it * 8 + wave) * 16384, DK + (size_t)it * 1024, lane); }
        else p2_wave((const u16*)(a.ws + WS_GM), (const u16*)(a.ws + WS_VM), NMETA, wave, (u16*)(a.ws + WS_UM) + (size_t)wave * 16384, nullptr, lane);
    }
}

__device__ __forceinline__ void p3_scan(const Args& a, LAS unsigned char* lds, int G) {
    const int tid = threadIdx.x, lane = tid & 63, wave = __builtin_amdgcn_readfirstlane(tid >> 6);
    {
        LAS float* scr = (LAS float*)(lds + wave * 16384);
        const int gw = (int)blockIdx.x * NWAVES + wave, NGW = G * NWAVES;
        for (int it = gw; it < 2 * 16 * 88; it += NGW) { const int up = it >= 16 * 88, r = up ? it - 16 * 88 : it, kb = r / 88, nb = r % 88, n0 = 32 * nb;
            tr_item(up ? a.w_up : a.w_gate, DFF, 64 * kb, n0, (u16*)(a.ws + WS_WGU), (n0 >> 7) * 256 + (n0 & 127) + (up ? 128 : 0), 1024, 0, a.g_ffn, scr, lane); }
    }
    u16* US = (u16*)a.out; const float* DK = (const float*)(a.ws + WS_DK); const u16* UM = (const u16*)(a.ws + WS_UM);
    for (int idx = blockIdx.x * NTHR + tid; idx < BATCH * 8 * 128 * 64; idx += G * NTHR) {
        const int pr = idx & 8191, h = (idx >> 13) & 7, b = idx >> 16;
        const int d = 32 * ((pr >> 8) & 3) + 8 * ((pr >> 6) & 3) + 2 * (pr & 3);
        const unsigned um = *(const unsigned*)(UM + (size_t)h * 16384 + 2 * pr);
        float s0 = bf_lo(um), s1 = bf_hi(um);
        unsigned* up = (unsigned*)(US + ((size_t)(b * NCH) * 8 + h) * 16384 + 2 * pr);
        const float* dkp = DK + (size_t)(b * NCH) * 1024 + h * 128 + d;
#pragma unroll 1
        for (int c0 = 0; c0 < NCH; c0 += 16) {
            unsigned uu[16]; float dd0[16], dd1[16];
#pragma unroll
            for (int i = 0; i < 16; ++i) { uu[i] = up[(size_t)(c0 + i) * 8 * 8192]; const f32v2_t dk2 = *(const f32v2_t*)(dkp + (size_t)(c0 + i) * 1024); dd0[i] = dk2[0]; dd1[i] = dk2[1]; }
#pragma unroll
            for (int i = 0; i < 16; ++i) { up[(size_t)(c0 + i) * 8 * 8192] = cvt_pk_bf16(s0, s1); s0 = dd0[i] * s0 + bf_lo(uu[i]); s1 = dd1[i] * s1 + bf_hi(uu[i]); }
        }
    }
}

constexpr int P4_PITCH = 272, P4_MAT = 64 * P4_PITCH  , P4_VPITCH = 136, P4_HS = 4 * P4_MAT  , P4_TOT = 2 * P4_HS  , P4_PLD = P4_TOT + 4096  ;
static_assert(P4_PLD + P4_MAT + 64 <= LDS_BYTES, "LDS map");
__device__ __forceinline__ unsigned ld_pl(const u16* PB, const u16* PLM, int b, int tx, int cofs) {
    return tx >= 0 ? *(const unsigned*)(PB + (size_t)(b * SEQ + tx) * 1024 + 512 + cofs) : *(const unsigned*)(PLM + (size_t)(NMETA + tx) * 512 + cofs);
}
__device__ __forceinline__ void p4_outputs(const Args& a, LAS unsigned char* lds, int G, int skip = 0) {
    (void)skip;
    const int tid = threadIdx.x, lane = tid & 63, wave = __builtin_amdgcn_readfirstlane(tid >> 6);
    const int r = lane & 15, q = lane >> 4;
    u16* Qb = (u16*)(a.ws + WS_Q); const u16* Gb = (const u16*)(a.ws + WS_G); const u16* Vb = (const u16*)(a.ws + WS_V); const u16* OGb = (const u16*)(a.ws + WS_OG);
    u16* PB = (u16*)(a.ws + WS_PB); const u16* PLM = (const u16*)(a.ws + WS_PLM); const u16* PWT = (const u16*)(a.ws + WS_PWT); const u16* US = (const u16*)a.out;
    LAS unsigned char* PLD = lds + P4_PLD;
    for (int item = blockIdx.x; item < BATCH * NCH * 4; item += G) {
        const int hp = item & 3, bc = item >> 2, c = bc & (NCH - 1), b = bc >> 7;
        const size_t row0 = (size_t)b * SEQ + (size_t)c * CHK;
        const int hs = wave >> 2, tq = wave & 3, h = 2 * hp + hs;
        LAS unsigned char* L = lds + hs * P4_HS;
        LAS unsigned char* KT = L, *QT = L + P4_MAT, *QH = L + 2 * P4_MAT, *VT = L + 3 * P4_MAT;
        LAS float* TOT = (LAS float*)(lds + P4_TOT) + hs * 512;
        const int d0 = 2 * lane; const size_t cofs = (size_t)h * 128 + d0;
        unsigned gp[16], qv[16], vv[16];
#pragma unroll
        for (int i = 0; i < 16; ++i) { const size_t o = (row0 + 16 * tq + i) * 1024 + cofs; gp[i] = __builtin_nontemporal_load((const unsigned*)(Gb + o)); qv[i] = __builtin_nontemporal_load((const unsigned*)(Qb + o)); vv[i] = __builtin_nontemporal_load((const unsigned*)(Vb + o)); }
        const int gi = hp, wlen = 2 << gi; const float inv = 1.0f / (float)wlen;
        const int t0 = 8 * wave, pcofs = gi * 128 + 2 * lane, tx0 = c * CHK + t0;
        unsigned pu[23];
#pragma unroll
        for (int j = 1; j < 16; ++j) pu[15 - j] = (j < wlen) ? ld_pl(PB, PLM, b, tx0 - j, pcofs) : 0u;
#pragma unroll
        for (int i = 0; i < 8; ++i) pu[15 + i] = ld_pl(PB, PLM, b, tx0 + i, pcofs);
        bf16x8 wf[4];
#pragma unroll
        for (int kd = 0; kd < 4; ++kd) wf[kd] = *(const bf16x8*)(PWT + (size_t)(gi * 128 + 16 * wave + r) * 128 + 32 * kd + 8 * q);
        float s0 = 0.f, s1 = 0.f;
#pragma unroll
        for (int i = 0; i < 16; ++i) { s0 += h2f((u16)(gp[i] & 0xffffu)); s1 += h2f((u16)(gp[i] >> 16)); }
        TOT[tq * 128 + d0] = s0; TOT[tq * 128 + d0 + 1] = s1;
        __syncthreads();
        {
            float w0 = 0.f, w1 = 0.f;
#pragma unroll
            for (int j = 1; j < 16; ++j) if (j < wlen) { w0 += bf_lo(pu[15 - j]); w1 += bf_hi(pu[15 - j]); }
#pragma unroll
            for (int i = 0; i < 8; ++i) { const float u0 = bf_lo(pu[15 + i]), u1 = bf_hi(pu[15 + i]); w0 += u0; w1 += u1;
                *(LAS unsigned*)(PLD + (t0 + i) * P4_PITCH + 4 * lane) = cvt_pk_bf16(w0 * inv - u0, w1 * inv - u1);
                const unsigned o = wlen == 2 ? pu[15 + i - 1] : (wlen == 4 ? pu[15 + i - 3] : (wlen == 8 ? pu[15 + i - 7] : pu[15 + i - 15]));
                w0 -= bf_lo(o); w1 -= bf_hi(o); }
        }
        float b0 = 0.f, b1 = 0.f;
#pragma unroll
        for (int t2 = 0; t2 < 3; ++t2) if (t2 < tq) { b0 += TOT[t2 * 128 + d0]; b1 += TOT[t2 * 128 + d0 + 1]; }
        const float bm0 = TOT[d0] + TOT[128 + d0], bm1 = TOT[d0 + 1] + TOT[128 + d0 + 1];
#pragma unroll
        for (int i = 0; i < 16; ++i) { const int t = 16 * tq + i; const float g0 = h2f((u16)(gp[i] & 0xffffu)), g1 = h2f((u16)(gp[i] >> 16)); b0 += g0; b1 += g1;
            const unsigned q2 = qv[i], v2 = vv[i];
            const float q0 = bf_lo(q2), q1 = bf_hi(q2), k0 = 1.0f - __expf(g0), k1 = 1.0f - __expf(g1);
            const float eb0 = __expf(b0), eb1 = __expf(b1), em0 = __expf(fminf(b0 - bm0, 80.f)), em1 = __expf(fminf(b1 - bm1, 80.f)), ek0 = __expf(fminf(bm0 - b0, 80.f)), ek1 = __expf(fminf(bm1 - b1, 80.f));
            *(LAS unsigned*)(QT + t * P4_PITCH + d0 * 2) = cvt_pk_bf16(q0 * em0, q1 * em1);
            *(LAS unsigned*)(QH + t * P4_PITCH + d0 * 2) = cvt_pk_bf16(q0 * eb0, q1 * eb1);
            *(LAS unsigned*)(KT + t * P4_PITCH + d0 * 2) = cvt_pk_bf16(k0 * ek0, k1 * ek1);
            *(LAS u16*)(VT + d0 * P4_VPITCH + t * 2) = (u16)(v2 & 0xffffu); *(LAS u16*)(VT + (d0 + 1) * P4_VPITCH + t * 2) = (u16)(v2 >> 16); }
        const u16* Sp = US + ((size_t)bc * 8 + h) * 16384;
        bf16x8 sfr[8][4];
#pragma unroll
        for (int et = 0; et < 8; ++et)
#pragma unroll
            for (int kd = 0; kd < 4; ++kd) sfr[et][kd] = *(const bf16x8*)(Sp + ((size_t)(et * 4 + kd) * 64 + lane) * 8);
        const int tt = tq;
        const size_t orow = (row0 + 16 * tt + r) * 1024 + (size_t)h * 128;
        __syncthreads();
        u32x2 ogv[8];
#pragma unroll
        for (int et = 0; et < 8; ++et) ogv[et] = __builtin_nontemporal_load((const u32x2*)(OGb + orow + 16 * et + 4 * q));
        {
            f32x4 acc[4];
#pragma unroll
            for (int t4 = 0; t4 < 4; ++t4) acc[t4] = (f32x4){0.f, 0.f, 0.f, 0.f};
#pragma unroll
            for (int kd = 0; kd < 4; ++kd)
#pragma unroll
                for (int t4 = 0; t4 < 4; ++t4) { const bf16x8 pfr = *(const LAS bf16x8*)(PLD + (16 * t4 + r) * P4_PITCH + (32 * kd + 8 * q) * 2); acc[t4] = __builtin_amdgcn_mfma_f32_16x16x32_bf16(wf[kd], pfr, acc[t4], 0, 0, 0); }
            const int n0 = gi * 128 + 16 * wave + 4 * q; const f32x4 psc = *(const f32x4*)(a.pool_scale + n0);
#pragma unroll
            for (int t4 = 0; t4 < 4; ++t4) { u32x2 w; w.x = cvt_pk_bf16(acc[t4][0] * psc[0], acc[t4][1] * psc[1]); w.y = cvt_pk_bf16(acc[t4][2] * psc[2], acc[t4][3] * psc[3]);
                *(u32x2*)(PB + (row0 + 16 * t4 + r) * 1024 + n0) = w; }
        }
        bf16x8 qt[4], qh[4];
#pragma unroll
        for (int kd = 0; kd < 4; ++kd) { qt[kd] = *(const LAS bf16x8*)(QT + (16 * tt + r) * P4_PITCH + (32 * kd + 8 * q) * 2); qh[kd] = *(const LAS bf16x8*)(QH + (16 * tt + r) * P4_PITCH + (32 * kd + 8 * q) * 2); }
        f32x4 sc[4];
#pragma unroll
        for (int st = 0; st < 4; ++st) { f32x4 acc = (f32x4){0.f, 0.f, 0.f, 0.f};
            if (st <= tt) {
#pragma unroll
                for (int kd = 0; kd < 4; ++kd) { const bf16x8 kfr = *(const LAS bf16x8*)(KT + (16 * st + r) * P4_PITCH + (32 * kd + 8 * q) * 2); acc = __builtin_amdgcn_mfma_f32_16x16x32_bf16(kfr, qt[kd], acc, 0, 0, 0); }
                if (st == tt) {
#pragma unroll
                    for (int i = 0; i < 4; ++i) if (4 * q + i > r) acc[i] = 0.f; }
            }
            sc[st] = acc; }
        bf16x8 pf[2];
#pragma unroll
        for (int ks = 0; ks < 2; ++ks) { u32x4 w; w.x = cvt_pk_bf16(sc[2 * ks][0], sc[2 * ks][1]); w.y = cvt_pk_bf16(sc[2 * ks][2], sc[2 * ks][3]); w.z = cvt_pk_bf16(sc[2 * ks + 1][0], sc[2 * ks + 1][1]); w.w = cvt_pk_bf16(sc[2 * ks + 1][2], sc[2 * ks + 1][3]);
            pf[ks] = __builtin_bit_cast(bf16x8, w); }
        f32x4 oa[8]; float ss = 0.f;
#pragma unroll
        for (int et = 0; et < 8; ++et) { f32x4 acc = (f32x4){0.f, 0.f, 0.f, 0.f};
#pragma unroll
            for (int kd = 0; kd < 4; ++kd) acc = __builtin_amdgcn_mfma_f32_16x16x32_bf16(sfr[et][kd], qh[kd], acc, 0, 0, 0);
#pragma unroll
            for (int ks = 0; ks < 2; ++ks) if (2 * ks <= tt) {
                const u32x2 lo = *(const LAS u32x2*)(VT + (16 * et + r) * P4_VPITCH + (32 * ks + 4 * q) * 2), hi = *(const LAS u32x2*)(VT + (16 * et + r) * P4_VPITCH + (32 * ks + 16 + 4 * q) * 2);
                const u32x4 w = (u32x4){lo.x, lo.y, hi.x, hi.y};
                acc = __builtin_amdgcn_mfma_f32_16x16x32_bf16(__builtin_bit_cast(bf16x8, w), pf[ks], acc, 0, 0, 0); }
            oa[et] = acc; ss += (acc[0] * acc[0] + acc[1] * acc[1]) + (acc[2] * acc[2] + acc[3] * acc[3]); }
        ss += __shfl_xor(ss, 16); ss += __shfl_xor(ss, 32);
        const float rstd = rsqrtf(ss * (1.f / 128.f) + EPS);
#pragma unroll
        for (int et = 0; et < 8; ++et) { const int e0 = 16 * et + 4 * q; const f32x4 gn = *(const f32x4*)(a.g_hn + e0); const u32x2 og = ogv[et];
            u32x2 w; w.x = cvt_pk_bf16(oa[et][0] * rstd * gn[0] * bf_lo(og.x), oa[et][1] * rstd * gn[1] * bf_hi(og.x)); w.y = cvt_pk_bf16(oa[et][2] * rstd * gn[2] * bf_lo(og.y), oa[et][3] * rstd * gn[3] * bf_hi(og.y));
            *(LAS u32x2*)(QT + (16 * tt + r) * P4_PITCH + e0 * 2) = w; }
        asm volatile("s_waitcnt lgkmcnt(0)" ::: "memory");
#pragma unroll
        for (int i = 0; i < 4; ++i) { const int rr = 16 * tt + 4 * i + (lane >> 4); const u32x4 v = *(const LAS u32x4*)(QT + rr * P4_PITCH + (lane & 15) * 16);
            *(u32x4*)(Qb + (row0 + rr) * 1024 + (size_t)h * 128 + (lane & 15) * 8) = v; }
    }
    __syncthreads();
}

__device__ __forceinline__ void p9_final(const Args& a, int G) {
    const int tid = threadIdx.x, lane = tid & 63, wave = __builtin_amdgcn_readfirstlane(tid >> 6);
    const float* rsq = (const float*)(a.ws + WS_RSQ);
    const f32x4* gr = (const f32x4*)a.g_fin + lane; f32x4 gv[4];
#pragma unroll
    for (int j = 0; j < 4; ++j) gv[j] = gr[64 * j];
    for (int m = 2 * (blockIdx.x * NWAVES + wave); m < M; m += 2 * G * NWAVES) {
        float p = lane < 32 ? rsq[(size_t)m * 16 + lane] : 0.f;
        f32x4* xr = (f32x4*)(a.out + (size_t)m * DM) + lane; f32x4 v[8];
#pragma unroll
        for (int j = 0; j < 8; ++j) v[j] = xr[64 * j];
        p += __shfl_xor(p, 1); p += __shfl_xor(p, 2); p += __shfl_xor(p, 4); p += __shfl_xor(p, 8);
        const float r0 = rsqrtf(__shfl(p, 0) * (1.f / DM) + EPS), r1 = rsqrtf(__shfl(p, 16) * (1.f / DM) + EPS);
#pragma unroll
        for (int j = 0; j < 8; ++j) { const float rs = j < 4 ? r0 : r1; const f32x4 g4 = gv[j & 3]; xr[64 * j] = (f32x4){v[j].x * rs * g4.x, v[j].y * rs * g4.y, v[j].z * rs * g4.z, v[j].w * rs * g4.w}; }
    }
}

#ifdef PROBE_STOP
__device__ __forceinline__ void p_dump(const Args& a, int G) {
    const u16* Qb = (const u16*)(a.ws + WS_Q); const u16* Gb = (const u16*)(a.ws + WS_G); const u16* Vb = (const u16*)(a.ws + WS_V); const u16* OGb = (const u16*)(a.ws + WS_OG);
    const u16* GAb = (const u16*)(a.ws + WS_GA); const u16* GBb = (const u16*)(a.ws + WS_GB); const u16* PB = (const u16*)(a.ws + WS_PB);
    for (size_t i = (size_t)blockIdx.x * NTHR + threadIdx.x; i < (size_t)M * DM; i += (size_t)G * NTHR) {
        float v = 0.f;
        if (PROBE_STOP == 1) v = bf1(Qb[i]) + h2f(Gb[i]) + bf1(Vb[i]) + bf1(OGb[i]) + bf1(GAb[i]) + bf1(GBb[i]) + bf1(PB[i]);
        else if (PROBE_STOP == 2 || PROBE_STOP == 3) { float t = bf1(((const u16*)a.out)[i]) + bf1(((const u16*)a.out)[i + (size_t)M * DM]); if (!(fabsf(t) < 1e30f)) t = 12345.f; ((float*)(a.ws + WS_GA))[i] = t; continue; }
        else if (PROBE_STOP == 4) v = bf1(Qb[i]) + bf1(PB[i]);
        else if (PROBE_STOP == 5) v = bf1(Gb[i]);
        else continue;
        a.out[i] = v;
    }
}
#endif
__device__ __forceinline__ void flat_barrier(unsigned* cnt) {
    asm volatile("s_waitcnt vmcnt(0)" ::: "memory");
    __syncthreads();
    if (threadIdx.x == 0) {
        const unsigned Gn = gridDim.x;
        __builtin_amdgcn_fence(__ATOMIC_RELEASE, "agent");
        asm volatile("s_waitcnt vmcnt(0)" ::: "memory");
        const unsigned old = __hip_atomic_fetch_add(cnt, 1u, __ATOMIC_RELAXED, __HIP_MEMORY_SCOPE_AGENT);
        const unsigned target = (old / Gn + 1u) * Gn; unsigned sp = 0;
        while (__hip_atomic_load(cnt, __ATOMIC_RELAXED, __HIP_MEMORY_SCOPE_AGENT) < target) { __builtin_amdgcn_s_sleep(1); if (++sp > (1u << 22)) break; }
        __builtin_amdgcn_fence(__ATOMIC_ACQUIRE, "agent");
        asm volatile("s_waitcnt vmcnt(0)" ::: "memory");
    }
    __syncthreads();
}
constexpr int NPH = 10;
__global__ void __launch_bounds__(NTHR, 2) mega(Args a) {
    extern __shared__ __attribute__((aligned(16))) unsigned char lds_raw[];
    LAS unsigned char* lds = (LAS unsigned char*)lds_raw;
    cg::grid_group grid = cg::this_grid();
    const int G = gridDim.x, lo = a.ph_lo, hi = a.ph_hi;
    unsigned char* ws = a.ws;
    volatile LAS unsigned* MISC = (volatile LAS unsigned*)(lds + LDS_BYTES - 64);
    if (threadIdx.x < 16) MISC[threadIdx.x] = 0u;
    __syncthreads();
    XcdBarrier bar; bar.bar = (unsigned*)(ws + WS_BAR); bar.x = 0; bar.st = nullptr;
    if (hi - lo > 1) bar = xcd_barrier_post((unsigned*)(ws + WS_BAR), MISC);
    if (hi < 0) grid.sync();
#ifndef PHMASK
#define PHMASK 0x3ff
#endif
#define IN(k) (((PHMASK >> (k)) & 1) && lo <= (k) && (k) < hi)
#ifndef CG_SEAMS
#define CG_SEAMS 0x0
#endif
#define SEAM(k) do { if (IN(k) && IN((k) + 1)) { if ((CG_SEAMS >> (k)) & 1) grid.sync(); else xcd_barrier(bar); } } while (0)
#ifndef PROBE_DUP
#define PROBE_DUP 0
#endif
#ifndef PROBE_XSYNC
#define PROBE_XSYNC 0
#endif
#define DUP(k) (((PROBE_DUP >> (k)) & 1) ? 2 : 1)
    if (IN(0)) { p0_prologue(a, lds, G); } SEAM(0);
#ifdef PROBE_XBAR
    for (int xs = 0; xs < PROBE_XBAR; ++xs) flat_barrier((unsigned*)(ws + WS_BAR + 14 * KiB));
#endif
    if (IN(1)) { pg8::Gemm g{(const u16*)a.out, (const u16*)(ws + WS_WIN), M, INW, DM, DM, 1 << 30, 0L}; pg8::StaticOrder S; S.init(M, INW, G, (int)blockIdx.x);
        EpiIn E{ws}; pg8::gemm_phase<EpiIn, true>(lds, g, S, E);
        if (G == 256 && blockIdx.x == 255) p2_wave((const u16*)(ws + WS_GM), (const u16*)(ws + WS_VM), NMETA, (int)(threadIdx.x >> 6), (u16*)(ws + WS_UM) + (size_t)(threadIdx.x >> 6) * 16384, nullptr, (int)(threadIdx.x & 63));
        else if (G == 256 && blockIdx.x >= 128) late_weights(a, lds, ((int)blockIdx.x - 128) * NWAVES + (int)(threadIdx.x >> 6), 127 * NWAVES); }
    SEAM(1);
    if (IN(2)) { p2_states(a, G); } SEAM(2);
    if (IN(3)) { p3_scan(a, lds, G); } SEAM(3);
    if (IN(4)) { p4_outputs(a, lds, G); } SEAM(4);
    if (IN(5)) { pg8::Gemm g{(const u16*)(ws + WS_Q), (const u16*)(ws + WS_WAB), M, DM, 1536, DM, 16, (long)(WS_PB - WS_Q) - 16L * 128L}; pg8::StaticOrder S; S.init(M, DM, G, (int)blockIdx.x);
        EpiMerge E{(const u16*)(ws + WS_GA), (const u16*)(ws + WS_GB), (u16*)(ws + WS_MG)}; pg8::gemm_phase<EpiMerge, false>(lds, g, S, E); } SEAM(5);
    if (IN(6)) { pg8::Gemm g{(const u16*)(ws + WS_MG), (const u16*)(ws + WS_WOUT), M, DM, DM, DM, 1 << 30, 0L}; pg8::StaticOrder S; S.init(M, DM, G, (int)blockIdx.x);
        const bool fuse9_ = (G == (M / 256) * (DM / 256)) && (hi - lo > 1);
        EpiRes<true> E{a.x, fuse9_ ? nullptr : a.out, (u16*)(ws + WS_H1B), (float*)(ws + WS_RSQ)}; pg8::gemm_phase<EpiRes<true>, false>(lds, g, S, E); } SEAM(6);
    if (IN(7)) { pg8::Gemm g{(const u16*)(ws + WS_H1B), (const u16*)(ws + WS_WGU), M, NGU, DM, DM, 1 << 30, 0L}; pg8::StaticOrder S; S.init(M, NGU, G, (int)blockIdx.x);
        EpiFfn1 E{(const float*)(ws + WS_RSQ), (u16*)(ws + WS_ACT)}; pg8::gemm_phase<EpiFfn1, true>(lds, g, S, E); } SEAM(7);
    const bool fuse9 = (G == (M / 256) * (DM / 256)) && (hi - lo > 1);
    if (IN(8)) { pg8::Gemm g{(const u16*)(ws + WS_ACT), (const u16*)(ws + WS_WD), M, DM, DFF, DFF, 1 << 30, 0L}; pg8::StaticOrder S; S.init(M, DM, G, (int)blockIdx.x);
        if (fuse9) { EpiResNorm E{(const u16*)(ws + WS_H1B), a.out, a.g_fin, (float*)(ws + WS_RSQ), (unsigned*)(ws + WS_CNT)}; pg8::gemm_phase<EpiResNorm, false>(lds, g, S, E); }
        else { EpiRes<false> E{a.out, a.out, nullptr, (float*)(ws + WS_RSQ)}; pg8::gemm_phase<EpiRes<false>, false>(lds, g, S, E); } }
    if (!fuse9) { SEAM(8);
    if (IN(9)) { p9_final(a, G); } }
#ifdef PROBE_LIST
    if (lo == 20) p0_prologue(a, lds, G, 1);
    if (lo == 30) p0_prologue(a, lds, G, 2);
    if (lo == 40) p0_prologue(a, lds, G, 4);
    if (lo == 14) p4_outputs(a, lds, G, 1);
    if (lo == 24) p4_outputs(a, lds, G, 2);
    if (lo == 34) p4_outputs(a, lds, G, 2 | 4);
    if (lo == 44) p4_outputs(a, lds, G, 2 | 8);
    if (lo == 54) p4_outputs(a, lds, G, 2 | 16);
    if (lo == 64) p4_outputs(a, lds, G, 2 | 32);
    if (lo == 74) p4_outputs(a, lds, G, 2 | 64);
    if (lo == 18) { pg8::Gemm g{(const u16*)(ws + WS_ACT), (const u16*)(ws + WS_WD), M, DM, DFF, DFF, 1 << 30, 0L}; pg8::StaticOrder S; S.init(M, DM, G, (int)blockIdx.x);
        EpiRes<false> E{(const float*)(ws + WS_GA), (float*)(ws + WS_GA), nullptr, (float*)(ws + WS_OG)}; pg8::gemm_phase<EpiRes<false>, false>(lds, g, S, E); }
    if (lo == 19) { Args b = a; b.out = (float*)(ws + WS_GA); p9_final(b, G); }
#endif
#ifdef PROBE_STOP
    if (lo == 10) p_dump(a, G);
    if (lo == 11 && (PROBE_STOP == 2 || PROBE_STOP == 3)) { for (size_t i = (size_t)blockIdx.x * NTHR + threadIdx.x; i < (size_t)M * DM; i += (size_t)G * NTHR) a.out[i] = ((const float*)(a.ws + WS_GA))[i]; }
#endif
#undef IN
#undef SEAM
}

extern "C" void kernel_launch(void* const* d_in, const int* in_sizes, int n_in, void* d_out, int out_size, void* d_ws, size_t ws_size, hipStream_t stream) {
    static int grid = 0;
    if (grid == 0) {
        if (n_in != 16 || in_sizes[0] != M * DM || out_size != M * DM || ws_size < WS_END) { fprintf(stderr, "kernel_launch: unexpected shapes (n_in %d, in0 %d, out %d, ws %zu); nothing launched\n", n_in, n_in > 0 ? in_sizes[0] : -1, out_size, ws_size); grid = -1; return; }
        int dev = 0, cus = 0, per_cu = 0;
        (void)hipGetDevice(&dev); (void)hipDeviceGetAttribute(&cus, hipDeviceAttributeMultiprocessorCount, dev);
        if (hipFuncSetAttribute((const void*)mega, hipFuncAttributeMaxDynamicSharedMemorySize, LDS_BYTES) != hipSuccess) { fprintf(stderr, "kernel_launch: hipFuncSetAttribute failed\n"); }
        if (hipOccupancyMaxActiveBlocksPerMultiprocessor(&per_cu, (const void*)mega, NTHR, LDS_BYTES) != hipSuccess || per_cu < 1) per_cu = 1;
        (void)hipGetLastError();
        if (cus <= 0) cus = 256;
        grid = cus * per_cu;
    }
    if (grid < 0) return;
#if MK_COOP
    if (hipMemsetAsync((char*)d_ws + WS_BAR, 0, CTL_ZERO, stream) != hipSuccess) { fprintf(stderr, "kernel_launch: hipMemsetAsync of the barrier words failed\n"); return; }
#endif
    Args a{};
    a.x = (const float*)d_in[0]; a.meta = (const float*)d_in[1]; a.g_mix = (const float*)d_in[2]; a.w_in = (const float*)d_in[3]; a.lb_raw = (const float*)d_in[4]; a.g_hn = (const float*)d_in[5];
    a.pool_w = (const float*)d_in[6]; a.pool_scale = (const float*)d_in[7]; a.w_a = (const float*)d_in[8]; a.w_b = (const float*)d_in[9]; a.w_out = (const float*)d_in[10]; a.g_ffn = (const float*)d_in[11];
    a.w_gate = (const float*)d_in[12]; a.w_up = (const float*)d_in[13]; a.w_down = (const float*)d_in[14]; a.g_fin = (const float*)d_in[15];
    a.out = (float*)d_out; a.ws = (unsigned char*)d_ws;
#if MK_COOP
    a.ph_lo = 0; a.ph_hi = NPH;
    void* args[] = {&a};
    const hipError_t e = hipLaunchCooperativeKernel((const void*)mega, dim3(grid), dim3(NTHR), args, LDS_BYTES, stream);
    if (e != hipSuccess) fprintf(stderr, "kernel_launch: cooperative launch failed: %s (grid %d)\n", hipGetErrorString(e), grid);
#else
#ifdef PROBE_STOP
    for (int ph = 0; ph <= PROBE_STOP; ++ph) { a.ph_lo = ph; a.ph_hi = ph + 1; hipLaunchKernelGGL(mega, dim3(grid), dim3(NTHR), LDS_BYTES, stream, a); }
    a.ph_lo = 10; a.ph_hi = 11; hipLaunchKernelGGL(mega, dim3(grid), dim3(NTHR), LDS_BYTES, stream, a);
    a.ph_lo = 11; a.ph_hi = 12; hipLaunchKernelGGL(mega, dim3(grid), dim3(NTHR), LDS_BYTES, stream, a);
#else
#ifdef PROBE_LIST
    { const int lst[] = PROBE_LIST; for (int i = 0; i < (int)(sizeof(lst) / sizeof(int)); ++i) { a.ph_lo = lst[i]; a.ph_hi = lst[i] + 1; hipLaunchKernelGGL(mega, dim3(grid), dim3(NTHR), LDS_BYTES, stream, a); } }
#else
    for (int ph = 0; ph < NPH; ++ph) { a.ph_lo = ph; a.ph_hi = ph + 1; hipLaunchKernelGGL(mega, dim3(grid), dim3(NTHR), LDS_BYTES, stream, a); }
#endif
#endif
#endif
}
```

```cpp
#include <hip/hip_runtime.h>
#include <hip/hip_cooperative_groups.h>
#include <cstdio>
#include <cstdint>
namespace cg = cooperative_groups;

#ifndef MK_COOP
#define MK_COOP 1
#endif

#define LAS __attribute__((address_space(3)))
typedef unsigned short u16;
typedef short bf16x8 __attribute__((ext_vector_type(8)));
typedef float f32x4 __attribute__((ext_vector_type(4)));
typedef unsigned u32x4 __attribute__((ext_vector_type(4)));
typedef unsigned u32x2 __attribute__((ext_vector_type(2)));

typedef __bf16 bf16v2_t __attribute__((ext_vector_type(2)));
typedef float f32v2_t __attribute__((ext_vector_type(2)));
__device__ __forceinline__ unsigned cvt_pk_bf16(float lo, float hi) { const f32v2_t f = {lo, hi}; const bf16v2_t v = __builtin_convertvector(f, bf16v2_t); return __builtin_bit_cast(unsigned, v); }
__device__ __forceinline__ float bf_lo(unsigned w) { return __uint_as_float(w << 16); }
__device__ __forceinline__ float bf_hi(unsigned w) { return __uint_as_float(w & 0xffff0000u); }
__device__ __forceinline__ float bf1(u16 w) { return __uint_as_float((unsigned)w << 16); }
__device__ __forceinline__ unsigned pk_h(float a, float b) { const _Float16 x = (_Float16)a, y = (_Float16)b; return (unsigned)__builtin_bit_cast(unsigned short, x) | ((unsigned)__builtin_bit_cast(unsigned short, y) << 16); }
__device__ __forceinline__ float h2f(u16 w) { return (float)__builtin_bit_cast(_Float16, w); }
__device__ __forceinline__ float fexp(float x) { return __builtin_amdgcn_exp2f(x * 1.44269504088896341f); }
__device__ __forceinline__ float flog(float x) { return __builtin_amdgcn_logf(x) * 0.693147180559945309f; }
__device__ __forceinline__ float sigm(float z) { return __builtin_amdgcn_rcpf(1.0f + fexp(-z)); }

namespace pg8 {
constexpr int BM = 256, BK = 64, HALF = 128, HTB = HALF * BK * 2, STAGE_BYTES = 8 * HTB, NXCD = 8, WGM = 8;
__host__ __device__ __forceinline__ int lds_byte(int r, int c) { const int st = (r >> 4) * 2 + (c >> 5), rr = r & 15, cc = c & 31, ob = rr * 64 + cc * 2; return st * 1024 + (ob ^ (((ob >> 9) & 1) << 5)); }
__host__ __device__ __forceinline__ void stage_rc(int b, int& R, int& C) { const int st = b / 1024, sb = b % 1024, swz = sb ^ (((sb >> 9) & 1) << 5); R = (st >> 1) * 16 + swz / 64; C = (st & 1) * 32 + (swz % 64) / 2; }
__host__ __device__ __forceinline__ int perm32(int rho) { const int n = rho >> 4, i = rho & 15; return 8 * (i >> 2) + 4 * n + (i & 3); }
struct Unit { int pm, pn; };
struct Gemm { const u16* A; const u16* Bt; int M, N, K, lda, ksplit; long a2delta; };
struct StaticOrder {
    int nM, nN, nwg, G, c;
    __host__ __device__ void init(int M, int N, int G_, int c_) { nM = M / BM; nN = N / BM; nwg = nM * nN; G = G_; c = c_; }
    __host__ __device__ bool next(int i, Unit& u) const {
        const long L = (long)i * G + c; if (L >= nwg) return false;
        int wgid = (int)L; { const int q = nwg / NXCD, r = nwg % NXCD, xcd = wgid % NXCD, off = wgid / NXCD; wgid = (xcd < r ? xcd * (q + 1) : r * (q + 1) + (xcd - r) * q) + off; }
        const int nig = WGM * nN, gid = wgid / nig, fm = gid * WGM, gsz = (nM - fm) < WGM ? (nM - fm) : WGM;
        u.pm = fm + ((wgid % nig) % gsz); u.pn = (wgid % nig) / gsz; return true;
    }
};
template <class Epi, bool ALIGN_EPI>
__device__ __forceinline__ void gemm_phase(LAS unsigned char* lds, const Gemm g, const StaticOrder& S, const Epi& E) {
    const int tid = threadIdx.x, wid = __builtin_amdgcn_readfirstlane(tid >> 6), lane = tid & 63, wr = wid >> 2, wc = wid & 3, fr = lane & 15, fq = lane >> 4;
    const int K = g.K, nt = K / BK, lda = g.lda;
    unsigned voffA[2], voffB[2];
#pragma unroll
    for (int i = 0; i < 2; ++i) { int R, C; stage_rc(tid * 16 + i * 8192, R, C); const int Rb = Epi::PERM ? ((R & ~31) + perm32(R & 31)) : R;
        voffA[i] = (unsigned)(R * lda + C) * 2u; voffB[i] = (unsigned)(Rb * K + C) * 2u; }
    const size_t kstep = (size_t)(BK * 2);
    const size_t hstepA = (size_t)HALF * lda * 2, tstepA = 2 * hstepA;
    const size_t hstepB = (size_t)HALF * K * 2, tstepB = 2 * hstepB;
    const unsigned ldsw = (unsigned)wid * 1024u;
    const int aoff = lds_byte(wr * 64 + fr, fq * 8), boff = lds_byte(wc * 32 + fr, fq * 8);
#define PG8_SA(b, h) (((b) * 2 + (h)) * HTB)
#define PG8_SB(b, h) ((4 + (b) * 2 + (h)) * HTB)
#define PG8_STAGE(bufoff, gbase, voff) do { _Pragma("unroll") for (int _i = 0; _i < 2; ++_i) \
        __builtin_amdgcn_global_load_lds((const unsigned*)((const char*)(gbase) + (voff)[_i]), (LAS unsigned*)(lds + (bufoff) + ldsw + _i * 8192), 16, 0, 0); } while (0)
#define PG8_STAGEA(bufoff, gbase, voff) do { _Pragma("unroll") for (int _i = 0; _i < 2; ++_i) \
        __builtin_amdgcn_global_load_lds((const unsigned*)((const char*)(gbase) + (voff)[_i]), (LAS unsigned*)(lds + (bufoff) + ldsw + _i * 8192), 16, 0, Epi::A_AUX); } while (0)
#define PG8_LDA(dst, b, h) do { _Pragma("unroll") for (int m = 0; m < 4; ++m) _Pragma("unroll") for (int k = 0; k < 2; ++k) dst[m][k] = *(const LAS bf16x8*)(lds + PG8_SA(b, h) + aoff + m * 2048 + k * 1024); } while (0)
#define PG8_LDB(dst, b, h) do { _Pragma("unroll") for (int n = 0; n < 2; ++n) _Pragma("unroll") for (int k = 0; k < 2; ++k) dst[n][k] = *(const LAS bf16x8*)(lds + PG8_SB(b, h) + boff + n * 2048 + k * 1024); } while (0)
#define PG8_MMA(ai, bj, At, Bt) do { __builtin_amdgcn_s_setprio(1); _Pragma("unroll") for (int m = 0; m < 4; ++m) _Pragma("unroll") for (int n = 0; n < 2; ++n) _Pragma("unroll") for (int k = 0; k < 2; ++k) \
        acc[ai][bj][m][n] = __builtin_amdgcn_mfma_f32_16x16x32_bf16(Bt[n][k], At[m][k], acc[ai][bj][m][n], 0, 0, 0); __builtin_amdgcn_s_setprio(0); } while (0)
#define PG8_WAIT_V(n) asm volatile("s_waitcnt vmcnt(" #n ")" ::: "memory")
#define PG8_WAIT_L(n) asm volatile("s_waitcnt lgkmcnt(" #n ")" ::: "memory")
#define PG8_BAR __builtin_amdgcn_s_barrier()
#define PG8_SCHED __builtin_amdgcn_sched_barrier(0)
    Unit cur, nxt; int ui = 0;
    if (!S.next(0, cur)) return;
    f32x4 acc[2][2][4][2];
#pragma unroll
    for (int a = 0; a < 2; ++a)
#pragma unroll
        for (int b = 0; b < 2; ++b)
#pragma unroll
            for (int m = 0; m < 4; ++m)
#pragma unroll
                for (int n = 0; n < 2; ++n) acc[a][b][m][n] = (f32x4){0.f, 0.f, 0.f, 0.f};
    bf16x8 At[4][2], B0[2][2], B1[2][2];
    const char* cA = (const char*)g.A + (size_t)cur.pm * tstepA; const char* cB = (const char*)g.Bt + (size_t)cur.pn * tstepB;
    PG8_STAGE(PG8_SB(0, 0), cB, voffB); PG8_STAGE(PG8_SB(0, 1), cB + hstepB, voffB); PG8_STAGEA(PG8_SA(0, 0), cA, voffA); PG8_STAGEA(PG8_SA(0, 1), cA + hstepA, voffA);
    if (wr == 1) PG8_BAR;
    PG8_WAIT_V(2); PG8_BAR;
    PG8_STAGE(PG8_SB(1, 0), cB + kstep, voffB); PG8_STAGEA(PG8_SA(1, 0), cA + kstep, voffA); PG8_STAGE(PG8_SB(1, 1), cB + hstepB + kstep, voffB);
    PG8_WAIT_V(6); PG8_BAR;
    for (;;) {
        const bool has_next = S.next(ui + 1, nxt);
        const char* nA = has_next ? (const char*)g.A + (size_t)nxt.pm * tstepA : cA; const char* nB = has_next ? (const char*)g.Bt + (size_t)nxt.pn * tstepB : cB;
        for (int t = 0; t < nt; t += 2) {
            const bool last = (t == nt - 2);
            if constexpr (Epi::MID) { if (t == g.ksplit) E.mid(acc, cur, wr, wc, fr, fq); }
            const char* a1 = cA + (size_t)(t + 1) * kstep + (t >= g.ksplit ? g.a2delta : 0L);
            const char* a2 = last ? nA : cA + (size_t)(t + 2) * kstep + (t + 2 >= g.ksplit ? g.a2delta : 0L);
            const char* b2 = last ? nB : cB + (size_t)(t + 2) * kstep;
            const char* a3 = a2 + kstep; const char* b3 = b2 + kstep;
            PG8_LDB(B0, 0, 0); PG8_LDB(B1, 0, 1); PG8_SCHED; PG8_LDA(At, 0, 0); PG8_STAGEA(PG8_SA(1, 1), a1 + hstepA, voffA);
            PG8_WAIT_V(8); PG8_WAIT_L(0); PG8_BAR; PG8_MMA(0, 0, At, B0); PG8_MMA(0, 1, At, B1); PG8_BAR; PG8_SCHED;
            PG8_LDA(At, 0, 1); PG8_STAGE(PG8_SB(0, 0), b2, voffB); PG8_STAGE(PG8_SB(0, 1), b2 + hstepB, voffB); PG8_STAGEA(PG8_SA(0, 0), a2, voffA);
            PG8_WAIT_V(8); PG8_WAIT_L(0); PG8_BAR; PG8_MMA(1, 0, At, B0); PG8_MMA(1, 1, At, B1); PG8_BAR; PG8_SCHED;
            PG8_LDB(B0, 1, 0); PG8_LDB(B1, 1, 1); PG8_SCHED; PG8_LDA(At, 1, 0); PG8_STAGEA(PG8_SA(0, 1), a2 + hstepA, voffA);
            PG8_WAIT_V(8); PG8_WAIT_L(0); PG8_BAR; PG8_MMA(0, 0, At, B0); PG8_MMA(0, 1, At, B1); PG8_BAR; PG8_SCHED;
            PG8_LDA(At, 1, 1); PG8_STAGE(PG8_SB(1, 0), b3, voffB); PG8_STAGE(PG8_SB(1, 1), b3 + hstepB, voffB); PG8_STAGEA(PG8_SA(1, 0), a3, voffA);
            PG8_WAIT_V(8); PG8_WAIT_L(0); PG8_BAR; PG8_MMA(1, 0, At, B0); PG8_MMA(1, 1, At, B1); PG8_BAR; PG8_SCHED;
        }
        if constexpr (ALIGN_EPI) { if (wr == 0) PG8_BAR; }
        if constexpr (!Epi::AFTER) E(acc, cur, wr, wc, fr, fq);
        if (!has_next) break;
#pragma unroll
        for (int a = 0; a < 2; ++a)
#pragma unroll
            for (int b = 0; b < 2; ++b)
#pragma unroll
                for (int m = 0; m < 4; ++m)
#pragma unroll
                    for (int n = 0; n < 2; ++n) acc[a][b][m][n] = (f32x4){0.f, 0.f, 0.f, 0.f};
        cur = nxt; cA = nA; cB = nB; ++ui;
        if constexpr (ALIGN_EPI) { if (wr == 1) PG8_BAR; }
    }
    PG8_WAIT_V(0);
    if constexpr (!ALIGN_EPI) { if (wr == 0) PG8_BAR; }
    PG8_BAR;
    if constexpr (Epi::AFTER) E.after(acc, cur, wr, wc, fr, fq, lds, wid, lane);
#undef PG8_SA
#undef PG8_SB
#undef PG8_STAGE
#undef PG8_STAGEA
#undef PG8_LDA
#undef PG8_LDB
#undef PG8_MMA
#undef PG8_WAIT_V
#undef PG8_WAIT_L
#undef PG8_BAR
#undef PG8_SCHED
}
}

constexpr int NWAVES = 8, NTHR = 512;
constexpr int SEQ = 8192, BATCH = 2, DM = 1024, M = BATCH * SEQ, NMETA = 16, INW = 6656, DFF = 2816, NGU = 2 * DFF, CHK = 64, NCH = SEQ / CHK;
constexpr float EPS = 1e-6f;
constexpr size_t KiB = 1024, MiB = 1u << 20;
constexpr size_t WS_LB = 0, WS_GM = 64 * KiB, WS_VM = 128 * KiB, WS_PLM = 192 * KiB, WS_PWT = 256 * KiB, WS_UM = 512 * KiB, WS_DK = 1 * MiB, WS_RSQ = 2 * MiB;
constexpr size_t WS_WAB = 3 * MiB, WS_WOUT = 6 * MiB, WS_WD = 8 * MiB, WS_WIN = 14 * MiB, WS_WGU = 14 * MiB;
constexpr size_t WS_Q = 28 * MiB, WS_G = 60 * MiB, WS_V = 92 * MiB, WS_OG = 124 * MiB, WS_GA = 156 * MiB, WS_GB = 188 * MiB, WS_PB = 220 * MiB, WS_END = 252 * MiB;
constexpr size_t WS_MG = WS_G, WS_H1B = WS_GB, WS_ACT = WS_Q;
static_assert(WS_WD + (size_t)DM * DFF * 2 <= WS_WIN && WS_WIN + (size_t)INW * DM * 2 <= WS_Q && WS_WGU + (size_t)NGU * DM * 2 <= WS_Q && WS_ACT + (size_t)M * DFF * 2 <= WS_H1B, "ws map");
#ifndef AUX_STREAM
#define AUX_STREAM 0
#endif
constexpr int LDS_BYTES = 163840;
constexpr size_t WS_BAR = 16 * KiB, WS_CNT = 32 * KiB, CTL_ZERO = 32 * KiB;

struct Args {
    const float *x, *meta, *g_mix, *w_in, *lb_raw, *g_hn, *pool_w, *pool_scale, *w_a, *w_b, *w_out, *g_ffn, *w_gate, *w_up, *w_down, *g_fin;
    float* out; unsigned char* ws; int ph_lo, ph_hi;
};

#define LDS_WAIT() asm volatile("s_waitcnt lgkmcnt(0)" ::: "memory")
__device__ __forceinline__ float wave_sum(float v) {
#pragma unroll
    for (int o = 1; o < 64; o <<= 1) v += __shfl_xor(v, o);
    return v;
}

__device__ __forceinline__ void tr_item(const float* W, int N, int k0, int n0, u16* WT, int drow0, int dpitch, int dk0, const float* ks, LAS float* scr, int lane) {
    f32x4 wv[8];
#pragma unroll
    for (int i = 0; i < 8; ++i) wv[i] = __builtin_nontemporal_load((const f32x4*)(W + (size_t)(k0 + 8 * i + (lane >> 3)) * N + n0 + 4 * (lane & 7)));
#pragma unroll
    for (int i = 0; i < 8; ++i) { const int kk = 8 * i + (lane >> 3); f32x4 w = wv[i]; if (ks) w *= ks[k0 + kk];
        LAS float* d = scr + kk * 33 + 4 * (lane & 7); d[0] = w.x; d[1] = w.y; d[2] = w.z; d[3] = w.w; }
    LDS_WAIT(); asm volatile("" ::: "memory");
    const int c = lane & 7;
#pragma unroll
    for (int j = 0; j < 4; ++j) { const int n = (lane >> 3) + 8 * j; const LAS float* s = scr + (8 * c) * 33 + n;
        u32x4 o; o.x = cvt_pk_bf16(s[0 * 33], s[1 * 33]); o.y = cvt_pk_bf16(s[2 * 33], s[3 * 33]); o.z = cvt_pk_bf16(s[4 * 33], s[5 * 33]); o.w = cvt_pk_bf16(s[6 * 33], s[7 * 33]);
        *(u32x4*)(WT + (size_t)(drow0 + n) * dpitch + dk0 + k0 + 8 * c) = o; }
    LDS_WAIT(); asm volatile("" ::: "memory");
}
__device__ __forceinline__ void rms_row_bf16(const float* xrow, const float* g, u16* orow, int lane) {
    const f32x4* xr = (const f32x4*)xrow + lane; const f32x4* gr = (const f32x4*)g + lane;
    f32x4 v[4]; float s = 0.f;
#pragma unroll
    for (int j = 0; j < 4; ++j) { v[j] = xr[64 * j]; s += (v[j].x * v[j].x + v[j].y * v[j].y) + (v[j].z * v[j].z + v[j].w * v[j].w); }
    const float rstd = rsqrtf(wave_sum(s) * (1.f / DM) + EPS);
    u32x2* o8 = (u32x2*)orow + lane;
#pragma unroll
    for (int j = 0; j < 4; ++j) { const f32x4 gv = gr[64 * j]; u32x2 o; o.x = cvt_pk_bf16(v[j].x * rstd * gv.x, v[j].y * rstd * gv.y); o.y = cvt_pk_bf16(v[j].z * rstd * gv.z, v[j].w * rstd * gv.w); o8[64 * j] = o; }
}

__device__ __forceinline__ void p0_meta(const Args& a, LAS unsigned char* lds, int j, int tid, int wave, int lane) {
    LAS float* nm = (LAS float*)lds;
    LAS float* part = (LAS float*)(lds + 65536);
#pragma unroll
    for (int rr = 0; rr < 2; ++rr) { const int r = 2 * wave + rr; const f32x4* xr = (const f32x4*)(a.meta + (size_t)r * DM) + lane; const f32x4* gr = (const f32x4*)a.g_mix + lane;
        f32x4 v[4]; float s = 0.f;
#pragma unroll
        for (int q = 0; q < 4; ++q) { v[q] = xr[64 * q]; s += (v[q].x * v[q].x + v[q].y * v[q].y) + (v[q].z * v[q].z + v[q].w * v[q].w); }
        const float rstd = rsqrtf(wave_sum(s) * (1.f / DM) + EPS);
#pragma unroll
        for (int q = 0; q < 4; ++q) { const f32x4 gv = gr[64 * q]; *(LAS f32x4*)(nm + r * 1024 + 4 * (lane + 64 * q)) = (f32x4){v[q].x * rstd * gv.x, v[q].y * rstd * gv.y, v[q].z * rstd * gv.z, v[q].w * rstd * gv.w}; }
    }
    __syncthreads();
    const int colbase = j < 32 ? 1024 + 32 * j : (j < 64 ? 2048 + 32 * (j - 32) : 4096 + 32 * (j - 64));
    {
        const int col = colbase + (lane & 31), kh = lane >> 5; float acc[16];
#pragma unroll
        for (int r = 0; r < 16; ++r) acc[r] = 0.f;
#pragma unroll 4
        for (int k = 128 * wave + 64 * kh; k < 128 * wave + 64 * kh + 64; k += 4) {
            const float w0 = a.w_in[(size_t)(k + 0) * INW + col], w1 = a.w_in[(size_t)(k + 1) * INW + col], w2 = a.w_in[(size_t)(k + 2) * INW + col], w3 = a.w_in[(size_t)(k + 3) * INW + col];
#pragma unroll
            for (int r = 0; r < 16; ++r) { const f32x4 n4 = *(const LAS f32x4*)(nm + r * 1024 + k); acc[r] += (n4.x * w0 + n4.y * w1) + (n4.z * w2 + n4.w * w3); }
        }
#pragma unroll
        for (int r = 0; r < 16; ++r) part[(wave * 16 + r) * 64 + lane] = acc[r];
    }
    __syncthreads();
    {
        const int r = tid >> 5, cl = tid & 31; float z = 0.f;
#pragma unroll
        for (int w = 0; w < 8; ++w) z += part[(w * 16 + r) * 64 + cl] + part[(w * 16 + r) * 64 + 32 + cl];
        const int col = colbase + cl;
        if (col < 2048) { const int c = col - 1024; const float lb = 1.0f / (1.0f + fexp(a.lb_raw[1024 + c] - a.lb_raw[c])); const float f = lb + (1.0f - lb) * sigm(z);
            const _Float16 hv = (_Float16)flog(f); ((u16*)(a.ws + WS_GM))[r * 1024 + c] = __builtin_bit_cast(unsigned short, hv); }
        else if (col < 3072) { ((u16*)(a.ws + WS_VM))[r * 1024 + (col - 2048)] = (u16)(cvt_pk_bf16(z, 0.f) & 0xffffu); }
        else { ((u16*)(a.ws + WS_PLM))[r * 512 + (col - 4096)] = (u16)(cvt_pk_bf16(z, 0.f) & 0xffffu); }
    }
    __syncthreads();
}

__device__ __forceinline__ void late_weights(const Args& a, LAS unsigned char* lds, int gw, int NGW) {
    const int lane = threadIdx.x & 63, wave = __builtin_amdgcn_readfirstlane(threadIdx.x >> 6);
    LAS float* scr = (LAS float*)(lds + wave * 16384);
    constexpr int I_A = 16 * 32, I_B = 8 * 32, I_O = 16 * 32, I_D = 44 * 32, I_P = 32;
    constexpr int NIT = I_A + I_B + I_O + I_D + I_P;
    for (int it = gw; it < NIT; it += NGW) {
        int r = it;
        if (r < I_A) { tr_item(a.w_a, 1024, 64 * (r / 32), 32 * (r % 32), (u16*)(a.ws + WS_WAB), 32 * (r % 32), 1536, 0, nullptr, scr, lane); continue; } r -= I_A;
        if (r < I_B) { tr_item(a.w_b, 1024, 64 * (r / 32), 32 * (r % 32), (u16*)(a.ws + WS_WAB), 32 * (r % 32), 1536, 1024, nullptr, scr, lane); continue; } r -= I_B;
        if (r < I_O) { tr_item(a.w_out, 1024, 64 * (r / 32), 32 * (r % 32), (u16*)(a.ws + WS_WOUT), 32 * (r % 32), 1024, 0, nullptr, scr, lane); continue; } r -= I_O;
        if (r < I_D) { tr_item(a.w_down, 1024, 64 * (r / 32), 32 * (r % 32), (u16*)(a.ws + WS_WD), 32 * (r % 32), DFF, 0, nullptr, scr, lane); continue; } r -= I_D;
        { const int gi = r >> 3, q = r & 7; tr_item(a.pool_w + (size_t)gi * 16384, 128, 64 * (q >> 2), 32 * (q & 3), (u16*)(a.ws + WS_PWT) + (size_t)gi * 16384, 32 * (q & 3), 128, 0, nullptr, scr, lane); }
    }
}

__device__ __forceinline__ void p0_prologue(const Args& a, LAS unsigned char* lds, int G, int skip = 0) {
    const int tid = threadIdx.x, lane = tid & 63, wave = __builtin_amdgcn_readfirstlane(tid >> 6);
    const bool split = G > 160;
    if (!(skip & 4)) for (int j = (int)blockIdx.x; j < 80; j += G) p0_meta(a, lds, j, tid, wave, lane);
    if (split && (int)blockIdx.x < 80) return;
    if (blockIdx.x == 80 || (G <= 80 && blockIdx.x == 0)) { for (int c = tid; c < 1024; c += NTHR) ((float*)(a.ws + WS_LB))[c] = 1.0f / (1.0f + fexp(a.lb_raw[1024 + c] - a.lb_raw[c])); }
    LAS float* scr = (LAS float*)(lds + wave * 16384);
    const int gw = ((int)blockIdx.x - (split ? 80 : 0)) * NWAVES + wave, NGW = (G - (split ? 80 : 0)) * NWAVES;
    constexpr int I_IN = 16 * 208;
    for (int it = gw; it < I_IN && !(skip & 1); it += NGW) tr_item(a.w_in, INW, 64 * (it / 208), 32 * (it % 208), (u16*)(a.ws + WS_WIN), 32 * (it % 208), 1024, 0, nullptr, scr, lane);
    if (G != 256) late_weights(a, lds, gw, NGW);
    u16* XN = (u16*)a.out;
    {
        const f32x4* gr = (const f32x4*)a.g_mix + lane; f32x4 gv[4];
#pragma unroll
        for (int j = 0; j < 4; ++j) gv[j] = gr[64 * j];
        for (int m = 4 * gw; m < M && !(skip & 2); m += 4 * NGW) {
            const f32x4* xr = (const f32x4*)(a.x + (size_t)m * DM) + lane; f32x4 v[16]; float ss[4];
#pragma unroll
            for (int j = 0; j < 16; ++j) v[j] = __builtin_nontemporal_load(&xr[64 * j]);
#pragma unroll
            for (int rr = 0; rr < 4; ++rr) { float t = 0.f;
#pragma unroll
                for (int j = 0; j < 4; ++j) { const f32x4 w = v[4 * rr + j]; t += (w.x * w.x + w.y * w.y) + (w.z * w.z + w.w * w.w); }
                ss[rr] = t; }
#pragma unroll
            for (int o = 1; o < 64; o <<= 1) {
#pragma unroll
                for (int rr = 0; rr < 4; ++rr) ss[rr] += __shfl_xor(ss[rr], o); }
            u32x2* o8 = (u32x2*)(XN + (size_t)m * DM) + lane;
#pragma unroll
            for (int j = 0; j < 16; ++j) { const float rs = rsqrtf(ss[j >> 2] * (1.f / DM) + EPS); const f32x4 g4 = gv[j & 3]; u32x2 o; o.x = cvt_pk_bf16(v[j].x * rs * g4.x, v[j].y * rs * g4.y); o.y = cvt_pk_bf16(v[j].z * rs * g4.z, v[j].w * rs * g4.w); o8[64 * j] = o; }
        }
    }
}

struct EpiIn {
    static constexpr bool PERM = true, MID = false, AFTER = false; static constexpr int A_AUX = 0;
    unsigned char* ws;
    __device__ __forceinline__ void mid(f32x4 (&)[2][2][4][2], const pg8::Unit&, int, int, int, int) const {}
    __device__ __forceinline__ void operator()(f32x4 (&acc)[2][2][4][2], const pg8::Unit& u, int wr, int wc, int fr, int fq) const {
        const int colt = u.pn * 256; int type, c0; size_t boff;
        if (colt < 1024) { type = 1; boff = WS_Q; c0 = colt; }
        else if (colt < 2048) { type = 3; boff = WS_G; c0 = colt - 1024; }
        else if (colt < 3072) { type = 0; boff = WS_V; c0 = colt - 2048; }
        else if (colt < 4096) { type = 1; boff = WS_OG; c0 = colt - 3072; }
        else if (colt < 4608) { type = 0; boff = WS_PB; c0 = colt - 4096 + 512; }
        else if (colt < 5632) { type = 2; boff = WS_GA; c0 = colt - 4608; }
        else { type = 2; boff = WS_GB; c0 = colt - 5632; }
        u16* base = (u16*)(ws + boff);
        const int col0 = c0 + wc * 32 + 8 * fq, row0 = u.pm * 256 + wr * 64 + fr;
        const float* LB = (const float*)(ws + WS_LB);
        f32x4 lbv[2][2];
        if (type == 3) {
#pragma unroll
            for (int bj = 0; bj < 2; ++bj) { lbv[bj][0] = *(const f32x4*)(LB + col0 + bj * 128); lbv[bj][1] = *(const f32x4*)(LB + col0 + bj * 128 + 4); }
        } else {
#pragma unroll
            for (int bj = 0; bj < 2; ++bj) { lbv[bj][0] = (f32x4){0.f, 0.f, 0.f, 0.f}; lbv[bj][1] = (f32x4){0.f, 0.f, 0.f, 0.f}; }
        }
#pragma unroll
        for (int ai = 0; ai < 2; ++ai)
#pragma unroll
            for (int m = 0; m < 4; ++m) { u16* rowp = base + (size_t)(row0 + ai * 128 + m * 16) * 1024 + col0;
#pragma unroll
                for (int bj = 0; bj < 2; ++bj) { f32x4 v0 = acc[ai][bj][m][0], v1 = acc[ai][bj][m][1]; u32x4 w;
                    if (type == 3) {
                        const f32x4 l0 = lbv[bj][0], l1 = lbv[bj][1];
#pragma unroll
                        for (int e = 0; e < 4; ++e) { v0[e] = flog(l0[e] + (1.0f - l0[e]) * sigm(v0[e])); v1[e] = flog(l1[e] + (1.0f - l1[e]) * sigm(v1[e])); }
                        w.x = pk_h(v0[0], v0[1]); w.y = pk_h(v0[2], v0[3]); w.z = pk_h(v1[0], v1[1]); w.w = pk_h(v1[2], v1[3]);
                    } else {
                        if (type == 1) {
#pragma unroll
                            for (int e = 0; e < 4; ++e) { v0[e] = v0[e] * sigm(v0[e]); v1[e] = v1[e] * sigm(v1[e]); }
                        } else if (type == 2) {
#pragma unroll
                            for (int e = 0; e < 4; ++e) { v0[e] = sigm(v0[e]); v1[e] = sigm(v1[e]); }
                        }
                        w.x = cvt_pk_bf16(v0[0], v0[1]); w.y = cvt_pk_bf16(v0[2], v0[3]); w.z = cvt_pk_bf16(v1[0], v1[1]); w.w = cvt_pk_bf16(v1[2], v1[3]);
                    }
                    __builtin_nontemporal_store(w, (u32x4*)(rowp + bj * 128)); } }
    }
};
struct EpiMerge {
    static constexpr bool PERM = true, MID = true, AFTER = false; static constexpr int A_AUX = AUX_STREAM;
    const u16 *GA, *GB; u16* MG;
    __device__ __forceinline__ void mid(f32x4 (&acc)[2][2][4][2], const pg8::Unit& u, int wr, int wc, int fr, int fq) const {
        int zz = 0; asm volatile("" : "+v"(zz));
        const int col0 = u.pn * 256 + wc * 32 + 8 * fq, row0 = u.pm * 256 + wr * 64 + fr + zz;
#pragma unroll
        for (int ai = 0; ai < 2; ++ai)
#pragma unroll
            for (int m = 0; m < 4; ++m) { const size_t off = (size_t)(row0 + ai * 128 + m * 16) * 1024 + col0;
#pragma unroll
                for (int bj = 0; bj < 2; ++bj) { const u32x4 ga = __builtin_nontemporal_load((const u32x4*)(GA + off + bj * 128)), gb = *(const u32x4*)(GB + off + bj * 128);
#pragma unroll
                    for (int e = 0; e < 2; ++e) { acc[ai][bj][m][0][2 * e] *= bf_lo(ga[e]) * __builtin_amdgcn_rcpf(bf_lo(gb[e])); acc[ai][bj][m][0][2 * e + 1] *= bf_hi(ga[e]) * __builtin_amdgcn_rcpf(bf_hi(gb[e]));
                        acc[ai][bj][m][1][2 * e] *= bf_lo(ga[2 + e]) * __builtin_amdgcn_rcpf(bf_lo(gb[2 + e])); acc[ai][bj][m][1][2 * e + 1] *= bf_hi(ga[2 + e]) * __builtin_amdgcn_rcpf(bf_hi(gb[2 + e])); } }
                asm volatile("" ::: "memory"); }
    }
    __device__ __forceinline__ void operator()(f32x4 (&acc)[2][2][4][2], const pg8::Unit& u, int wr, int wc, int fr, int fq) const {
        const int col0 = u.pn * 256 + wc * 32 + 8 * fq, row0 = u.pm * 256 + wr * 64 + fr;
#pragma unroll
        for (int ai = 0; ai < 2; ++ai)
#pragma unroll
            for (int m = 0; m < 4; ++m) { const size_t off = (size_t)(row0 + ai * 128 + m * 16) * 1024 + col0;
#pragma unroll
                for (int bj = 0; bj < 2; ++bj) { const u32x4 gb = *(const u32x4*)(GB + off + bj * 128);
                    acc[ai][bj][m][0] *= (f32x4){bf_lo(gb[0]), bf_hi(gb[0]), bf_lo(gb[1]), bf_hi(gb[1])}; acc[ai][bj][m][1] *= (f32x4){bf_lo(gb[2]), bf_hi(gb[2]), bf_lo(gb[3]), bf_hi(gb[3])}; } }
#pragma unroll
        for (int ai = 0; ai < 2; ++ai)
#pragma unroll
            for (int m = 0; m < 4; ++m) { const size_t off = (size_t)(row0 + ai * 128 + m * 16) * 1024 + col0;
#pragma unroll
                for (int bj = 0; bj < 2; ++bj) { const f32x4 v0 = acc[ai][bj][m][0], v1 = acc[ai][bj][m][1]; u32x4 w;
                    w.x = cvt_pk_bf16(v0[0], v0[1]); w.y = cvt_pk_bf16(v0[2], v0[3]); w.z = cvt_pk_bf16(v1[0], v1[1]); w.w = cvt_pk_bf16(v1[2], v1[3]);
                    *(u32x4*)(MG + off + bj * 128) = w; } }
    }
};
template <bool WITH_BF16>
struct EpiRes {
    static constexpr bool PERM = false, MID = false, AFTER = false; static constexpr int A_AUX = AUX_STREAM;
    const float* base; float* H; u16* Hb; float* rsq;
    __device__ __forceinline__ void mid(f32x4 (&)[2][2][4][2], const pg8::Unit&, int, int, int, int) const {}
    __device__ __forceinline__ void operator()(f32x4 (&acc)[2][2][4][2], const pg8::Unit& u, int wr, int wc, int fr, int fq) const {
        const int col0 = u.pn * 256 + wc * 32 + 4 * fq, row0 = u.pm * 256 + wr * 64 + fr;
#pragma unroll
        for (int ai = 0; ai < 2; ++ai) {
            f32x4 pre[4][2][2];
#pragma unroll
            for (int m = 0; m < 4; ++m) { const size_t off = (size_t)(row0 + ai * 128 + m * 16) * 1024 + col0;
#pragma unroll
                for (int bj = 0; bj < 2; ++bj)
#pragma unroll
                    for (int n = 0; n < 2; ++n) pre[m][bj][n] = __builtin_nontemporal_load((const f32x4*)(base + off + bj * 128 + n * 16)); }
            asm volatile("" ::: "memory");
#pragma unroll
            for (int m = 0; m < 4; ++m) { const int row = row0 + ai * 128 + m * 16; const size_t off = (size_t)row * 1024 + col0; float s = 0.f;
#pragma unroll
                for (int bj = 0; bj < 2; ++bj)
#pragma unroll
                    for (int n = 0; n < 2; ++n) { const f32x4 hv = pre[m][bj][n] + acc[ai][bj][m][n];
                        if (H) *(f32x4*)(H + off + bj * 128 + n * 16) = hv;
                        s += (hv[0] * hv[0] + hv[1] * hv[1]) + (hv[2] * hv[2] + hv[3] * hv[3]);
                        if (WITH_BF16) { u32x2 w; w.x = cvt_pk_bf16(hv[0], hv[1]); w.y = cvt_pk_bf16(hv[2], hv[3]); *(u32x2*)(Hb + off + bj * 128 + n * 16) = w; } }
                s += __shfl_xor(s, 16); s += __shfl_xor(s, 32);
                if (fq == 0) rsq[(size_t)row * 16 + u.pn * 4 + wc] = s; }
            asm volatile("" ::: "memory");
        }
    }
};
struct EpiFfn1 {
    static constexpr bool PERM = true, MID = false, AFTER = false; static constexpr int A_AUX = 0;
    const float* rsq; u16* ACT;
    __device__ __forceinline__ void mid(f32x4 (&)[2][2][4][2], const pg8::Unit&, int, int, int, int) const {}
    __device__ __forceinline__ void operator()(const f32x4 (&acc)[2][2][4][2], const pg8::Unit& u, int wr, int wc, int fr, int fq) const {
        const int col0 = u.pn * 128 + wc * 32 + 8 * fq, row0 = u.pm * 256 + wr * 64 + fr;
        float rstdv[2][4];
#pragma unroll
        for (int ai = 0; ai < 2; ++ai)
#pragma unroll
            for (int m = 0; m < 4; ++m) { const int row = row0 + ai * 128 + m * 16; const f32x4* rp = (const f32x4*)(rsq + (size_t)row * 16);
                const f32x4 r0 = rp[0], r1 = rp[1], r2 = rp[2], r3 = rp[3];
                const float ss = ((r0[0] + r0[1]) + (r0[2] + r0[3])) + ((r1[0] + r1[1]) + (r1[2] + r1[3])) + ((r2[0] + r2[1]) + (r2[2] + r2[3])) + ((r3[0] + r3[1]) + (r3[2] + r3[3]));
                rstdv[ai][m] = rsqrtf(ss * (1.f / DM) + EPS); }
#pragma unroll
        for (int ai = 0; ai < 2; ++ai)
#pragma unroll
            for (int m = 0; m < 4; ++m) { const int row = row0 + ai * 128 + m * 16;
                const float rstd = rstdv[ai][m];
                float o[8];
#pragma unroll
                for (int n = 0; n < 2; ++n)
#pragma unroll
                    for (int e = 0; e < 4; ++e) { const float gt = acc[ai][0][m][n][e] * rstd, up = acc[ai][1][m][n][e] * rstd; o[4 * n + e] = gt * sigm(gt) * up; }
                u32x4 w; w.x = cvt_pk_bf16(o[0], o[1]); w.y = cvt_pk_bf16(o[2], o[3]); w.z = cvt_pk_bf16(o[4], o[5]); w.w = cvt_pk_bf16(o[6], o[7]);
                __builtin_nontemporal_store(w, (u32x4*)(ACT + (size_t)row * DFF + col0)); }
    }
};

struct EpiResNorm {
    static constexpr bool PERM = false, MID = false, AFTER = true; static constexpr int A_AUX = AUX_STREAM;
    const u16* base; float* out; const float* gfin; float* slots; unsigned* cnt;
    __device__ __forceinline__ void mid(f32x4 (&)[2][2][4][2], const pg8::Unit&, int, int, int, int) const {}
    __device__ __forceinline__ void operator()(const f32x4 (&)[2][2][4][2], const pg8::Unit&, int, int, int, int) const {}
    __device__ __forceinline__ void after(f32x4 (&acc)[2][2][4][2], const pg8::Unit& u, int wr, int wc, int fr, int fq, LAS unsigned char* lds, int wid, int lane) const {
        LAS float* P = (LAS float*)lds; LAS float* R = (LAS float*)(lds + 4096);
        const int col0 = u.pn * 256 + wc * 32 + 4 * fq;
#pragma unroll
        for (int ai = 0; ai < 2; ++ai)
#pragma unroll
            for (int m = 0; m < 4; ++m) { const int rl = ai * 128 + wr * 64 + m * 16 + fr; const size_t off = (size_t)(u.pm * 256 + rl) * 1024 + col0; float s = 0.f;
#pragma unroll
                for (int bj = 0; bj < 2; ++bj)
#pragma unroll
                    for (int n = 0; n < 2; ++n) { const u32x2 hb = __builtin_nontemporal_load((const u32x2*)(base + off + bj * 128 + n * 16));
                        const f32x4 hv = (f32x4){bf_lo(hb.x), bf_hi(hb.x), bf_lo(hb.y), bf_hi(hb.y)} + acc[ai][bj][m][n]; acc[ai][bj][m][n] = hv; s += (hv[0] * hv[0] + hv[1] * hv[1]) + (hv[2] * hv[2] + hv[3] * hv[3]); }
                s += __shfl_xor(s, 16); s += __shfl_xor(s, 32);
                if (fq == 0) P[rl * 4 + wc] = s;
                if (m & 1) asm volatile("" ::: "memory"); }
        asm volatile("s_waitcnt lgkmcnt(0)" ::: "memory"); __builtin_amdgcn_s_barrier(); asm volatile("" ::: "memory");
        const int row = wid * 32 + (lane & 31);
        unsigned* slot = (unsigned*)slots + (size_t)(u.pm * 256 + row) * 16;
        if (lane < 32) { const float t = (P[row * 4 + 0] + P[row * 4 + 1]) + (P[row * 4 + 2] + P[row * 4 + 3]);
            __hip_atomic_store(slot + u.pn, __float_as_uint(t), __ATOMIC_RELAXED, __HIP_MEMORY_SCOPE_AGENT); }
        asm volatile("s_waitcnt vmcnt(0)" ::: "memory");
        if (lane == 0) __hip_atomic_fetch_add(cnt + 64 * u.pm, 1u, __ATOMIC_RELAXED, __HIP_MEMORY_SCOPE_AGENT);
        if (wid == 0) { unsigned sp = 0;
            while ((unsigned)__builtin_amdgcn_readfirstlane(__hip_atomic_load(cnt + 64 * u.pm, __ATOMIC_RELAXED, __HIP_MEMORY_SCOPE_AGENT)) < 32u) { __builtin_amdgcn_s_sleep(2); if (++sp > (1u << 20)) break; }
            __builtin_amdgcn_fence(__ATOMIC_ACQUIRE, "agent"); }
        asm volatile("s_waitcnt vmcnt(0) lgkmcnt(0)" ::: "memory"); __builtin_amdgcn_s_barrier(); asm volatile("" ::: "memory");
        if (lane < 32) { float t = 0.f;
#pragma unroll
            for (int k = 0; k < 4; ++k) t += __uint_as_float(__hip_atomic_load(slot + k, __ATOMIC_RELAXED, __HIP_MEMORY_SCOPE_AGENT));
            R[row] = rsqrtf(t * (1.f / DM) + EPS); }
        asm volatile("s_waitcnt lgkmcnt(0)" ::: "memory"); __builtin_amdgcn_s_barrier(); asm volatile("" ::: "memory");
        f32x4 gv[2][2];
#pragma unroll
        for (int bj = 0; bj < 2; ++bj)
#pragma unroll
            for (int n = 0; n < 2; ++n) gv[bj][n] = *(const f32x4*)(gfin + col0 + bj * 128 + n * 16);
#pragma unroll
        for (int ai = 0; ai < 2; ++ai)
#pragma unroll
            for (int m = 0; m < 4; ++m) { const int rl = ai * 128 + wr * 64 + m * 16 + fr; const size_t off = (size_t)(u.pm * 256 + rl) * 1024 + col0; const float rs = R[rl];
#pragma unroll
                for (int bj = 0; bj < 2; ++bj)
#pragma unroll
                    for (int n = 0; n < 2; ++n) *(f32x4*)(out + off + bj * 128 + n * 16) = acc[ai][bj][m][n] * rs * gv[bj][n]; }
    }
};
#define RLX_AGENT __ATOMIC_RELAXED, __HIP_MEMORY_SCOPE_AGENT
#define XB_TMO      128
#define XB_XCNT(j)  (256  + 64 * (j))
#define XB_XSUB(j)  (1280 + 64 * (j))
#define XB_XGEN(j)  (2304 + 64 * (j))
#define XB_TOP      3328
#define XB_TOPGEN   3392
#define XCD_BAR_WORDS 3456
#define XB_SPIN_CAP (1u << 18)

__device__ __forceinline__ unsigned xb_ld(unsigned* p)              { return __hip_atomic_load(p, __ATOMIC_RELAXED, __HIP_MEMORY_SCOPE_AGENT); }
__device__ __forceinline__ unsigned xb_add(unsigned* p, unsigned v) { return __hip_atomic_fetch_add(p, v, __ATOMIC_RELAXED, __HIP_MEMORY_SCOPE_AGENT); }
__device__ __forceinline__ unsigned xb_xcc_id() { return (unsigned)__builtin_amdgcn_s_getreg((3 << 11) | 20) & 0xFu; }
#define XB_SPIN(cond, bar) do { unsigned _sp = 0; while (cond) { __builtin_amdgcn_s_sleep(1); \
    if ((++_sp & 255u) == 0u) { if (xb_ld(&(bar)[XB_TMO])) break; if (_sp > XB_SPIN_CAP) { atomicAdd(&(bar)[XB_TMO], 1u); break; } } } } while (0)

struct XcdBarrier {
    unsigned* bar; unsigned x;
    volatile LAS unsigned* st;
};

__device__ __forceinline__ XcdBarrier xcd_barrier_post(unsigned* bar, volatile LAS unsigned* st) {
    XcdBarrier b; b.bar = bar; b.x = xb_xcc_id(); b.st = st;
    if (threadIdx.x == 0) (void)xb_add(&bar[XB_XCNT(b.x)], 1u);
    return b;
}
__device__ __forceinline__ void xcd_barrier_complete(unsigned* bar, unsigned x, unsigned& nloc, unsigned& nx) {
    const unsigned G = gridDim.x * gridDim.y * gridDim.z;
    unsigned sum, cnt, mine, sp = 0u;
    for (;;) {
        sum = 0u; cnt = 0u; mine = 0u;
#pragma unroll
        for (unsigned j = 0; j < 16; ++j) { const unsigned c = xb_ld(&bar[XB_XCNT(j)]); sum += c; cnt += (c > 0u) ? 1u : 0u; mine = (j == x) ? c : mine; }
        if (sum == G) break;
        __builtin_amdgcn_s_sleep(1);
        if ((++sp & 255u) == 0u) { if (xb_ld(&bar[XB_TMO])) break; if (sp > XB_SPIN_CAP) { atomicAdd(&bar[XB_TMO], 1u); break; } }
    }
    nloc = mine > 0u ? mine : 1u; nx = cnt > 0u ? cnt : 1u;
}

__device__ __forceinline__ void xcd_barrier(const XcdBarrier& b) {
    asm volatile("s_waitcnt vmcnt(0)" ::: "memory");
    __syncthreads();
    if (threadIdx.x == 0) {
        unsigned* bar = b.bar;
        __builtin_amdgcn_s_waitcnt(0);
        unsigned nloc = b.st[0], nx = b.st[1];
        if (nloc == 0u) { xcd_barrier_complete(bar, b.x, nloc, nx); b.st[0] = nloc; b.st[1] = nx; }
        const unsigned old = xb_add(&bar[XB_XSUB(b.x)], 1u);
        const unsigned gen = old / nloc;
        if (old + 1u == (gen + 1u) * nloc) {
            __builtin_amdgcn_fence(__ATOMIC_RELEASE, "agent");
            asm volatile("s_waitcnt vmcnt(0)" ::: "memory");
            const unsigned og = xb_add(&bar[XB_TOP], 1u);
            const unsigned tg = og / nx;
            if (og + 1u == (tg + 1u) * nx) xb_add(&bar[XB_TOPGEN], 1u);
            else XB_SPIN(xb_ld(&bar[XB_TOPGEN]) == tg, bar);
            __builtin_amdgcn_fence(__ATOMIC_ACQUIRE, "agent");
            xb_add(&bar[XB_XGEN(b.x)], 1u);
            asm volatile("s_waitcnt vmcnt(0)" ::: "memory");
        } else {
            XB_SPIN(xb_ld(&bar[XB_XGEN(b.x)]) == gen, bar);
            __builtin_amdgcn_fence(__ATOMIC_ACQUIRE, "agent");
            asm volatile("s_waitcnt vmcnt(0)" ::: "memory");
        }
    }
    __syncthreads();
}

__device__ __forceinline__ void p2_wave(const u16* Gp, const u16* Vp, int nrows, int h, u16* Uout, float* dk, int lane) {
    const int r = lane & 15, q = lane >> 4;
    bf16x8 kf[8][2]; float tot1[8];
#pragma unroll
    for (int kk = 0; kk < 2; ++kk) { const int ks = 1 - kk;
#pragma unroll
        for (int dg = 0; dg < 2; ++dg) {
            int zz = 0; asm volatile("" : "+v"(zz));
            u32x4 wq[4];
#pragma unroll
            for (int p2 = 0; p2 < 2; ++p2) { const int dp = 2 * dg + p2; const int dcol = 32 * dp + 2 * r + zz; unsigned gw[8];
#pragma unroll
                for (int j = 0; j < 8; ++j) { const int s = 32 * ks + 8 * q + j; gw[j] = s < nrows ? *(const unsigned*)(Gp + (size_t)s * 1024 + h * 128 + dcol) : 0u; }
#pragma unroll
                for (int par = 0; par < 2; ++par) { const int dt = 2 * dp + par; float gv[8];
#pragma unroll
                    for (int j = 0; j < 8; ++j) gv[j] = h2f((u16)(par ? (gw[j] >> 16) : (gw[j] & 0xffffu)));
                    float suf[8]; float run = 0.f;
#pragma unroll
                    for (int j = 7; j >= 0; --j) { suf[j] = run; run += gv[j]; }
                    const float T = run, ta = __shfl_xor(T, 16), tb = __shfl_xor(T, 32), tc = __shfl_xor(ta, 32);
                    const float after = ((q ^ 1) > q ? ta : 0.f) + ((q ^ 2) > q ? tb : 0.f) + ((q ^ 3) > q ? tc : 0.f);
                    const float tot = (T + ta) + (tb + tc);
                    float base;
                    if (ks == 1) { tot1[dt] = tot; base = after; } else { base = after + tot1[dt]; if (dk && q == 0) dk[h * 128 + dcol + par] = fexp(tot + tot1[dt]); }
                    float kh[8];
#pragma unroll
                    for (int j = 0; j < 8; ++j) kh[j] = (1.0f - fexp(gv[j])) * fexp(suf[j] + base);
                    u32x4& w = wq[2 * p2 + par];
                    w.x = cvt_pk_bf16(kh[0], kh[1]); w.y = cvt_pk_bf16(kh[2], kh[3]); w.z = cvt_pk_bf16(kh[4], kh[5]); w.w = cvt_pk_bf16(kh[6], kh[7]); } }
            asm volatile("" : "+v"(wq[0].x), "+v"(wq[0].y), "+v"(wq[0].z), "+v"(wq[0].w), "+v"(wq[1].x), "+v"(wq[1].y), "+v"(wq[1].z), "+v"(wq[1].w),
                              "+v"(wq[2].x), "+v"(wq[2].y), "+v"(wq[2].z), "+v"(wq[2].w), "+v"(wq[3].x), "+v"(wq[3].y), "+v"(wq[3].z), "+v"(wq[3].w));
#pragma unroll
            for (int d4 = 0; d4 < 4; ++d4) kf[4 * dg + d4][ks] = __builtin_bit_cast(bf16x8, wq[d4]); } }
#pragma unroll 1
    for (int ep = 0; ep < 4; ++ep) {
        int zz = 0; asm volatile("" : "+v"(zz)); const int ecol = 32 * ep + 2 * r + zz;
        unsigned vw[2][8];
#pragma unroll
        for (int ks = 0; ks < 2; ++ks)
#pragma unroll
            for (int j = 0; j < 8; ++j) { const int s = 32 * ks + 8 * q + j; vw[ks][j] = s < nrows ? *(const unsigned*)(Vp + (size_t)s * 1024 + h * 128 + ecol) : 0u; }
#pragma unroll
        for (int par = 0; par < 2; ++par) {
            bf16x8 vf[2];
#pragma unroll
            for (int ks = 0; ks < 2; ++ks) { u32x4 w;
                if (par == 0) { w.x = (vw[ks][0] & 0xffffu) | (vw[ks][1] << 16); w.y = (vw[ks][2] & 0xffffu) | (vw[ks][3] << 16); w.z = (vw[ks][4] & 0xffffu) | (vw[ks][5] << 16); w.w = (vw[ks][6] & 0xffffu) | (vw[ks][7] << 16); }
                else { w.x = (vw[ks][0] >> 16) | (vw[ks][1] & 0xffff0000u); w.y = (vw[ks][2] >> 16) | (vw[ks][3] & 0xffff0000u); w.z = (vw[ks][4] >> 16) | (vw[ks][5] & 0xffff0000u); w.w = (vw[ks][6] >> 16) | (vw[ks][7] & 0xffff0000u); }
                vf[ks] = __builtin_bit_cast(bf16x8, w); }
            f32x4 acc[8];
#pragma unroll
            for (int dt = 0; dt < 8; ++dt) { acc[dt] = (f32x4){0.f, 0.f, 0.f, 0.f};
#pragma unroll
                for (int ks = 0; ks < 2; ++ks) acc[dt] = __builtin_amdgcn_mfma_f32_16x16x32_bf16(kf[dt][ks], vf[ks], acc[dt], 0, 0, 0); }
#pragma unroll
            for (int dp = 0; dp < 4; ++dp) { u32x4 w; w.x = cvt_pk_bf16(acc[2 * dp][0], acc[2 * dp + 1][0]); w.y = cvt_pk_bf16(acc[2 * dp][1], acc[2 * dp + 1][1]); w.z = cvt_pk_bf16(acc[2 * dp][2], acc[2 * dp + 1][2]); w.w = cvt_pk_bf16(acc[2 * dp][3], acc[2 * dp + 1][3]);
                { const int e = 32 * ep + 2 * r + par;
                  *(u32x4*)(Uout + ((size_t)((e >> 4) * 4 + dp) * 64 + q * 16 + (e & 15)) * 8) = w; } } }
    }
}
__device__ __forceinline__ void p2_states(const Args& a, int G) {
    const int tid = threadIdx.x, lane = tid & 63, wave = __builtin_amdgcn_readfirstlane(tid >> 6);
    const u16* Gb = (const u16*)(a.ws + WS_G); const u16* Vb = (const u16*)(a.ws + WS_V); u16* US = (u16*)a.out; float* DK = (float*)(a.ws + WS_DK);
    for (int it = blockIdx.x; it < BATCH * NCH + (G == 256 ? 0 : 1); it += G) {
        if (it < BATCH * NCH) { const size_t row0 = (size_t)it * CHK;
            p2_wave(Gb + row0 * 1024, Vb + row0 * 1024, CHK, wave, US + ((size_t)it * 8 + wave) * 16384, DK + (size_t)it * 1024, lane); }
        else p2_wave((const u16*)(a.ws + WS_GM), (const u16*)(a.ws + WS_VM), NMETA, wave, (u16*)(a.ws + WS_UM) + (size_t)wave * 16384, nullptr, lane);
    }
}

__device__ __forceinline__ void p3_scan(const Args& a, LAS unsigned char* lds, int G) {
    const int tid = threadIdx.x, lane = tid & 63, wave = __builtin_amdgcn_readfirstlane(tid >> 6);
    {
        LAS float* scr = (LAS float*)(lds + wave * 16384);
        const int gw = (int)blockIdx.x * NWAVES + wave, NGW = G * NWAVES;
        for (int it = gw; it < 2 * 16 * 88; it += NGW) { const int up = it >= 16 * 88, r = up ? it - 16 * 88 : it, kb = r / 88, nb = r % 88, n0 = 32 * nb;
            tr_item(up ? a.w_up : a.w_gate, DFF, 64 * kb, n0, (u16*)(a.ws + WS_WGU), (n0 >> 7) * 256 + (n0 & 127) + (up ? 128 : 0), 1024, 0, a.g_ffn, scr, lane); }
    }
    u16* US = (u16*)a.out; const float* DK = (const float*)(a.ws + WS_DK); const u16* UM = (const u16*)(a.ws + WS_UM);
    for (int idx = blockIdx.x * NTHR + tid; idx < BATCH * 8 * 128 * 64; idx += G * NTHR) {
        const int pr = idx & 8191, h = (idx >> 13) & 7, b = idx >> 16;
        const int d = 32 * ((pr >> 8) & 3) + 8 * ((pr >> 6) & 3) + 2 * (pr & 3);
        const unsigned um = *(const unsigned*)(UM + (size_t)h * 16384 + 2 * pr);
        float s0 = bf_lo(um), s1 = bf_hi(um);
        unsigned* up = (unsigned*)(US + ((size_t)(b * NCH) * 8 + h) * 16384 + 2 * pr);
        const float* dkp = DK + (size_t)(b * NCH) * 1024 + h * 128 + d;
#pragma unroll 1
        for (int c0 = 0; c0 < NCH; c0 += 16) {
            unsigned uu[16]; float dd0[16], dd1[16];
#pragma unroll
            for (int i = 0; i < 16; ++i) { uu[i] = up[(size_t)(c0 + i) * 8 * 8192]; const f32v2_t dk2 = *(const f32v2_t*)(dkp + (size_t)(c0 + i) * 1024); dd0[i] = dk2[0]; dd1[i] = dk2[1]; }
#pragma unroll
            for (int i = 0; i < 16; ++i) { up[(size_t)(c0 + i) * 8 * 8192] = cvt_pk_bf16(s0, s1); s0 = dd0[i] * s0 + bf_lo(uu[i]); s1 = dd1[i] * s1 + bf_hi(uu[i]); }
        }
    }
}

constexpr int P4_PITCH = 272, P4_MAT = 64 * P4_PITCH  , P4_VPITCH = 136, P4_HS = 4 * P4_MAT  , P4_TOT = 2 * P4_HS  , P4_PLD = P4_TOT + 4096  ;
static_assert(P4_PLD + P4_MAT + 64 <= LDS_BYTES, "LDS map");
__device__ __forceinline__ unsigned ld_pl(const u16* PB, const u16* PLM, int b, int tx, int cofs) {
    return tx >= 0 ? *(const unsigned*)(PB + (size_t)(b * SEQ + tx) * 1024 + 512 + cofs) : *(const unsigned*)(PLM + (size_t)(NMETA + tx) * 512 + cofs);
}
__device__ __forceinline__ void p4_outputs(const Args& a, LAS unsigned char* lds, int G, int skip = 0) {
    (void)skip;
    const int tid = threadIdx.x, lane = tid & 63, wave = __builtin_amdgcn_readfirstlane(tid >> 6);
    const int r = lane & 15, q = lane >> 4;
    u16* Qb = (u16*)(a.ws + WS_Q); const u16* Gb = (const u16*)(a.ws + WS_G); const u16* Vb = (const u16*)(a.ws + WS_V); const u16* OGb = (const u16*)(a.ws + WS_OG);
    u16* PB = (u16*)(a.ws + WS_PB); const u16* PLM = (const u16*)(a.ws + WS_PLM); const u16* PWT = (const u16*)(a.ws + WS_PWT); const u16* US = (const u16*)a.out;
    LAS unsigned char* PLD = lds + P4_PLD;
    for (int item = blockIdx.x; item < BATCH * NCH * 4; item += G) {
        const int hp = item & 3, bc = item >> 2, c = bc & (NCH - 1), b = bc >> 7;
        const size_t row0 = (size_t)b * SEQ + (size_t)c * CHK;
        const int hs = wave >> 2, tq = wave & 3, h = 2 * hp + hs;
        LAS unsigned char* L = lds + hs * P4_HS;
        LAS unsigned char* KT = L, *QT = L + P4_MAT, *QH = L + 2 * P4_MAT, *VT = L + 3 * P4_MAT;
        LAS float* TOT = (LAS float*)(lds + P4_TOT) + hs * 512;
        const int d0 = 2 * lane; const size_t cofs = (size_t)h * 128 + d0;
        unsigned gp[16], qv[16], vv[16];
#pragma unroll
        for (int i = 0; i < 16; ++i) { const size_t o = (row0 + 16 * tq + i) * 1024 + cofs; gp[i] = __builtin_nontemporal_load((const unsigned*)(Gb + o)); qv[i] = __builtin_nontemporal_load((const unsigned*)(Qb + o)); vv[i] = __builtin_nontemporal_load((const unsigned*)(Vb + o)); }
        const int gi = hp, wlen = 2 << gi; const float inv = 1.0f / (float)wlen;
        const int t0 = 8 * wave, pcofs = gi * 128 + 2 * lane, tx0 = c * CHK + t0;
        unsigned pu[23];
#pragma unroll
        for (int j = 1; j < 16; ++j) pu[15 - j] = (j < wlen) ? ld_pl(PB, PLM, b, tx0 - j, pcofs) : 0u;
#pragma unroll
        for (int i = 0; i < 8; ++i) pu[15 + i] = ld_pl(PB, PLM, b, tx0 + i, pcofs);
        bf16x8 wf[4];
#pragma unroll
        for (int kd = 0; kd < 4; ++kd) wf[kd] = *(const bf16x8*)(PWT + (size_t)(gi * 128 + 16 * wave + r) * 128 + 32 * kd + 8 * q);
        float s0 = 0.f, s1 = 0.f;
#pragma unroll
        for (int i = 0; i < 16; ++i) { s0 += h2f((u16)(gp[i] & 0xffffu)); s1 += h2f((u16)(gp[i] >> 16)); }
        TOT[tq * 128 + d0] = s0; TOT[tq * 128 + d0 + 1] = s1;
        __syncthreads();
        {
            float w0 = 0.f, w1 = 0.f;
#pragma unroll
            for (int j = 1; j < 16; ++j) if (j < wlen) { w0 += bf_lo(pu[15 - j]); w1 += bf_hi(pu[15 - j]); }
#pragma unroll
            for (int i = 0; i < 8; ++i) { const float u0 = bf_lo(pu[15 + i]), u1 = bf_hi(pu[15 + i]); w0 += u0; w1 += u1;
                *(LAS unsigned*)(PLD + (t0 + i) * P4_PITCH + 4 * lane) = cvt_pk_bf16(w0 * inv - u0, w1 * inv - u1);
                const unsigned o = wlen == 2 ? pu[15 + i - 1] : (wlen == 4 ? pu[15 + i - 3] : (wlen == 8 ? pu[15 + i - 7] : pu[15 + i - 15]));
                w0 -= bf_lo(o); w1 -= bf_hi(o); }
        }
        float b0 = 0.f, b1 = 0.f;
#pragma unroll
        for (int t2 = 0; t2 < 3; ++t2) if (t2 < tq) { b0 += TOT[t2 * 128 + d0]; b1 += TOT[t2 * 128 + d0 + 1]; }
        const float bm0 = TOT[d0] + TOT[128 + d0], bm1 = TOT[d0 + 1] + TOT[128 + d0 + 1];
#pragma unroll
        for (int i = 0; i < 16; ++i) { const int t = 16 * tq + i; const float g0 = h2f((u16)(gp[i] & 0xffffu)), g1 = h2f((u16)(gp[i] >> 16)); b0 += g0; b1 += g1;
            const unsigned q2 = qv[i], v2 = vv[i];
            const float q0 = bf_lo(q2), q1 = bf_hi(q2), k0 = 1.0f - fexp(g0), k1 = 1.0f - fexp(g1);
            const float eb0 = fexp(b0), eb1 = fexp(b1), em0 = fexp(fminf(b0 - bm0, 80.f)), em1 = fexp(fminf(b1 - bm1, 80.f)), ek0 = fexp(fminf(bm0 - b0, 80.f)), ek1 = fexp(fminf(bm1 - b1, 80.f));
            *(LAS unsigned*)(QT + t * P4_PITCH + d0 * 2) = cvt_pk_bf16(q0 * em0, q1 * em1);
            *(LAS unsigned*)(QH + t * P4_PITCH + d0 * 2) = cvt_pk_bf16(q0 * eb0, q1 * eb1);
            *(LAS unsigned*)(KT + t * P4_PITCH + d0 * 2) = cvt_pk_bf16(k0 * ek0, k1 * ek1);
            *(LAS u16*)(VT + d0 * P4_VPITCH + t * 2) = (u16)(v2 & 0xffffu); *(LAS u16*)(VT + (d0 + 1) * P4_VPITCH + t * 2) = (u16)(v2 >> 16); }
        const u16* Sp = US + ((size_t)bc * 8 + h) * 16384;
        bf16x8 sfr[8][4];
#pragma unroll
        for (int et = 0; et < 8; ++et)
#pragma unroll
            for (int kd = 0; kd < 4; ++kd) sfr[et][kd] = *(const bf16x8*)(Sp + ((size_t)(et * 4 + kd) * 64 + lane) * 8);
        const int tt = tq;
        const size_t orow = (row0 + 16 * tt + r) * 1024 + (size_t)h * 128;
        __syncthreads();
        u32x2 ogv[8];
#pragma unroll
        for (int et = 0; et < 8; ++et) ogv[et] = __builtin_nontemporal_load((const u32x2*)(OGb + orow + 16 * et + 4 * q));
        {
            f32x4 acc[4];
#pragma unroll
            for (int t4 = 0; t4 < 4; ++t4) acc[t4] = (f32x4){0.f, 0.f, 0.f, 0.f};
#pragma unroll
            for (int kd = 0; kd < 4; ++kd)
#pragma unroll
                for (int t4 = 0; t4 < 4; ++t4) { const bf16x8 pfr = *(const LAS bf16x8*)(PLD + (16 * t4 + r) * P4_PITCH + (32 * kd + 8 * q) * 2); acc[t4] = __builtin_amdgcn_mfma_f32_16x16x32_bf16(wf[kd], pfr, acc[t4], 0, 0, 0); }
            const int n0 = gi * 128 + 16 * wave + 4 * q; const f32x4 psc = *(const f32x4*)(a.pool_scale + n0);
#pragma unroll
            for (int t4 = 0; t4 < 4; ++t4) { u32x2 w; w.x = cvt_pk_bf16(acc[t4][0] * psc[0], acc[t4][1] * psc[1]); w.y = cvt_pk_bf16(acc[t4][2] * psc[2], acc[t4][3] * psc[3]);
                *(u32x2*)(PB + (row0 + 16 * t4 + r) * 1024 + n0) = w; }
        }
        bf16x8 qt[4], qh[4];
#pragma unroll
        for (int kd = 0; kd < 4; ++kd) { qt[kd] = *(const LAS bf16x8*)(QT + (16 * tt + r) * P4_PITCH + (32 * kd + 8 * q) * 2); qh[kd] = *(const LAS bf16x8*)(QH + (16 * tt + r) * P4_PITCH + (32 * kd + 8 * q) * 2); }
        f32x4 sc[4];
#pragma unroll
        for (int st = 0; st < 4; ++st) { f32x4 acc = (f32x4){0.f, 0.f, 0.f, 0.f};
            if (st <= tt) {
#pragma unroll
                for (int kd = 0; kd < 4; ++kd) { const bf16x8 kfr = *(const LAS bf16x8*)(KT + (16 * st + r) * P4_PITCH + (32 * kd + 8 * q) * 2); acc = __builtin_amdgcn_mfma_f32_16x16x32_bf16(kfr, qt[kd], acc, 0, 0, 0); }
                if (st == tt) {
#pragma unroll
                    for (int i = 0; i < 4; ++i) if (4 * q + i > r) acc[i] = 0.f; }
            }
            sc[st] = acc; }
        bf16x8 pf[2];
#pragma unroll
        for (int ks = 0; ks < 2; ++ks) { u32x4 w; w.x = cvt_pk_bf16(sc[2 * ks][0], sc[2 * ks][1]); w.y = cvt_pk_bf16(sc[2 * ks][2], sc[2 * ks][3]); w.z = cvt_pk_bf16(sc[2 * ks + 1][0], sc[2 * ks + 1][1]); w.w = cvt_pk_bf16(sc[2 * ks + 1][2], sc[2 * ks + 1][3]);
            pf[ks] = __builtin_bit_cast(bf16x8, w); }
        f32x4 oa[8]; float ss = 0.f;
#pragma unroll
        for (int et = 0; et < 8; ++et) { f32x4 acc = (f32x4){0.f, 0.f, 0.f, 0.f};
#pragma unroll
            for (int kd = 0; kd < 4; ++kd) acc = __builtin_amdgcn_mfma_f32_16x16x32_bf16(sfr[et][kd], qh[kd], acc, 0, 0, 0);
#pragma unroll
            for (int ks = 0; ks < 2; ++ks) if (2 * ks <= tt) {
                const u32x2 lo = *(const LAS u32x2*)(VT + (16 * et + r) * P4_VPITCH + (32 * ks + 4 * q) * 2), hi = *(const LAS u32x2*)(VT + (16 * et + r) * P4_VPITCH + (32 * ks + 16 + 4 * q) * 2);
                const u32x4 w = (u32x4){lo.x, lo.y, hi.x, hi.y};
                acc = __builtin_amdgcn_mfma_f32_16x16x32_bf16(__builtin_bit_cast(bf16x8, w), pf[ks], acc, 0, 0, 0); }
            oa[et] = acc; ss += (acc[0] * acc[0] + acc[1] * acc[1]) + (acc[2] * acc[2] + acc[3] * acc[3]); }
        ss += __shfl_xor(ss, 16); ss += __shfl_xor(ss, 32);
        const float rstd = rsqrtf(ss * (1.f / 128.f) + EPS);
#pragma unroll
        for (int et = 0; et < 8; ++et) { const int e0 = 16 * et + 4 * q; const f32x4 gn = *(const f32x4*)(a.g_hn + e0); const u32x2 og = ogv[et];
            u32x2 w; w.x = cvt_pk_bf16(oa[et][0] * rstd * gn[0] * bf_lo(og.x), oa[et][1] * rstd * gn[1] * bf_hi(og.x)); w.y = cvt_pk_bf16(oa[et][2] * rstd * gn[2] * bf_lo(og.y), oa[et][3] * rstd * gn[3] * bf_hi(og.y));
            *(LAS u32x2*)(QT + (16 * tt + r) * P4_PITCH + e0 * 2) = w; }
        asm volatile("s_waitcnt lgkmcnt(0)" ::: "memory");
#pragma unroll
        for (int i = 0; i < 4; ++i) { const int rr = 16 * tt + 4 * i + (lane >> 4); const u32x4 v = *(const LAS u32x4*)(QT + rr * P4_PITCH + (lane & 15) * 16);
            *(u32x4*)(Qb + (row0 + rr) * 1024 + (size_t)h * 128 + (lane & 15) * 8) = v; }
    }
    __syncthreads();
}

__device__ __forceinline__ void p9_final(const Args& a, int G) {
    const int tid = threadIdx.x, lane = tid & 63, wave = __builtin_amdgcn_readfirstlane(tid >> 6);
    const float* rsq = (const float*)(a.ws + WS_RSQ);
    const f32x4* gr = (const f32x4*)a.g_fin + lane; f32x4 gv[4];
#pragma unroll
    for (int j = 0; j < 4; ++j) gv[j] = gr[64 * j];
    for (int m = 2 * (blockIdx.x * NWAVES + wave); m < M; m += 2 * G * NWAVES) {
        float p = lane < 32 ? rsq[(size_t)m * 16 + lane] : 0.f;
        f32x4* xr = (f32x4*)(a.out + (size_t)m * DM) + lane; f32x4 v[8];
#pragma unroll
        for (int j = 0; j < 8; ++j) v[j] = xr[64 * j];
        p += __shfl_xor(p, 1); p += __shfl_xor(p, 2); p += __shfl_xor(p, 4); p += __shfl_xor(p, 8);
        const float r0 = rsqrtf(__shfl(p, 0) * (1.f / DM) + EPS), r1 = rsqrtf(__shfl(p, 16) * (1.f / DM) + EPS);
#pragma unroll
        for (int j = 0; j < 8; ++j) { const float rs = j < 4 ? r0 : r1; const f32x4 g4 = gv[j & 3]; xr[64 * j] = (f32x4){v[j].x * rs * g4.x, v[j].y * rs * g4.y, v[j].z * rs * g4.z, v[j].w * rs * g4.w}; }
    }
}

#ifdef PROBE_STOP
__device__ __forceinline__ void p_dump(const Args& a, int G) {
    const u16* Qb = (const u16*)(a.ws + WS_Q); const u16* Gb = (const u16*)(a.ws + WS_G); const u16* Vb = (const u16*)(a.ws + WS_V); const u16* OGb = (const u16*)(a.ws + WS_OG);
    const u16* GAb = (const u16*)(a.ws + WS_GA); const u16* GBb = (const u16*)(a.ws + WS_GB); const u16* PB = (const u16*)(a.ws + WS_PB);
    for (size_t i = (size_t)blockIdx.x * NTHR + threadIdx.x; i < (size_t)M * DM; i += (size_t)G * NTHR) {
        float v = 0.f;
        if (PROBE_STOP == 1) v = bf1(Qb[i]) + h2f(Gb[i]) + bf1(Vb[i]) + bf1(OGb[i]) + bf1(GAb[i]) + bf1(GBb[i]) + bf1(PB[i]);
        else if (PROBE_STOP == 2 || PROBE_STOP == 3) { float t = bf1(((const u16*)a.out)[i]) + bf1(((const u16*)a.out)[i + (size_t)M * DM]); if (!(fabsf(t) < 1e30f)) t = 12345.f; ((float*)(a.ws + WS_GA))[i] = t; continue; }
        else if (PROBE_STOP == 4) v = bf1(Qb[i]) + bf1(PB[i]);
        else if (PROBE_STOP == 5) v = bf1(Gb[i]);
        else continue;
        a.out[i] = v;
    }
}
#endif
__device__ __forceinline__ void flat_barrier(unsigned* cnt) {
    asm volatile("s_waitcnt vmcnt(0)" ::: "memory");
    __syncthreads();
    if (threadIdx.x == 0) {
        const unsigned Gn = gridDim.x;
        __builtin_amdgcn_fence(__ATOMIC_RELEASE, "agent");
        asm volatile("s_waitcnt vmcnt(0)" ::: "memory");
        const unsigned old = __hip_atomic_fetch_add(cnt, 1u, __ATOMIC_RELAXED, __HIP_MEMORY_SCOPE_AGENT);
        const unsigned target = (old / Gn + 1u) * Gn; unsigned sp = 0;
        while (__hip_atomic_load(cnt, __ATOMIC_RELAXED, __HIP_MEMORY_SCOPE_AGENT) < target) { __builtin_amdgcn_s_sleep(1); if (++sp > (1u << 22)) break; }
        __builtin_amdgcn_fence(__ATOMIC_ACQUIRE, "agent");
        asm volatile("s_waitcnt vmcnt(0)" ::: "memory");
    }
    __syncthreads();
}
constexpr int NPH = 10;
__global__ void __launch_bounds__(NTHR, 2) mega(Args a) {
    extern __shared__ __attribute__((aligned(16))) unsigned char lds_raw[];
    LAS unsigned char* lds = (LAS unsigned char*)lds_raw;
    cg::grid_group grid = cg::this_grid();
    const int G = gridDim.x, lo = a.ph_lo, hi = a.ph_hi;
    unsigned char* ws = a.ws;
    volatile LAS unsigned* MISC = (volatile LAS unsigned*)(lds + LDS_BYTES - 64);
    if (threadIdx.x < 16) MISC[threadIdx.x] = 0u;
    __syncthreads();
    XcdBarrier bar; bar.bar = (unsigned*)(ws + WS_BAR); bar.x = 0; bar.st = nullptr;
    if (hi - lo > 1) bar = xcd_barrier_post((unsigned*)(ws + WS_BAR), MISC);
    if (hi < 0) grid.sync();
#ifndef PHMASK
#define PHMASK 0x3ff
#endif
#define IN(k) (((PHMASK >> (k)) & 1) && lo <= (k) && (k) < hi)
#ifndef CG_SEAMS
#define CG_SEAMS 0x0
#endif
#define SEAM(k) do { if (IN(k) && IN((k) + 1)) { if ((CG_SEAMS >> (k)) & 1) grid.sync(); else xcd_barrier(bar); } } while (0)
#ifndef PROBE_DUP
#define PROBE_DUP 0
#endif
#ifndef PROBE_XSYNC
#define PROBE_XSYNC 0
#endif
#define DUP(k) (((PROBE_DUP >> (k)) & 1) ? 2 : 1)
    if (IN(0)) { p0_prologue(a, lds, G); } SEAM(0);
#ifdef PROBE_XBAR
    for (int xs = 0; xs < PROBE_XBAR; ++xs) flat_barrier((unsigned*)(ws + WS_BAR + 14 * KiB));
#endif
    if (IN(1)) { pg8::Gemm g{(const u16*)a.out, (const u16*)(ws + WS_WIN), M, INW, DM, DM, 1 << 30, 0L}; pg8::StaticOrder S; S.init(M, INW, G, (int)blockIdx.x);
        EpiIn E{ws}; pg8::gemm_phase<EpiIn, true>(lds, g, S, E);
        if (G == 256 && blockIdx.x == 255) p2_wave((const u16*)(ws + WS_GM), (const u16*)(ws + WS_VM), NMETA, (int)(threadIdx.x >> 6), (u16*)(ws + WS_UM) + (size_t)(threadIdx.x >> 6) * 16384, nullptr, (int)(threadIdx.x & 63));
        else if (G == 256 && blockIdx.x >= 128) late_weights(a, lds, ((int)blockIdx.x - 128) * NWAVES + (int)(threadIdx.x >> 6), 127 * NWAVES); }
    SEAM(1);
    if (IN(2)) { p2_states(a, G); } SEAM(2);
    if (IN(3)) { p3_scan(a, lds, G); } SEAM(3);
    if (IN(4)) { p4_outputs(a, lds, G); } SEAM(4);
    if (IN(5)) { pg8::Gemm g{(const u16*)(ws + WS_Q), (const u16*)(ws + WS_WAB), M, DM, 1536, DM, 16, (long)(WS_PB - WS_Q) - 16L * 128L}; pg8::StaticOrder S; S.init(M, DM, G, (int)blockIdx.x);
        EpiMerge E{(const u16*)(ws + WS_GA), (const u16*)(ws + WS_GB), (u16*)(ws + WS_MG)}; pg8::gemm_phase<EpiMerge, false>(lds, g, S, E); } SEAM(5);
    if (IN(6)) { pg8::Gemm g{(const u16*)(ws + WS_MG), (const u16*)(ws + WS_WOUT), M, DM, DM, DM, 1 << 30, 0L}; pg8::StaticOrder S; S.init(M, DM, G, (int)blockIdx.x);
        const bool fuse9_ = (G == (M / 256) * (DM / 256)) && (hi - lo > 1);
        EpiRes<true> E{a.x, fuse9_ ? nullptr : a.out, (u16*)(ws + WS_H1B), (float*)(ws + WS_RSQ)}; pg8::gemm_phase<EpiRes<true>, false>(lds, g, S, E); } SEAM(6);
    if (IN(7)) { pg8::Gemm g{(const u16*)(ws + WS_H1B), (const u16*)(ws + WS_WGU), M, NGU, DM, DM, 1 << 30, 0L}; pg8::StaticOrder S; S.init(M, NGU, G, (int)blockIdx.x);
        EpiFfn1 E{(const float*)(ws + WS_RSQ), (u16*)(ws + WS_ACT)}; pg8::gemm_phase<EpiFfn1, true>(lds, g, S, E); } SEAM(7);
    const bool fuse9 = (G == (M / 256) * (DM / 256)) && (hi - lo > 1);
    if (IN(8)) { pg8::Gemm g{(const u16*)(ws + WS_ACT), (const u16*)(ws + WS_WD), M, DM, DFF, DFF, 1 << 30, 0L}; pg8::StaticOrder S; S.init(M, DM, G, (int)blockIdx.x);
        if (fuse9) { EpiResNorm E{(const u16*)(ws + WS_H1B), a.out, a.g_fin, (float*)(ws + WS_RSQ), (unsigned*)(ws + WS_CNT)}; pg8::gemm_phase<EpiResNorm, false>(lds, g, S, E); }
        else { EpiRes<false> E{a.out, a.out, nullptr, (float*)(ws + WS_RSQ)}; pg8::gemm_phase<EpiRes<false>, false>(lds, g, S, E); } }
    if (!fuse9) { SEAM(8);
    if (IN(9)) { p9_final(a, G); } }
#ifdef PROBE_LIST
    if (lo == 20) p0_prologue(a, lds, G, 1);
    if (lo == 30) p0_prologue(a, lds, G, 2);
    if (lo == 40) p0_prologue(a, lds, G, 4);
    if (lo == 14) p4_outputs(a, lds, G, 1);
    if (lo == 24) p4_outputs(a, lds, G, 2);
    if (lo == 34) p4_outputs(a, lds, G, 2 | 4);
    if (lo == 44) p4_outputs(a, lds, G, 2 | 8);
    if (lo == 54) p4_outputs(a, lds, G, 2 | 16);
    if (lo == 64) p4_outputs(a, lds, G, 2 | 32);
    if (lo == 74) p4_outputs(a, lds, G, 2 | 64);
    if (lo == 18) { pg8::Gemm g{(const u16*)(ws + WS_ACT), (const u16*)(ws + WS_WD), M, DM, DFF, DFF, 1 << 30, 0L}; pg8::StaticOrder S; S.init(M, DM, G, (int)blockIdx.x);
        EpiRes<false> E{(const float*)(ws + WS_GA), (float*)(ws + WS_GA), nullptr, (float*)(ws + WS_OG)}; pg8::gemm_phase<EpiRes<false>, false>(lds, g, S, E); }
    if (lo == 19) { Args b = a; b.out = (float*)(ws + WS_GA); p9_final(b, G); }
#endif
#ifdef PROBE_STOP
    if (lo == 10) p_dump(a, G);
    if (lo == 11 && (PROBE_STOP == 2 || PROBE_STOP == 3)) { for (size_t i = (size_t)blockIdx.x * NTHR + threadIdx.x; i < (size_t)M * DM; i += (size_t)G * NTHR) a.out[i] = ((const float*)(a.ws + WS_GA))[i]; }
#endif
#undef IN
#undef SEAM
}

extern "C" void kernel_launch(void* const* d_in, const int* in_sizes, int n_in, void* d_out, int out_size, void* d_ws, size_t ws_size, hipStream_t stream) {
    static int grid = 0;
    if (grid == 0) {
        if (n_in != 16 || in_sizes[0] != M * DM || out_size != M * DM || ws_size < WS_END) { fprintf(stderr, "kernel_launch: unexpected shapes (n_in %d, in0 %d, out %d, ws %zu); nothing launched\n", n_in, n_in > 0 ? in_sizes[0] : -1, out_size, ws_size); grid = -1; return; }
        int dev = 0, cus = 0, per_cu = 0;
        (void)hipGetDevice(&dev); (void)hipDeviceGetAttribute(&cus, hipDeviceAttributeMultiprocessorCount, dev);
        if (hipFuncSetAttribute((const void*)mega, hipFuncAttributeMaxDynamicSharedMemorySize, LDS_BYTES) != hipSuccess) { fprintf(stderr, "kernel_launch: hipFuncSetAttribute failed\n"); }
        if (hipOccupancyMaxActiveBlocksPerMultiprocessor(&per_cu, (const void*)mega, NTHR, LDS_BYTES) != hipSuccess || per_cu < 1) per_cu = 1;
        (void)hipGetLastError();
        if (cus <= 0) cus = 256;
        grid = cus * per_cu;
    }
    if (grid < 0) return;
#if MK_COOP
    if (hipMemsetAsync((char*)d_ws + WS_BAR, 0, CTL_ZERO, stream) != hipSuccess) { fprintf(stderr, "kernel_launch: hipMemsetAsync of the barrier words failed\n"); return; }
#endif
    Args a{};
    a.x = (const float*)d_in[0]; a.meta = (const float*)d_in[1]; a.g_mix = (const float*)d_in[2]; a.w_in = (const float*)d_in[3]; a.lb_raw = (const float*)d_in[4]; a.g_hn = (const float*)d_in[5];
    a.pool_w = (const float*)d_in[6]; a.pool_scale = (const float*)d_in[7]; a.w_a = (const float*)d_in[8]; a.w_b = (const float*)d_in[9]; a.w_out = (const float*)d_in[10]; a.g_ffn = (const float*)d_in[11];
    a.w_gate = (const float*)d_in[12]; a.w_up = (const float*)d_in[13]; a.w_down = (const float*)d_in[14]; a.g_fin = (const float*)d_in[15];
    a.out = (float*)d_out; a.ws = (unsigned char*)d_ws;
#if MK_COOP
    a.ph_lo = 0; a.ph_hi = NPH;
    void* args[] = {&a};
    const hipError_t e = hipLaunchCooperativeKernel((const void*)mega, dim3(grid), dim3(NTHR), args, LDS_BYTES, stream);
    if (e != hipSuccess) fprintf(stderr, "kernel_launch: cooperative launch failed: %s (grid %d)\n", hipGetErrorString(e), grid);
#else
#ifdef PROBE_STOP
    for (int ph = 0; ph <= PROBE_STOP; ++ph) { a.ph_lo = ph; a.ph_hi = ph + 1; hipLaunchKernelGGL(mega, dim3(grid), dim3(NTHR), LDS_BYTES, stream, a); }
    a.ph_lo = 10; a.ph_hi = 11; hipLaunchKernelGGL(mega, dim3(grid), dim3(NTHR), LDS_BYTES, stream, a);
    a.ph_lo = 11; a.ph_hi = 12; hipLaunchKernelGGL(mega, dim3(grid), dim3(NTHR), LDS_BYTES, stream, a);
#else
#ifdef PROBE_LIST
    { const int lst[] = PROBE_LIST; for (int i = 0; i < (int)(sizeof(lst) / sizeof(int)); ++i) { a.ph_lo = lst[i]; a.ph_hi = lst[i] + 1; hipLaunchKernelGGL(mega, dim3(grid), dim3(NTHR), LDS_BYTES, stream, a); } }
#else
    for (int ph = 0; ph < NPH; ++ph) { a.ph_lo = ph; a.ph_hi = ph + 1; hipLaunchKernelGGL(mega, dim3(grid), dim3(NTHR), LDS_BYTES, stream, a); }
#endif
#endif
#endif
}
```

```cpp
#include <hip/hip_runtime.h>
#include <hip/hip_cooperative_groups.h>
#include <cstdio>
#include <cstdint>
namespace cg = cooperative_groups;

#ifndef MK_COOP
#define MK_COOP 1
#endif

#define LAS __attribute__((address_space(3)))
typedef unsigned short u16;
typedef short bf16x8 __attribute__((ext_vector_type(8)));
typedef float f32x4 __attribute__((ext_vector_type(4)));
typedef unsigned u32x4 __attribute__((ext_vector_type(4)));
typedef unsigned u32x2 __attribute__((ext_vector_type(2)));

typedef __bf16 bf16v2_t __attribute__((ext_vector_type(2)));
typedef float f32v2_t __attribute__((ext_vector_type(2)));
__device__ __forceinline__ unsigned cvt_pk_bf16(float lo, float hi) { const f32v2_t f = {lo, hi}; const bf16v2_t v = __builtin_convertvector(f, bf16v2_t); return __builtin_bit_cast(unsigned, v); }
__device__ __forceinline__ float bf_lo(unsigned w) { return __uint_as_float(w << 16); }
__device__ __forceinline__ float bf_hi(unsigned w) { return __uint_as_float(w & 0xffff0000u); }
__device__ __forceinline__ float bf1(u16 w) { return __uint_as_float((unsigned)w << 16); }
__device__ __forceinline__ unsigned pk_h(float a, float b) { const _Float16 x = (_Float16)a, y = (_Float16)b; return (unsigned)__builtin_bit_cast(unsigned short, x) | ((unsigned)__builtin_bit_cast(unsigned short, y) << 16); }
__device__ __forceinline__ float h2f(u16 w) { return (float)__builtin_bit_cast(_Float16, w); }
__device__ __forceinline__ float fexp(float x) { return __builtin_amdgcn_exp2f(x * 1.44269504088896341f); }
__device__ __forceinline__ float flog(float x) { return __builtin_amdgcn_logf(x) * 0.693147180559945309f; }
__device__ __forceinline__ float sigm(float z) { return __builtin_amdgcn_rcpf(1.0f + fexp(-z)); }

namespace pg8 {
constexpr int BM = 256, BK = 64, HALF = 128, HTB = HALF * BK * 2, STAGE_BYTES = 8 * HTB, NXCD = 8, WGM = 8;
__host__ __device__ __forceinline__ int lds_byte(int r, int c) { const int st = (r >> 4) * 2 + (c >> 5), rr = r & 15, cc = c & 31, ob = rr * 64 + cc * 2; return st * 1024 + (ob ^ (((ob >> 9) & 1) << 5)); }
__host__ __device__ __forceinline__ void stage_rc(int b, int& R, int& C) { const int st = b / 1024, sb = b % 1024, swz = sb ^ (((sb >> 9) & 1) << 5); R = (st >> 1) * 16 + swz / 64; C = (st & 1) * 32 + (swz % 64) / 2; }
__host__ __device__ __forceinline__ int perm32(int rho) { const int n = rho >> 4, i = rho & 15; return 8 * (i >> 2) + 4 * n + (i & 3); }
struct Unit { int pm, pn; };
struct Gemm { const u16* A; const u16* Bt; int M, N, K, lda, ksplit; long a2delta; };
struct StaticOrder {
    int nM, nN, nwg, G, c;
    __host__ __device__ void init(int M, int N, int G_, int c_) { nM = M / BM; nN = N / BM; nwg = nM * nN; G = G_; c = c_; }
    __host__ __device__ bool next(int i, Unit& u) const {
        const long L = (long)i * G + c; if (L >= nwg) return false;
        int wgid = (int)L; { const int q = nwg / NXCD, r = nwg % NXCD, xcd = wgid % NXCD, off = wgid / NXCD; wgid = (xcd < r ? xcd * (q + 1) : r * (q + 1) + (xcd - r) * q) + off; }
        const int nig = WGM * nN, gid = wgid / nig, fm = gid * WGM, gsz = (nM - fm) < WGM ? (nM - fm) : WGM;
        u.pm = fm + ((wgid % nig) % gsz); u.pn = (wgid % nig) / gsz; return true;
    }
};
template <class Epi, bool ALIGN_EPI>
__device__ __forceinline__ void gemm_phase(LAS unsigned char* lds, const Gemm g, const StaticOrder& S, const Epi& E) {
    const int tid = threadIdx.x, wid = __builtin_amdgcn_readfirstlane(tid >> 6), lane = tid & 63, wr = wid >> 2, wc = wid & 3, fr = lane & 15, fq = lane >> 4;
    const int K = g.K, nt = K / BK, lda = g.lda;
    unsigned voffA[2], voffB[2];
#pragma unroll
    for (int i = 0; i < 2; ++i) { int R, C; stage_rc(tid * 16 + i * 8192, R, C); const int Rb = Epi::PERM ? ((R & ~31) + perm32(R & 31)) : R;
        voffA[i] = (unsigned)(R * lda + C) * 2u; voffB[i] = (unsigned)(Rb * K + C) * 2u; }
    const size_t kstep = (size_t)(BK * 2);
    const size_t hstepA = (size_t)HALF * lda * 2, tstepA = 2 * hstepA;
    const size_t hstepB = (size_t)HALF * K * 2, tstepB = 2 * hstepB;
    const unsigned ldsw = (unsigned)wid * 1024u;
    const int aoff = lds_byte(wr * 64 + fr, fq * 8), boff = lds_byte(wc * 32 + fr, fq * 8);
#define PG8_SA(b, h) (((b) * 2 + (h)) * HTB)
#define PG8_SB(b, h) ((4 + (b) * 2 + (h)) * HTB)
#define PG8_STAGE(bufoff, gbase, voff) do { _Pragma("unroll") for (int _i = 0; _i < 2; ++_i) \
        __builtin_amdgcn_global_load_lds((const unsigned*)((const char*)(gbase) + (voff)[_i]), (LAS unsigned*)(lds + (bufoff) + ldsw + _i * 8192), 16, 0, 0); } while (0)
#define PG8_STAGEA(bufoff, gbase, voff) do { _Pragma("unroll") for (int _i = 0; _i < 2; ++_i) \
        __builtin_amdgcn_global_load_lds((const unsigned*)((const char*)(gbase) + (voff)[_i]), (LAS unsigned*)(lds + (bufoff) + ldsw + _i * 8192), 16, 0, Epi::A_AUX); } while (0)
#define PG8_LDA(dst, b, h) do { _Pragma("unroll") for (int m = 0; m < 4; ++m) _Pragma("unroll") for (int k = 0; k < 2; ++k) dst[m][k] = *(const LAS bf16x8*)(lds + PG8_SA(b, h) + aoff + m * 2048 + k * 1024); } while (0)
#define PG8_LDB(dst, b, h) do { _Pragma("unroll") for (int n = 0; n < 2; ++n) _Pragma("unroll") for (int k = 0; k < 2; ++k) dst[n][k] = *(const LAS bf16x8*)(lds + PG8_SB(b, h) + boff + n * 2048 + k * 1024); } while (0)
#define PG8_MMA(ai, bj, At, Bt) do { __builtin_amdgcn_s_setprio(1); _Pragma("unroll") for (int m = 0; m < 4; ++m) _Pragma("unroll") for (int n = 0; n < 2; ++n) _Pragma("unroll") for (int k = 0; k < 2; ++k) \
        acc[ai][bj][m][n] = __builtin_amdgcn_mfma_f32_16x16x32_bf16(Bt[n][k], At[m][k], acc[ai][bj][m][n], 0, 0, 0); __builtin_amdgcn_s_setprio(0); } while (0)
#define PG8_WAIT_V(n) asm volatile("s_waitcnt vmcnt(" #n ")" ::: "memory")
#define PG8_WAIT_L(n) asm volatile("s_waitcnt lgkmcnt(" #n ")" ::: "memory")
#define PG8_BAR __builtin_amdgcn_s_barrier()
#define PG8_SCHED __builtin_amdgcn_sched_barrier(0)
    Unit cur, nxt; int ui = 0;
    if (!S.next(0, cur)) return;
    f32x4 acc[2][2][4][2];
#pragma unroll
    for (int a = 0; a < 2; ++a)
#pragma unroll
        for (int b = 0; b < 2; ++b)
#pragma unroll
            for (int m = 0; m < 4; ++m)
#pragma unroll
                for (int n = 0; n < 2; ++n) acc[a][b][m][n] = (f32x4){0.f, 0.f, 0.f, 0.f};
    bf16x8 At[4][2], B0[2][2], B1[2][2];
    const char* cA = (const char*)g.A + (size_t)cur.pm * tstepA; const char* cB = (const char*)g.Bt + (size_t)cur.pn * tstepB;
    PG8_STAGE(PG8_SB(0, 0), cB, voffB); PG8_STAGE(PG8_SB(0, 1), cB + hstepB, voffB); PG8_STAGEA(PG8_SA(0, 0), cA, voffA); PG8_STAGEA(PG8_SA(0, 1), cA + hstepA, voffA);
    if (wr == 1) PG8_BAR;
    PG8_WAIT_V(2); PG8_BAR;
    PG8_STAGE(PG8_SB(1, 0), cB + kstep, voffB); PG8_STAGEA(PG8_SA(1, 0), cA + kstep, voffA); PG8_STAGE(PG8_SB(1, 1), cB + hstepB + kstep, voffB);
    PG8_WAIT_V(6); PG8_BAR;
    for (;;) {
        const bool has_next = S.next(ui + 1, nxt);
        const char* nA = has_next ? (const char*)g.A + (size_t)nxt.pm * tstepA : cA; const char* nB = has_next ? (const char*)g.Bt + (size_t)nxt.pn * tstepB : cB;
        for (int t = 0; t < nt; t += 2) {
            const bool last = (t == nt - 2);
            if constexpr (Epi::MID) { if (t == g.ksplit) E.mid(acc, cur, wr, wc, fr, fq); }
            const char* a1 = cA + (size_t)(t + 1) * kstep + (t >= g.ksplit ? g.a2delta : 0L);
            const char* a2 = last ? nA : cA + (size_t)(t + 2) * kstep + (t + 2 >= g.ksplit ? g.a2delta : 0L);
            const char* b2 = last ? nB : cB + (size_t)(t + 2) * kstep;
            const char* a3 = a2 + kstep; const char* b3 = b2 + kstep;
            PG8_LDB(B0, 0, 0); PG8_LDB(B1, 0, 1); PG8_SCHED; PG8_LDA(At, 0, 0); PG8_STAGEA(PG8_SA(1, 1), a1 + hstepA, voffA);
            PG8_WAIT_V(8); PG8_WAIT_L(0); PG8_BAR; PG8_MMA(0, 0, At, B0); PG8_MMA(0, 1, At, B1); PG8_BAR; PG8_SCHED;
            PG8_LDA(At, 0, 1); PG8_STAGE(PG8_SB(0, 0), b2, voffB); PG8_STAGE(PG8_SB(0, 1), b2 + hstepB, voffB); PG8_STAGEA(PG8_SA(0, 0), a2, voffA);
            PG8_WAIT_V(8); PG8_WAIT_L(0); PG8_BAR; PG8_MMA(1, 0, At, B0); PG8_MMA(1, 1, At, B1); PG8_BAR; PG8_SCHED;
            PG8_LDB(B0, 1, 0); PG8_LDB(B1, 1, 1); PG8_SCHED; PG8_LDA(At, 1, 0); PG8_STAGEA(PG8_SA(0, 1), a2 + hstepA, voffA);
            PG8_WAIT_V(8); PG8_WAIT_L(0); PG8_BAR; PG8_MMA(0, 0, At, B0); PG8_MMA(0, 1, At, B1); PG8_BAR; PG8_SCHED;
            PG8_LDA(At, 1, 1); PG8_STAGE(PG8_SB(1, 0), b3, voffB); PG8_STAGE(PG8_SB(1, 1), b3 + hstepB, voffB); PG8_STAGEA(PG8_SA(1, 0), a3, voffA);
            PG8_WAIT_V(8); PG8_WAIT_L(0); PG8_BAR; PG8_MMA(1, 0, At, B0); PG8_MMA(1, 1, At, B1); PG8_BAR; PG8_SCHED;
        }
        if constexpr (ALIGN_EPI) { if (wr == 0) PG8_BAR; }
        if constexpr (!Epi::AFTER) E(acc, cur, wr, wc, fr, fq);
        if (!has_next) break;
#pragma unroll
        for (int a = 0; a < 2; ++a)
#pragma unroll
            for (int b = 0; b < 2; ++b)
#pragma unroll
                for (int m = 0; m < 4; ++m)
#pragma unroll
                    for (int n = 0; n < 2; ++n) acc[a][b][m][n] = (f32x4){0.f, 0.f, 0.f, 0.f};
        cur = nxt; cA = nA; cB = nB; ++ui;
        if constexpr (ALIGN_EPI) { if (wr == 1) PG8_BAR; }
    }
    PG8_WAIT_V(0);
    if constexpr (!ALIGN_EPI) { if (wr == 0) PG8_BAR; }
    PG8_BAR;
    if constexpr (Epi::AFTER) E.after(acc, cur, wr, wc, fr, fq, lds, wid, lane);
#undef PG8_SA
#undef PG8_SB
#undef PG8_STAGE
#undef PG8_STAGEA
#undef PG8_LDA
#undef PG8_LDB
#undef PG8_MMA
#undef PG8_WAIT_V
#undef PG8_WAIT_L
#undef PG8_BAR
#undef PG8_SCHED
}
}

constexpr int NWAVES = 8, NTHR = 512;
constexpr int SEQ = 8192, BATCH = 2, DM = 1024, M = BATCH * SEQ, NMETA = 16, INW = 6656, DFF = 2816, NGU = 2 * DFF, CHK = 64, NCH = SEQ / CHK;
constexpr float EPS = 1e-6f;
constexpr size_t KiB = 1024, MiB = 1u << 20;
constexpr size_t WS_LB = 0, WS_GM = 64 * KiB, WS_VM = 128 * KiB, WS_PLM = 192 * KiB, WS_PWT = 256 * KiB, WS_UM = 512 * KiB, WS_DK = 1 * MiB, WS_RSQ = 2 * MiB;
constexpr size_t WS_WAB = 3 * MiB, WS_WOUT = 6 * MiB, WS_WD = 8 * MiB, WS_WIN = 14 * MiB, WS_WGU = 14 * MiB;
constexpr size_t WS_Q = 28 * MiB, WS_G = 60 * MiB, WS_V = 92 * MiB, WS_OG = 124 * MiB, WS_GA = 156 * MiB, WS_GB = 188 * MiB, WS_PB = 220 * MiB, WS_END = 252 * MiB;
constexpr size_t WS_MG = WS_G, WS_H1B = WS_GB, WS_ACT = WS_Q;
static_assert(WS_WD + (size_t)DM * DFF * 2 <= WS_WIN && WS_WIN + (size_t)INW * DM * 2 <= WS_Q && WS_WGU + (size_t)NGU * DM * 2 <= WS_Q && WS_ACT + (size_t)M * DFF * 2 <= WS_H1B, "ws map");
#ifndef AUX_STREAM
#define AUX_STREAM 0
#endif
constexpr int LDS_BYTES = 163840;
constexpr size_t WS_BAR = 16 * KiB, WS_CNT = 32 * KiB, CTL_ZERO = 32 * KiB;

struct Args {
    const float *x, *meta, *g_mix, *w_in, *lb_raw, *g_hn, *pool_w, *pool_scale, *w_a, *w_b, *w_out, *g_ffn, *w_gate, *w_up, *w_down, *g_fin;
    float* out; unsigned char* ws; int ph_lo, ph_hi;
};

#define LDS_WAIT() asm volatile("s_waitcnt lgkmcnt(0)" ::: "memory")
__device__ __forceinline__ float wave_sum(float v) {
#pragma unroll
    for (int o = 1; o < 64; o <<= 1) v += __shfl_xor(v, o);
    return v;
}

__device__ __forceinline__ void tr_item(const float* W, int N, int k0, int n0, u16* WT, int drow0, int dpitch, int dk0, const float* ks, LAS float* scr, int lane) {
    f32x4 wv[8];
#pragma unroll
    for (int i = 0; i < 8; ++i) wv[i] = __builtin_nontemporal_load((const f32x4*)(W + (size_t)(k0 + 8 * i + (lane >> 3)) * N + n0 + 4 * (lane & 7)));
#pragma unroll
    for (int i = 0; i < 8; ++i) { const int kk = 8 * i + (lane >> 3); f32x4 w = wv[i]; if (ks) w *= ks[k0 + kk];
        LAS float* d = scr + kk * 33 + 4 * (lane & 7); d[0] = w.x; d[1] = w.y; d[2] = w.z; d[3] = w.w; }
    LDS_WAIT(); asm volatile("" ::: "memory");
    const int c = lane & 7;
#pragma unroll
    for (int j = 0; j < 4; ++j) { const int n = (lane >> 3) + 8 * j; const LAS float* s = scr + (8 * c) * 33 + n;
        u32x4 o; o.x = cvt_pk_bf16(s[0 * 33], s[1 * 33]); o.y = cvt_pk_bf16(s[2 * 33], s[3 * 33]); o.z = cvt_pk_bf16(s[4 * 33], s[5 * 33]); o.w = cvt_pk_bf16(s[6 * 33], s[7 * 33]);
        *(u32x4*)(WT + (size_t)(drow0 + n) * dpitch + dk0 + k0 + 8 * c) = o; }
    LDS_WAIT(); asm volatile("" ::: "memory");
}
__device__ __forceinline__ void rms_row_bf16(const float* xrow, const float* g, u16* orow, int lane) {
    const f32x4* xr = (const f32x4*)xrow + lane; const f32x4* gr = (const f32x4*)g + lane;
    f32x4 v[4]; float s = 0.f;
#pragma unroll
    for (int j = 0; j < 4; ++j) { v[j] = xr[64 * j]; s += (v[j].x * v[j].x + v[j].y * v[j].y) + (v[j].z * v[j].z + v[j].w * v[j].w); }
    const float rstd = rsqrtf(wave_sum(s) * (1.f / DM) + EPS);
    u32x2* o8 = (u32x2*)orow + lane;
#pragma unroll
    for (int j = 0; j < 4; ++j) { const f32x4 gv = gr[64 * j]; u32x2 o; o.x = cvt_pk_bf16(v[j].x * rstd * gv.x, v[j].y * rstd * gv.y); o.y = cvt_pk_bf16(v[j].z * rstd * gv.z, v[j].w * rstd * gv.w); o8[64 * j] = o; }
}

__device__ __forceinline__ void p0_meta(const Args& a, LAS unsigned char* lds, int j, int tid, int wave, int lane) {
    LAS float* nm = (LAS float*)lds;
    LAS float* part = (LAS float*)(lds + 65536);
#pragma unroll
    for (int rr = 0; rr < 2; ++rr) { const int r = 2 * wave + rr; const f32x4* xr = (const f32x4*)(a.meta + (size_t)r * DM) + lane; const f32x4* gr = (const f32x4*)a.g_mix + lane;
        f32x4 v[4]; float s = 0.f;
#pragma unroll
        for (int q = 0; q < 4; ++q) { v[q] = xr[64 * q]; s += (v[q].x * v[q].x + v[q].y * v[q].y) + (v[q].z * v[q].z + v[q].w * v[q].w); }
        const float rstd = rsqrtf(wave_sum(s) * (1.f / DM) + EPS);
#pragma unroll
        for (int q = 0; q < 4; ++q) { const f32x4 gv = gr[64 * q]; *(LAS f32x4*)(nm + r * 1024 + 4 * (lane + 64 * q)) = (f32x4){v[q].x * rstd * gv.x, v[q].y * rstd * gv.y, v[q].z * rstd * gv.z, v[q].w * rstd * gv.w}; }
    }
    __syncthreads();
    const int colbase = j < 32 ? 1024 + 32 * j : (j < 64 ? 2048 + 32 * (j - 32) : 4096 + 32 * (j - 64));
    {
        const int col = colbase + (lane & 31), kh = lane >> 5; float acc[16];
#pragma unroll
        for (int r = 0; r < 16; ++r) acc[r] = 0.f;
#pragma unroll 4
        for (int k = 128 * wave + 64 * kh; k < 128 * wave + 64 * kh + 64; k += 4) {
            const float w0 = a.w_in[(size_t)(k + 0) * INW + col], w1 = a.w_in[(size_t)(k + 1) * INW + col], w2 = a.w_in[(size_t)(k + 2) * INW + col], w3 = a.w_in[(size_t)(k + 3) * INW + col];
#pragma unroll
            for (int r = 0; r < 16; ++r) { const f32x4 n4 = *(const LAS f32x4*)(nm + r * 1024 + k); acc[r] += (n4.x * w0 + n4.y * w1) + (n4.z * w2 + n4.w * w3); }
        }
#pragma unroll
        for (int r = 0; r < 16; ++r) part[(wave * 16 + r) * 64 + lane] = acc[r];
    }
    __syncthreads();
    {
        const int r = tid >> 5, cl = tid & 31; float z = 0.f;
#pragma unroll
        for (int w = 0; w < 8; ++w) z += part[(w * 16 + r) * 64 + cl] + part[(w * 16 + r) * 64 + 32 + cl];
        const int col = colbase + cl;
        if (col < 2048) { const int c = col - 1024; const float lb = 1.0f / (1.0f + fexp(a.lb_raw[1024 + c] - a.lb_raw[c])); const float f = lb + (1.0f - lb) * sigm(z);
            const _Float16 hv = (_Float16)flog(f); ((u16*)(a.ws + WS_GM))[r * 1024 + c] = __builtin_bit_cast(unsigned short, hv); }
        else if (col < 3072) { ((u16*)(a.ws + WS_VM))[r * 1024 + (col - 2048)] = (u16)(cvt_pk_bf16(z, 0.f) & 0xffffu); }
        else { ((u16*)(a.ws + WS_PLM))[r * 512 + (col - 4096)] = (u16)(cvt_pk_bf16(z, 0.f) & 0xffffu); }
    }
    __syncthreads();
}

__device__ __forceinline__ void late_weights(const Args& a, LAS unsigned char* lds, int gw, int NGW) {
    const int lane = threadIdx.x & 63, wave = __builtin_amdgcn_readfirstlane(threadIdx.x >> 6);
    LAS float* scr = (LAS float*)(lds + wave * 16384);
    constexpr int I_A = 16 * 32, I_B = 8 * 32, I_O = 16 * 32, I_D = 44 * 32, I_P = 32;
    constexpr int NIT = I_A + I_B + I_O + I_D + I_P;
    for (int it = gw; it < NIT; it += NGW) {
        int r = it;
        if (r < I_A) { tr_item(a.w_a, 1024, 64 * (r / 32), 32 * (r % 32), (u16*)(a.ws + WS_WAB), 32 * (r % 32), 1536, 0, nullptr, scr, lane); continue; } r -= I_A;
        if (r < I_B) { tr_item(a.w_b, 1024, 64 * (r / 32), 32 * (r % 32), (u16*)(a.ws + WS_WAB), 32 * (r % 32), 1536, 1024, nullptr, scr, lane); continue; } r -= I_B;
        if (r < I_O) { tr_item(a.w_out, 1024, 64 * (r / 32), 32 * (r % 32), (u16*)(a.ws + WS_WOUT), 32 * (r % 32), 1024, 0, nullptr, scr, lane); continue; } r -= I_O;
        if (r < I_D) { tr_item(a.w_down, 1024, 64 * (r / 32), 32 * (r % 32), (u16*)(a.ws + WS_WD), 32 * (r % 32), DFF, 0, nullptr, scr, lane); continue; } r -= I_D;
        { const int gi = r >> 3, q = r & 7; tr_item(a.pool_w + (size_t)gi * 16384, 128, 64 * (q >> 2), 32 * (q & 3), (u16*)(a.ws + WS_PWT) + (size_t)gi * 16384, 32 * (q & 3), 128, 0, nullptr, scr, lane); }
    }
}

__device__ __forceinline__ void p0_prologue(const Args& a, LAS unsigned char* lds, int G, int skip = 0) {
    const int tid = threadIdx.x, lane = tid & 63, wave = __builtin_amdgcn_readfirstlane(tid >> 6);
    const bool split = G > 160;
    if (!(skip & 4)) for (int j = (int)blockIdx.x; j < 80; j += G) p0_meta(a, lds, j, tid, wave, lane);
    if (split && (int)blockIdx.x < 80) return;
    if (blockIdx.x == 80 || (G <= 80 && blockIdx.x == 0)) { for (int c = tid; c < 1024; c += NTHR) ((float*)(a.ws + WS_LB))[c] = 1.0f / (1.0f + fexp(a.lb_raw[1024 + c] - a.lb_raw[c])); }
    LAS float* scr = (LAS float*)(lds + wave * 16384);
    const int gw = ((int)blockIdx.x - (split ? 80 : 0)) * NWAVES + wave, NGW = (G - (split ? 80 : 0)) * NWAVES;
    constexpr int I_IN = 16 * 208;
    for (int it = gw; it < I_IN && !(skip & 1); it += NGW) tr_item(a.w_in, INW, 64 * (it / 208), 32 * (it % 208), (u16*)(a.ws + WS_WIN), 32 * (it % 208), 1024, 0, nullptr, scr, lane);
    if (G != 256) late_weights(a, lds, gw, NGW);
    u16* XN = (u16*)a.out;
    {
        const f32x4* gr = (const f32x4*)a.g_mix + lane; f32x4 gv[4];
#pragma unroll
        for (int j = 0; j < 4; ++j) gv[j] = gr[64 * j];
        for (int m = 4 * gw; m < M && !(skip & 2); m += 4 * NGW) {
            const f32x4* xr = (const f32x4*)(a.x + (size_t)m * DM) + lane; f32x4 v[16]; float ss[4];
#pragma unroll
            for (int j = 0; j < 16; ++j) v[j] = __builtin_nontemporal_load(&xr[64 * j]);
#pragma unroll
            for (int rr = 0; rr < 4; ++rr) { float t = 0.f;
#pragma unroll
                for (int j = 0; j < 4; ++j) { const f32x4 w = v[4 * rr + j]; t += (w.x * w.x + w.y * w.y) + (w.z * w.z + w.w * w.w); }
                ss[rr] = t; }
#pragma unroll
            for (int o = 1; o < 64; o <<= 1) {
#pragma unroll
                for (int rr = 0; rr < 4; ++rr) ss[rr] += __shfl_xor(ss[rr], o); }
            u32x2* o8 = (u32x2*)(XN + (size_t)m * DM) + lane;
#pragma unroll
            for (int j = 0; j < 16; ++j) { const float rs = rsqrtf(ss[j >> 2] * (1.f / DM) + EPS); const f32x4 g4 = gv[j & 3]; u32x2 o; o.x = cvt_pk_bf16(v[j].x * rs * g4.x, v[j].y * rs * g4.y); o.y = cvt_pk_bf16(v[j].z * rs * g4.z, v[j].w * rs * g4.w); o8[64 * j] = o; }
        }
    }
}

struct EpiIn {
    static constexpr bool PERM = true, MID = false, AFTER = false; static constexpr int A_AUX = 0;
    unsigned char* ws;
    __device__ __forceinline__ void mid(f32x4 (&)[2][2][4][2], const pg8::Unit&, int, int, int, int) const {}
    __device__ __forceinline__ void operator()(f32x4 (&acc)[2][2][4][2], const pg8::Unit& u, int wr, int wc, int fr, int fq) const {
        const int colt = u.pn * 256; int type, c0; size_t boff;
        if (colt < 1024) { type = 1; boff = WS_Q; c0 = colt; }
        else if (colt < 2048) { type = 3; boff = WS_G; c0 = colt - 1024; }
        else if (colt < 3072) { type = 0; boff = WS_V; c0 = colt - 2048; }
        else if (colt < 4096) { type = 1; boff = WS_OG; c0 = colt - 3072; }
        else if (colt < 4608) { type = 0; boff = WS_PB; c0 = colt - 4096 + 512; }
        else if (colt < 5632) { type = 2; boff = WS_GA; c0 = colt - 4608; }
        else { type = 2; boff = WS_GB; c0 = colt - 5632; }
        u16* base = (u16*)(ws + boff);
        const int col0 = c0 + wc * 32 + 8 * fq, row0 = u.pm * 256 + wr * 64 + fr;
        const float* LB = (const float*)(ws + WS_LB);
        f32x4 lbv[2][2];
        if (type == 3) {
#pragma unroll
            for (int bj = 0; bj < 2; ++bj) { lbv[bj][0] = *(const f32x4*)(LB + col0 + bj * 128); lbv[bj][1] = *(const f32x4*)(LB + col0 + bj * 128 + 4); }
        } else {
#pragma unroll
            for (int bj = 0; bj < 2; ++bj) { lbv[bj][0] = (f32x4){0.f, 0.f, 0.f, 0.f}; lbv[bj][1] = (f32x4){0.f, 0.f, 0.f, 0.f}; }
        }
#pragma unroll
        for (int ai = 0; ai < 2; ++ai)
#pragma unroll
            for (int m = 0; m < 4; ++m) { u16* rowp = base + (size_t)(row0 + ai * 128 + m * 16) * 1024 + col0;
#pragma unroll
                for (int bj = 0; bj < 2; ++bj) { f32x4 v0 = acc[ai][bj][m][0], v1 = acc[ai][bj][m][1]; u32x4 w;
                    if (type == 3) {
                        const f32x4 l0 = lbv[bj][0], l1 = lbv[bj][1];
#pragma unroll
                        for (int e = 0; e < 4; ++e) { v0[e] = flog(l0[e] + (1.0f - l0[e]) * sigm(v0[e])); v1[e] = flog(l1[e] + (1.0f - l1[e]) * sigm(v1[e])); }
                        w.x = pk_h(v0[0], v0[1]); w.y = pk_h(v0[2], v0[3]); w.z = pk_h(v1[0], v1[1]); w.w = pk_h(v1[2], v1[3]);
                    } else {
                        if (type == 1) {
#pragma unroll
                            for (int e = 0; e < 4; ++e) { v0[e] = v0[e] * sigm(v0[e]); v1[e] = v1[e] * sigm(v1[e]); }
                        } else if (type == 2) {
#pragma unroll
                            for (int e = 0; e < 4; ++e) { v0[e] = sigm(v0[e]); v1[e] = sigm(v1[e]); }
                        }
                        w.x = cvt_pk_bf16(v0[0], v0[1]); w.y = cvt_pk_bf16(v0[2], v0[3]); w.z = cvt_pk_bf16(v1[0], v1[1]); w.w = cvt_pk_bf16(v1[2], v1[3]);
                    }
                    __builtin_nontemporal_store(w, (u32x4*)(rowp + bj * 128)); } }
    }
};
struct EpiMerge {
    static constexpr bool PERM = true, MID = true, AFTER = false; static constexpr int A_AUX = AUX_STREAM;
    const u16 *GA, *GB; u16* MG;
    __device__ __forceinline__ void mid(f32x4 (&acc)[2][2][4][2], const pg8::Unit& u, int wr, int wc, int fr, int fq) const {
        int zz = 0; asm volatile("" : "+v"(zz));
        const int col0 = u.pn * 256 + wc * 32 + 8 * fq, row0 = u.pm * 256 + wr * 64 + fr + zz;
#pragma unroll
        for (int ai = 0; ai < 2; ++ai)
#pragma unroll
            for (int m = 0; m < 4; ++m) { const size_t off = (size_t)(row0 + ai * 128 + m * 16) * 1024 + col0;
#pragma unroll
                for (int bj = 0; bj < 2; ++bj) { const u32x4 ga = __builtin_nontemporal_load((const u32x4*)(GA + off + bj * 128)), gb = *(const u32x4*)(GB + off + bj * 128);
#pragma unroll
                    for (int e = 0; e < 2; ++e) { acc[ai][bj][m][0][2 * e] *= bf_lo(ga[e]) * __builtin_amdgcn_rcpf(bf_lo(gb[e])); acc[ai][bj][m][0][2 * e + 1] *= bf_hi(ga[e]) * __builtin_amdgcn_rcpf(bf_hi(gb[e]));
                        acc[ai][bj][m][1][2 * e] *= bf_lo(ga[2 + e]) * __builtin_amdgcn_rcpf(bf_lo(gb[2 + e])); acc[ai][bj][m][1][2 * e + 1] *= bf_hi(ga[2 + e]) * __builtin_amdgcn_rcpf(bf_hi(gb[2 + e])); } }
                asm volatile("" ::: "memory"); }
    }
    __device__ __forceinline__ void operator()(f32x4 (&acc)[2][2][4][2], const pg8::Unit& u, int wr, int wc, int fr, int fq) const {
        const int col0 = u.pn * 256 + wc * 32 + 8 * fq, row0 = u.pm * 256 + wr * 64 + fr;
#pragma unroll
        for (int ai = 0; ai < 2; ++ai)
#pragma unroll
            for (int m = 0; m < 4; ++m) { const size_t off = (size_t)(row0 + ai * 128 + m * 16) * 1024 + col0;
#pragma unroll
                for (int bj = 0; bj < 2; ++bj) { const u32x4 gb = *(const u32x4*)(GB + off + bj * 128);
                    acc[ai][bj][m][0] *= (f32x4){bf_lo(gb[0]), bf_hi(gb[0]), bf_lo(gb[1]), bf_hi(gb[1])}; acc[ai][bj][m][1] *= (f32x4){bf_lo(gb[2]), bf_hi(gb[2]), bf_lo(gb[3]), bf_hi(gb[3])}; } }
#pragma unroll
        for (int ai = 0; ai < 2; ++ai)
#pragma unroll
            for (int m = 0; m < 4; ++m) { const size_t off = (size_t)(row0 + ai * 128 + m * 16) * 1024 + col0;
#pragma unroll
                for (int bj = 0; bj < 2; ++bj) { const f32x4 v0 = acc[ai][bj][m][0], v1 = acc[ai][bj][m][1]; u32x4 w;
                    w.x = cvt_pk_bf16(v0[0], v0[1]); w.y = cvt_pk_bf16(v0[2], v0[3]); w.z = cvt_pk_bf16(v1[0], v1[1]); w.w = cvt_pk_bf16(v1[2], v1[3]);
                    *(u32x4*)(MG + off + bj * 128) = w; } }
    }
};
template <bool WITH_BF16>
struct EpiRes {
    static constexpr bool PERM = false, MID = false, AFTER = false; static constexpr int A_AUX = AUX_STREAM;
    const float* base; float* H; u16* Hb; float* rsq;
    __device__ __forceinline__ void mid(f32x4 (&)[2][2][4][2], const pg8::Unit&, int, int, int, int) const {}
    __device__ __forceinline__ void operator()(f32x4 (&acc)[2][2][4][2], const pg8::Unit& u, int wr, int wc, int fr, int fq) const {
        const int col0 = u.pn * 256 + wc * 32 + 4 * fq, row0 = u.pm * 256 + wr * 64 + fr;
#pragma unroll
        for (int ai = 0; ai < 2; ++ai) {
            f32x4 pre[4][2][2];
#pragma unroll
            for (int m = 0; m < 4; ++m) { const size_t off = (size_t)(row0 + ai * 128 + m * 16) * 1024 + col0;
#pragma unroll
                for (int bj = 0; bj < 2; ++bj)
#pragma unroll
                    for (int n = 0; n < 2; ++n) pre[m][bj][n] = __builtin_nontemporal_load((const f32x4*)(base + off + bj * 128 + n * 16)); }
            asm volatile("" ::: "memory");
#pragma unroll
            for (int m = 0; m < 4; ++m) { const int row = row0 + ai * 128 + m * 16; const size_t off = (size_t)row * 1024 + col0; float s = 0.f;
#pragma unroll
                for (int bj = 0; bj < 2; ++bj)
#pragma unroll
                    for (int n = 0; n < 2; ++n) { const f32x4 hv = pre[m][bj][n] + acc[ai][bj][m][n];
                        if (H) *(f32x4*)(H + off + bj * 128 + n * 16) = hv;
                        s += (hv[0] * hv[0] + hv[1] * hv[1]) + (hv[2] * hv[2] + hv[3] * hv[3]);
                        if (WITH_BF16) { u32x2 w; w.x = cvt_pk_bf16(hv[0], hv[1]); w.y = cvt_pk_bf16(hv[2], hv[3]); *(u32x2*)(Hb + off + bj * 128 + n * 16) = w; } }
                s += __shfl_xor(s, 16); s += __shfl_xor(s, 32);
                if (fq == 0) rsq[(size_t)row * 16 + u.pn * 4 + wc] = s; }
            asm volatile("" ::: "memory");
        }
    }
};
struct EpiFfn1 {
    static constexpr bool PERM = true, MID = false, AFTER = false; static constexpr int A_AUX = 0;
    const float* rsq; u16* ACT;
    __device__ __forceinline__ void mid(f32x4 (&)[2][2][4][2], const pg8::Unit&, int, int, int, int) const {}
    __device__ __forceinline__ void operator()(const f32x4 (&acc)[2][2][4][2], const pg8::Unit& u, int wr, int wc, int fr, int fq) const {
        const int col0 = u.pn * 128 + wc * 32 + 8 * fq, row0 = u.pm * 256 + wr * 64 + fr;
        float rstdv[2][4];
#pragma unroll
        for (int ai = 0; ai < 2; ++ai)
#pragma unroll
            for (int m = 0; m < 4; ++m) { const int row = row0 + ai * 128 + m * 16; const f32x4* rp = (const f32x4*)(rsq + (size_t)row * 16);
                const f32x4 r0 = rp[fq];
                float ss = (r0[0] + r0[1]) + (r0[2] + r0[3]); ss += __shfl_xor(ss, 16); ss += __shfl_xor(ss, 32);
                rstdv[ai][m] = rsqrtf(ss * (1.f / DM) + EPS); }
#pragma unroll
        for (int ai = 0; ai < 2; ++ai)
#pragma unroll
            for (int m = 0; m < 4; ++m) { const int row = row0 + ai * 128 + m * 16;
                const float rstd = rstdv[ai][m];
                float o[8];
#pragma unroll
                for (int n = 0; n < 2; ++n)
#pragma unroll
                    for (int e = 0; e < 4; ++e) { const float gt = acc[ai][0][m][n][e] * rstd, up = acc[ai][1][m][n][e] * rstd; o[4 * n + e] = gt * sigm(gt) * up; }
                u32x4 w; w.x = cvt_pk_bf16(o[0], o[1]); w.y = cvt_pk_bf16(o[2], o[3]); w.z = cvt_pk_bf16(o[4], o[5]); w.w = cvt_pk_bf16(o[6], o[7]);
                __builtin_nontemporal_store(w, (u32x4*)(ACT + (size_t)row * DFF + col0)); }
    }
};

struct EpiResNorm {
    static constexpr bool PERM = false, MID = false, AFTER = true; static constexpr int A_AUX = AUX_STREAM;
    const u16* base; float* out; const float* gfin; float* slots; unsigned* cnt;
    __device__ __forceinline__ void mid(f32x4 (&)[2][2][4][2], const pg8::Unit&, int, int, int, int) const {}
    __device__ __forceinline__ void operator()(const f32x4 (&)[2][2][4][2], const pg8::Unit&, int, int, int, int) const {}
    __device__ __forceinline__ void after(f32x4 (&acc)[2][2][4][2], const pg8::Unit& u, int wr, int wc, int fr, int fq, LAS unsigned char* lds, int wid, int lane) const {
        LAS float* P = (LAS float*)lds; LAS float* R = (LAS float*)(lds + 4096);
        const int col0 = u.pn * 256 + wc * 32 + 4 * fq;
#pragma unroll
        for (int ai = 0; ai < 2; ++ai)
#pragma unroll
            for (int m = 0; m < 4; ++m) { const int rl = ai * 128 + wr * 64 + m * 16 + fr; const size_t off = (size_t)(u.pm * 256 + rl) * 1024 + col0; float s = 0.f;
#pragma unroll
                for (int bj = 0; bj < 2; ++bj)
#pragma unroll
                    for (int n = 0; n < 2; ++n) { const u32x2 hb = __builtin_nontemporal_load((const u32x2*)(base + off + bj * 128 + n * 16));
                        const f32x4 hv = (f32x4){bf_lo(hb.x), bf_hi(hb.x), bf_lo(hb.y), bf_hi(hb.y)} + acc[ai][bj][m][n]; acc[ai][bj][m][n] = hv; s += (hv[0] * hv[0] + hv[1] * hv[1]) + (hv[2] * hv[2] + hv[3] * hv[3]); }
                s += __shfl_xor(s, 16); s += __shfl_xor(s, 32);
                if (fq == 0) P[rl * 4 + wc] = s;
                if (m & 1) asm volatile("" ::: "memory"); }
        asm volatile("s_waitcnt lgkmcnt(0)" ::: "memory"); __builtin_amdgcn_s_barrier(); asm volatile("" ::: "memory");
        const int row = wid * 32 + (lane & 31);
        unsigned* slot = (unsigned*)slots + (size_t)(u.pm * 256 + row) * 16;
        if (lane < 32) { const float t = (P[row * 4 + 0] + P[row * 4 + 1]) + (P[row * 4 + 2] + P[row * 4 + 3]);
            __hip_atomic_store(slot + u.pn, __float_as_uint(t), __ATOMIC_RELAXED, __HIP_MEMORY_SCOPE_AGENT); }
        asm volatile("s_waitcnt vmcnt(0)" ::: "memory");
        if (lane == 0) __hip_atomic_fetch_add(cnt + 64 * u.pm, 1u, __ATOMIC_RELAXED, __HIP_MEMORY_SCOPE_AGENT);
        if (wid == 0) { unsigned sp = 0;
            while ((unsigned)__builtin_amdgcn_readfirstlane(__hip_atomic_load(cnt + 64 * u.pm, __ATOMIC_RELAXED, __HIP_MEMORY_SCOPE_AGENT)) < 32u) { __builtin_amdgcn_s_sleep(2); if (++sp > (1u << 20)) break; }
            __builtin_amdgcn_fence(__ATOMIC_ACQUIRE, "agent"); }
        asm volatile("s_waitcnt vmcnt(0) lgkmcnt(0)" ::: "memory"); __builtin_amdgcn_s_barrier(); asm volatile("" ::: "memory");
        if (lane < 32) { float t = 0.f;
#pragma unroll
            for (int k = 0; k < 4; ++k) t += __uint_as_float(__hip_atomic_load(slot + k, __ATOMIC_RELAXED, __HIP_MEMORY_SCOPE_AGENT));
            R[row] = rsqrtf(t * (1.f / DM) + EPS); }
        asm volatile("s_waitcnt lgkmcnt(0)" ::: "memory"); __builtin_amdgcn_s_barrier(); asm volatile("" ::: "memory");
        f32x4 gv[2][2];
#pragma unroll
        for (int bj = 0; bj < 2; ++bj)
#pragma unroll
            for (int n = 0; n < 2; ++n) gv[bj][n] = *(const f32x4*)(gfin + col0 + bj * 128 + n * 16);
#pragma unroll
        for (int ai = 0; ai < 2; ++ai)
#pragma unroll
            for (int m = 0; m < 4; ++m) { const int rl = ai * 128 + wr * 64 + m * 16 + fr; const size_t off = (size_t)(u.pm * 256 + rl) * 1024 + col0; const float rs = R[rl];
#pragma unroll
                for (int bj = 0; bj < 2; ++bj)
#pragma unroll
                    for (int n = 0; n < 2; ++n) *(f32x4*)(out + off + bj * 128 + n * 16) = acc[ai][bj][m][n] * rs * gv[bj][n]; }
    }
};
#define RLX_AGENT __ATOMIC_RELAXED, __HIP_MEMORY_SCOPE_AGENT
#define XB_TMO      128
#define XB_XCNT(j)  (256  + 64 * (j))
#define XB_XSUB(j)  (1280 + 64 * (j))
#define XB_XGEN(j)  (2304 + 64 * (j))
#define XB_TOP      3328
#define XB_TOPGEN   3392
#define XCD_BAR_WORDS 3456
#define XB_SPIN_CAP (1u << 18)

__device__ __forceinline__ unsigned xb_ld(unsigned* p)              { return __hip_atomic_load(p, __ATOMIC_RELAXED, __HIP_MEMORY_SCOPE_AGENT); }
__device__ __forceinline__ unsigned xb_add(unsigned* p, unsigned v) { return __hip_atomic_fetch_add(p, v, __ATOMIC_RELAXED, __HIP_MEMORY_SCOPE_AGENT); }
__device__ __forceinline__ unsigned xb_xcc_id() { return (unsigned)__builtin_amdgcn_s_getreg((3 << 11) | 20) & 0xFu; }
#define XB_SPIN(cond, bar) do { unsigned _sp = 0; while (cond) { __builtin_amdgcn_s_sleep(1); \
    if ((++_sp & 255u) == 0u) { if (xb_ld(&(bar)[XB_TMO])) break; if (_sp > XB_SPIN_CAP) { atomicAdd(&(bar)[XB_TMO], 1u); break; } } } } while (0)

struct XcdBarrier {
    unsigned* bar; unsigned x;
    volatile LAS unsigned* st;
};

__device__ __forceinline__ XcdBarrier xcd_barrier_post(unsigned* bar, volatile LAS unsigned* st) {
    XcdBarrier b; b.bar = bar; b.x = xb_xcc_id(); b.st = st;
    if (threadIdx.x == 0) (void)xb_add(&bar[XB_XCNT(b.x)], 1u);
    return b;
}
__device__ __forceinline__ void xcd_barrier_complete(unsigned* bar, unsigned x, unsigned& nloc, unsigned& nx) {
    const unsigned G = gridDim.x * gridDim.y * gridDim.z;
    unsigned sum, cnt, mine, sp = 0u;
    for (;;) {
        sum = 0u; cnt = 0u; mine = 0u;
#pragma unroll
        for (unsigned j = 0; j < 16; ++j) { const unsigned c = xb_ld(&bar[XB_XCNT(j)]); sum += c; cnt += (c > 0u) ? 1u : 0u; mine = (j == x) ? c : mine; }
        if (sum == G) break;
        __builtin_amdgcn_s_sleep(1);
        if ((++sp & 255u) == 0u) { if (xb_ld(&bar[XB_TMO])) break; if (sp > XB_SPIN_CAP) { atomicAdd(&bar[XB_TMO], 1u); break; } }
    }
    nloc = mine > 0u ? mine : 1u; nx = cnt > 0u ? cnt : 1u;
}

__device__ __forceinline__ void xcd_barrier(const XcdBarrier& b) {
    asm volatile("s_waitcnt vmcnt(0)" ::: "memory");
    __syncthreads();
    if (threadIdx.x == 0) {
        unsigned* bar = b.bar;
        __builtin_amdgcn_s_waitcnt(0);
        unsigned nloc = b.st[0], nx = b.st[1];
        if (nloc == 0u) { xcd_barrier_complete(bar, b.x, nloc, nx); b.st[0] = nloc; b.st[1] = nx; }
        const unsigned old = xb_add(&bar[XB_XSUB(b.x)], 1u);
        const unsigned gen = old / nloc;
        if (old + 1u == (gen + 1u) * nloc) {
            __builtin_amdgcn_fence(__ATOMIC_RELEASE, "agent");
            asm volatile("s_waitcnt vmcnt(0)" ::: "memory");
            const unsigned og = xb_add(&bar[XB_TOP], 1u);
            const unsigned tg = og / nx;
            if (og + 1u == (tg + 1u) * nx) xb_add(&bar[XB_TOPGEN], 1u);
            else XB_SPIN(xb_ld(&bar[XB_TOPGEN]) == tg, bar);
            __builtin_amdgcn_fence(__ATOMIC_ACQUIRE, "agent");
            xb_add(&bar[XB_XGEN(b.x)], 1u);
            asm volatile("s_waitcnt vmcnt(0)" ::: "memory");
        } else {
            XB_SPIN(xb_ld(&bar[XB_XGEN(b.x)]) == gen, bar);
            __builtin_amdgcn_fence(__ATOMIC_ACQUIRE, "agent");
            asm volatile("s_waitcnt vmcnt(0)" ::: "memory");
        }
    }
    __syncthreads();
}

__device__ __forceinline__ void p2_wave(const u16* Gp, const u16* Vp, int nrows, int h, u16* Uout, float* dk, int lane) {
    const int r = lane & 15, q = lane >> 4;
    bf16x8 kf[8][2]; float tot1[8];
#pragma unroll
    for (int kk = 0; kk < 2; ++kk) { const int ks = 1 - kk;
#pragma unroll
        for (int dg = 0; dg < 2; ++dg) {
            int zz = 0; asm volatile("" : "+v"(zz));
            u32x4 wq[4];
#pragma unroll
            for (int p2 = 0; p2 < 2; ++p2) { const int dp = 2 * dg + p2; const int dcol = 32 * dp + 2 * r + zz; unsigned gw[8];
#pragma unroll
                for (int j = 0; j < 8; ++j) { const int s = 32 * ks + 8 * q + j; gw[j] = s < nrows ? *(const unsigned*)(Gp + (size_t)s * 1024 + h * 128 + dcol) : 0u; }
#pragma unroll
                for (int par = 0; par < 2; ++par) { const int dt = 2 * dp + par; float gv[8];
#pragma unroll
                    for (int j = 0; j < 8; ++j) gv[j] = h2f((u16)(par ? (gw[j] >> 16) : (gw[j] & 0xffffu)));
                    float suf[8]; float run = 0.f;
#pragma unroll
                    for (int j = 7; j >= 0; --j) { suf[j] = run; run += gv[j]; }
                    const float T = run, ta = __shfl_xor(T, 16), tb = __shfl_xor(T, 32), tc = __shfl_xor(ta, 32);
                    const float after = ((q ^ 1) > q ? ta : 0.f) + ((q ^ 2) > q ? tb : 0.f) + ((q ^ 3) > q ? tc : 0.f);
                    const float tot = (T + ta) + (tb + tc);
                    float base;
                    if (ks == 1) { tot1[dt] = tot; base = after; } else { base = after + tot1[dt]; if (dk && q == 0) dk[h * 128 + dcol + par] = fexp(tot + tot1[dt]); }
                    float kh[8];
#pragma unroll
                    for (int j = 0; j < 8; ++j) kh[j] = (1.0f - fexp(gv[j])) * fexp(suf[j] + base);
                    u32x4& w = wq[2 * p2 + par];
                    w.x = cvt_pk_bf16(kh[0], kh[1]); w.y = cvt_pk_bf16(kh[2], kh[3]); w.z = cvt_pk_bf16(kh[4], kh[5]); w.w = cvt_pk_bf16(kh[6], kh[7]); } }
            asm volatile("" : "+v"(wq[0].x), "+v"(wq[0].y), "+v"(wq[0].z), "+v"(wq[0].w), "+v"(wq[1].x), "+v"(wq[1].y), "+v"(wq[1].z), "+v"(wq[1].w),
                              "+v"(wq[2].x), "+v"(wq[2].y), "+v"(wq[2].z), "+v"(wq[2].w), "+v"(wq[3].x), "+v"(wq[3].y), "+v"(wq[3].z), "+v"(wq[3].w));
#pragma unroll
            for (int d4 = 0; d4 < 4; ++d4) kf[4 * dg + d4][ks] = __builtin_bit_cast(bf16x8, wq[d4]); } }
#pragma unroll 1
    for (int ep = 0; ep < 4; ++ep) {
        int zz = 0; asm volatile("" : "+v"(zz)); const int ecol = 32 * ep + 2 * r + zz;
        unsigned vw[2][8];
#pragma unroll
        for (int ks = 0; ks < 2; ++ks)
#pragma unroll
            for (int j = 0; j < 8; ++j) { const int s = 32 * ks + 8 * q + j; vw[ks][j] = s < nrows ? *(const unsigned*)(Vp + (size_t)s * 1024 + h * 128 + ecol) : 0u; }
#pragma unroll
        for (int par = 0; par < 2; ++par) {
            bf16x8 vf[2];
#pragma unroll
            for (int ks = 0; ks < 2; ++ks) { u32x4 w;
                if (par == 0) { w.x = (vw[ks][0] & 0xffffu) | (vw[ks][1] << 16); w.y = (vw[ks][2] & 0xffffu) | (vw[ks][3] << 16); w.z = (vw[ks][4] & 0xffffu) | (vw[ks][5] << 16); w.w = (vw[ks][6] & 0xffffu) | (vw[ks][7] << 16); }
                else { w.x = (vw[ks][0] >> 16) | (vw[ks][1] & 0xffff0000u); w.y = (vw[ks][2] >> 16) | (vw[ks][3] & 0xffff0000u); w.z = (vw[ks][4] >> 16) | (vw[ks][5] & 0xffff0000u); w.w = (vw[ks][6] >> 16) | (vw[ks][7] & 0xffff0000u); }
                vf[ks] = __builtin_bit_cast(bf16x8, w); }
            f32x4 acc[8];
#pragma unroll
            for (int dt = 0; dt < 8; ++dt) { acc[dt] = (f32x4){0.f, 0.f, 0.f, 0.f};
#pragma unroll
                for (int ks = 0; ks < 2; ++ks) acc[dt] = __builtin_amdgcn_mfma_f32_16x16x32_bf16(kf[dt][ks], vf[ks], acc[dt], 0, 0, 0); }
#pragma unroll
            for (int dp = 0; dp < 4; ++dp) { u32x4 w; w.x = cvt_pk_bf16(acc[2 * dp][0], acc[2 * dp + 1][0]); w.y = cvt_pk_bf16(acc[2 * dp][1], acc[2 * dp + 1][1]); w.z = cvt_pk_bf16(acc[2 * dp][2], acc[2 * dp + 1][2]); w.w = cvt_pk_bf16(acc[2 * dp][3], acc[2 * dp + 1][3]);
                { const int e = 32 * ep + 2 * r + par;
                  *(u32x4*)(Uout + ((size_t)((e >> 4) * 4 + dp) * 64 + q * 16 + (e & 15)) * 8) = w; } } }
    }
}
__device__ __forceinline__ void p2_states(const Args& a, int G) {
    const int tid = threadIdx.x, lane = tid & 63, wave = __builtin_amdgcn_readfirstlane(tid >> 6);
    const u16* Gb = (const u16*)(a.ws + WS_G); const u16* Vb = (const u16*)(a.ws + WS_V); u16* US = (u16*)a.out; float* DK = (float*)(a.ws + WS_DK);
    for (int it = blockIdx.x; it < BATCH * NCH + (G == 256 ? 0 : 1); it += G) {
        if (it < BATCH * NCH) { const size_t row0 = (size_t)it * CHK;
            p2_wave(Gb + row0 * 1024, Vb + row0 * 1024, CHK, wave, US + ((size_t)it * 8 + wave) * 16384, DK + (size_t)it * 1024, lane); }
        else p2_wave((const u16*)(a.ws + WS_GM), (const u16*)(a.ws + WS_VM), NMETA, wave, (u16*)(a.ws + WS_UM) + (size_t)wave * 16384, nullptr, lane);
    }
}

__device__ __forceinline__ void p3_scan(const Args& a, LAS unsigned char* lds, int G) {
    const int tid = threadIdx.x, lane = tid & 63, wave = __builtin_amdgcn_readfirstlane(tid >> 6);
    {
        LAS float* scr = (LAS float*)(lds + wave * 16384);
        const int gw = (int)blockIdx.x * NWAVES + wave, NGW = G * NWAVES;
        for (int it = gw; it < 2 * 16 * 88; it += NGW) { const int up = it >= 16 * 88, r = up ? it - 16 * 88 : it, kb = r / 88, nb = r % 88, n0 = 32 * nb;
            tr_item(up ? a.w_up : a.w_gate, DFF, 64 * kb, n0, (u16*)(a.ws + WS_WGU), (n0 >> 7) * 256 + (n0 & 127) + (up ? 128 : 0), 1024, 0, a.g_ffn, scr, lane); }
    }
    u16* US = (u16*)a.out; const float* DK = (const float*)(a.ws + WS_DK); const u16* UM = (const u16*)(a.ws + WS_UM);
    for (int idx = blockIdx.x * NTHR + tid; idx < BATCH * 8 * 128 * 64; idx += G * NTHR) {
        const int pr = idx & 8191, h = (idx >> 13) & 7, b = idx >> 16;
        const int d = 32 * ((pr >> 8) & 3) + 8 * ((pr >> 6) & 3) + 2 * (pr & 3);
        const unsigned um = *(const unsigned*)(UM + (size_t)h * 16384 + 2 * pr);
        float s0 = bf_lo(um), s1 = bf_hi(um);
        unsigned* up = (unsigned*)(US + ((size_t)(b * NCH) * 8 + h) * 16384 + 2 * pr);
        const float* dkp = DK + (size_t)(b * NCH) * 1024 + h * 128 + d;
#pragma unroll 1
        for (int c0 = 0; c0 < NCH; c0 += 16) {
            unsigned uu[16]; float dd0[16], dd1[16];
#pragma unroll
            for (int i = 0; i < 16; ++i) { uu[i] = up[(size_t)(c0 + i) * 8 * 8192]; const f32v2_t dk2 = *(const f32v2_t*)(dkp + (size_t)(c0 + i) * 1024); dd0[i] = dk2[0]; dd1[i] = dk2[1]; }
#pragma unroll
            for (int i = 0; i < 16; ++i) { up[(size_t)(c0 + i) * 8 * 8192] = cvt_pk_bf16(s0, s1); s0 = dd0[i] * s0 + bf_lo(uu[i]); s1 = dd1[i] * s1 + bf_hi(uu[i]); }
        }
    }
}

constexpr int P4_PITCH = 272, P4_MAT = 64 * P4_PITCH  , P4_VPITCH = 136, P4_HS = 4 * P4_MAT  , P4_TOT = 2 * P4_HS  , P4_PLD = P4_TOT + 4096  ;
static_assert(P4_PLD + P4_MAT + 64 <= LDS_BYTES, "LDS map");
__device__ __forceinline__ unsigned ld_pl(const u16* PB, const u16* PLM, int b, int tx, int cofs) {
    return tx >= 0 ? *(const unsigned*)(PB + (size_t)(b * SEQ + tx) * 1024 + 512 + cofs) : *(const unsigned*)(PLM + (size_t)(NMETA + tx) * 512 + cofs);
}
__device__ __forceinline__ void p4_outputs(const Args& a, LAS unsigned char* lds, int G, int skip = 0) {
    (void)skip;
    const int tid = threadIdx.x, lane = tid & 63, wave = __builtin_amdgcn_readfirstlane(tid >> 6);
    const int r = lane & 15, q = lane >> 4;
    u16* Qb = (u16*)(a.ws + WS_Q); const u16* Gb = (const u16*)(a.ws + WS_G); const u16* Vb = (const u16*)(a.ws + WS_V); const u16* OGb = (const u16*)(a.ws + WS_OG);
    u16* PB = (u16*)(a.ws + WS_PB); const u16* PLM = (const u16*)(a.ws + WS_PLM); const u16* PWT = (const u16*)(a.ws + WS_PWT); const u16* US = (const u16*)a.out;
    LAS unsigned char* PLD = lds + P4_PLD;
    for (int item = blockIdx.x; item < BATCH * NCH * 4; item += G) {
        const int hp = item & 3, bc = item >> 2, c = bc & (NCH - 1), b = bc >> 7;
        const size_t row0 = (size_t)b * SEQ + (size_t)c * CHK;
        const int hs = wave >> 2, tq = wave & 3, h = 2 * hp + hs;
        LAS unsigned char* L = lds + hs * P4_HS;
        LAS unsigned char* KT = L, *QT = L + P4_MAT, *QH = L + 2 * P4_MAT, *VT = L + 3 * P4_MAT;
        LAS float* TOT = (LAS float*)(lds + P4_TOT) + hs * 512;
        const int d0 = 2 * lane; const size_t cofs = (size_t)h * 128 + d0;
        unsigned gp[16], qv[16], vv[16];
#pragma unroll
        for (int i = 0; i < 16; ++i) { const size_t o = (row0 + 16 * tq + i) * 1024 + cofs; gp[i] = __builtin_nontemporal_load((const unsigned*)(Gb + o)); qv[i] = __builtin_nontemporal_load((const unsigned*)(Qb + o)); vv[i] = __builtin_nontemporal_load((const unsigned*)(Vb + o)); }
        const int gi = hp, wlen = 2 << gi; const float inv = 1.0f / (float)wlen;
        const int t0 = 8 * wave, pcofs = gi * 128 + 2 * lane, tx0 = c * CHK + t0;
        unsigned pu[23];
#pragma unroll
        for (int j = 1; j < 16; ++j) pu[15 - j] = (j < wlen) ? ld_pl(PB, PLM, b, tx0 - j, pcofs) : 0u;
#pragma unroll
        for (int i = 0; i < 8; ++i) pu[15 + i] = ld_pl(PB, PLM, b, tx0 + i, pcofs);
        bf16x8 wf[4];
#pragma unroll
        for (int kd = 0; kd < 4; ++kd) wf[kd] = *(const bf16x8*)(PWT + (size_t)(gi * 128 + 16 * wave + r) * 128 + 32 * kd + 8 * q);
        float s0 = 0.f, s1 = 0.f;
#pragma unroll
        for (int i = 0; i < 16; ++i) { s0 += h2f((u16)(gp[i] & 0xffffu)); s1 += h2f((u16)(gp[i] >> 16)); }
        TOT[tq * 128 + d0] = s0; TOT[tq * 128 + d0 + 1] = s1;
        __syncthreads();
        {
            float w0 = 0.f, w1 = 0.f;
#pragma unroll
            for (int j = 1; j < 16; ++j) if (j < wlen) { w0 += bf_lo(pu[15 - j]); w1 += bf_hi(pu[15 - j]); }
#pragma unroll
            for (int i = 0; i < 8; ++i) { const float u0 = bf_lo(pu[15 + i]), u1 = bf_hi(pu[15 + i]); w0 += u0; w1 += u1;
                *(LAS unsigned*)(PLD + (t0 + i) * P4_PITCH + 4 * lane) = cvt_pk_bf16(w0 * inv - u0, w1 * inv - u1);
                const unsigned o = wlen == 2 ? pu[15 + i - 1] : (wlen == 4 ? pu[15 + i - 3] : (wlen == 8 ? pu[15 + i - 7] : pu[15 + i - 15]));
                w0 -= bf_lo(o); w1 -= bf_hi(o); }
        }
        float b0 = 0.f, b1 = 0.f;
#pragma unroll
        for (int t2 = 0; t2 < 3; ++t2) if (t2 < tq) { b0 += TOT[t2 * 128 + d0]; b1 += TOT[t2 * 128 + d0 + 1]; }
        const float bm0 = TOT[d0] + TOT[128 + d0], bm1 = TOT[d0 + 1] + TOT[128 + d0 + 1];
#pragma unroll
        for (int i = 0; i < 16; ++i) { const int t = 16 * tq + i; const float g0 = h2f((u16)(gp[i] & 0xffffu)), g1 = h2f((u16)(gp[i] >> 16)); b0 += g0; b1 += g1;
            const unsigned q2 = qv[i], v2 = vv[i];
            const float q0 = bf_lo(q2), q1 = bf_hi(q2), k0 = 1.0f - fexp(g0), k1 = 1.0f - fexp(g1);
            const float eb0 = fexp(b0), eb1 = fexp(b1), em0 = fexp(fminf(b0 - bm0, 80.f)), em1 = fexp(fminf(b1 - bm1, 80.f)), ek0 = fexp(fminf(bm0 - b0, 80.f)), ek1 = fexp(fminf(bm1 - b1, 80.f));
            *(LAS unsigned*)(QT + t * P4_PITCH + d0 * 2) = cvt_pk_bf16(q0 * em0, q1 * em1);
            *(LAS unsigned*)(QH + t * P4_PITCH + d0 * 2) = cvt_pk_bf16(q0 * eb0, q1 * eb1);
            *(LAS unsigned*)(KT + t * P4_PITCH + d0 * 2) = cvt_pk_bf16(k0 * ek0, k1 * ek1);
            *(LAS u16*)(VT + d0 * P4_VPITCH + t * 2) = (u16)(v2 & 0xffffu); *(LAS u16*)(VT + (d0 + 1) * P4_VPITCH + t * 2) = (u16)(v2 >> 16); }
        const u16* Sp = US + ((size_t)bc * 8 + h) * 16384;
        bf16x8 sfr[8][4];
#pragma unroll
        for (int et = 0; et < 8; ++et)
#pragma unroll
            for (int kd = 0; kd < 4; ++kd) sfr[et][kd] = *(const bf16x8*)(Sp + ((size_t)(et * 4 + kd) * 64 + lane) * 8);
        const int tt = tq;
        const size_t orow = (row0 + 16 * tt + r) * 1024 + (size_t)h * 128;
        __syncthreads();
        u32x2 ogv[8];
#pragma unroll
        for (int et = 0; et < 8; ++et) ogv[et] = __builtin_nontemporal_load((const u32x2*)(OGb + orow + 16 * et + 4 * q));
        {
            f32x4 acc[4];
#pragma unroll
            for (int t4 = 0; t4 < 4; ++t4) acc[t4] = (f32x4){0.f, 0.f, 0.f, 0.f};
#pragma unroll
            for (int kd = 0; kd < 4; ++kd)
#pragma unroll
                for (int t4 = 0; t4 < 4; ++t4) { const bf16x8 pfr = *(const LAS bf16x8*)(PLD + (16 * t4 + r) * P4_PITCH + (32 * kd + 8 * q) * 2); acc[t4] = __builtin_amdgcn_mfma_f32_16x16x32_bf16(wf[kd], pfr, acc[t4], 0, 0, 0); }
            const int n0 = gi * 128 + 16 * wave + 4 * q; const f32x4 psc = *(const f32x4*)(a.pool_scale + n0);
#pragma unroll
            for (int t4 = 0; t4 < 4; ++t4) { u32x2 w; w.x = cvt_pk_bf16(acc[t4][0] * psc[0], acc[t4][1] * psc[1]); w.y = cvt_pk_bf16(acc[t4][2] * psc[2], acc[t4][3] * psc[3]);
                *(u32x2*)(PB + (row0 + 16 * t4 + r) * 1024 + n0) = w; }
        }
        bf16x8 qt[4], qh[4];
#pragma unroll
        for (int kd = 0; kd < 4; ++kd) { qt[kd] = *(const LAS bf16x8*)(QT + (16 * tt + r) * P4_PITCH + (32 * kd + 8 * q) * 2); qh[kd] = *(const LAS bf16x8*)(QH + (16 * tt + r) * P4_PITCH + (32 * kd + 8 * q) * 2); }
        f32x4 sc[4];
#pragma unroll
        for (int st = 0; st < 4; ++st) { f32x4 acc = (f32x4){0.f, 0.f, 0.f, 0.f};
            if (st <= tt) {
#pragma unroll
                for (int kd = 0; kd < 4; ++kd) { const bf16x8 kfr = *(const LAS bf16x8*)(KT + (16 * st + r) * P4_PITCH + (32 * kd + 8 * q) * 2); acc = __builtin_amdgcn_mfma_f32_16x16x32_bf16(kfr, qt[kd], acc, 0, 0, 0); }
                if (st == tt) {
#pragma unroll
                    for (int i = 0; i < 4; ++i) if (4 * q + i > r) acc[i] = 0.f; }
            }
            sc[st] = acc; }
        bf16x8 pf[2];
#pragma unroll
        for (int ks = 0; ks < 2; ++ks) { u32x4 w; w.x = cvt_pk_bf16(sc[2 * ks][0], sc[2 * ks][1]); w.y = cvt_pk_bf16(sc[2 * ks][2], sc[2 * ks][3]); w.z = cvt_pk_bf16(sc[2 * ks + 1][0], sc[2 * ks + 1][1]); w.w = cvt_pk_bf16(sc[2 * ks + 1][2], sc[2 * ks + 1][3]);
            pf[ks] = __builtin_bit_cast(bf16x8, w); }
        f32x4 oa[8]; float ss = 0.f;
#pragma unroll
        for (int et = 0; et < 8; ++et) { f32x4 acc = (f32x4){0.f, 0.f, 0.f, 0.f};
#pragma unroll
            for (int kd = 0; kd < 4; ++kd) acc = __builtin_amdgcn_mfma_f32_16x16x32_bf16(sfr[et][kd], qh[kd], acc, 0, 0, 0);
#pragma unroll
            for (int ks = 0; ks < 2; ++ks) if (2 * ks <= tt) {
                const u32x2 lo = *(const LAS u32x2*)(VT + (16 * et + r) * P4_VPITCH + (32 * ks + 4 * q) * 2), hi = *(const LAS u32x2*)(VT + (16 * et + r) * P4_VPITCH + (32 * ks + 16 + 4 * q) * 2);
                const u32x4 w = (u32x4){lo.x, lo.y, hi.x, hi.y};
                acc = __builtin_amdgcn_mfma_f32_16x16x32_bf16(__builtin_bit_cast(bf16x8, w), pf[ks], acc, 0, 0, 0); }
            oa[et] = acc; ss += (acc[0] * acc[0] + acc[1] * acc[1]) + (acc[2] * acc[2] + acc[3] * acc[3]); }
        ss += __shfl_xor(ss, 16); ss += __shfl_xor(ss, 32);
        const float rstd = rsqrtf(ss * (1.f / 128.f) + EPS);
#pragma unroll
        for (int et = 0; et < 8; ++et) { const int e0 = 16 * et + 4 * q; const f32x4 gn = *(const f32x4*)(a.g_hn + e0); const u32x2 og = ogv[et];
            u32x2 w; w.x = cvt_pk_bf16(oa[et][0] * rstd * gn[0] * bf_lo(og.x), oa[et][1] * rstd * gn[1] * bf_hi(og.x)); w.y = cvt_pk_bf16(oa[et][2] * rstd * gn[2] * bf_lo(og.y), oa[et][3] * rstd * gn[3] * bf_hi(og.y));
            *(LAS u32x2*)(QT + (16 * tt + r) * P4_PITCH + e0 * 2) = w; }
        asm volatile("s_waitcnt lgkmcnt(0)" ::: "memory");
#pragma unroll
        for (int i = 0; i < 4; ++i) { const int rr = 16 * tt + 4 * i + (lane >> 4); const u32x4 v = *(const LAS u32x4*)(QT + rr * P4_PITCH + (lane & 15) * 16);
            *(u32x4*)(Qb + (row0 + rr) * 1024 + (size_t)h * 128 + (lane & 15) * 8) = v; }
    }
    __syncthreads();
}

__device__ __forceinline__ void p9_final(const Args& a, int G) {
    const int tid = threadIdx.x, lane = tid & 63, wave = __builtin_amdgcn_readfirstlane(tid >> 6);
    const float* rsq = (const float*)(a.ws + WS_RSQ);
    const f32x4* gr = (const f32x4*)a.g_fin + lane; f32x4 gv[4];
#pragma unroll
    for (int j = 0; j < 4; ++j) gv[j] = gr[64 * j];
    for (int m = 2 * (blockIdx.x * NWAVES + wave); m < M; m += 2 * G * NWAVES) {
        float p = lane < 32 ? rsq[(size_t)m * 16 + lane] : 0.f;
        f32x4* xr = (f32x4*)(a.out + (size_t)m * DM) + lane; f32x4 v[8];
#pragma unroll
        for (int j = 0; j < 8; ++j) v[j] = xr[64 * j];
        p += __shfl_xor(p, 1); p += __shfl_xor(p, 2); p += __shfl_xor(p, 4); p += __shfl_xor(p, 8);
        const float r0 = rsqrtf(__shfl(p, 0) * (1.f / DM) + EPS), r1 = rsqrtf(__shfl(p, 16) * (1.f / DM) + EPS);
#pragma unroll
        for (int j = 0; j < 8; ++j) { const float rs = j < 4 ? r0 : r1; const f32x4 g4 = gv[j & 3]; xr[64 * j] = (f32x4){v[j].x * rs * g4.x, v[j].y * rs * g4.y, v[j].z * rs * g4.z, v[j].w * rs * g4.w}; }
    }
}

#ifdef PROBE_STOP
__device__ __forceinline__ void p_dump(const Args& a, int G) {
    const u16* Qb = (const u16*)(a.ws + WS_Q); const u16* Gb = (const u16*)(a.ws + WS_G); const u16* Vb = (const u16*)(a.ws + WS_V); const u16* OGb = (const u16*)(a.ws + WS_OG);
    const u16* GAb = (const u16*)(a.ws + WS_GA); const u16* GBb = (const u16*)(a.ws + WS_GB); const u16* PB = (const u16*)(a.ws + WS_PB);
    for (size_t i = (size_t)blockIdx.x * NTHR + threadIdx.x; i < (size_t)M * DM; i += (size_t)G * NTHR) {
        float v = 0.f;
        if (PROBE_STOP == 1) v = bf1(Qb[i]) + h2f(Gb[i]) + bf1(Vb[i]) + bf1(OGb[i]) + bf1(GAb[i]) + bf1(GBb[i]) + bf1(PB[i]);
        else if (PROBE_STOP == 2 || PROBE_STOP == 3) { float t = bf1(((const u16*)a.out)[i]) + bf1(((const u16*)a.out)[i + (size_t)M * DM]); if (!(fabsf(t) < 1e30f)) t = 12345.f; ((float*)(a.ws + WS_GA))[i] = t; continue; }
        else if (PROBE_STOP == 4) v = bf1(Qb[i]) + bf1(PB[i]);
        else if (PROBE_STOP == 5) v = bf1(Gb[i]);
        else continue;
        a.out[i] = v;
    }
}
#endif
__device__ __forceinline__ void flat_barrier(unsigned* cnt) {
    asm volatile("s_waitcnt vmcnt(0)" ::: "memory");
    __syncthreads();
    if (threadIdx.x == 0) {
        const unsigned Gn = gridDim.x;
        __builtin_amdgcn_fence(__ATOMIC_RELEASE, "agent");
        asm volatile("s_waitcnt vmcnt(0)" ::: "memory");
        const unsigned old = __hip_atomic_fetch_add(cnt, 1u, __ATOMIC_RELAXED, __HIP_MEMORY_SCOPE_AGENT);
        const unsigned target = (old / Gn + 1u) * Gn; unsigned sp = 0;
        while (__hip_atomic_load(cnt, __ATOMIC_RELAXED, __HIP_MEMORY_SCOPE_AGENT) < target) { __builtin_amdgcn_s_sleep(1); if (++sp > (1u << 22)) break; }
        __builtin_amdgcn_fence(__ATOMIC_ACQUIRE, "agent");
        asm volatile("s_waitcnt vmcnt(0)" ::: "memory");
    }
    __syncthreads();
}
constexpr int NPH = 10;
__global__ void __launch_bounds__(NTHR, 2) mega(Args a) {
    extern __shared__ __attribute__((aligned(16))) unsigned char lds_raw[];
    LAS unsigned char* lds = (LAS unsigned char*)lds_raw;
    cg::grid_group grid = cg::this_grid();
    const int G = gridDim.x, lo = a.ph_lo, hi = a.ph_hi;
    unsigned char* ws = a.ws;
    volatile LAS unsigned* MISC = (volatile LAS unsigned*)(lds + LDS_BYTES - 64);
    if (threadIdx.x < 16) MISC[threadIdx.x] = 0u;
    __syncthreads();
    XcdBarrier bar; bar.bar = (unsigned*)(ws + WS_BAR); bar.x = 0; bar.st = nullptr;
    if (hi - lo > 1) bar = xcd_barrier_post((unsigned*)(ws + WS_BAR), MISC);
    if (hi < 0) grid.sync();
#ifndef PHMASK
#define PHMASK 0x3ff
#endif
#define IN(k) (((PHMASK >> (k)) & 1) && lo <= (k) && (k) < hi)
#ifndef CG_SEAMS
#define CG_SEAMS 0x0
#endif
#define SEAM(k) do { if (IN(k) && IN((k) + 1)) { if ((CG_SEAMS >> (k)) & 1) grid.sync(); else xcd_barrier(bar); } } while (0)
#ifndef PROBE_DUP
#define PROBE_DUP 0
#endif
#ifndef PROBE_XSYNC
#define PROBE_XSYNC 0
#endif
#define DUP(k) (((PROBE_DUP >> (k)) & 1) ? 2 : 1)
    if (IN(0)) { p0_prologue(a, lds, G); } SEAM(0);
#ifdef PROBE_XBAR
    for (int xs = 0; xs < PROBE_XBAR; ++xs) flat_barrier((unsigned*)(ws + WS_BAR + 14 * KiB));
#endif
    if (IN(1)) { pg8::Gemm g{(const u16*)a.out, (const u16*)(ws + WS_WIN), M, INW, DM, DM, 1 << 30, 0L}; pg8::StaticOrder S; S.init(M, INW, G, (int)blockIdx.x);
        EpiIn E{ws}; pg8::gemm_phase<EpiIn, true>(lds, g, S, E);
        if (G == 256 && blockIdx.x == 255) p2_wave((const u16*)(ws + WS_GM), (const u16*)(ws + WS_VM), NMETA, (int)(threadIdx.x >> 6), (u16*)(ws + WS_UM) + (size_t)(threadIdx.x >> 6) * 16384, nullptr, (int)(threadIdx.x & 63));
        else if (G == 256 && blockIdx.x >= 128) late_weights(a, lds, ((int)blockIdx.x - 128) * NWAVES + (int)(threadIdx.x >> 6), 127 * NWAVES); }
    SEAM(1);
    if (IN(2)) { p2_states(a, G); } SEAM(2);
    if (IN(3)) { p3_scan(a, lds, G); } SEAM(3);
    if (IN(4)) { p4_outputs(a, lds, G); } SEAM(4);
    if (IN(5)) { pg8::Gemm g{(const u16*)(ws + WS_Q), (const u16*)(ws + WS_WAB), M, DM, 1536, DM, 16, (long)(WS_PB - WS_Q) - 16L * 128L}; pg8::StaticOrder S; S.init(M, DM, G, (int)blockIdx.x);
        EpiMerge E{(const u16*)(ws + WS_GA), (const u16*)(ws + WS_GB), (u16*)(ws + WS_MG)}; pg8::gemm_phase<EpiMerge, false>(lds, g, S, E); } SEAM(5);
    if (IN(6)) { pg8::Gemm g{(const u16*)(ws + WS_MG), (const u16*)(ws + WS_WOUT), M, DM, DM, DM, 1 << 30, 0L}; pg8::StaticOrder S; S.init(M, DM, G, (int)blockIdx.x);
        const bool fuse9_ = (G == (M / 256) * (DM / 256)) && (hi - lo > 1);
        EpiRes<true> E{a.x, fuse9_ ? nullptr : a.out, (u16*)(ws + WS_H1B), (float*)(ws + WS_RSQ)}; pg8::gemm_phase<EpiRes<true>, false>(lds, g, S, E); } SEAM(6);
    if (IN(7)) { pg8::Gemm g{(const u16*)(ws + WS_H1B), (const u16*)(ws + WS_WGU), M, NGU, DM, DM, 1 << 30, 0L}; pg8::StaticOrder S; S.init(M, NGU, G, (int)blockIdx.x);
        EpiFfn1 E{(const float*)(ws + WS_RSQ), (u16*)(ws + WS_ACT)}; pg8::gemm_phase<EpiFfn1, true>(lds, g, S, E); } SEAM(7);
    const bool fuse9 = (G == (M / 256) * (DM / 256)) && (hi - lo > 1);
    if (IN(8)) { pg8::Gemm g{(const u16*)(ws + WS_ACT), (const u16*)(ws + WS_WD), M, DM, DFF, DFF, 1 << 30, 0L}; pg8::StaticOrder S; S.init(M, DM, G, (int)blockIdx.x);
        if (fuse9) { EpiResNorm E{(const u16*)(ws + WS_H1B), a.out, a.g_fin, (float*)(ws + WS_RSQ), (unsigned*)(ws + WS_CNT)}; pg8::gemm_phase<EpiResNorm, false>(lds, g, S, E); }
        else { EpiRes<false> E{a.out, a.out, nullptr, (float*)(ws + WS_RSQ)}; pg8::gemm_phase<EpiRes<false>, false>(lds, g, S, E); } }
    if (!fuse9) { SEAM(8);
    if (IN(9)) { p9_final(a, G); } }
#ifdef PROBE_LIST
    if (lo == 20) p0_prologue(a, lds, G, 1);
    if (lo == 30) p0_prologue(a, lds, G, 2);
    if (lo == 40) p0_prologue(a, lds, G, 4);
    if (lo == 14) p4_outputs(a, lds, G, 1);
    if (lo == 24) p4_outputs(a, lds, G, 2);
    if (lo == 34) p4_outputs(a, lds, G, 2 | 4);
    if (lo == 44) p4_outputs(a, lds, G, 2 | 8);
    if (lo == 54) p4_outputs(a, lds, G, 2 | 16);
    if (lo == 64) p4_outputs(a, lds, G, 2 | 32);
    if (lo == 74) p4_outputs(a, lds, G, 2 | 64);
    if (lo == 18) { pg8::Gemm g{(const u16*)(ws + WS_ACT), (const u16*)(ws + WS_WD), M, DM, DFF, DFF, 1 << 30, 0L}; pg8::StaticOrder S; S.init(M, DM, G, (int)blockIdx.x);
        EpiRes<false> E{(const float*)(ws + WS_GA), (float*)(ws + WS_GA), nullptr, (float*)(ws + WS_OG)}; pg8::gemm_phase<EpiRes<false>, false>(lds, g, S, E); }
    if (lo == 19) { Args b = a; b.out = (float*)(ws + WS_GA); p9_final(b, G); }
#endif
#ifdef PROBE_STOP
    if (lo == 10) p_dump(a, G);
    if (lo == 11 && (PROBE_STOP == 2 || PROBE_STOP == 3)) { for (size_t i = (size_t)blockIdx.x * NTHR + threadIdx.x; i < (size_t)M * DM; i += (size_t)G * NTHR) a.out[i] = ((const float*)(a.ws + WS_GA))[i]; }
#endif
#undef IN
#undef SEAM
}

extern "C" void kernel_launch(void* const* d_in, const int* in_sizes, int n_in, void* d_out, int out_size, void* d_ws, size_t ws_size, hipStream_t stream) {
    static int grid = 0;
    if (grid == 0) {
        if (n_in != 16 || in_sizes[0] != M * DM || out_size != M * DM || ws_size < WS_END) { fprintf(stderr, "kernel_launch: unexpected shapes (n_in %d, in0 %d, out %d, ws %zu); nothing launched\n", n_in, n_in > 0 ? in_sizes[0] : -1, out_size, ws_size); grid = -1; return; }
        int dev = 0, cus = 0, per_cu = 0;
        (void)hipGetDevice(&dev); (void)hipDeviceGetAttribute(&cus, hipDeviceAttributeMultiprocessorCount, dev);
        if (hipFuncSetAttribute((const void*)mega, hipFuncAttributeMaxDynamicSharedMemorySize, LDS_BYTES) != hipSuccess) { fprintf(stderr, "kernel_launch: hipFuncSetAttribute failed\n"); }
        if (hipOccupancyMaxActiveBlocksPerMultiprocessor(&per_cu, (const void*)mega, NTHR, LDS_BYTES) != hipSuccess || per_cu < 1) per_cu = 1;
        (void)hipGetLastError();
        if (cus <= 0) cus = 256;
        grid = cus * per_cu;
    }
    if (grid < 0) return;
#if MK_COOP
    if (hipMemsetAsync((char*)d_ws + WS_BAR, 0, CTL_ZERO, stream) != hipSuccess) { fprintf(stderr, "kernel_launch: hipMemsetAsync of the barrier words failed\n"); return; }
#endif
    Args a{};
    a.x = (const float*)d_in[0]; a.meta = (const float*)d_in[1]; a.g_mix = (const float*)d_in[2]; a.w_in = (const float*)d_in[3]; a.lb_raw = (const float*)d_in[4]; a.g_hn = (const float*)d_in[5];
    a.pool_w = (const float*)d_in[6]; a.pool_scale = (const float*)d_in[7]; a.w_a = (const float*)d_in[8]; a.w_b = (const float*)d_in[9]; a.w_out = (const float*)d_in[10]; a.g_ffn = (const float*)d_in[11];
    a.w_gate = (const float*)d_in[12]; a.w_up = (const float*)d_in[13]; a.w_down = (const float*)d_in[14]; a.g_fin = (const float*)d_in[15];
    a.out = (float*)d_out; a.ws = (unsigned char*)d_ws;
#if MK_COOP
    a.ph_lo = 0; a.ph_hi = NPH;
    void* args[] = {&a};
    const hipError_t e = hipLaunchCooperativeKernel((const void*)mega, dim3(grid), dim3(NTHR), args, LDS_BYTES, stream);
    if (e != hipSuccess) fprintf(stderr, "kernel_launch: cooperative launch failed: %s (grid %d)\n", hipGetErrorString(e), grid);
#else
#ifdef PROBE_STOP
    for (int ph = 0; ph <= PROBE_STOP; ++ph) { a.ph_lo = ph; a.ph_hi = ph + 1; hipLaunchKernelGGL(mega, dim3(grid), dim3(NTHR), LDS_BYTES, stream, a); }
    a.ph_lo = 10; a.ph_hi = 11; hipLaunchKernelGGL(mega, dim3(grid), dim3(NTHR), LDS_BYTES, stream, a);
    a.ph_lo = 11; a.ph_hi = 12; hipLaunchKernelGGL(mega, dim3(grid), dim3(NTHR), LDS_BYTES, stream, a);
#else
#ifdef PROBE_LIST
    { const int lst[] = PROBE_LIST; for (int i = 0; i < (int)(sizeof(lst) / sizeof(int)); ++i) { a.ph_lo = lst[i]; a.ph_hi = lst[i] + 1; hipLaunchKernelGGL(mega, dim3(grid), dim3(NTHR), LDS_BYTES, stream, a); } }
#else
    for (int ph = 0; ph < NPH; ++ph) { a.ph_lo = ph; a.ph_hi = ph + 1; hipLaunchKernelGGL(mega, dim3(grid), dim3(NTHR), LDS_BYTES, stream, a); }
#endif
#endif
#endif
}
```

```cpp
#include <hip/hip_runtime.h>
#include <hip/hip_cooperative_groups.h>
#include <cstdio>
#include <cstdint>
namespace cg = cooperative_groups;

#ifndef MK_COOP
#define MK_COOP 1
#endif

#define LAS __attribute__((address_space(3)))
typedef unsigned short u16;
typedef short bf16x8 __attribute__((ext_vector_type(8)));
typedef float f32x4 __attribute__((ext_vector_type(4)));
typedef unsigned u32x4 __attribute__((ext_vector_type(4)));
typedef unsigned u32x2 __attribute__((ext_vector_type(2)));

typedef __bf16 bf16v2_t __attribute__((ext_vector_type(2)));
typedef float f32v2_t __attribute__((ext_vector_type(2)));
__device__ __forceinline__ unsigned cvt_pk_bf16(float lo, float hi) { const f32v2_t f = {lo, hi}; const bf16v2_t v = __builtin_convertvector(f, bf16v2_t); return __builtin_bit_cast(unsigned, v); }
__device__ __forceinline__ float bf_lo(unsigned w) { return __uint_as_float(w << 16); }
__device__ __forceinline__ float bf_hi(unsigned w) { return __uint_as_float(w & 0xffff0000u); }
__device__ __forceinline__ float bf1(u16 w) { return __uint_as_float((unsigned)w << 16); }
__device__ __forceinline__ unsigned pk_h(float a, float b) { const _Float16 x = (_Float16)a, y = (_Float16)b; return (unsigned)__builtin_bit_cast(unsigned short, x) | ((unsigned)__builtin_bit_cast(unsigned short, y) << 16); }
__device__ __forceinline__ float h2f(u16 w) { return (float)__builtin_bit_cast(_Float16, w); }
__device__ __forceinline__ float fexp(float x) { return __builtin_amdgcn_exp2f(x * 1.44269504088896341f); }
__device__ __forceinline__ float flog(float x) { return __builtin_amdgcn_logf(x) * 0.693147180559945309f; }
__device__ __forceinline__ float sigm(float z) { return __builtin_amdgcn_rcpf(1.0f + fexp(-z)); }

namespace pg8 {
constexpr int BM = 256, BK = 64, HALF = 128, HTB = HALF * BK * 2, STAGE_BYTES = 8 * HTB, NXCD = 8, WGM = 8;
__host__ __device__ __forceinline__ int lds_byte(int r, int c) { const int st = (r >> 4) * 2 + (c >> 5), rr = r & 15, cc = c & 31, ob = rr * 64 + cc * 2; return st * 1024 + (ob ^ (((ob >> 9) & 1) << 5)); }
__host__ __device__ __forceinline__ void stage_rc(int b, int& R, int& C) { const int st = b / 1024, sb = b % 1024, swz = sb ^ (((sb >> 9) & 1) << 5); R = (st >> 1) * 16 + swz / 64; C = (st & 1) * 32 + (swz % 64) / 2; }
__host__ __device__ __forceinline__ int perm32(int rho) { const int n = rho >> 4, i = rho & 15; return 8 * (i >> 2) + 4 * n + (i & 3); }
struct Unit { int pm, pn; };
struct Gemm { const u16* A; const u16* Bt; int M, N, K, lda, ksplit; long a2delta; };
struct StaticOrder {
    int nM, nN, nwg, G, c;
    __host__ __device__ void init(int M, int N, int G_, int c_) { nM = M / BM; nN = N / BM; nwg = nM * nN; G = G_; c = c_; }
    __host__ __device__ bool next(int i, Unit& u) const {
        const long L = (long)i * G + c; if (L >= nwg) return false;
        int wgid = (int)L; { const int q = nwg / NXCD, r = nwg % NXCD, xcd = wgid % NXCD, off = wgid / NXCD; wgid = (xcd < r ? xcd * (q + 1) : r * (q + 1) + (xcd - r) * q) + off; }
        const int nig = WGM * nN, gid = wgid / nig, fm = gid * WGM, gsz = (nM - fm) < WGM ? (nM - fm) : WGM;
        u.pm = fm + ((wgid % nig) % gsz); u.pn = (wgid % nig) / gsz; return true;
    }
};
template <class Epi, bool ALIGN_EPI>
__device__ __forceinline__ void gemm_phase(LAS unsigned char* lds, const Gemm g, const StaticOrder& S, const Epi& E) {
    const int tid = threadIdx.x, wid = __builtin_amdgcn_readfirstlane(tid >> 6), lane = tid & 63, wr = wid >> 2, wc = wid & 3, fr = lane & 15, fq = lane >> 4;
    const int K = g.K, nt = K / BK, lda = g.lda;
    unsigned voffA[2], voffB[2];
#pragma unroll
    for (int i = 0; i < 2; ++i) { int R, C; stage_rc(tid * 16 + i * 8192, R, C); const int Rb = Epi::PERM ? ((R & ~31) + perm32(R & 31)) : R;
        voffA[i] = (unsigned)(R * lda + C) * 2u; voffB[i] = (unsigned)(Rb * K + C) * 2u; }
    const size_t kstep = (size_t)(BK * 2);
    const size_t hstepA = (size_t)HALF * lda * 2, tstepA = 2 * hstepA;
    const size_t hstepB = (size_t)HALF * K * 2, tstepB = 2 * hstepB;
    const unsigned ldsw = (unsigned)wid * 1024u;
    const int aoff = lds_byte(wr * 64 + fr, fq * 8), boff = lds_byte(wc * 32 + fr, fq * 8);
#define PG8_SA(b, h) (((b) * 2 + (h)) * HTB)
#define PG8_SB(b, h) ((4 + (b) * 2 + (h)) * HTB)
#define PG8_STAGE(bufoff, gbase, voff) do { _Pragma("unroll") for (int _i = 0; _i < 2; ++_i) \
        __builtin_amdgcn_global_load_lds((const unsigned*)((const char*)(gbase) + (voff)[_i]), (LAS unsigned*)(lds + (bufoff) + ldsw + _i * 8192), 16, 0, 0); } while (0)
#define PG8_STAGEA(bufoff, gbase, voff) do { _Pragma("unroll") for (int _i = 0; _i < 2; ++_i) \
        __builtin_amdgcn_global_load_lds((const unsigned*)((const char*)(gbase) + (voff)[_i]), (LAS unsigned*)(lds + (bufoff) + ldsw + _i * 8192), 16, 0, Epi::A_AUX); } while (0)
#define PG8_LDA(dst, b, h) do { _Pragma("unroll") for (int m = 0; m < 4; ++m) _Pragma("unroll") for (int k = 0; k < 2; ++k) dst[m][k] = *(const LAS bf16x8*)(lds + PG8_SA(b, h) + aoff + m * 2048 + k * 1024); } while (0)
#define PG8_LDB(dst, b, h) do { _Pragma("unroll") for (int n = 0; n < 2; ++n) _Pragma("unroll") for (int k = 0; k < 2; ++k) dst[n][k] = *(const LAS bf16x8*)(lds + PG8_SB(b, h) + boff + n * 2048 + k * 1024); } while (0)
#define PG8_MMA(ai, bj, At, Bt) do { __builtin_amdgcn_s_setprio(1); _Pragma("unroll") for (int m = 0; m < 4; ++m) _Pragma("unroll") for (int n = 0; n < 2; ++n) _Pragma("unroll") for (int k = 0; k < 2; ++k) \
        acc[ai][bj][m][n] = __builtin_amdgcn_mfma_f32_16x16x32_bf16(Bt[n][k], At[m][k], acc[ai][bj][m][n], 0, 0, 0); __builtin_amdgcn_s_setprio(0); } while (0)
#define PG8_WAIT_V(n) asm volatile("s_waitcnt vmcnt(" #n ")" ::: "memory")
#define PG8_WAIT_L(n) asm volatile("s_waitcnt lgkmcnt(" #n ")" ::: "memory")
#define PG8_BAR __builtin_amdgcn_s_barrier()
#define PG8_SCHED __builtin_amdgcn_sched_barrier(0)
    Unit cur, nxt; int ui = 0;
    if (!S.next(0, cur)) return;
    f32x4 acc[2][2][4][2];
#pragma unroll
    for (int a = 0; a < 2; ++a)
#pragma unroll
        for (int b = 0; b < 2; ++b)
#pragma unroll
            for (int m = 0; m < 4; ++m)
#pragma unroll
                for (int n = 0; n < 2; ++n) acc[a][b][m][n] = (f32x4){0.f, 0.f, 0.f, 0.f};
    bf16x8 At[4][2], B0[2][2], B1[2][2];
    const char* cA = (const char*)g.A + (size_t)cur.pm * tstepA; const char* cB = (const char*)g.Bt + (size_t)cur.pn * tstepB;
    PG8_STAGE(PG8_SB(0, 0), cB, voffB); PG8_STAGE(PG8_SB(0, 1), cB + hstepB, voffB); PG8_STAGEA(PG8_SA(0, 0), cA, voffA); PG8_STAGEA(PG8_SA(0, 1), cA + hstepA, voffA);
    if (wr == 1) PG8_BAR;
    PG8_WAIT_V(2); PG8_BAR;
    PG8_STAGE(PG8_SB(1, 0), cB + kstep, voffB); PG8_STAGEA(PG8_SA(1, 0), cA + kstep, voffA); PG8_STAGE(PG8_SB(1, 1), cB + hstepB + kstep, voffB);
    PG8_WAIT_V(6); PG8_BAR;
    for (;;) {
        const bool has_next = S.next(ui + 1, nxt);
        const char* nA = has_next ? (const char*)g.A + (size_t)nxt.pm * tstepA : cA; const char* nB = has_next ? (const char*)g.Bt + (size_t)nxt.pn * tstepB : cB;
        for (int t = 0; t < nt; t += 2) {
            const bool last = (t == nt - 2);
            if constexpr (Epi::MID) { if (t == g.ksplit) E.mid(acc, cur, wr, wc, fr, fq); }
            const char* a1 = cA + (size_t)(t + 1) * kstep + (t >= g.ksplit ? g.a2delta : 0L);
            const char* a2 = last ? nA : cA + (size_t)(t + 2) * kstep + (t + 2 >= g.ksplit ? g.a2delta : 0L);
            const char* b2 = last ? nB : cB + (size_t)(t + 2) * kstep;
            const char* a3 = a2 + kstep; const char* b3 = b2 + kstep;
            PG8_LDB(B0, 0, 0); PG8_LDB(B1, 0, 1); PG8_SCHED; PG8_LDA(At, 0, 0); PG8_STAGEA(PG8_SA(1, 1), a1 + hstepA, voffA);
            PG8_WAIT_V(8); PG8_WAIT_L(0); PG8_BAR; PG8_MMA(0, 0, At, B0); PG8_MMA(0, 1, At, B1); PG8_BAR; PG8_SCHED;
            PG8_LDA(At, 0, 1); PG8_STAGE(PG8_SB(0, 0), b2, voffB); PG8_STAGE(PG8_SB(0, 1), b2 + hstepB, voffB); PG8_STAGEA(PG8_SA(0, 0), a2, voffA);
            PG8_WAIT_V(8); PG8_WAIT_L(0); PG8_BAR; PG8_MMA(1, 0, At, B0); PG8_MMA(1, 1, At, B1); PG8_BAR; PG8_SCHED;
            PG8_LDB(B0, 1, 0); PG8_LDB(B1, 1, 1); PG8_SCHED; PG8_LDA(At, 1, 0); PG8_STAGEA(PG8_SA(0, 1), a2 + hstepA, voffA);
            PG8_WAIT_V(8); PG8_WAIT_L(0); PG8_BAR; PG8_MMA(0, 0, At, B0); PG8_MMA(0, 1, At, B1); PG8_BAR; PG8_SCHED;
            PG8_LDA(At, 1, 1); PG8_STAGE(PG8_SB(1, 0), b3, voffB); PG8_STAGE(PG8_SB(1, 1), b3 + hstepB, voffB); PG8_STAGEA(PG8_SA(1, 0), a3, voffA);
            PG8_WAIT_V(8); PG8_WAIT_L(0); PG8_BAR; PG8_MMA(1, 0, At, B0); PG8_MMA(1, 1, At, B1); PG8_BAR; PG8_SCHED;
        }
        if constexpr (ALIGN_EPI) { if (wr == 0) PG8_BAR; }
        if constexpr (!Epi::AFTER) E(acc, cur, wr, wc, fr, fq);
        if (!has_next) break;
#pragma unroll
        for (int a = 0; a < 2; ++a)
#pragma unroll
            for (int b = 0; b < 2; ++b)
#pragma unroll
                for (int m = 0; m < 4; ++m)
#pragma unroll
                    for (int n = 0; n < 2; ++n) acc[a][b][m][n] = (f32x4){0.f, 0.f, 0.f, 0.f};
        cur = nxt; cA = nA; cB = nB; ++ui;
        if constexpr (ALIGN_EPI) { if (wr == 1) PG8_BAR; }
    }
    PG8_WAIT_V(0);
    if constexpr (!ALIGN_EPI) { if (wr == 0) PG8_BAR; }
    PG8_BAR;
    if constexpr (Epi::AFTER) E.after(acc, cur, wr, wc, fr, fq, lds, wid, lane);
#undef PG8_SA
#undef PG8_SB
#undef PG8_STAGE
#undef PG8_STAGEA
#undef PG8_LDA
#undef PG8_LDB
#undef PG8_MMA
#undef PG8_WAIT_V
#undef PG8_WAIT_L
#undef PG8_BAR
#undef PG8_SCHED
}
}

constexpr int NWAVES = 8, NTHR = 512;
constexpr int SEQ = 8192, BATCH = 2, DM = 1024, M = BATCH * SEQ, NMETA = 16, INW = 6656, DFF = 2816, NGU = 2 * DFF, CHK = 64, NCH = SEQ / CHK;
constexpr float EPS = 1e-6f;
constexpr size_t KiB = 1024, MiB = 1u << 20;
constexpr size_t WS_LB = 0, WS_GM = 64 * KiB, WS_VM = 128 * KiB, WS_PLM = 192 * KiB, WS_PWT = 256 * KiB, WS_UM = 512 * KiB, WS_DK = 1 * MiB, WS_RSQ = 2 * MiB;
constexpr size_t WS_WAB = 3 * MiB, WS_WOUT = 6 * MiB, WS_WD = 8 * MiB, WS_WIN = 14 * MiB, WS_WGU = 14 * MiB;
constexpr size_t WS_Q = 28 * MiB, WS_G = 60 * MiB, WS_V = 92 * MiB, WS_OG = 124 * MiB, WS_GA = 156 * MiB, WS_GB = 188 * MiB, WS_PB = 220 * MiB, WS_END = 252 * MiB;
constexpr size_t WS_MG = WS_G, WS_H1B = WS_GB, WS_ACT = WS_Q;
static_assert(WS_WD + (size_t)DM * DFF * 2 <= WS_WIN && WS_WIN + (size_t)INW * DM * 2 <= WS_Q && WS_WGU + (size_t)NGU * DM * 2 <= WS_Q && WS_ACT + (size_t)M * DFF * 2 <= WS_H1B, "ws map");
#ifndef AUX_STREAM
#define AUX_STREAM 0
#endif
constexpr int LDS_BYTES = 163840;
constexpr size_t WS_BAR = 16 * KiB, WS_CNT = 32 * KiB, CTL_ZERO = 32 * KiB;

struct Args {
    const float *x, *meta, *g_mix, *w_in, *lb_raw, *g_hn, *pool_w, *pool_scale, *w_a, *w_b, *w_out, *g_ffn, *w_gate, *w_up, *w_down, *g_fin;
    float* out; unsigned char* ws; int ph_lo, ph_hi;
};

#define LDS_WAIT() asm volatile("s_waitcnt lgkmcnt(0)" ::: "memory")
__device__ __forceinline__ float wave_sum(float v) {
#pragma unroll
    for (int o = 1; o < 64; o <<= 1) v += __shfl_xor(v, o);
    return v;
}

__device__ __forceinline__ void tr_item(const float* W, int N, int k0, int n0, u16* WT, int drow0, int dpitch, int dk0, const float* ks, LAS float* scr, int lane) {
    f32x4 wv[8];
#pragma unroll
    for (int i = 0; i < 8; ++i) wv[i] = __builtin_nontemporal_load((const f32x4*)(W + (size_t)(k0 + 8 * i + (lane >> 3)) * N + n0 + 4 * (lane & 7)));
#pragma unroll
    for (int i = 0; i < 8; ++i) { const int kk = 8 * i + (lane >> 3); f32x4 w = wv[i]; if (ks) w *= ks[k0 + kk];
        LAS float* d = scr + kk * 33 + 4 * (lane & 7); d[0] = w.x; d[1] = w.y; d[2] = w.z; d[3] = w.w; }
    LDS_WAIT(); asm volatile("" ::: "memory");
    const int c = lane & 7;
#pragma unroll
    for (int j = 0; j < 4; ++j) { const int n = (lane >> 3) + 8 * j; const LAS float* s = scr + (8 * c) * 33 + n;
        u32x4 o; o.x = cvt_pk_bf16(s[0 * 33], s[1 * 33]); o.y = cvt_pk_bf16(s[2 * 33], s[3 * 33]); o.z = cvt_pk_bf16(s[4 * 33], s[5 * 33]); o.w = cvt_pk_bf16(s[6 * 33], s[7 * 33]);
        *(u32x4*)(WT + (size_t)(drow0 + n) * dpitch + dk0 + k0 + 8 * c) = o; }
    LDS_WAIT(); asm volatile("" ::: "memory");
}
__device__ __forceinline__ void rms_row_bf16(const float* xrow, const float* g, u16* orow, int lane) {
    const f32x4* xr = (const f32x4*)xrow + lane; const f32x4* gr = (const f32x4*)g + lane;
    f32x4 v[4]; float s = 0.f;
#pragma unroll
    for (int j = 0; j < 4; ++j) { v[j] = xr[64 * j]; s += (v[j].x * v[j].x + v[j].y * v[j].y) + (v[j].z * v[j].z + v[j].w * v[j].w); }
    const float rstd = rsqrtf(wave_sum(s) * (1.f / DM) + EPS);
    u32x2* o8 = (u32x2*)orow + lane;
#pragma unroll
    for (int j = 0; j < 4; ++j) { const f32x4 gv = gr[64 * j]; u32x2 o; o.x = cvt_pk_bf16(v[j].x * rstd * gv.x, v[j].y * rstd * gv.y); o.y = cvt_pk_bf16(v[j].z * rstd * gv.z, v[j].w * rstd * gv.w); o8[64 * j] = o; }
}

__device__ __forceinline__ void p0_meta(const Args& a, LAS unsigned char* lds, int j, int tid, int wave, int lane) {
    LAS float* nm = (LAS float*)lds;
    LAS float* part = (LAS float*)(lds + 65536);
#pragma unroll
    for (int rr = 0; rr < 2; ++rr) { const int r = 2 * wave + rr; const f32x4* xr = (const f32x4*)(a.meta + (size_t)r * DM) + lane; const f32x4* gr = (const f32x4*)a.g_mix + lane;
        f32x4 v[4]; float s = 0.f;
#pragma unroll
        for (int q = 0; q < 4; ++q) { v[q] = xr[64 * q]; s += (v[q].x * v[q].x + v[q].y * v[q].y) + (v[q].z * v[q].z + v[q].w * v[q].w); }
        const float rstd = rsqrtf(wave_sum(s) * (1.f / DM) + EPS);
#pragma unroll
        for (int q = 0; q < 4; ++q) { const f32x4 gv = gr[64 * q]; *(LAS f32x4*)(nm + r * 1024 + 4 * (lane + 64 * q)) = (f32x4){v[q].x * rstd * gv.x, v[q].y * rstd * gv.y, v[q].z * rstd * gv.z, v[q].w * rstd * gv.w}; }
    }
    __syncthreads();
    const int colbase = j < 32 ? 1024 + 32 * j : (j < 64 ? 2048 + 32 * (j - 32) : 4096 + 32 * (j - 64));
    {
        const int col = colbase + (lane & 31), kh = lane >> 5; float acc[16];
#pragma unroll
        for (int r = 0; r < 16; ++r) acc[r] = 0.f;
#pragma unroll 4
        for (int k = 128 * wave + 64 * kh; k < 128 * wave + 64 * kh + 64; k += 4) {
            const float w0 = a.w_in[(size_t)(k + 0) * INW + col], w1 = a.w_in[(size_t)(k + 1) * INW + col], w2 = a.w_in[(size_t)(k + 2) * INW + col], w3 = a.w_in[(size_t)(k + 3) * INW + col];
#pragma unroll
            for (int r = 0; r < 16; ++r) { const f32x4 n4 = *(const LAS f32x4*)(nm + r * 1024 + k); acc[r] += (n4.x * w0 + n4.y * w1) + (n4.z * w2 + n4.w * w3); }
        }
#pragma unroll
        for (int r = 0; r < 16; ++r) part[(wave * 16 + r) * 64 + lane] = acc[r];
    }
    __syncthreads();
    {
        const int r = tid >> 5, cl = tid & 31; float z = 0.f;
#pragma unroll
        for (int w = 0; w < 8; ++w) z += part[(w * 16 + r) * 64 + cl] + part[(w * 16 + r) * 64 + 32 + cl];
        const int col = colbase + cl;
        if (col < 2048) { const int c = col - 1024; const float lb = 1.0f / (1.0f + fexp(a.lb_raw[1024 + c] - a.lb_raw[c])); const float f = lb + (1.0f - lb) * sigm(z);
            const _Float16 hv = (_Float16)flog(f); ((u16*)(a.ws + WS_GM))[r * 1024 + c] = __builtin_bit_cast(unsigned short, hv); }
        else if (col < 3072) { ((u16*)(a.ws + WS_VM))[r * 1024 + (col - 2048)] = (u16)(cvt_pk_bf16(z, 0.f) & 0xffffu); }
        else { ((u16*)(a.ws + WS_PLM))[r * 512 + (col - 4096)] = (u16)(cvt_pk_bf16(z, 0.f) & 0xffffu); }
    }
    __syncthreads();
}

__device__ __forceinline__ void late_weights(const Args& a, LAS unsigned char* lds, int gw, int NGW) {
    const int lane = threadIdx.x & 63, wave = __builtin_amdgcn_readfirstlane(threadIdx.x >> 6);
    LAS float* scr = (LAS float*)(lds + wave * 16384);
    constexpr int I_A = 16 * 32, I_B = 8 * 32, I_O = 16 * 32, I_D = 44 * 32, I_P = 32;
    constexpr int NIT = I_A + I_B + I_O + I_D + I_P;
    for (int it = gw; it < NIT; it += NGW) {
        int r = it;
        if (r < I_A) { tr_item(a.w_a, 1024, 64 * (r / 32), 32 * (r % 32), (u16*)(a.ws + WS_WAB), 32 * (r % 32), 1536, 0, nullptr, scr, lane); continue; } r -= I_A;
        if (r < I_B) { tr_item(a.w_b, 1024, 64 * (r / 32), 32 * (r % 32), (u16*)(a.ws + WS_WAB), 32 * (r % 32), 1536, 1024, nullptr, scr, lane); continue; } r -= I_B;
        if (r < I_O) { tr_item(a.w_out, 1024, 64 * (r / 32), 32 * (r % 32), (u16*)(a.ws + WS_WOUT), 32 * (r % 32), 1024, 0, nullptr, scr, lane); continue; } r -= I_O;
        if (r < I_D) { tr_item(a.w_down, 1024, 64 * (r / 32), 32 * (r % 32), (u16*)(a.ws + WS_WD), 32 * (r % 32), DFF, 0, nullptr, scr, lane); continue; } r -= I_D;
        { const int gi = r >> 3, q = r & 7; tr_item(a.pool_w + (size_t)gi * 16384, 128, 64 * (q >> 2), 32 * (q & 3), (u16*)(a.ws + WS_PWT) + (size_t)gi * 16384, 32 * (q & 3), 128, 0, nullptr, scr, lane); }
    }
}

__device__ __forceinline__ void p0_prologue(const Args& a, LAS unsigned char* lds, int G, int skip = 0) {
    const int tid = threadIdx.x, lane = tid & 63, wave = __builtin_amdgcn_readfirstlane(tid >> 6);
    const bool split = G > 160;
    if (!(skip & 4)) for (int j = (int)blockIdx.x; j < 80; j += G) p0_meta(a, lds, j, tid, wave, lane);
    if (split && (int)blockIdx.x < 80) return;
    if (blockIdx.x == 80 || (G <= 80 && blockIdx.x == 0)) { for (int c = tid; c < 1024; c += NTHR) ((float*)(a.ws + WS_LB))[c] = 1.0f / (1.0f + fexp(a.lb_raw[1024 + c] - a.lb_raw[c])); }
    LAS float* scr = (LAS float*)(lds + wave * 16384);
    const int gw = ((int)blockIdx.x - (split ? 80 : 0)) * NWAVES + wave, NGW = (G - (split ? 80 : 0)) * NWAVES;
    constexpr int I_IN = 16 * 208;
    for (int it = gw; it < I_IN && !(skip & 1); it += NGW) tr_item(a.w_in, INW, 64 * (it / 208), 32 * (it % 208), (u16*)(a.ws + WS_WIN), 32 * (it % 208), 1024, 0, nullptr, scr, lane);
    if (G != 256) late_weights(a, lds, gw, NGW);
    u16* XN = (u16*)a.out;
    {
        const f32x4* gr = (const f32x4*)a.g_mix + lane; f32x4 gv[4];
#pragma unroll
        for (int j = 0; j < 4; ++j) gv[j] = gr[64 * j];
        for (int m = 4 * gw; m < M && !(skip & 2); m += 4 * NGW) {
            const f32x4* xr = (const f32x4*)(a.x + (size_t)m * DM) + lane; f32x4 v[16]; float ss[4];
#pragma unroll
            for (int j = 0; j < 16; ++j) v[j] = __builtin_nontemporal_load(&xr[64 * j]);
#pragma unroll
            for (int rr = 0; rr < 4; ++rr) { float t = 0.f;
#pragma unroll
                for (int j = 0; j < 4; ++j) { const f32x4 w = v[4 * rr + j]; t += (w.x * w.x + w.y * w.y) + (w.z * w.z + w.w * w.w); }
                ss[rr] = t; }
#pragma unroll
            for (int o = 1; o < 64; o <<= 1) {
#pragma unroll
                for (int rr = 0; rr < 4; ++rr) ss[rr] += __shfl_xor(ss[rr], o); }
            u32x2* o8 = (u32x2*)(XN + (size_t)m * DM) + lane;
#pragma unroll
            for (int j = 0; j < 16; ++j) { const float rs = rsqrtf(ss[j >> 2] * (1.f / DM) + EPS); const f32x4 g4 = gv[j & 3]; u32x2 o; o.x = cvt_pk_bf16(v[j].x * rs * g4.x, v[j].y * rs * g4.y); o.y = cvt_pk_bf16(v[j].z * rs * g4.z, v[j].w * rs * g4.w); o8[64 * j] = o; }
        }
    }
}

struct EpiIn {
    static constexpr bool PERM = true, MID = false, AFTER = false; static constexpr int A_AUX = 0;
    unsigned char* ws;
    __device__ __forceinline__ void mid(f32x4 (&)[2][2][4][2], const pg8::Unit&, int, int, int, int) const {}
    __device__ __forceinline__ void operator()(f32x4 (&acc)[2][2][4][2], const pg8::Unit& u, int wr, int wc, int fr, int fq) const {
        const int colt = u.pn * 256; int type, c0; size_t boff;
        if (colt < 1024) { type = 1; boff = WS_Q; c0 = colt; }
        else if (colt < 2048) { type = 3; boff = WS_G; c0 = colt - 1024; }
        else if (colt < 3072) { type = 0; boff = WS_V; c0 = colt - 2048; }
        else if (colt < 4096) { type = 1; boff = WS_OG; c0 = colt - 3072; }
        else if (colt < 4608) { type = 0; boff = WS_PB; c0 = colt - 4096 + 512; }
        else if (colt < 5632) { type = 2; boff = WS_GA; c0 = colt - 4608; }
        else { type = 2; boff = WS_GB; c0 = colt - 5632; }
        u16* base = (u16*)(ws + boff);
        const int col0 = c0 + wc * 32 + 8 * fq, row0 = u.pm * 256 + wr * 64 + fr;
        const float* LB = (const float*)(ws + WS_LB);
        f32x4 lbv[2][2];
        if (type == 3) {
#pragma unroll
            for (int bj = 0; bj < 2; ++bj) { lbv[bj][0] = *(const f32x4*)(LB + col0 + bj * 128); lbv[bj][1] = *(const f32x4*)(LB + col0 + bj * 128 + 4); }
        } else {
#pragma unroll
            for (int bj = 0; bj < 2; ++bj) { lbv[bj][0] = (f32x4){0.f, 0.f, 0.f, 0.f}; lbv[bj][1] = (f32x4){0.f, 0.f, 0.f, 0.f}; }
        }
#pragma unroll
        for (int ai = 0; ai < 2; ++ai)
#pragma unroll
            for (int m = 0; m < 4; ++m) { u16* rowp = base + (size_t)(row0 + ai * 128 + m * 16) * 1024 + col0;
#pragma unroll
                for (int bj = 0; bj < 2; ++bj) { f32x4 v0 = acc[ai][bj][m][0], v1 = acc[ai][bj][m][1]; u32x4 w;
                    if (type == 3) {
                        const f32x4 l0 = lbv[bj][0], l1 = lbv[bj][1];
#pragma unroll
                        for (int e = 0; e < 4; ++e) { v0[e] = flog(l0[e] + (1.0f - l0[e]) * sigm(v0[e])); v1[e] = flog(l1[e] + (1.0f - l1[e]) * sigm(v1[e])); }
                        w.x = pk_h(v0[0], v0[1]); w.y = pk_h(v0[2], v0[3]); w.z = pk_h(v1[0], v1[1]); w.w = pk_h(v1[2], v1[3]);
                    } else {
                        if (type == 1) {
#pragma unroll
                            for (int e = 0; e < 4; ++e) { v0[e] = v0[e] * sigm(v0[e]); v1[e] = v1[e] * sigm(v1[e]); }
                        } else if (type == 2) {
#pragma unroll
                            for (int e = 0; e < 4; ++e) { v0[e] = sigm(v0[e]); v1[e] = sigm(v1[e]); }
                        }
                        w.x = cvt_pk_bf16(v0[0], v0[1]); w.y = cvt_pk_bf16(v0[2], v0[3]); w.z = cvt_pk_bf16(v1[0], v1[1]); w.w = cvt_pk_bf16(v1[2], v1[3]);
                    }
                    __builtin_nontemporal_store(w, (u32x4*)(rowp + bj * 128)); } }
    }
};
struct EpiMerge {
    static constexpr bool PERM = true, MID = true, AFTER = false; static constexpr int A_AUX = AUX_STREAM;
    const u16 *GA, *GB; u16* MG;
    __device__ __forceinline__ void mid(f32x4 (&acc)[2][2][4][2], const pg8::Unit& u, int wr, int wc, int fr, int fq) const {
        int zz = 0; asm volatile("" : "+v"(zz));
        const int col0 = u.pn * 256 + wc * 32 + 8 * fq, row0 = u.pm * 256 + wr * 64 + fr + zz;
#pragma unroll
        for (int ai = 0; ai < 2; ++ai)
#pragma unroll
            for (int m = 0; m < 4; ++m) { const size_t off = (size_t)(row0 + ai * 128 + m * 16) * 1024 + col0;
#pragma unroll
                for (int bj = 0; bj < 2; ++bj) { const u32x4 ga = __builtin_nontemporal_load((const u32x4*)(GA + off + bj * 128)), gb = *(const u32x4*)(GB + off + bj * 128);
#pragma unroll
                    for (int e = 0; e < 2; ++e) { acc[ai][bj][m][0][2 * e] *= bf_lo(ga[e]) * __builtin_amdgcn_rcpf(bf_lo(gb[e])); acc[ai][bj][m][0][2 * e + 1] *= bf_hi(ga[e]) * __builtin_amdgcn_rcpf(bf_hi(gb[e]));
                        acc[ai][bj][m][1][2 * e] *= bf_lo(ga[2 + e]) * __builtin_amdgcn_rcpf(bf_lo(gb[2 + e])); acc[ai][bj][m][1][2 * e + 1] *= bf_hi(ga[2 + e]) * __builtin_amdgcn_rcpf(bf_hi(gb[2 + e])); } }
                asm volatile("" ::: "memory"); }
    }
    __device__ __forceinline__ void operator()(f32x4 (&acc)[2][2][4][2], const pg8::Unit& u, int wr, int wc, int fr, int fq) const {
        const int col0 = u.pn * 256 + wc * 32 + 8 * fq, row0 = u.pm * 256 + wr * 64 + fr;
#pragma unroll
        for (int ai = 0; ai < 2; ++ai)
#pragma unroll
            for (int m = 0; m < 4; ++m) { const size_t off = (size_t)(row0 + ai * 128 + m * 16) * 1024 + col0;
#pragma unroll
                for (int bj = 0; bj < 2; ++bj) { const u32x4 gb = *(const u32x4*)(GB + off + bj * 128);
                    acc[ai][bj][m][0] *= (f32x4){bf_lo(gb[0]), bf_hi(gb[0]), bf_lo(gb[1]), bf_hi(gb[1])}; acc[ai][bj][m][1] *= (f32x4){bf_lo(gb[2]), bf_hi(gb[2]), bf_lo(gb[3]), bf_hi(gb[3])}; } }
#pragma unroll
        for (int ai = 0; ai < 2; ++ai)
#pragma unroll
            for (int m = 0; m < 4; ++m) { const size_t off = (size_t)(row0 + ai * 128 + m * 16) * 1024 + col0;
#pragma unroll
                for (int bj = 0; bj < 2; ++bj) { const f32x4 v0 = acc[ai][bj][m][0], v1 = acc[ai][bj][m][1]; u32x4 w;
                    w.x = cvt_pk_bf16(v0[0], v0[1]); w.y = cvt_pk_bf16(v0[2], v0[3]); w.z = cvt_pk_bf16(v1[0], v1[1]); w.w = cvt_pk_bf16(v1[2], v1[3]);
                    *(u32x4*)(MG + off + bj * 128) = w; } }
    }
};
template <bool WITH_BF16>
struct EpiRes {
    static constexpr bool PERM = true, MID = false, AFTER = false; static constexpr int A_AUX = AUX_STREAM;
    const float* base; float* H; u16* Hb; float* rsq;
    __device__ __forceinline__ void mid(f32x4 (&)[2][2][4][2], const pg8::Unit&, int, int, int, int) const {}
    __device__ __forceinline__ void operator()(f32x4 (&acc)[2][2][4][2], const pg8::Unit& u, int wr, int wc, int fr, int fq) const {
        const int col0 = u.pn * 256 + wc * 32 + 8 * fq, row0 = u.pm * 256 + wr * 64 + fr;
#pragma unroll
        for (int ai = 0; ai < 2; ++ai) {
            f32x4 pre[4][2][2];
#pragma unroll
            for (int m = 0; m < 4; ++m) { const size_t off = (size_t)(row0 + ai * 128 + m * 16) * 1024 + col0;
#pragma unroll
                for (int bj = 0; bj < 2; ++bj)
#pragma unroll
                    for (int n = 0; n < 2; ++n) pre[m][bj][n] = __builtin_nontemporal_load((const f32x4*)(base + off + bj * 128 + n * 4)); }
            asm volatile("" ::: "memory");
#pragma unroll
            for (int m = 0; m < 4; ++m) { const int row = row0 + ai * 128 + m * 16; const size_t off = (size_t)row * 1024 + col0; float s = 0.f;
#pragma unroll
                for (int bj = 0; bj < 2; ++bj) { const f32x4 h0 = pre[m][bj][0] + acc[ai][bj][m][0], h1 = pre[m][bj][1] + acc[ai][bj][m][1];
                    if (H) { *(f32x4*)(H + off + bj * 128) = h0; *(f32x4*)(H + off + bj * 128 + 4) = h1; }
                    s += ((h0[0] * h0[0] + h0[1] * h0[1]) + (h0[2] * h0[2] + h0[3] * h0[3])) + ((h1[0] * h1[0] + h1[1] * h1[1]) + (h1[2] * h1[2] + h1[3] * h1[3]));
                    if (WITH_BF16) { u32x4 w; w.x = cvt_pk_bf16(h0[0], h0[1]); w.y = cvt_pk_bf16(h0[2], h0[3]); w.z = cvt_pk_bf16(h1[0], h1[1]); w.w = cvt_pk_bf16(h1[2], h1[3]); *(u32x4*)(Hb + off + bj * 128) = w; } }
                s += __shfl_xor(s, 16); s += __shfl_xor(s, 32);
                if (fq == 0) rsq[(size_t)row * 16 + u.pn * 4 + wc] = s; }
            asm volatile("" ::: "memory");
        }
    }
};
struct EpiFfn1 {
    static constexpr bool PERM = true, MID = false, AFTER = false; static constexpr int A_AUX = 0;
    const float* rsq; u16* ACT;
    __device__ __forceinline__ void mid(f32x4 (&)[2][2][4][2], const pg8::Unit&, int, int, int, int) const {}
    __device__ __forceinline__ void operator()(const f32x4 (&acc)[2][2][4][2], const pg8::Unit& u, int wr, int wc, int fr, int fq) const {
        const int col0 = u.pn * 128 + wc * 32 + 8 * fq, row0 = u.pm * 256 + wr * 64 + fr;
        float rstdv[2][4];
#pragma unroll
        for (int ai = 0; ai < 2; ++ai)
#pragma unroll
            for (int m = 0; m < 4; ++m) { const int row = row0 + ai * 128 + m * 16; const f32x4* rp = (const f32x4*)(rsq + (size_t)row * 16);
                const f32x4 r0 = rp[fq];
                float ss = (r0[0] + r0[1]) + (r0[2] + r0[3]); ss += __shfl_xor(ss, 16); ss += __shfl_xor(ss, 32);
                rstdv[ai][m] = rsqrtf(ss * (1.f / DM) + EPS); }
#pragma unroll
        for (int ai = 0; ai < 2; ++ai)
#pragma unroll
            for (int m = 0; m < 4; ++m) { const int row = row0 + ai * 128 + m * 16;
                const float rstd = rstdv[ai][m];
                float o[8];
#pragma unroll
                for (int n = 0; n < 2; ++n)
#pragma unroll
                    for (int e = 0; e < 4; ++e) { const float gt = acc[ai][0][m][n][e] * rstd, up = acc[ai][1][m][n][e] * rstd; o[4 * n + e] = gt * sigm(gt) * up; }
                u32x4 w; w.x = cvt_pk_bf16(o[0], o[1]); w.y = cvt_pk_bf16(o[2], o[3]); w.z = cvt_pk_bf16(o[4], o[5]); w.w = cvt_pk_bf16(o[6], o[7]);
                __builtin_nontemporal_store(w, (u32x4*)(ACT + (size_t)row * DFF + col0)); }
    }
};

struct EpiResNorm {
    static constexpr bool PERM = false, MID = false, AFTER = true; static constexpr int A_AUX = AUX_STREAM;
    const u16* base; float* out; const float* gfin; float* slots; unsigned* cnt;
    __device__ __forceinline__ void mid(f32x4 (&)[2][2][4][2], const pg8::Unit&, int, int, int, int) const {}
    __device__ __forceinline__ void operator()(const f32x4 (&)[2][2][4][2], const pg8::Unit&, int, int, int, int) const {}
    __device__ __forceinline__ void after(f32x4 (&acc)[2][2][4][2], const pg8::Unit& u, int wr, int wc, int fr, int fq, LAS unsigned char* lds, int wid, int lane) const {
        LAS float* P = (LAS float*)lds; LAS float* R = (LAS float*)(lds + 4096);
        const int col0 = u.pn * 256 + wc * 32 + 4 * fq;
#pragma unroll
        for (int ai = 0; ai < 2; ++ai)
#pragma unroll
            for (int m = 0; m < 4; ++m) { const int rl = ai * 128 + wr * 64 + m * 16 + fr; const size_t off = (size_t)(u.pm * 256 + rl) * 1024 + col0; float s = 0.f;
#pragma unroll
                for (int bj = 0; bj < 2; ++bj)
#pragma unroll
                    for (int n = 0; n < 2; ++n) { const u32x2 hb = __builtin_nontemporal_load((const u32x2*)(base + off + bj * 128 + n * 16));
                        const f32x4 hv = (f32x4){bf_lo(hb.x), bf_hi(hb.x), bf_lo(hb.y), bf_hi(hb.y)} + acc[ai][bj][m][n]; acc[ai][bj][m][n] = hv; s += (hv[0] * hv[0] + hv[1] * hv[1]) + (hv[2] * hv[2] + hv[3] * hv[3]); }
                s += __shfl_xor(s, 16); s += __shfl_xor(s, 32);
                if (fq == 0) P[rl * 4 + wc] = s;
                if (m & 1) asm volatile("" ::: "memory"); }
        asm volatile("s_waitcnt lgkmcnt(0)" ::: "memory"); __builtin_amdgcn_s_barrier(); asm volatile("" ::: "memory");
        const int row = wid * 32 + (lane & 31);
        unsigned* slot = (unsigned*)slots + (size_t)(u.pm * 256 + row) * 16;
        if (lane < 32) { const float t = (P[row * 4 + 0] + P[row * 4 + 1]) + (P[row * 4 + 2] + P[row * 4 + 3]);
            __hip_atomic_store(slot + u.pn, __float_as_uint(t), __ATOMIC_RELAXED, __HIP_MEMORY_SCOPE_AGENT); }
        asm volatile("s_waitcnt vmcnt(0)" ::: "memory");
        if (lane == 0) __hip_atomic_fetch_add(cnt + 64 * u.pm, 1u, __ATOMIC_RELAXED, __HIP_MEMORY_SCOPE_AGENT);
        if (wid == 0) { unsigned sp = 0;
            while ((unsigned)__builtin_amdgcn_readfirstlane(__hip_atomic_load(cnt + 64 * u.pm, __ATOMIC_RELAXED, __HIP_MEMORY_SCOPE_AGENT)) < 32u) { __builtin_amdgcn_s_sleep(2); if (++sp > (1u << 20)) break; }
            __builtin_amdgcn_fence(__ATOMIC_ACQUIRE, "agent"); }
        asm volatile("s_waitcnt vmcnt(0) lgkmcnt(0)" ::: "memory"); __builtin_amdgcn_s_barrier(); asm volatile("" ::: "memory");
        if (lane < 32) { float t = 0.f;
#pragma unroll
            for (int k = 0; k < 4; ++k) t += __uint_as_float(__hip_atomic_load(slot + k, __ATOMIC_RELAXED, __HIP_MEMORY_SCOPE_AGENT));
            R[row] = rsqrtf(t * (1.f / DM) + EPS); }
        asm volatile("s_waitcnt lgkmcnt(0)" ::: "memory"); __builtin_amdgcn_s_barrier(); asm volatile("" ::: "memory");
        f32x4 gv[2][2];
#pragma unroll
        for (int bj = 0; bj < 2; ++bj)
#pragma unroll
            for (int n = 0; n < 2; ++n) gv[bj][n] = *(const f32x4*)(gfin + col0 + bj * 128 + n * 16);
#pragma unroll
        for (int ai = 0; ai < 2; ++ai)
#pragma unroll
            for (int m = 0; m < 4; ++m) { const int rl = ai * 128 + wr * 64 + m * 16 + fr; const size_t off = (size_t)(u.pm * 256 + rl) * 1024 + col0; const float rs = R[rl];
#pragma unroll
                for (int bj = 0; bj < 2; ++bj)
#pragma unroll
                    for (int n = 0; n < 2; ++n) *(f32x4*)(out + off + bj * 128 + n * 16) = acc[ai][bj][m][n] * rs * gv[bj][n]; }
    }
};
#define RLX_AGENT __ATOMIC_RELAXED, __HIP_MEMORY_SCOPE_AGENT
#define XB_TMO      128
#define XB_XCNT(j)  (256  + 64 * (j))
#define XB_XSUB(j)  (1280 + 64 * (j))
#define XB_XGEN(j)  (2304 + 64 * (j))
#define XB_TOP      3328
#define XB_TOPGEN   3392
#define XCD_BAR_WORDS 3456
#define XB_SPIN_CAP (1u << 18)

__device__ __forceinline__ unsigned xb_ld(unsigned* p)              { return __hip_atomic_load(p, __ATOMIC_RELAXED, __HIP_MEMORY_SCOPE_AGENT); }
__device__ __forceinline__ unsigned xb_add(unsigned* p, unsigned v) { return __hip_atomic_fetch_add(p, v, __ATOMIC_RELAXED, __HIP_MEMORY_SCOPE_AGENT); }
__device__ __forceinline__ unsigned xb_xcc_id() { return (unsigned)__builtin_amdgcn_s_getreg((3 << 11) | 20) & 0xFu; }
#define XB_SPIN(cond, bar) do { unsigned _sp = 0; while (cond) { __builtin_amdgcn_s_sleep(1); \
    if ((++_sp & 255u) == 0u) { if (xb_ld(&(bar)[XB_TMO])) break; if (_sp > XB_SPIN_CAP) { atomicAdd(&(bar)[XB_TMO], 1u); break; } } } } while (0)

struct XcdBarrier {
    unsigned* bar; unsigned x;
    volatile LAS unsigned* st;
};

__device__ __forceinline__ XcdBarrier xcd_barrier_post(unsigned* bar, volatile LAS unsigned* st) {
    XcdBarrier b; b.bar = bar; b.x = xb_xcc_id(); b.st = st;
    if (threadIdx.x == 0) (void)xb_add(&bar[XB_XCNT(b.x)], 1u);
    return b;
}
__device__ __forceinline__ void xcd_barrier_complete(unsigned* bar, unsigned x, unsigned& nloc, unsigned& nx) {
    const unsigned G = gridDim.x * gridDim.y * gridDim.z;
    unsigned sum, cnt, mine, sp = 0u;
    for (;;) {
        sum = 0u; cnt = 0u; mine = 0u;
#pragma unroll
        for (unsigned j = 0; j < 16; ++j) { const unsigned c = xb_ld(&bar[XB_XCNT(j)]); sum += c; cnt += (c > 0u) ? 1u : 0u; mine = (j == x) ? c : mine; }
        if (sum == G) break;
        __builtin_amdgcn_s_sleep(1);
        if ((++sp & 255u) == 0u) { if (xb_ld(&bar[XB_TMO])) break; if (sp > XB_SPIN_CAP) { atomicAdd(&bar[XB_TMO], 1u); break; } }
    }
    nloc = mine > 0u ? mine : 1u; nx = cnt > 0u ? cnt : 1u;
}

__device__ __forceinline__ void xcd_barrier(const XcdBarrier& b) {
    asm volatile("s_waitcnt vmcnt(0)" ::: "memory");
    __syncthreads();
    if (threadIdx.x == 0) {
        unsigned* bar = b.bar;
        __builtin_amdgcn_s_waitcnt(0);
        unsigned nloc = b.st[0], nx = b.st[1];
        if (nloc == 0u) { xcd_barrier_complete(bar, b.x, nloc, nx); b.st[0] = nloc; b.st[1] = nx; }
        const unsigned old = xb_add(&bar[XB_XSUB(b.x)], 1u);
        const unsigned gen = old / nloc;
        if (old + 1u == (gen + 1u) * nloc) {
            __builtin_amdgcn_fence(__ATOMIC_RELEASE, "agent");
            asm volatile("s_waitcnt vmcnt(0)" ::: "memory");
            const unsigned og = xb_add(&bar[XB_TOP], 1u);
            const unsigned tg = og / nx;
            if (og + 1u == (tg + 1u) * nx) xb_add(&bar[XB_TOPGEN], 1u);
            else XB_SPIN(xb_ld(&bar[XB_TOPGEN]) == tg, bar);
            __builtin_amdgcn_fence(__ATOMIC_ACQUIRE, "agent");
            xb_add(&bar[XB_XGEN(b.x)], 1u);
            asm volatile("s_waitcnt vmcnt(0)" ::: "memory");
        } else {
            XB_SPIN(xb_ld(&bar[XB_XGEN(b.x)]) == gen, bar);
            __builtin_amdgcn_fence(__ATOMIC_ACQUIRE, "agent");
            asm volatile("s_waitcnt vmcnt(0)" ::: "memory");
        }
    }
    __syncthreads();
}

__device__ __forceinline__ void p2_wave(const u16* Gp, const u16* Vp, int nrows, int h, u16* Uout, float* dk, int lane) {
    const int r = lane & 15, q = lane >> 4;
    bf16x8 kf[8][2]; float tot1[8];
#pragma unroll
    for (int kk = 0; kk < 2; ++kk) { const int ks = 1 - kk;
#pragma unroll
        for (int dg = 0; dg < 2; ++dg) {
            int zz = 0; asm volatile("" : "+v"(zz));
            u32x4 wq[4];
#pragma unroll
            for (int p2 = 0; p2 < 2; ++p2) { const int dp = 2 * dg + p2; const int dcol = 32 * dp + 2 * r + zz; unsigned gw[8];
#pragma unroll
                for (int j = 0; j < 8; ++j) { const int s = 32 * ks + 8 * q + j; gw[j] = s < nrows ? *(const unsigned*)(Gp + (size_t)s * 1024 + h * 128 + dcol) : 0u; }
#pragma unroll
                for (int par = 0; par < 2; ++par) { const int dt = 2 * dp + par; float gv[8];
#pragma unroll
                    for (int j = 0; j < 8; ++j) gv[j] = h2f((u16)(par ? (gw[j] >> 16) : (gw[j] & 0xffffu)));
                    float suf[8]; float run = 0.f;
#pragma unroll
                    for (int j = 7; j >= 0; --j) { suf[j] = run; run += gv[j]; }
                    const float T = run, ta = __shfl_xor(T, 16), tb = __shfl_xor(T, 32), tc = __shfl_xor(ta, 32);
                    const float after = ((q ^ 1) > q ? ta : 0.f) + ((q ^ 2) > q ? tb : 0.f) + ((q ^ 3) > q ? tc : 0.f);
                    const float tot = (T + ta) + (tb + tc);
                    float base;
                    if (ks == 1) { tot1[dt] = tot; base = after; } else { base = after + tot1[dt]; if (dk && q == 0) dk[h * 128 + dcol + par] = fexp(tot + tot1[dt]); }
                    float kh[8];
#pragma unroll
                    for (int j = 0; j < 8; ++j) kh[j] = (1.0f - fexp(gv[j])) * fexp(suf[j] + base);
                    u32x4& w = wq[2 * p2 + par];
                    w.x = cvt_pk_bf16(kh[0], kh[1]); w.y = cvt_pk_bf16(kh[2], kh[3]); w.z = cvt_pk_bf16(kh[4], kh[5]); w.w = cvt_pk_bf16(kh[6], kh[7]); } }
            asm volatile("" : "+v"(wq[0].x), "+v"(wq[0].y), "+v"(wq[0].z), "+v"(wq[0].w), "+v"(wq[1].x), "+v"(wq[1].y), "+v"(wq[1].z), "+v"(wq[1].w),
                              "+v"(wq[2].x), "+v"(wq[2].y), "+v"(wq[2].z), "+v"(wq[2].w), "+v"(wq[3].x), "+v"(wq[3].y), "+v"(wq[3].z), "+v"(wq[3].w));
#pragma unroll
            for (int d4 = 0; d4 < 4; ++d4) kf[4 * dg + d4][ks] = __builtin_bit_cast(bf16x8, wq[d4]); } }
#pragma unroll 1
    for (int ep = 0; ep < 4; ++ep) {
        int zz = 0; asm volatile("" : "+v"(zz)); const int ecol = 32 * ep + 2 * r + zz;
        unsigned vw[2][8];
#pragma unroll
        for (int ks = 0; ks < 2; ++ks)
#pragma unroll
            for (int j = 0; j < 8; ++j) { const int s = 32 * ks + 8 * q + j; vw[ks][j] = s < nrows ? *(const unsigned*)(Vp + (size_t)s * 1024 + h * 128 + ecol) : 0u; }
#pragma unroll
        for (int par = 0; par < 2; ++par) {
            bf16x8 vf[2];
#pragma unroll
            for (int ks = 0; ks < 2; ++ks) { u32x4 w;
                if (par == 0) { w.x = (vw[ks][0] & 0xffffu) | (vw[ks][1] << 16); w.y = (vw[ks][2] & 0xffffu) | (vw[ks][3] << 16); w.z = (vw[ks][4] & 0xffffu) | (vw[ks][5] << 16); w.w = (vw[ks][6] & 0xffffu) | (vw[ks][7] << 16); }
                else { w.x = (vw[ks][0] >> 16) | (vw[ks][1] & 0xffff0000u); w.y = (vw[ks][2] >> 16) | (vw[ks][3] & 0xffff0000u); w.z = (vw[ks][4] >> 16) | (vw[ks][5] & 0xffff0000u); w.w = (vw[ks][6] >> 16) | (vw[ks][7] & 0xffff0000u); }
                vf[ks] = __builtin_bit_cast(bf16x8, w); }
            f32x4 acc[8];
#pragma unroll
            for (int dt = 0; dt < 8; ++dt) { acc[dt] = (f32x4){0.f, 0.f, 0.f, 0.f};
#pragma unroll
                for (int ks = 0; ks < 2; ++ks) acc[dt] = __builtin_amdgcn_mfma_f32_16x16x32_bf16(kf[dt][ks], vf[ks], acc[dt], 0, 0, 0); }
#pragma unroll
            for (int dp = 0; dp < 4; ++dp) { u32x4 w; w.x = cvt_pk_bf16(acc[2 * dp][0], acc[2 * dp + 1][0]); w.y = cvt_pk_bf16(acc[2 * dp][1], acc[2 * dp + 1][1]); w.z = cvt_pk_bf16(acc[2 * dp][2], acc[2 * dp + 1][2]); w.w = cvt_pk_bf16(acc[2 * dp][3], acc[2 * dp + 1][3]);
                { const int e = 32 * ep + 2 * r + par;
                  *(u32x4*)(Uout + ((size_t)((e >> 4) * 4 + dp) * 64 + q * 16 + (e & 15)) * 8) = w; } } }
    }
}
__device__ __forceinline__ void p2_states(const Args& a, int G) {
    const int tid = threadIdx.x, lane = tid & 63, wave = __builtin_amdgcn_readfirstlane(tid >> 6);
    const u16* Gb = (const u16*)(a.ws + WS_G); const u16* Vb = (const u16*)(a.ws + WS_V); u16* US = (u16*)a.out; float* DK = (float*)(a.ws + WS_DK);
    for (int it = blockIdx.x; it < BATCH * NCH + (G == 256 ? 0 : 1); it += G) {
        if (it < BATCH * NCH) { const size_t row0 = (size_t)it * CHK;
            p2_wave(Gb + row0 * 1024, Vb + row0 * 1024, CHK, wave, US + ((size_t)it * 8 + wave) * 16384, DK + (size_t)it * 1024, lane); }
        else p2_wave((const u16*)(a.ws + WS_GM), (const u16*)(a.ws + WS_VM), NMETA, wave, (u16*)(a.ws + WS_UM) + (size_t)wave * 16384, nullptr, lane);
    }
}

__device__ __forceinline__ void p3_scan(const Args& a, LAS unsigned char* lds, int G) {
    const int tid = threadIdx.x, lane = tid & 63, wave = __builtin_amdgcn_readfirstlane(tid >> 6);
    {
        LAS float* scr = (LAS float*)(lds + wave * 16384);
        const int gw = (int)blockIdx.x * NWAVES + wave, NGW = G * NWAVES;
        for (int it = gw; it < 2 * 16 * 88; it += NGW) { const int up = it >= 16 * 88, r = up ? it - 16 * 88 : it, kb = r / 88, nb = r % 88, n0 = 32 * nb;
            tr_item(up ? a.w_up : a.w_gate, DFF, 64 * kb, n0, (u16*)(a.ws + WS_WGU), (n0 >> 7) * 256 + (n0 & 127) + (up ? 128 : 0), 1024, 0, a.g_ffn, scr, lane); }
    }
    u16* US = (u16*)a.out; const float* DK = (const float*)(a.ws + WS_DK); const u16* UM = (const u16*)(a.ws + WS_UM);
    for (int idx = blockIdx.x * NTHR + tid; idx < BATCH * 8 * 128 * 64; idx += G * NTHR) {
        const int pr = idx & 8191, h = (idx >> 13) & 7, b = idx >> 16;
        const int d = 32 * ((pr >> 8) & 3) + 8 * ((pr >> 6) & 3) + 2 * (pr & 3);
        const unsigned um = *(const unsigned*)(UM + (size_t)h * 16384 + 2 * pr);
        float s0 = bf_lo(um), s1 = bf_hi(um);
        unsigned* up = (unsigned*)(US + ((size_t)(b * NCH) * 8 + h) * 16384 + 2 * pr);
        const float* dkp = DK + (size_t)(b * NCH) * 1024 + h * 128 + d;
#pragma unroll 1
        for (int c0 = 0; c0 < NCH; c0 += 16) {
            unsigned uu[16]; float dd0[16], dd1[16];
#pragma unroll
            for (int i = 0; i < 16; ++i) { uu[i] = up[(size_t)(c0 + i) * 8 * 8192]; const f32v2_t dk2 = *(const f32v2_t*)(dkp + (size_t)(c0 + i) * 1024); dd0[i] = dk2[0]; dd1[i] = dk2[1]; }
#pragma unroll
            for (int i = 0; i < 16; ++i) { up[(size_t)(c0 + i) * 8 * 8192] = cvt_pk_bf16(s0, s1); s0 = dd0[i] * s0 + bf_lo(uu[i]); s1 = dd1[i] * s1 + bf_hi(uu[i]); }
        }
    }
}

constexpr int P4_PITCH = 272, P4_MAT = 64 * P4_PITCH  , P4_VPITCH = 136, P4_HS = 4 * P4_MAT  , P4_TOT = 2 * P4_HS  , P4_PLD = P4_TOT + 4096  ;
static_assert(P4_PLD + P4_MAT + 64 <= LDS_BYTES, "LDS map");
__device__ __forceinline__ unsigned ld_pl(const u16* PB, const u16* PLM, int b, int tx, int cofs) {
    return tx >= 0 ? *(const unsigned*)(PB + (size_t)(b * SEQ + tx) * 1024 + 512 + cofs) : *(const unsigned*)(PLM + (size_t)(NMETA + tx) * 512 + cofs);
}
__device__ __forceinline__ void p4_outputs(const Args& a, LAS unsigned char* lds, int G, int skip = 0) {
    (void)skip;
    const int tid = threadIdx.x, lane = tid & 63, wave = __builtin_amdgcn_readfirstlane(tid >> 6);
    const int r = lane & 15, q = lane >> 4;
    u16* Qb = (u16*)(a.ws + WS_Q); const u16* Gb = (const u16*)(a.ws + WS_G); const u16* Vb = (const u16*)(a.ws + WS_V); const u16* OGb = (const u16*)(a.ws + WS_OG);
    u16* PB = (u16*)(a.ws + WS_PB); const u16* PLM = (const u16*)(a.ws + WS_PLM); const u16* PWT = (const u16*)(a.ws + WS_PWT); const u16* US = (const u16*)a.out;
    LAS unsigned char* PLD = lds + P4_PLD;
    for (int item = blockIdx.x; item < BATCH * NCH * 4; item += G) {
        const int hp = item & 3, bc = item >> 2, c = bc & (NCH - 1), b = bc >> 7;
        const size_t row0 = (size_t)b * SEQ + (size_t)c * CHK;
        const int hs = wave >> 2, tq = wave & 3, h = 2 * hp + hs;
        LAS unsigned char* L = lds + hs * P4_HS;
        LAS unsigned char* KT = L, *QT = L + P4_MAT, *QH = L + 2 * P4_MAT, *VT = L + 3 * P4_MAT;
        LAS float* TOT = (LAS float*)(lds + P4_TOT) + hs * 512;
        const int d0 = 2 * lane; const size_t cofs = (size_t)h * 128 + d0;
        unsigned gp[16], qv[16], vv[16];
#pragma unroll
        for (int i = 0; i < 16; ++i) { const size_t o = (row0 + 16 * tq + i) * 1024 + cofs; gp[i] = __builtin_nontemporal_load((const unsigned*)(Gb + o)); qv[i] = __builtin_nontemporal_load((const unsigned*)(Qb + o)); vv[i] = __builtin_nontemporal_load((const unsigned*)(Vb + o)); }
        const int gi = hp, wlen = 2 << gi; const float inv = 1.0f / (float)wlen;
        const int t0 = 8 * wave, pcofs = gi * 128 + 2 * lane, tx0 = c * CHK + t0;
        unsigned pu[23];
#pragma unroll
        for (int j = 1; j < 16; ++j) pu[15 - j] = (j < wlen) ? ld_pl(PB, PLM, b, tx0 - j, pcofs) : 0u;
#pragma unroll
        for (int i = 0; i < 8; ++i) pu[15 + i] = ld_pl(PB, PLM, b, tx0 + i, pcofs);
        bf16x8 wf[4];
#pragma unroll
        for (int kd = 0; kd < 4; ++kd) wf[kd] = *(const bf16x8*)(PWT + (size_t)(gi * 128 + 16 * wave + r) * 128 + 32 * kd + 8 * q);
        float s0 = 0.f, s1 = 0.f;
#pragma unroll
        for (int i = 0; i < 16; ++i) { s0 += h2f((u16)(gp[i] & 0xffffu)); s1 += h2f((u16)(gp[i] >> 16)); }
        TOT[tq * 128 + d0] = s0; TOT[tq * 128 + d0 + 1] = s1;
        __syncthreads();
        {
            float w0 = 0.f, w1 = 0.f;
#pragma unroll
            for (int j = 1; j < 16; ++j) if (j < wlen) { w0 += bf_lo(pu[15 - j]); w1 += bf_hi(pu[15 - j]); }
#pragma unroll
            for (int i = 0; i < 8; ++i) { const float u0 = bf_lo(pu[15 + i]), u1 = bf_hi(pu[15 + i]); w0 += u0; w1 += u1;
                *(LAS unsigned*)(PLD + (t0 + i) * P4_PITCH + 4 * lane) = cvt_pk_bf16(w0 * inv - u0, w1 * inv - u1);
                const unsigned o = wlen == 2 ? pu[15 + i - 1] : (wlen == 4 ? pu[15 + i - 3] : (wlen == 8 ? pu[15 + i - 7] : pu[15 + i - 15]));
                w0 -= bf_lo(o); w1 -= bf_hi(o); }
        }
        float b0 = 0.f, b1 = 0.f;
#pragma unroll
        for (int t2 = 0; t2 < 3; ++t2) if (t2 < tq) { b0 += TOT[t2 * 128 + d0]; b1 += TOT[t2 * 128 + d0 + 1]; }
        const float bm0 = TOT[d0] + TOT[128 + d0], bm1 = TOT[d0 + 1] + TOT[128 + d0 + 1];
#pragma unroll
        for (int i = 0; i < 16; ++i) { const int t = 16 * tq + i; const float g0 = h2f((u16)(gp[i] & 0xffffu)), g1 = h2f((u16)(gp[i] >> 16)); b0 += g0; b1 += g1;
            const unsigned q2 = qv[i], v2 = vv[i];
            const float q0 = bf_lo(q2), q1 = bf_hi(q2), k0 = 1.0f - fexp(g0), k1 = 1.0f - fexp(g1);
            const float eb0 = fexp(b0), eb1 = fexp(b1), em0 = fexp(fminf(b0 - bm0, 80.f)), em1 = fexp(fminf(b1 - bm1, 80.f)), ek0 = fexp(fminf(bm0 - b0, 80.f)), ek1 = fexp(fminf(bm1 - b1, 80.f));
            *(LAS unsigned*)(QT + t * P4_PITCH + d0 * 2) = cvt_pk_bf16(q0 * em0, q1 * em1);
            *(LAS unsigned*)(QH + t * P4_PITCH + d0 * 2) = cvt_pk_bf16(q0 * eb0, q1 * eb1);
            *(LAS unsigned*)(KT + t * P4_PITCH + d0 * 2) = cvt_pk_bf16(k0 * ek0, k1 * ek1);
            *(LAS u16*)(VT + d0 * P4_VPITCH + t * 2) = (u16)(v2 & 0xffffu); *(LAS u16*)(VT + (d0 + 1) * P4_VPITCH + t * 2) = (u16)(v2 >> 16); }
        const u16* Sp = US + ((size_t)bc * 8 + h) * 16384;
        bf16x8 sfr[8][4];
#pragma unroll
        for (int et = 0; et < 8; ++et)
#pragma unroll
            for (int kd = 0; kd < 4; ++kd) sfr[et][kd] = *(const bf16x8*)(Sp + ((size_t)(et * 4 + kd) * 64 + lane) * 8);
        const int tt = tq;
        const size_t orow = (row0 + 16 * tt + r) * 1024 + (size_t)h * 128;
        __syncthreads();
        u32x2 ogv[8];
#pragma unroll
        for (int et = 0; et < 8; ++et) ogv[et] = __builtin_nontemporal_load((const u32x2*)(OGb + orow + 16 * et + 4 * q));
        {
            f32x4 acc[4];
#pragma unroll
            for (int t4 = 0; t4 < 4; ++t4) acc[t4] = (f32x4){0.f, 0.f, 0.f, 0.f};
#pragma unroll
            for (int kd = 0; kd < 4; ++kd)
#pragma unroll
                for (int t4 = 0; t4 < 4; ++t4) { const bf16x8 pfr = *(const LAS bf16x8*)(PLD + (16 * t4 + r) * P4_PITCH + (32 * kd + 8 * q) * 2); acc[t4] = __builtin_amdgcn_mfma_f32_16x16x32_bf16(wf[kd], pfr, acc[t4], 0, 0, 0); }
            const int n0 = gi * 128 + 16 * wave + 4 * q; const f32x4 psc = *(const f32x4*)(a.pool_scale + n0);
#pragma unroll
            for (int t4 = 0; t4 < 4; ++t4) { u32x2 w; w.x = cvt_pk_bf16(acc[t4][0] * psc[0], acc[t4][1] * psc[1]); w.y = cvt_pk_bf16(acc[t4][2] * psc[2], acc[t4][3] * psc[3]);
                *(u32x2*)(PB + (row0 + 16 * t4 + r) * 1024 + n0) = w; }
        }
        bf16x8 qt[4], qh[4];
#pragma unroll
        for (int kd = 0; kd < 4; ++kd) { qt[kd] = *(const LAS bf16x8*)(QT + (16 * tt + r) * P4_PITCH + (32 * kd + 8 * q) * 2); qh[kd] = *(const LAS bf16x8*)(QH + (16 * tt + r) * P4_PITCH + (32 * kd + 8 * q) * 2); }
        f32x4 sc[4];
#pragma unroll
        for (int st = 0; st < 4; ++st) { f32x4 acc = (f32x4){0.f, 0.f, 0.f, 0.f};
            if (st <= tt) {
#pragma unroll
                for (int kd = 0; kd < 4; ++kd) { const bf16x8 kfr = *(const LAS bf16x8*)(KT + (16 * st + r) * P4_PITCH + (32 * kd + 8 * q) * 2); acc = __builtin_amdgcn_mfma_f32_16x16x32_bf16(kfr, qt[kd], acc, 0, 0, 0); }
                if (st == tt) {
#pragma unroll
                    for (int i = 0; i < 4; ++i) if (4 * q + i > r) acc[i] = 0.f; }
            }
            sc[st] = acc; }
        bf16x8 pf[2];
#pragma unroll
        for (int ks = 0; ks < 2; ++ks) { u32x4 w; w.x = cvt_pk_bf16(sc[2 * ks][0], sc[2 * ks][1]); w.y = cvt_pk_bf16(sc[2 * ks][2], sc[2 * ks][3]); w.z = cvt_pk_bf16(sc[2 * ks + 1][0], sc[2 * ks + 1][1]); w.w = cvt_pk_bf16(sc[2 * ks + 1][2], sc[2 * ks + 1][3]);
            pf[ks] = __builtin_bit_cast(bf16x8, w); }
        f32x4 oa[8]; float ss = 0.f;
#pragma unroll
        for (int et = 0; et < 8; ++et) { f32x4 acc = (f32x4){0.f, 0.f, 0.f, 0.f};
#pragma unroll
            for (int kd = 0; kd < 4; ++kd) acc = __builtin_amdgcn_mfma_f32_16x16x32_bf16(sfr[et][kd], qh[kd], acc, 0, 0, 0);
#pragma unroll
            for (int ks = 0; ks < 2; ++ks) if (2 * ks <= tt) {
                const u32x2 lo = *(const LAS u32x2*)(VT + (16 * et + r) * P4_VPITCH + (32 * ks + 4 * q) * 2), hi = *(const LAS u32x2*)(VT + (16 * et + r) * P4_VPITCH + (32 * ks + 16 + 4 * q) * 2);
                const u32x4 w = (u32x4){lo.x, lo.y, hi.x, hi.y};
                acc = __builtin_amdgcn_mfma_f32_16x16x32_bf16(__builtin_bit_cast(bf16x8, w), pf[ks], acc, 0, 0, 0); }
            oa[et] = acc; ss += (acc[0] * acc[0] + acc[1] * acc[1]) + (acc[2] * acc[2] + acc[3] * acc[3]); }
        ss += __shfl_xor(ss, 16); ss += __shfl_xor(ss, 32);
        const float rstd = rsqrtf(ss * (1.f / 128.f) + EPS);
#pragma unroll
        for (int et = 0; et < 8; ++et) { const int e0 = 16 * et + 4 * q; const f32x4 gn = *(const f32x4*)(a.g_hn + e0); const u32x2 og = ogv[et];
            u32x2 w; w.x = cvt_pk_bf16(oa[et][0] * rstd * gn[0] * bf_lo(og.x), oa[et][1] * rstd * gn[1] * bf_hi(og.x)); w.y = cvt_pk_bf16(oa[et][2] * rstd * gn[2] * bf_lo(og.y), oa[et][3] * rstd * gn[3] * bf_hi(og.y));
            *(LAS u32x2*)(QT + (16 * tt + r) * P4_PITCH + e0 * 2) = w; }
        asm volatile("s_waitcnt lgkmcnt(0)" ::: "memory");
#pragma unroll
        for (int i = 0; i < 4; ++i) { const int rr = 16 * tt + 4 * i + (lane >> 4); const u32x4 v = *(const LAS u32x4*)(QT + rr * P4_PITCH + (lane & 15) * 16);
            *(u32x4*)(Qb + (row0 + rr) * 1024 + (size_t)h * 128 + (lane & 15) * 8) = v; }
    }
    __syncthreads();
}

__device__ __forceinline__ void p9_final(const Args& a, int G) {
    const int tid = threadIdx.x, lane = tid & 63, wave = __builtin_amdgcn_readfirstlane(tid >> 6);
    const float* rsq = (const float*)(a.ws + WS_RSQ);
    const f32x4* gr = (const f32x4*)a.g_fin + lane; f32x4 gv[4];
#pragma unroll
    for (int j = 0; j < 4; ++j) gv[j] = gr[64 * j];
    for (int m = 2 * (blockIdx.x * NWAVES + wave); m < M; m += 2 * G * NWAVES) {
        float p = lane < 32 ? rsq[(size_t)m * 16 + lane] : 0.f;
        f32x4* xr = (f32x4*)(a.out + (size_t)m * DM) + lane; f32x4 v[8];
#pragma unroll
        for (int j = 0; j < 8; ++j) v[j] = xr[64 * j];
        p += __shfl_xor(p, 1); p += __shfl_xor(p, 2); p += __shfl_xor(p, 4); p += __shfl_xor(p, 8);
        const float r0 = rsqrtf(__shfl(p, 0) * (1.f / DM) + EPS), r1 = rsqrtf(__shfl(p, 16) * (1.f / DM) + EPS);
#pragma unroll
        for (int j = 0; j < 8; ++j) { const float rs = j < 4 ? r0 : r1; const f32x4 g4 = gv[j & 3]; xr[64 * j] = (f32x4){v[j].x * rs * g4.x, v[j].y * rs * g4.y, v[j].z * rs * g4.z, v[j].w * rs * g4.w}; }
    }
}

#ifdef PROBE_STOP
__device__ __forceinline__ void p_dump(const Args& a, int G) {
    const u16* Qb = (const u16*)(a.ws + WS_Q); const u16* Gb = (const u16*)(a.ws + WS_G); const u16* Vb = (const u16*)(a.ws + WS_V); const u16* OGb = (const u16*)(a.ws + WS_OG);
    const u16* GAb = (const u16*)(a.ws + WS_GA); const u16* GBb = (const u16*)(a.ws + WS_GB); const u16* PB = (const u16*)(a.ws + WS_PB);
    for (size_t i = (size_t)blockIdx.x * NTHR + threadIdx.x; i < (size_t)M * DM; i += (size_t)G * NTHR) {
        float v = 0.f;
        if (PROBE_STOP == 1) v = bf1(Qb[i]) + h2f(Gb[i]) + bf1(Vb[i]) + bf1(OGb[i]) + bf1(GAb[i]) + bf1(GBb[i]) + bf1(PB[i]);
        else if (PROBE_STOP == 2 || PROBE_STOP == 3) { float t = bf1(((const u16*)a.out)[i]) + bf1(((const u16*)a.out)[i + (size_t)M * DM]); if (!(fabsf(t) < 1e30f)) t = 12345.f; ((float*)(a.ws + WS_GA))[i] = t; continue; }
        else if (PROBE_STOP == 4) v = bf1(Qb[i]) + bf1(PB[i]);
        else if (PROBE_STOP == 5) v = bf1(Gb[i]);
        else continue;
        a.out[i] = v;
    }
}
#endif
__device__ __forceinline__ void flat_barrier(unsigned* cnt) {
    asm volatile("s_waitcnt vmcnt(0)" ::: "memory");
    __syncthreads();
    if (threadIdx.x == 0) {
        const unsigned Gn = gridDim.x;
        __builtin_amdgcn_fence(__ATOMIC_RELEASE, "agent");
        asm volatile("s_waitcnt vmcnt(0)" ::: "memory");
        const unsigned old = __hip_atomic_fetch_add(cnt, 1u, __ATOMIC_RELAXED, __HIP_MEMORY_SCOPE_AGENT);
        const unsigned target = (old / Gn + 1u) * Gn; unsigned sp = 0;
        while (__hip_atomic_load(cnt, __ATOMIC_RELAXED, __HIP_MEMORY_SCOPE_AGENT) < target) { __builtin_amdgcn_s_sleep(1); if (++sp > (1u << 22)) break; }
        __builtin_amdgcn_fence(__ATOMIC_ACQUIRE, "agent");
        asm volatile("s_waitcnt vmcnt(0)" ::: "memory");
    }
    __syncthreads();
}
constexpr int NPH = 10;
__global__ void __launch_bounds__(NTHR, 2) mega(Args a) {
    extern __shared__ __attribute__((aligned(16))) unsigned char lds_raw[];
    LAS unsigned char* lds = (LAS unsigned char*)lds_raw;
    cg::grid_group grid = cg::this_grid();
    const int G = gridDim.x, lo = a.ph_lo, hi = a.ph_hi;
    unsigned char* ws = a.ws;
    volatile LAS unsigned* MISC = (volatile LAS unsigned*)(lds + LDS_BYTES - 64);
    if (threadIdx.x < 16) MISC[threadIdx.x] = 0u;
    __syncthreads();
    XcdBarrier bar; bar.bar = (unsigned*)(ws + WS_BAR); bar.x = 0; bar.st = nullptr;
    if (hi - lo > 1) bar = xcd_barrier_post((unsigned*)(ws + WS_BAR), MISC);
    if (hi < 0) grid.sync();
#ifndef PHMASK
#define PHMASK 0x3ff
#endif
#define IN(k) (((PHMASK >> (k)) & 1) && lo <= (k) && (k) < hi)
#ifndef CG_SEAMS
#define CG_SEAMS 0x0
#endif
#define SEAM(k) do { if (IN(k) && IN((k) + 1)) { if ((CG_SEAMS >> (k)) & 1) grid.sync(); else xcd_barrier(bar); } } while (0)
#ifndef PROBE_DUP
#define PROBE_DUP 0
#endif
#ifndef PROBE_XSYNC
#define PROBE_XSYNC 0
#endif
#define DUP(k) (((PROBE_DUP >> (k)) & 1) ? 2 : 1)
    if (IN(0)) { p0_prologue(a, lds, G); } SEAM(0);
#ifdef PROBE_XBAR
    for (int xs = 0; xs < PROBE_XBAR; ++xs) flat_barrier((unsigned*)(ws + WS_BAR + 14 * KiB));
#endif
    if (IN(1)) { pg8::Gemm g{(const u16*)a.out, (const u16*)(ws + WS_WIN), M, INW, DM, DM, 1 << 30, 0L}; pg8::StaticOrder S; S.init(M, INW, G, (int)blockIdx.x);
        EpiIn E{ws}; pg8::gemm_phase<EpiIn, true>(lds, g, S, E);
        if (G == 256 && blockIdx.x == 255) p2_wave((const u16*)(ws + WS_GM), (const u16*)(ws + WS_VM), NMETA, (int)(threadIdx.x >> 6), (u16*)(ws + WS_UM) + (size_t)(threadIdx.x >> 6) * 16384, nullptr, (int)(threadIdx.x & 63));
        else if (G == 256 && blockIdx.x >= 128) late_weights(a, lds, ((int)blockIdx.x - 128) * NWAVES + (int)(threadIdx.x >> 6), 127 * NWAVES); }
    SEAM(1);
    if (IN(2)) { p2_states(a, G); } SEAM(2);
    if (IN(3)) { p3_scan(a, lds, G); } SEAM(3);
    if (IN(4)) { p4_outputs(a, lds, G); } SEAM(4);
    if (IN(5)) { pg8::Gemm g{(const u16*)(ws + WS_Q), (const u16*)(ws + WS_WAB), M, DM, 1536, DM, 16, (long)(WS_PB - WS_Q) - 16L * 128L}; pg8::StaticOrder S; S.init(M, DM, G, (int)blockIdx.x);
        EpiMerge E{(const u16*)(ws + WS_GA), (const u16*)(ws + WS_GB), (u16*)(ws + WS_MG)}; pg8::gemm_phase<EpiMerge, false>(lds, g, S, E); } SEAM(5);
    if (IN(6)) { pg8::Gemm g{(const u16*)(ws + WS_MG), (const u16*)(ws + WS_WOUT), M, DM, DM, DM, 1 << 30, 0L}; pg8::StaticOrder S; S.init(M, DM, G, (int)blockIdx.x);
        const bool fuse9_ = (G == (M / 256) * (DM / 256)) && (hi - lo > 1);
        EpiRes<true> E{a.x, fuse9_ ? nullptr : a.out, (u16*)(ws + WS_H1B), (float*)(ws + WS_RSQ)}; pg8::gemm_phase<EpiRes<true>, false>(lds, g, S, E); } SEAM(6);
    if (IN(7)) { pg8::Gemm g{(const u16*)(ws + WS_H1B), (const u16*)(ws + WS_WGU), M, NGU, DM, DM, 1 << 30, 0L}; pg8::StaticOrder S; S.init(M, NGU, G, (int)blockIdx.x);
        EpiFfn1 E{(const float*)(ws + WS_RSQ), (u16*)(ws + WS_ACT)}; pg8::gemm_phase<EpiFfn1, true>(lds, g, S, E); } SEAM(7);
    const bool fuse9 = (G == (M / 256) * (DM / 256)) && (hi - lo > 1);
    if (IN(8)) { pg8::Gemm g{(const u16*)(ws + WS_ACT), (const u16*)(ws + WS_WD), M, DM, DFF, DFF, 1 << 30, 0L}; pg8::StaticOrder S; S.init(M, DM, G, (int)blockIdx.x);
        if (fuse9) { EpiResNorm E{(const u16*)(ws + WS_H1B), a.out, a.g_fin, (float*)(ws + WS_RSQ), (unsigned*)(ws + WS_CNT)}; pg8::gemm_phase<EpiResNorm, false>(lds, g, S, E); }
        else { EpiRes<false> E{a.out, a.out, nullptr, (float*)(ws + WS_RSQ)}; pg8::gemm_phase<EpiRes<false>, false>(lds, g, S, E); } }
    if (!fuse9) { SEAM(8);
    if (IN(9)) { p9_final(a, G); } }
#ifdef PROBE_LIST
    if (lo == 20) p0_prologue(a, lds, G, 1);
    if (lo == 30) p0_prologue(a, lds, G, 2);
    if (lo == 40) p0_prologue(a, lds, G, 4);
    if (lo == 14) p4_outputs(a, lds, G, 1);
    if (lo == 24) p4_outputs(a, lds, G, 2);
    if (lo == 34) p4_outputs(a, lds, G, 2 | 4);
    if (lo == 44) p4_outputs(a, lds, G, 2 | 8);
    if (lo == 54) p4_outputs(a, lds, G, 2 | 16);
    if (lo == 64) p4_outputs(a, lds, G, 2 | 32);
    if (lo == 74) p4_outputs(a, lds, G, 2 | 64);
    if (lo == 18) { pg8::Gemm g{(const u16*)(ws + WS_ACT), (const u16*)(ws + WS_WD), M, DM, DFF, DFF, 1 << 30, 0L}; pg8::StaticOrder S; S.init(M, DM, G, (int)blockIdx.x);
        EpiRes<false> E{(const float*)(ws + WS_GA), (float*)(ws + WS_GA), nullptr, (float*)(ws + WS_OG)}; pg8::gemm_phase<EpiRes<false>, false>(lds, g, S, E); }
    if (lo == 19) { Args b = a; b.out = (float*)(ws + WS_GA); p9_final(b, G); }
#endif
#ifdef PROBE_STOP
    if (lo == 10) p_dump(a, G);
    if (lo == 11 && (PROBE_STOP == 2 || PROBE_STOP == 3)) { for (size_t i = (size_t)blockIdx.x * NTHR + threadIdx.x; i < (size_t)M * DM; i += (size_t)G * NTHR) a.out[i] = ((const float*)(a.ws + WS_GA))[i]; }
#endif
#undef IN
#undef SEAM
}

extern "C" void kernel_launch(void* const* d_in, const int* in_sizes, int n_in, void* d_out, int out_size, void* d_ws, size_t ws_size, hipStream_t stream) {
    static int grid = 0;
    if (grid == 0) {
        if (n_in != 16 || in_sizes[0] != M * DM || out_size != M * DM || ws_size < WS_END) { fprintf(stderr, "kernel_launch: unexpected shapes (n_in %d, in0 %d, out %d, ws %zu); nothing launched\n", n_in, n_in > 0 ? in_sizes[0] : -1, out_size, ws_size); grid = -1; return; }
        int dev = 0, cus = 0, per_cu = 0;
        (void)hipGetDevice(&dev); (void)hipDeviceGetAttribute(&cus, hipDeviceAttributeMultiprocessorCount, dev);
        if (hipFuncSetAttribute((const void*)mega, hipFuncAttributeMaxDynamicSharedMemorySize, LDS_BYTES) != hipSuccess) { fprintf(stderr, "kernel_launch: hipFuncSetAttribute failed\n"); }
        if (hipOccupancyMaxActiveBlocksPerMultiprocessor(&per_cu, (const void*)mega, NTHR, LDS_BYTES) != hipSuccess || per_cu < 1) per_cu = 1;
        (void)hipGetLastError();
        if (cus <= 0) cus = 256;
        grid = cus * per_cu;
    }
    if (grid < 0) return;
#if MK_COOP
    if (hipMemsetAsync((char*)d_ws + WS_BAR, 0, CTL_ZERO, stream) != hipSuccess) { fprintf(stderr, "kernel_launch: hipMemsetAsync of the barrier words failed\n"); return; }
#endif
    Args a{};
    a.x = (const float*)d_in[0]; a.meta = (const float*)d_in[1]; a.g_mix = (const float*)d_in[2]; a.w_in = (const float*)d_in[3]; a.lb_raw = (const float*)d_in[4]; a.g_hn = (const float*)d_in[5];
    a.pool_w = (const float*)d_in[6]; a.pool_scale = (const float*)d_in[7]; a.w_a = (const float*)d_in[8]; a.w_b = (const float*)d_in[9]; a.w_out = (const float*)d_in[10]; a.g_ffn = (const float*)d_in[11];
    a.w_gate = (const float*)d_in[12]; a.w_up = (const float*)d_in[13]; a.w_down = (const float*)d_in[14]; a.g_fin = (const float*)d_in[15];
    a.out = (float*)d_out; a.ws = (unsigned char*)d_ws;
#if MK_COOP
    a.ph_lo = 0; a.ph_hi = NPH;
    void* args[] = {&a};
    const hipError_t e = hipLaunchCooperativeKernel((const void*)mega, dim3(grid), dim3(NTHR), args, LDS_BYTES, stream);
    if (e != hipSuccess) fprintf(stderr, "kernel_launch: cooperative launch failed: %s (grid %d)\n", hipGetErrorString(e), grid);
#else
#ifdef PROBE_STOP
    for (int ph = 0; ph <= PROBE_STOP; ++ph) { a.ph_lo = ph; a.ph_hi = ph + 1; hipLaunchKernelGGL(mega, dim3(grid), dim3(NTHR), LDS_BYTES, stream, a); }
    a.ph_lo = 10; a.ph_hi = 11; hipLaunchKernelGGL(mega, dim3(grid), dim3(NTHR), LDS_BYTES, stream, a);
    a.ph_lo = 11; a.ph_hi = 12; hipLaunchKernelGGL(mega, dim3(grid), dim3(NTHR), LDS_BYTES, stream, a);
#else
#ifdef PROBE_LIST
    { const int lst[] = PROBE_LIST; for (int i = 0; i < (int)(sizeof(lst) / sizeof(int)); ++i) { a.ph_lo = lst[i]; a.ph_hi = lst[i] + 1; hipLaunchKernelGGL(mega, dim3(grid), dim3(NTHR), LDS_BYTES, stream, a); } }
#else
    for (int ph = 0; ph < NPH; ++ph) { a.ph_lo = ph; a.ph_hi = ph + 1; hipLaunchKernelGGL(mega, dim3(grid), dim3(NTHR), LDS_BYTES, stream, a); }
#endif
#endif
#endif
}
```

```cpp
#include <hip/hip_runtime.h>
#include <hip/hip_cooperative_groups.h>
#include <cstdio>
#include <cstdint>
namespace cg = cooperative_groups;

#ifndef MK_COOP
#define MK_COOP 1
#endif

#define LAS __attribute__((address_space(3)))
typedef unsigned short u16;
typedef short bf16x8 __attribute__((ext_vector_type(8)));
typedef float f32x4 __attribute__((ext_vector_type(4)));
typedef unsigned u32x4 __attribute__((ext_vector_type(4)));
typedef unsigned u32x2 __attribute__((ext_vector_type(2)));

typedef __bf16 bf16v2_t __attribute__((ext_vector_type(2)));
typedef float f32v2_t __attribute__((ext_vector_type(2)));
__device__ __forceinline__ unsigned cvt_pk_bf16(float lo, float hi) { const f32v2_t f = {lo, hi}; const bf16v2_t v = __builtin_convertvector(f, bf16v2_t); return __builtin_bit_cast(unsigned, v); }
__device__ __forceinline__ float bf_lo(unsigned w) { return __uint_as_float(w << 16); }
__device__ __forceinline__ float bf_hi(unsigned w) { return __uint_as_float(w & 0xffff0000u); }
__device__ __forceinline__ float bf1(u16 w) { return __uint_as_float((unsigned)w << 16); }
__device__ __forceinline__ unsigned pk_h(float a, float b) { const _Float16 x = (_Float16)a, y = (_Float16)b; return (unsigned)__builtin_bit_cast(unsigned short, x) | ((unsigned)__builtin_bit_cast(unsigned short, y) << 16); }
__device__ __forceinline__ float h2f(u16 w) { return (float)__builtin_bit_cast(_Float16, w); }
__device__ __forceinline__ float fexp(float x) { return __builtin_amdgcn_exp2f(x * 1.44269504088896341f); }
__device__ __forceinline__ float flog(float x) { return __builtin_amdgcn_logf(x) * 0.693147180559945309f; }
__device__ __forceinline__ float sigm(float z) { return __builtin_amdgcn_rcpf(1.0f + fexp(-z)); }

namespace pg8 {
constexpr int BM = 256, BK = 64, HALF = 128, HTB = HALF * BK * 2, STAGE_BYTES = 8 * HTB, NXCD = 8, WGM = 8;
__host__ __device__ __forceinline__ int lds_byte(int r, int c) { const int st = (r >> 4) * 2 + (c >> 5), rr = r & 15, cc = c & 31, ob = rr * 64 + cc * 2; return st * 1024 + (ob ^ (((ob >> 9) & 1) << 5)); }
__host__ __device__ __forceinline__ void stage_rc(int b, int& R, int& C) { const int st = b / 1024, sb = b % 1024, swz = sb ^ (((sb >> 9) & 1) << 5); R = (st >> 1) * 16 + swz / 64; C = (st & 1) * 32 + (swz % 64) / 2; }
__host__ __device__ __forceinline__ int perm32(int rho) { const int n = rho >> 4, i = rho & 15; return 8 * (i >> 2) + 4 * n + (i & 3); }
struct Unit { int pm, pn; };
struct Gemm { const u16* A; const u16* Bt; int M, N, K, lda, ksplit; long a2delta; };
struct StaticOrder {
    int nM, nN, nwg, G, c;
    __host__ __device__ void init(int M, int N, int G_, int c_) { nM = M / BM; nN = N / BM; nwg = nM * nN; G = G_; c = c_; }
    __host__ __device__ bool next(int i, Unit& u) const {
        const long L = (long)i * G + c; if (L >= nwg) return false;
        int wgid = (int)L; { const int q = nwg / NXCD, r = nwg % NXCD, xcd = wgid % NXCD, off = wgid / NXCD; wgid = (xcd < r ? xcd * (q + 1) : r * (q + 1) + (xcd - r) * q) + off; }
        const int nig = WGM * nN, gid = wgid / nig, fm = gid * WGM, gsz = (nM - fm) < WGM ? (nM - fm) : WGM;
        u.pm = fm + ((wgid % nig) % gsz); u.pn = (wgid % nig) / gsz; return true;
    }
};
template <class Epi, bool ALIGN_EPI>
__device__ __forceinline__ void gemm_phase(LAS unsigned char* lds, const Gemm g, const StaticOrder& S, const Epi& E) {
    const int tid = threadIdx.x, wid = __builtin_amdgcn_readfirstlane(tid >> 6), lane = tid & 63, wr = wid >> 2, wc = wid & 3, fr = lane & 15, fq = lane >> 4;
    const int K = g.K, nt = K / BK, lda = g.lda;
    unsigned voffA[2], voffB[2];
#pragma unroll
    for (int i = 0; i < 2; ++i) { int R, C; stage_rc(tid * 16 + i * 8192, R, C); const int Rb = Epi::PERM ? ((R & ~31) + perm32(R & 31)) : R;
        voffA[i] = (unsigned)(R * lda + C) * 2u; voffB[i] = (unsigned)(Rb * K + C) * 2u; }
    const size_t kstep = (size_t)(BK * 2);
    const size_t hstepA = (size_t)HALF * lda * 2, tstepA = 2 * hstepA;
    const size_t hstepB = (size_t)HALF * K * 2, tstepB = 2 * hstepB;
    const unsigned ldsw = (unsigned)wid * 1024u;
    const int aoff = lds_byte(wr * 64 + fr, fq * 8), boff = lds_byte(wc * 32 + fr, fq * 8);
#define PG8_SA(b, h) (((b) * 2 + (h)) * HTB)
#define PG8_SB(b, h) ((4 + (b) * 2 + (h)) * HTB)
#define PG8_STAGE(bufoff, gbase, voff) do { _Pragma("unroll") for (int _i = 0; _i < 2; ++_i) \
        __builtin_amdgcn_global_load_lds((const unsigned*)((const char*)(gbase) + (voff)[_i]), (LAS unsigned*)(lds + (bufoff) + ldsw + _i * 8192), 16, 0, 0); } while (0)
#define PG8_STAGEA(bufoff, gbase, voff) do { _Pragma("unroll") for (int _i = 0; _i < 2; ++_i) \
        __builtin_amdgcn_global_load_lds((const unsigned*)((const char*)(gbase) + (voff)[_i]), (LAS unsigned*)(lds + (bufoff) + ldsw + _i * 8192), 16, 0, Epi::A_AUX); } while (0)
#define PG8_LDA(dst, b, h) do { _Pragma("unroll") for (int m = 0; m < 4; ++m) _Pragma("unroll") for (int k = 0; k < 2; ++k) dst[m][k] = *(const LAS bf16x8*)(lds + PG8_SA(b, h) + aoff + m * 2048 + k * 1024); } while (0)
#define PG8_LDB(dst, b, h) do { _Pragma("unroll") for (int n = 0; n < 2; ++n) _Pragma("unroll") for (int k = 0; k < 2; ++k) dst[n][k] = *(const LAS bf16x8*)(lds + PG8_SB(b, h) + boff + n * 2048 + k * 1024); } while (0)
#define PG8_MMA(ai, bj, At, Bt) do { __builtin_amdgcn_s_setprio(1); _Pragma("unroll") for (int m = 0; m < 4; ++m) _Pragma("unroll") for (int n = 0; n < 2; ++n) _Pragma("unroll") for (int k = 0; k < 2; ++k) \
        acc[ai][bj][m][n] = __builtin_amdgcn_mfma_f32_16x16x32_bf16(Bt[n][k], At[m][k], acc[ai][bj][m][n], 0, 0, 0); __builtin_amdgcn_s_setprio(0); } while (0)
#define PG8_WAIT_V(n) asm volatile("s_waitcnt vmcnt(" #n ")" ::: "memory")
#define PG8_WAIT_L(n) asm volatile("s_waitcnt lgkmcnt(" #n ")" ::: "memory")
#define PG8_BAR __builtin_amdgcn_s_barrier()
#define PG8_SCHED __builtin_amdgcn_sched_barrier(0)
    Unit cur, nxt; int ui = 0;
    if (!S.next(0, cur)) return;
    f32x4 acc[2][2][4][2];
#pragma unroll
    for (int a = 0; a < 2; ++a)
#pragma unroll
        for (int b = 0; b < 2; ++b)
#pragma unroll
            for (int m = 0; m < 4; ++m)
#pragma unroll
                for (int n = 0; n < 2; ++n) acc[a][b][m][n] = (f32x4){0.f, 0.f, 0.f, 0.f};
    bf16x8 At[4][2], B0[2][2], B1[2][2];
    const char* cA = (const char*)g.A + (size_t)cur.pm * tstepA; const char* cB = (const char*)g.Bt + (size_t)cur.pn * tstepB;
    PG8_STAGE(PG8_SB(0, 0), cB, voffB); PG8_STAGE(PG8_SB(0, 1), cB + hstepB, voffB); PG8_STAGEA(PG8_SA(0, 0), cA, voffA); PG8_STAGEA(PG8_SA(0, 1), cA + hstepA, voffA);
    if (wr == 1) PG8_BAR;
    PG8_WAIT_V(2); PG8_BAR;
    PG8_STAGE(PG8_SB(1, 0), cB + kstep, voffB); PG8_STAGEA(PG8_SA(1, 0), cA + kstep, voffA); PG8_STAGE(PG8_SB(1, 1), cB + hstepB + kstep, voffB);
    PG8_WAIT_V(6); PG8_BAR;
    for (;;) {
        const bool has_next = S.next(ui + 1, nxt);
        const char* nA = has_next ? (const char*)g.A + (size_t)nxt.pm * tstepA : cA; const char* nB = has_next ? (const char*)g.Bt + (size_t)nxt.pn * tstepB : cB;
        for (int t = 0; t < nt; t += 2) {
            const bool last = (t == nt - 2);
            if constexpr (Epi::MID) { if (t == g.ksplit) E.mid(acc, cur, wr, wc, fr, fq); }
            const char* a1 = cA + (size_t)(t + 1) * kstep + (t >= g.ksplit ? g.a2delta : 0L);
            const char* a2 = last ? nA : cA + (size_t)(t + 2) * kstep + (t + 2 >= g.ksplit ? g.a2delta : 0L);
            const char* b2 = last ? nB : cB + (size_t)(t + 2) * kstep;
            const char* a3 = a2 + kstep; const char* b3 = b2 + kstep;
            PG8_LDB(B0, 0, 0); PG8_LDB(B1, 0, 1); PG8_SCHED; PG8_LDA(At, 0, 0); PG8_STAGEA(PG8_SA(1, 1), a1 + hstepA, voffA);
            PG8_WAIT_V(8); PG8_WAIT_L(0); PG8_BAR; PG8_MMA(0, 0, At, B0); PG8_MMA(0, 1, At, B1); PG8_BAR; PG8_SCHED;
            PG8_LDA(At, 0, 1); PG8_STAGE(PG8_SB(0, 0), b2, voffB); PG8_STAGE(PG8_SB(0, 1), b2 + hstepB, voffB); PG8_STAGEA(PG8_SA(0, 0), a2, voffA);
            PG8_WAIT_V(8); PG8_WAIT_L(0); PG8_BAR; PG8_MMA(1, 0, At, B0); PG8_MMA(1, 1, At, B1); PG8_BAR; PG8_SCHED;
            PG8_LDB(B0, 1, 0); PG8_LDB(B1, 1, 1); PG8_SCHED; PG8_LDA(At, 1, 0); PG8_STAGEA(PG8_SA(0, 1), a2 + hstepA, voffA);
            PG8_WAIT_V(8); PG8_WAIT_L(0); PG8_BAR; PG8_MMA(0, 0, At, B0); PG8_MMA(0, 1, At, B1); PG8_BAR; PG8_SCHED;
            PG8_LDA(At, 1, 1); PG8_STAGE(PG8_SB(1, 0), b3, voffB); PG8_STAGE(PG8_SB(1, 1), b3 + hstepB, voffB); PG8_STAGEA(PG8_SA(1, 0), a3, voffA);
            PG8_WAIT_V(8); PG8_WAIT_L(0); PG8_BAR; PG8_MMA(1, 0, At, B0); PG8_MMA(1, 1, At, B1); PG8_BAR; PG8_SCHED;
        }
        if constexpr (ALIGN_EPI) { if (wr == 0) PG8_BAR; }
        if constexpr (!Epi::AFTER) E(acc, cur, wr, wc, fr, fq);
        if (!has_next) break;
#pragma unroll
        for (int a = 0; a < 2; ++a)
#pragma unroll
            for (int b = 0; b < 2; ++b)
#pragma unroll
                for (int m = 0; m < 4; ++m)
#pragma unroll
                    for (int n = 0; n < 2; ++n) acc[a][b][m][n] = (f32x4){0.f, 0.f, 0.f, 0.f};
        cur = nxt; cA = nA; cB = nB; ++ui;
        if constexpr (ALIGN_EPI) { if (wr == 1) PG8_BAR; }
    }
    PG8_WAIT_V(0);
    if constexpr (!ALIGN_EPI) { if (wr == 0) PG8_BAR; }
    PG8_BAR;
    if constexpr (Epi::AFTER) E.after(acc, cur, wr, wc, fr, fq, lds, wid, lane);
#undef PG8_SA
#undef PG8_SB
#undef PG8_STAGE
#undef PG8_STAGEA
#undef PG8_LDA
#undef PG8_LDB
#undef PG8_MMA
#undef PG8_WAIT_V
#undef PG8_WAIT_L
#undef PG8_BAR
#undef PG8_SCHED
}
}

constexpr int NWAVES = 8, NTHR = 512;
constexpr int SEQ = 8192, BATCH = 2, DM = 1024, M = BATCH * SEQ, NMETA = 16, INW = 6656, DFF = 2816, NGU = 2 * DFF, CHK = 64, NCH = SEQ / CHK;
constexpr float EPS = 1e-6f;
constexpr size_t KiB = 1024, MiB = 1u << 20;
constexpr size_t WS_LB = 0, WS_GM = 64 * KiB, WS_VM = 128 * KiB, WS_PLM = 192 * KiB, WS_PWT = 256 * KiB, WS_UM = 512 * KiB, WS_DK = 1 * MiB, WS_RSQ = 2 * MiB;
constexpr size_t WS_WAB = 3 * MiB, WS_WOUT = 6 * MiB, WS_WD = 8 * MiB, WS_WIN = 14 * MiB, WS_WGU = 14 * MiB;
constexpr size_t WS_Q = 28 * MiB, WS_G = 60 * MiB, WS_V = 92 * MiB, WS_OG = 124 * MiB, WS_GA = 156 * MiB, WS_GB = 188 * MiB, WS_PB = 220 * MiB, WS_END = 252 * MiB;
constexpr size_t WS_MG = WS_G, WS_H1B = WS_GB, WS_ACT = WS_Q;
static_assert(WS_WD + (size_t)DM * DFF * 2 <= WS_WIN && WS_WIN + (size_t)INW * DM * 2 <= WS_Q && WS_WGU + (size_t)NGU * DM * 2 <= WS_Q && WS_ACT + (size_t)M * DFF * 2 <= WS_H1B, "ws map");
#ifndef AUX_STREAM
#define AUX_STREAM 0
#endif
constexpr int LDS_BYTES = 163840;
constexpr size_t WS_BAR = 16 * KiB, WS_CNT = 32 * KiB, CTL_ZERO = 32 * KiB;

struct Args {
    const float *x, *meta, *g_mix, *w_in, *lb_raw, *g_hn, *pool_w, *pool_scale, *w_a, *w_b, *w_out, *g_ffn, *w_gate, *w_up, *w_down, *g_fin;
    float* out; unsigned char* ws; int ph_lo, ph_hi;
};

#define LDS_WAIT() asm volatile("s_waitcnt lgkmcnt(0)" ::: "memory")
__device__ __forceinline__ float wave_sum(float v) {
#pragma unroll
    for (int o = 1; o < 64; o <<= 1) v += __shfl_xor(v, o);
    return v;
}

__device__ __forceinline__ void tr_item(const float* W, int N, int k0, int n0, u16* WT, int drow0, int dpitch, int dk0, const float* ks, LAS float* scr, int lane) {
    f32x4 wv[8];
#pragma unroll
    for (int i = 0; i < 8; ++i) wv[i] = __builtin_nontemporal_load((const f32x4*)(W + (size_t)(k0 + 8 * i + (lane >> 3)) * N + n0 + 4 * (lane & 7)));
#pragma unroll
    for (int i = 0; i < 8; ++i) { const int kk = 8 * i + (lane >> 3); f32x4 w = wv[i]; if (ks) w *= ks[k0 + kk];
        LAS float* d = scr + kk * 33 + 4 * (lane & 7); d[0] = w.x; d[1] = w.y; d[2] = w.z; d[3] = w.w; }
    LDS_WAIT(); asm volatile("" ::: "memory");
    const int c = lane & 7;
#pragma unroll
    for (int j = 0; j < 4; ++j) { const int n = (lane >> 3) + 8 * j; const LAS float* s = scr + (8 * c) * 33 + n;
        u32x4 o; o.x = cvt_pk_bf16(s[0 * 33], s[1 * 33]); o.y = cvt_pk_bf16(s[2 * 33], s[3 * 33]); o.z = cvt_pk_bf16(s[4 * 33], s[5 * 33]); o.w = cvt_pk_bf16(s[6 * 33], s[7 * 33]);
        *(u32x4*)(WT + (size_t)(drow0 + n) * dpitch + dk0 + k0 + 8 * c) = o; }
    LDS_WAIT(); asm volatile("" ::: "memory");
}
__device__ __forceinline__ void rms_row_bf16(const float* xrow, const float* g, u16* orow, int lane) {
    const f32x4* xr = (const f32x4*)xrow + lane; const f32x4* gr = (const f32x4*)g + lane;
    f32x4 v[4]; float s = 0.f;
#pragma unroll
    for (int j = 0; j < 4; ++j) { v[j] = xr[64 * j]; s += (v[j].x * v[j].x + v[j].y * v[j].y) + (v[j].z * v[j].z + v[j].w * v[j].w); }
    const float rstd = rsqrtf(wave_sum(s) * (1.f / DM) + EPS);
    u32x2* o8 = (u32x2*)orow + lane;
#pragma unroll
    for (int j = 0; j < 4; ++j) { const f32x4 gv = gr[64 * j]; u32x2 o; o.x = cvt_pk_bf16(v[j].x * rstd * gv.x, v[j].y * rstd * gv.y); o.y = cvt_pk_bf16(v[j].z * rstd * gv.z, v[j].w * rstd * gv.w); o8[64 * j] = o; }
}

__device__ __forceinline__ void p0_meta(const Args& a, LAS unsigned char* lds, int j, int tid, int wave, int lane) {
    LAS float* nm = (LAS float*)lds;
    LAS float* part = (LAS float*)(lds + 65536);
#pragma unroll
    for (int rr = 0; rr < 2; ++rr) { const int r = 2 * wave + rr; const f32x4* xr = (const f32x4*)(a.meta + (size_t)r * DM) + lane; const f32x4* gr = (const f32x4*)a.g_mix + lane;
        f32x4 v[4]; float s = 0.f;
#pragma unroll
        for (int q = 0; q < 4; ++q) { v[q] = xr[64 * q]; s += (v[q].x * v[q].x + v[q].y * v[q].y) + (v[q].z * v[q].z + v[q].w * v[q].w); }
        const float rstd = rsqrtf(wave_sum(s) * (1.f / DM) + EPS);
#pragma unroll
        for (int q = 0; q < 4; ++q) { const f32x4 gv = gr[64 * q]; *(LAS f32x4*)(nm + r * 1024 + 4 * (lane + 64 * q)) = (f32x4){v[q].x * rstd * gv.x, v[q].y * rstd * gv.y, v[q].z * rstd * gv.z, v[q].w * rstd * gv.w}; }
    }
    __syncthreads();
    const int colbase = j < 32 ? 1024 + 32 * j : (j < 64 ? 2048 + 32 * (j - 32) : 4096 + 32 * (j - 64));
    {
        const int col = colbase + (lane & 31), kh = lane >> 5; float acc[16];
#pragma unroll
        for (int r = 0; r < 16; ++r) acc[r] = 0.f;
#pragma unroll 4
        for (int k = 128 * wave + 64 * kh; k < 128 * wave + 64 * kh + 64; k += 4) {
            const float w0 = a.w_in[(size_t)(k + 0) * INW + col], w1 = a.w_in[(size_t)(k + 1) * INW + col], w2 = a.w_in[(size_t)(k + 2) * INW + col], w3 = a.w_in[(size_t)(k + 3) * INW + col];
#pragma unroll
            for (int r = 0; r < 16; ++r) { const f32x4 n4 = *(const LAS f32x4*)(nm + r * 1024 + k); acc[r] += (n4.x * w0 + n4.y * w1) + (n4.z * w2 + n4.w * w3); }
        }
#pragma unroll
        for (int r = 0; r < 16; ++r) part[(wave * 16 + r) * 64 + lane] = acc[r];
    }
    __syncthreads();
    {
        const int r = tid >> 5, cl = tid & 31; float z = 0.f;
#pragma unroll
        for (int w = 0; w < 8; ++w) z += part[(w * 16 + r) * 64 + cl] + part[(w * 16 + r) * 64 + 32 + cl];
        const int col = colbase + cl;
        if (col < 2048) { const int c = col - 1024; const float lb = 1.0f / (1.0f + fexp(a.lb_raw[1024 + c] - a.lb_raw[c])); const float f = lb + (1.0f - lb) * sigm(z);
            const _Float16 hv = (_Float16)flog(f); ((u16*)(a.ws + WS_GM))[r * 1024 + c] = __builtin_bit_cast(unsigned short, hv); }
        else if (col < 3072) { ((u16*)(a.ws + WS_VM))[r * 1024 + (col - 2048)] = (u16)(cvt_pk_bf16(z, 0.f) & 0xffffu); }
        else { ((u16*)(a.ws + WS_PLM))[r * 512 + (col - 4096)] = (u16)(cvt_pk_bf16(z, 0.f) & 0xffffu); }
    }
    __syncthreads();
}

__device__ __forceinline__ void late_weights(const Args& a, LAS unsigned char* lds, int gw, int NGW) {
    const int lane = threadIdx.x & 63, wave = __builtin_amdgcn_readfirstlane(threadIdx.x >> 6);
    LAS float* scr = (LAS float*)(lds + wave * 16384);
    constexpr int I_A = 16 * 32, I_B = 8 * 32, I_O = 16 * 32, I_D = 44 * 32, I_P = 32;
    constexpr int NIT = I_A + I_B + I_O + I_D + I_P;
    for (int it = gw; it < NIT; it += NGW) {
        int r = it;
        if (r < I_A) { tr_item(a.w_a, 1024, 64 * (r / 32), 32 * (r % 32), (u16*)(a.ws + WS_WAB), 32 * (r % 32), 1536, 0, nullptr, scr, lane); continue; } r -= I_A;
        if (r < I_B) { tr_item(a.w_b, 1024, 64 * (r / 32), 32 * (r % 32), (u16*)(a.ws + WS_WAB), 32 * (r % 32), 1536, 1024, nullptr, scr, lane); continue; } r -= I_B;
        if (r < I_O) { tr_item(a.w_out, 1024, 64 * (r / 32), 32 * (r % 32), (u16*)(a.ws + WS_WOUT), 32 * (r % 32), 1024, 0, nullptr, scr, lane); continue; } r -= I_O;
        if (r < I_D) { tr_item(a.w_down, 1024, 64 * (r / 32), 32 * (r % 32), (u16*)(a.ws + WS_WD), 32 * (r % 32), DFF, 0, nullptr, scr, lane); continue; } r -= I_D;
        { const int gi = r >> 3, q = r & 7; tr_item(a.pool_w + (size_t)gi * 16384, 128, 64 * (q >> 2), 32 * (q & 3), (u16*)(a.ws + WS_PWT) + (size_t)gi * 16384, 32 * (q & 3), 128, 0, nullptr, scr, lane); }
    }
}

__device__ __forceinline__ void p0_prologue(const Args& a, LAS unsigned char* lds, int G, int skip = 0) {
    const int tid = threadIdx.x, lane = tid & 63, wave = __builtin_amdgcn_readfirstlane(tid >> 6);
    const bool split = G > 160;
    if (!(skip & 4)) for (int j = (int)blockIdx.x; j < 80; j += G) p0_meta(a, lds, j, tid, wave, lane);
    if (split && (int)blockIdx.x < 80) return;
    if (blockIdx.x == 80 || (G <= 80 && blockIdx.x == 0)) { for (int c = tid; c < 1024; c += NTHR) ((float*)(a.ws + WS_LB))[c] = 1.0f / (1.0f + fexp(a.lb_raw[1024 + c] - a.lb_raw[c])); }
    LAS float* scr = (LAS float*)(lds + wave * 16384);
    const int gw = ((int)blockIdx.x - (split ? 80 : 0)) * NWAVES + wave, NGW = (G - (split ? 80 : 0)) * NWAVES;
    constexpr int I_IN = 16 * 208;
    for (int it = gw; it < I_IN && !(skip & 1); it += NGW) tr_item(a.w_in, INW, 64 * (it / 208), 32 * (it % 208), (u16*)(a.ws + WS_WIN), 32 * (it % 208), 1024, 0, nullptr, scr, lane);
    if (G != 256) late_weights(a, lds, gw, NGW);
    u16* XN = (u16*)a.out;
    {
        const f32x4* gr = (const f32x4*)a.g_mix + lane; f32x4 gv[4];
#pragma unroll
        for (int j = 0; j < 4; ++j) gv[j] = gr[64 * j];
        for (int m = 4 * gw; m < M && !(skip & 2); m += 4 * NGW) {
            const f32x4* xr = (const f32x4*)(a.x + (size_t)m * DM) + lane; f32x4 v[16]; float ss[4];
#pragma unroll
            for (int j = 0; j < 16; ++j) v[j] = __builtin_nontemporal_load(&xr[64 * j]);
#pragma unroll
            for (int rr = 0; rr < 4; ++rr) { float t = 0.f;
#pragma unroll
                for (int j = 0; j < 4; ++j) { const f32x4 w = v[4 * rr + j]; t += (w.x * w.x + w.y * w.y) + (w.z * w.z + w.w * w.w); }
                ss[rr] = t; }
#pragma unroll
            for (int o = 1; o < 64; o <<= 1) {
#pragma unroll
                for (int rr = 0; rr < 4; ++rr) ss[rr] += __shfl_xor(ss[rr], o); }
            u32x2* o8 = (u32x2*)(XN + (size_t)m * DM) + lane;
#pragma unroll
            for (int j = 0; j < 16; ++j) { const float rs = rsqrtf(ss[j >> 2] * (1.f / DM) + EPS); const f32x4 g4 = gv[j & 3]; u32x2 o; o.x = cvt_pk_bf16(v[j].x * rs * g4.x, v[j].y * rs * g4.y); o.y = cvt_pk_bf16(v[j].z * rs * g4.z, v[j].w * rs * g4.w); o8[64 * j] = o; }
        }
    }
}

struct EpiIn {
    static constexpr bool PERM = true, MID = false, AFTER = false; static constexpr int A_AUX = 0;
    unsigned char* ws;
    __device__ __forceinline__ void mid(f32x4 (&)[2][2][4][2], const pg8::Unit&, int, int, int, int) const {}
    __device__ __forceinline__ void operator()(f32x4 (&acc)[2][2][4][2], const pg8::Unit& u, int wr, int wc, int fr, int fq) const {
        const int colt = u.pn * 256; int type, c0; size_t boff;
        if (colt < 1024) { type = 1; boff = WS_Q; c0 = colt; }
        else if (colt < 2048) { type = 3; boff = WS_G; c0 = colt - 1024; }
        else if (colt < 3072) { type = 0; boff = WS_V; c0 = colt - 2048; }
        else if (colt < 4096) { type = 1; boff = WS_OG; c0 = colt - 3072; }
        else if (colt < 4608) { type = 0; boff = WS_PB; c0 = colt - 4096 + 512; }
        else if (colt < 5632) { type = 2; boff = WS_GA; c0 = colt - 4608; }
        else { type = 2; boff = WS_GB; c0 = colt - 5632; }
        u16* base = (u16*)(ws + boff);
        const int col0 = c0 + wc * 32 + 8 * fq, row0 = u.pm * 256 + wr * 64 + fr;
        const float* LB = (const float*)(ws + WS_LB);
        f32x4 lbv[2][2];
        if (type == 3) {
#pragma unroll
            for (int bj = 0; bj < 2; ++bj) { lbv[bj][0] = *(const f32x4*)(LB + col0 + bj * 128); lbv[bj][1] = *(const f32x4*)(LB + col0 + bj * 128 + 4); }
        } else {
#pragma unroll
            for (int bj = 0; bj < 2; ++bj) { lbv[bj][0] = (f32x4){0.f, 0.f, 0.f, 0.f}; lbv[bj][1] = (f32x4){0.f, 0.f, 0.f, 0.f}; }
        }
#pragma unroll
        for (int ai = 0; ai < 2; ++ai)
#pragma unroll
            for (int m = 0; m < 4; ++m) { u16* rowp = base + (size_t)(row0 + ai * 128 + m * 16) * 1024 + col0;
#pragma unroll
                for (int bj = 0; bj < 2; ++bj) { f32x4 v0 = acc[ai][bj][m][0], v1 = acc[ai][bj][m][1]; u32x4 w;
                    if (type == 3) {
                        const f32x4 l0 = lbv[bj][0], l1 = lbv[bj][1];
#pragma unroll
                        for (int e = 0; e < 4; ++e) { v0[e] = flog(l0[e] + (1.0f - l0[e]) * sigm(v0[e])); v1[e] = flog(l1[e] + (1.0f - l1[e]) * sigm(v1[e])); }
                        w.x = pk_h(v0[0], v0[1]); w.y = pk_h(v0[2], v0[3]); w.z = pk_h(v1[0], v1[1]); w.w = pk_h(v1[2], v1[3]);
                    } else {
                        if (type == 1) {
#pragma unroll
                            for (int e = 0; e < 4; ++e) { v0[e] = v0[e] * sigm(v0[e]); v1[e] = v1[e] * sigm(v1[e]); }
                        } else if (type == 2) {
#pragma unroll
                            for (int e = 0; e < 4; ++e) { v0[e] = sigm(v0[e]); v1[e] = sigm(v1[e]); }
                        }
                        w.x = cvt_pk_bf16(v0[0], v0[1]); w.y = cvt_pk_bf16(v0[2], v0[3]); w.z = cvt_pk_bf16(v1[0], v1[1]); w.w = cvt_pk_bf16(v1[2], v1[3]);
                    }
                    __builtin_nontemporal_store(w, (u32x4*)(rowp + bj * 128)); } }
    }
};
struct EpiMerge {
    static constexpr bool PERM = true, MID = true, AFTER = false; static constexpr int A_AUX = AUX_STREAM;
    const u16 *GA, *GB; u16* MG;
    __device__ __forceinline__ void mid(f32x4 (&acc)[2][2][4][2], const pg8::Unit& u, int wr, int wc, int fr, int fq) const {
        int zz = 0; asm volatile("" : "+v"(zz));
        const int col0 = u.pn * 256 + wc * 32 + 8 * fq, row0 = u.pm * 256 + wr * 64 + fr + zz;
#pragma unroll
        for (int ai = 0; ai < 2; ++ai)
#pragma unroll
            for (int m = 0; m < 4; ++m) { const size_t off = (size_t)(row0 + ai * 128 + m * 16) * 1024 + col0;
#pragma unroll
                for (int bj = 0; bj < 2; ++bj) { const u32x4 ga = __builtin_nontemporal_load((const u32x4*)(GA + off + bj * 128)), gb = *(const u32x4*)(GB + off + bj * 128);
#pragma unroll
                    for (int e = 0; e < 2; ++e) { acc[ai][bj][m][0][2 * e] *= bf_lo(ga[e]) * __builtin_amdgcn_rcpf(bf_lo(gb[e])); acc[ai][bj][m][0][2 * e + 1] *= bf_hi(ga[e]) * __builtin_amdgcn_rcpf(bf_hi(gb[e]));
                        acc[ai][bj][m][1][2 * e] *= bf_lo(ga[2 + e]) * __builtin_amdgcn_rcpf(bf_lo(gb[2 + e])); acc[ai][bj][m][1][2 * e + 1] *= bf_hi(ga[2 + e]) * __builtin_amdgcn_rcpf(bf_hi(gb[2 + e])); } }
                asm volatile("" ::: "memory"); }
    }
    __device__ __forceinline__ void operator()(f32x4 (&acc)[2][2][4][2], const pg8::Unit& u, int wr, int wc, int fr, int fq) const {
        const int col0 = u.pn * 256 + wc * 32 + 8 * fq, row0 = u.pm * 256 + wr * 64 + fr;
#pragma unroll
        for (int ai = 0; ai < 2; ++ai)
#pragma unroll
            for (int m = 0; m < 4; ++m) { const size_t off = (size_t)(row0 + ai * 128 + m * 16) * 1024 + col0;
#pragma unroll
                for (int bj = 0; bj < 2; ++bj) { const u32x4 gb = *(const u32x4*)(GB + off + bj * 128);
                    acc[ai][bj][m][0] *= (f32x4){bf_lo(gb[0]), bf_hi(gb[0]), bf_lo(gb[1]), bf_hi(gb[1])}; acc[ai][bj][m][1] *= (f32x4){bf_lo(gb[2]), bf_hi(gb[2]), bf_lo(gb[3]), bf_hi(gb[3])}; } }
#pragma unroll
        for (int ai = 0; ai < 2; ++ai)
#pragma unroll
            for (int m = 0; m < 4; ++m) { const size_t off = (size_t)(row0 + ai * 128 + m * 16) * 1024 + col0;
#pragma unroll
                for (int bj = 0; bj < 2; ++bj) { const f32x4 v0 = acc[ai][bj][m][0], v1 = acc[ai][bj][m][1]; u32x4 w;
                    w.x = cvt_pk_bf16(v0[0], v0[1]); w.y = cvt_pk_bf16(v0[2], v0[3]); w.z = cvt_pk_bf16(v1[0], v1[1]); w.w = cvt_pk_bf16(v1[2], v1[3]);
                    *(u32x4*)(MG + off + bj * 128) = w; } }
    }
};
template <bool WITH_BF16>
struct EpiRes {
    static constexpr bool PERM = true, MID = false, AFTER = false; static constexpr int A_AUX = AUX_STREAM;
    const float* base; float* H; u16* Hb; float* rsq;
    __device__ __forceinline__ void mid(f32x4 (&)[2][2][4][2], const pg8::Unit&, int, int, int, int) const {}
    __device__ __forceinline__ void operator()(f32x4 (&acc)[2][2][4][2], const pg8::Unit& u, int wr, int wc, int fr, int fq) const {
        const int col0 = u.pn * 256 + wc * 32 + 8 * fq, row0 = u.pm * 256 + wr * 64 + fr;
#pragma unroll
        for (int ai = 0; ai < 2; ++ai) {
            f32x4 pre[4][2][2];
#pragma unroll
            for (int m = 0; m < 4; ++m) { const size_t off = (size_t)(row0 + ai * 128 + m * 16) * 1024 + col0;
#pragma unroll
                for (int bj = 0; bj < 2; ++bj)
#pragma unroll
                    for (int n = 0; n < 2; ++n) pre[m][bj][n] = __builtin_nontemporal_load((const f32x4*)(base + off + bj * 128 + n * 4)); }
            asm volatile("" ::: "memory");
#pragma unroll
            for (int m = 0; m < 4; ++m) { const int row = row0 + ai * 128 + m * 16; const size_t off = (size_t)row * 1024 + col0; float s = 0.f;
#pragma unroll
                for (int bj = 0; bj < 2; ++bj) { const f32x4 h0 = pre[m][bj][0] + acc[ai][bj][m][0], h1 = pre[m][bj][1] + acc[ai][bj][m][1];
                    if (H) { *(f32x4*)(H + off + bj * 128) = h0; *(f32x4*)(H + off + bj * 128 + 4) = h1; }
                    s += ((h0[0] * h0[0] + h0[1] * h0[1]) + (h0[2] * h0[2] + h0[3] * h0[3])) + ((h1[0] * h1[0] + h1[1] * h1[1]) + (h1[2] * h1[2] + h1[3] * h1[3]));
                    if (WITH_BF16) { u32x4 w; w.x = cvt_pk_bf16(h0[0], h0[1]); w.y = cvt_pk_bf16(h0[2], h0[3]); w.z = cvt_pk_bf16(h1[0], h1[1]); w.w = cvt_pk_bf16(h1[2], h1[3]); *(u32x4*)(Hb + off + bj * 128) = w; } }
                s += __shfl_xor(s, 16); s += __shfl_xor(s, 32);
                if (fq == 0) rsq[(size_t)row * 16 + u.pn * 4 + wc] = s; }
            asm volatile("" ::: "memory");
        }
    }
};
struct EpiFfn1 {
    static constexpr bool PERM = true, MID = false, AFTER = false; static constexpr int A_AUX = 0;
    const float* rsq; u16* ACT;
    __device__ __forceinline__ void mid(f32x4 (&)[2][2][4][2], const pg8::Unit&, int, int, int, int) const {}
    __device__ __forceinline__ void operator()(const f32x4 (&acc)[2][2][4][2], const pg8::Unit& u, int wr, int wc, int fr, int fq) const {
        const int col0 = u.pn * 128 + wc * 32 + 8 * fq, row0 = u.pm * 256 + wr * 64 + fr;
        float rstdv[2][4];
#pragma unroll
        for (int ai = 0; ai < 2; ++ai)
#pragma unroll
            for (int m = 0; m < 4; ++m) { const int row = row0 + ai * 128 + m * 16; const f32x4* rp = (const f32x4*)(rsq + (size_t)row * 16);
                const f32x4 r0 = rp[fq];
                float ss = (r0[0] + r0[1]) + (r0[2] + r0[3]); ss += __shfl_xor(ss, 16); ss += __shfl_xor(ss, 32);
                rstdv[ai][m] = rsqrtf(ss * (1.f / DM) + EPS); }
#pragma unroll
        for (int ai = 0; ai < 2; ++ai)
#pragma unroll
            for (int m = 0; m < 4; ++m) { const int row = row0 + ai * 128 + m * 16;
                const float rstd = rstdv[ai][m];
                float o[8];
#pragma unroll
                for (int n = 0; n < 2; ++n)
#pragma unroll
                    for (int e = 0; e < 4; ++e) { const float gt = acc[ai][0][m][n][e] * rstd, up = acc[ai][1][m][n][e] * rstd; o[4 * n + e] = gt * sigm(gt) * up; }
                u32x4 w; w.x = cvt_pk_bf16(o[0], o[1]); w.y = cvt_pk_bf16(o[2], o[3]); w.z = cvt_pk_bf16(o[4], o[5]); w.w = cvt_pk_bf16(o[6], o[7]);
                __builtin_nontemporal_store(w, (u32x4*)(ACT + (size_t)row * DFF + col0)); }
    }
};

struct EpiResNorm {
    static constexpr bool PERM = true, MID = false, AFTER = true; static constexpr int A_AUX = AUX_STREAM;
    const u16* base; float* out; const float* gfin; float* slots; unsigned* cnt;
    __device__ __forceinline__ void mid(f32x4 (&)[2][2][4][2], const pg8::Unit&, int, int, int, int) const {}
    __device__ __forceinline__ void operator()(const f32x4 (&)[2][2][4][2], const pg8::Unit&, int, int, int, int) const {}
    __device__ __forceinline__ void after(f32x4 (&acc)[2][2][4][2], const pg8::Unit& u, int wr, int wc, int fr, int fq, LAS unsigned char* lds, int wid, int lane) const {
        LAS float* P = (LAS float*)lds; LAS float* R = (LAS float*)(lds + 4096);
        const int col0 = u.pn * 256 + wc * 32 + 8 * fq;
#pragma unroll
        for (int ai = 0; ai < 2; ++ai)
#pragma unroll
            for (int m = 0; m < 4; ++m) { const int rl = ai * 128 + wr * 64 + m * 16 + fr; const size_t off = (size_t)(u.pm * 256 + rl) * 1024 + col0; float s = 0.f;
#pragma unroll
                for (int bj = 0; bj < 2; ++bj) { const u32x4 hb = __builtin_nontemporal_load((const u32x4*)(base + off + bj * 128));
                    const f32x4 h0 = (f32x4){bf_lo(hb.x), bf_hi(hb.x), bf_lo(hb.y), bf_hi(hb.y)} + acc[ai][bj][m][0], h1 = (f32x4){bf_lo(hb.z), bf_hi(hb.z), bf_lo(hb.w), bf_hi(hb.w)} + acc[ai][bj][m][1];
                    acc[ai][bj][m][0] = h0; acc[ai][bj][m][1] = h1;
                    s += ((h0[0] * h0[0] + h0[1] * h0[1]) + (h0[2] * h0[2] + h0[3] * h0[3])) + ((h1[0] * h1[0] + h1[1] * h1[1]) + (h1[2] * h1[2] + h1[3] * h1[3])); }
                s += __shfl_xor(s, 16); s += __shfl_xor(s, 32);
                if (fq == 0) P[rl * 4 + wc] = s;
                if (m & 1) asm volatile("" ::: "memory"); }
        asm volatile("s_waitcnt lgkmcnt(0)" ::: "memory"); __builtin_amdgcn_s_barrier(); asm volatile("" ::: "memory");
        const int row = wid * 32 + (lane & 31);
        unsigned* slot = (unsigned*)slots + (size_t)(u.pm * 256 + row) * 16;
        if (lane < 32) { const float t = (P[row * 4 + 0] + P[row * 4 + 1]) + (P[row * 4 + 2] + P[row * 4 + 3]);
            __hip_atomic_store(slot + u.pn, __float_as_uint(t), __ATOMIC_RELAXED, __HIP_MEMORY_SCOPE_AGENT); }
        asm volatile("s_waitcnt vmcnt(0)" ::: "memory");
        if (lane == 0) __hip_atomic_fetch_add(cnt + 64 * u.pm, 1u, __ATOMIC_RELAXED, __HIP_MEMORY_SCOPE_AGENT);
        if (wid == 0) { unsigned sp = 0;
            while ((unsigned)__builtin_amdgcn_readfirstlane(__hip_atomic_load(cnt + 64 * u.pm, __ATOMIC_RELAXED, __HIP_MEMORY_SCOPE_AGENT)) < 32u) { __builtin_amdgcn_s_sleep(2); if (++sp > (1u << 20)) break; }
            __builtin_amdgcn_fence(__ATOMIC_ACQUIRE, "agent"); }
        asm volatile("s_waitcnt vmcnt(0) lgkmcnt(0)" ::: "memory"); __builtin_amdgcn_s_barrier(); asm volatile("" ::: "memory");
        if (lane < 32) { float t = 0.f;
#pragma unroll
            for (int k = 0; k < 4; ++k) t += __uint_as_float(__hip_atomic_load(slot + k, __ATOMIC_RELAXED, __HIP_MEMORY_SCOPE_AGENT));
            R[row] = rsqrtf(t * (1.f / DM) + EPS); }
        asm volatile("s_waitcnt lgkmcnt(0)" ::: "memory"); __builtin_amdgcn_s_barrier(); asm volatile("" ::: "memory");
        f32x4 gv[2][2];
#pragma unroll
        for (int bj = 0; bj < 2; ++bj)
#pragma unroll
            for (int n = 0; n < 2; ++n) gv[bj][n] = *(const f32x4*)(gfin + col0 + bj * 128 + n * 4);
#pragma unroll
        for (int ai = 0; ai < 2; ++ai)
#pragma unroll
            for (int m = 0; m < 4; ++m) { const int rl = ai * 128 + wr * 64 + m * 16 + fr; const size_t off = (size_t)(u.pm * 256 + rl) * 1024 + col0; const float rs = R[rl];
#pragma unroll
                for (int bj = 0; bj < 2; ++bj)
#pragma unroll
                    for (int n = 0; n < 2; ++n) *(f32x4*)(out + off + bj * 128 + n * 4) = acc[ai][bj][m][n] * rs * gv[bj][n]; }
    }
};
#define RLX_AGENT __ATOMIC_RELAXED, __HIP_MEMORY_SCOPE_AGENT
#define XB_TMO      128
#define XB_XCNT(j)  (256  + 64 * (j))
#define XB_XSUB(j)  (1280 + 64 * (j))
#define XB_XGEN(j)  (2304 + 64 * (j))
#define XB_TOP      3328
#define XB_TOPGEN   3392
#define XCD_BAR_WORDS 3456
#define XB_SPIN_CAP (1u << 18)

__device__ __forceinline__ unsigned xb_ld(unsigned* p)              { return __hip_atomic_load(p, __ATOMIC_RELAXED, __HIP_MEMORY_SCOPE_AGENT); }
__device__ __forceinline__ unsigned xb_add(unsigned* p, unsigned v) { return __hip_atomic_fetch_add(p, v, __ATOMIC_RELAXED, __HIP_MEMORY_SCOPE_AGENT); }
__device__ __forceinline__ unsigned xb_xcc_id() { return (unsigned)__builtin_amdgcn_s_getreg((3 << 11) | 20) & 0xFu; }
#define XB_SPIN(cond, bar) do { unsigned _sp = 0; while (cond) { __builtin_amdgcn_s_sleep(1); \
    if ((++_sp & 255u) == 0u) { if (xb_ld(&(bar)[XB_TMO])) break; if (_sp > XB_SPIN_CAP) { atomicAdd(&(bar)[XB_TMO], 1u); break; } } } } while (0)

struct XcdBarrier {
    unsigned* bar; unsigned x;
    volatile LAS unsigned* st;
};

__device__ __forceinline__ XcdBarrier xcd_barrier_post(unsigned* bar, volatile LAS unsigned* st) {
    XcdBarrier b; b.bar = bar; b.x = xb_xcc_id(); b.st = st;
    if (threadIdx.x == 0) (void)xb_add(&bar[XB_XCNT(b.x)], 1u);
    return b;
}
__device__ __forceinline__ void xcd_barrier_complete(unsigned* bar, unsigned x, unsigned& nloc, unsigned& nx) {
    const unsigned G = gridDim.x * gridDim.y * gridDim.z;
    unsigned sum, cnt, mine, sp = 0u;
    for (;;) {
        sum = 0u; cnt = 0u; mine = 0u;
#pragma unroll
        for (unsigned j = 0; j < 16; ++j) { const unsigned c = xb_ld(&bar[XB_XCNT(j)]); sum += c; cnt += (c > 0u) ? 1u : 0u; mine = (j == x) ? c : mine; }
        if (sum == G) break;
        __builtin_amdgcn_s_sleep(1);
        if ((++sp & 255u) == 0u) { if (xb_ld(&bar[XB_TMO])) break; if (sp > XB_SPIN_CAP) { atomicAdd(&bar[XB_TMO], 1u); break; } }
    }
    nloc = mine > 0u ? mine : 1u; nx = cnt > 0u ? cnt : 1u;
}

__device__ __forceinline__ void xcd_barrier(const XcdBarrier& b) {
    asm volatile("s_waitcnt vmcnt(0)" ::: "memory");
    __syncthreads();
    if (threadIdx.x == 0) {
        unsigned* bar = b.bar;
        __builtin_amdgcn_s_waitcnt(0);
        unsigned nloc = b.st[0], nx = b.st[1];
        if (nloc == 0u) { xcd_barrier_complete(bar, b.x, nloc, nx); b.st[0] = nloc; b.st[1] = nx; }
        const unsigned old = xb_add(&bar[XB_XSUB(b.x)], 1u);
        const unsigned gen = old / nloc;
        if (old + 1u == (gen + 1u) * nloc) {
            __builtin_amdgcn_fence(__ATOMIC_RELEASE, "agent");
            asm volatile("s_waitcnt vmcnt(0)" ::: "memory");
            const unsigned og = xb_add(&bar[XB_TOP], 1u);
            const unsigned tg = og / nx;
            if (og + 1u == (tg + 1u) * nx) xb_add(&bar[XB_TOPGEN], 1u);
            else XB_SPIN(xb_ld(&bar[XB_TOPGEN]) == tg, bar);
            __builtin_amdgcn_fence(__ATOMIC_ACQUIRE, "agent");
            xb_add(&bar[XB_XGEN(b.x)], 1u);
            asm volatile("s_waitcnt vmcnt(0)" ::: "memory");
        } else {
            XB_SPIN(xb_ld(&bar[XB_XGEN(b.x)]) == gen, bar);
            __builtin_amdgcn_fence(__ATOMIC_ACQUIRE, "agent");
            asm volatile("s_waitcnt vmcnt(0)" ::: "memory");
        }
    }
    __syncthreads();
}

__device__ __forceinline__ void p2_wave(const u16* Gp, const u16* Vp, int nrows, int h, u16* Uout, float* dk, int lane) {
    const int r = lane & 15, q = lane >> 4;
    bf16x8 kf[8][2]; float tot1[8];
#pragma unroll
    for (int kk = 0; kk < 2; ++kk) { const int ks = 1 - kk;
#pragma unroll
        for (int dg = 0; dg < 2; ++dg) {
            int zz = 0; asm volatile("" : "+v"(zz));
            u32x4 wq[4];
#pragma unroll
            for (int p2 = 0; p2 < 2; ++p2) { const int dp = 2 * dg + p2; const int dcol = 32 * dp + 2 * r + zz; unsigned gw[8];
#pragma unroll
                for (int j = 0; j < 8; ++j) { const int s = 32 * ks + 8 * q + j; gw[j] = s < nrows ? *(const unsigned*)(Gp + (size_t)s * 1024 + h * 128 + dcol) : 0u; }
#pragma unroll
                for (int par = 0; par < 2; ++par) { const int dt = 2 * dp + par; float gv[8];
#pragma unroll
                    for (int j = 0; j < 8; ++j) gv[j] = h2f((u16)(par ? (gw[j] >> 16) : (gw[j] & 0xffffu)));
                    float suf[8]; float run = 0.f;
#pragma unroll
                    for (int j = 7; j >= 0; --j) { suf[j] = run; run += gv[j]; }
                    const float T = run, ta = __shfl_xor(T, 16), tb = __shfl_xor(T, 32), tc = __shfl_xor(ta, 32);
                    const float after = ((q ^ 1) > q ? ta : 0.f) + ((q ^ 2) > q ? tb : 0.f) + ((q ^ 3) > q ? tc : 0.f);
                    const float tot = (T + ta) + (tb + tc);
                    float base;
                    if (ks == 1) { tot1[dt] = tot; base = after; } else { base = after + tot1[dt]; if (dk && q == 0) dk[h * 128 + dcol + par] = fexp(tot + tot1[dt]); }
                    float kh[8];
#pragma unroll
                    for (int j = 0; j < 8; ++j) kh[j] = (1.0f - fexp(gv[j])) * fexp(suf[j] + base);
                    u32x4& w = wq[2 * p2 + par];
                    w.x = cvt_pk_bf16(kh[0], kh[1]); w.y = cvt_pk_bf16(kh[2], kh[3]); w.z = cvt_pk_bf16(kh[4], kh[5]); w.w = cvt_pk_bf16(kh[6], kh[7]); } }
            asm volatile("" : "+v"(wq[0].x), "+v"(wq[0].y), "+v"(wq[0].z), "+v"(wq[0].w), "+v"(wq[1].x), "+v"(wq[1].y), "+v"(wq[1].z), "+v"(wq[1].w),
                              "+v"(wq[2].x), "+v"(wq[2].y), "+v"(wq[2].z), "+v"(wq[2].w), "+v"(wq[3].x), "+v"(wq[3].y), "+v"(wq[3].z), "+v"(wq[3].w));
#pragma unroll
            for (int d4 = 0; d4 < 4; ++d4) kf[4 * dg + d4][ks] = __builtin_bit_cast(bf16x8, wq[d4]); } }
#pragma unroll 1
    for (int ep = 0; ep < 4; ++ep) {
        int zz = 0; asm volatile("" : "+v"(zz)); const int ecol = 32 * ep + 2 * r + zz;
        unsigned vw[2][8];
#pragma unroll
        for (int ks = 0; ks < 2; ++ks)
#pragma unroll
            for (int j = 0; j < 8; ++j) { const int s = 32 * ks + 8 * q + j; vw[ks][j] = s < nrows ? *(const unsigned*)(Vp + (size_t)s * 1024 + h * 128 + ecol) : 0u; }
#pragma unroll
        for (int par = 0; par < 2; ++par) {
            bf16x8 vf[2];
#pragma unroll
            for (int ks = 0; ks < 2; ++ks) { u32x4 w;
                if (par == 0) { w.x = (vw[ks][0] & 0xffffu) | (vw[ks][1] << 16); w.y = (vw[ks][2] & 0xffffu) | (vw[ks][3] << 16); w.z = (vw[ks][4] & 0xffffu) | (vw[ks][5] << 16); w.w = (vw[ks][6] & 0xffffu) | (vw[ks][7] << 16); }
                else { w.x = (vw[ks][0] >> 16) | (vw[ks][1] & 0xffff0000u); w.y = (vw[ks][2] >> 16) | (vw[ks][3] & 0xffff0000u); w.z = (vw[ks][4] >> 16) | (vw[ks][5] & 0xffff0000u); w.w = (vw[ks][6] >> 16) | (vw[ks][7] & 0xffff0000u); }
                vf[ks] = __builtin_bit_cast(bf16x8, w); }
            f32x4 acc[8];
#pragma unroll
            for (int dt = 0; dt < 8; ++dt) { acc[dt] = (f32x4){0.f, 0.f, 0.f, 0.f};
#pragma unroll
                for (int ks = 0; ks < 2; ++ks) acc[dt] = __builtin_amdgcn_mfma_f32_16x16x32_bf16(kf[dt][ks], vf[ks], acc[dt], 0, 0, 0); }
#pragma unroll
            for (int dp = 0; dp < 4; ++dp) { u32x4 w; w.x = cvt_pk_bf16(acc[2 * dp][0], acc[2 * dp + 1][0]); w.y = cvt_pk_bf16(acc[2 * dp][1], acc[2 * dp + 1][1]); w.z = cvt_pk_bf16(acc[2 * dp][2], acc[2 * dp + 1][2]); w.w = cvt_pk_bf16(acc[2 * dp][3], acc[2 * dp + 1][3]);
                { const int e = 32 * ep + 2 * r + par;
                  *(u32x4*)(Uout + ((size_t)((e >> 4) * 4 + dp) * 64 + q * 16 + (e & 15)) * 8) = w; } } }
    }
}
__device__ __forceinline__ void p2_states(const Args& a, int G) {
    const int tid = threadIdx.x, lane = tid & 63, wave = __builtin_amdgcn_readfirstlane(tid >> 6);
    const u16* Gb = (const u16*)(a.ws + WS_G); const u16* Vb = (const u16*)(a.ws + WS_V); u16* US = (u16*)a.out; float* DK = (float*)(a.ws + WS_DK);
    for (int it = blockIdx.x; it < BATCH * NCH + (G == 256 ? 0 : 1); it += G) {
        if (it < BATCH * NCH) { const size_t row0 = (size_t)it * CHK;
            p2_wave(Gb + row0 * 1024, Vb + row0 * 1024, CHK, wave, US + ((size_t)it * 8 + wave) * 16384, DK + (size_t)it * 1024, lane); }
        else p2_wave((const u16*)(a.ws + WS_GM), (const u16*)(a.ws + WS_VM), NMETA, wave, (u16*)(a.ws + WS_UM) + (size_t)wave * 16384, nullptr, lane);
    }
}

__device__ __forceinline__ void p3_scan(const Args& a, LAS unsigned char* lds, int G) {
    const int tid = threadIdx.x, lane = tid & 63, wave = __builtin_amdgcn_readfirstlane(tid >> 6);
    {
        LAS float* scr = (LAS float*)(lds + wave * 16384);
        const int gw = (int)blockIdx.x * NWAVES + wave, NGW = G * NWAVES;
        for (int it = gw; it < 2 * 16 * 88; it += NGW) { const int up = it >= 16 * 88, r = up ? it - 16 * 88 : it, kb = r / 88, nb = r % 88, n0 = 32 * nb;
            tr_item(up ? a.w_up : a.w_gate, DFF, 64 * kb, n0, (u16*)(a.ws + WS_WGU), (n0 >> 7) * 256 + (n0 & 127) + (up ? 128 : 0), 1024, 0, a.g_ffn, scr, lane); }
    }
    u16* US = (u16*)a.out; const float* DK = (const float*)(a.ws + WS_DK); const u16* UM = (const u16*)(a.ws + WS_UM);
    if (tid < 256)
    for (int qi = blockIdx.x * 256 + tid; qi < BATCH * 8 * 4096; qi += G * 256) {
        const int qd = qi & 4095, h = (qi >> 12) & 7, b = qi >> 15;
        const int d = 32 * ((qd >> 7) & 3) + 8 * ((qd >> 5) & 3) + 4 * (qd & 1);
        const u32x2 um = *(const u32x2*)(UM + (size_t)h * 16384 + 4 * qd);
        float s0 = bf_lo(um.x), s1 = bf_hi(um.x), s2 = bf_lo(um.y), s3 = bf_hi(um.y);
        u32x2* up = (u32x2*)(US + ((size_t)(b * NCH) * 8 + h) * 16384 + 4 * qd);
        const float* dkp = DK + (size_t)(b * NCH) * 1024 + h * 128 + d;
#pragma unroll 1
        for (int c0 = 0; c0 < NCH; c0 += 16) {
            u32x2 uu[16]; f32x4 dd[16];
#pragma unroll
            for (int i = 0; i < 16; ++i) { uu[i] = up[(size_t)(c0 + i) * 8 * 4096]; dd[i] = *(const f32x4*)(dkp + (size_t)(c0 + i) * 1024); }
#pragma unroll
            for (int i = 0; i < 16; ++i) { up[(size_t)(c0 + i) * 8 * 4096] = (u32x2){cvt_pk_bf16(s0, s1), cvt_pk_bf16(s2, s3)};
                s0 = dd[i][0] * s0 + bf_lo(uu[i].x); s1 = dd[i][1] * s1 + bf_hi(uu[i].x); s2 = dd[i][2] * s2 + bf_lo(uu[i].y); s3 = dd[i][3] * s3 + bf_hi(uu[i].y); }
        }
    }
}

constexpr int P4_PITCH = 272, P4_MAT = 64 * P4_PITCH  , P4_VPITCH = 136, P4_HS = 4 * P4_MAT  , P4_TOT = 2 * P4_HS  , P4_PLD = P4_TOT + 4096  ;
static_assert(P4_PLD + P4_MAT + 64 <= LDS_BYTES, "LDS map");
__device__ __forceinline__ unsigned ld_pl(const u16* PB, const u16* PLM, int b, int tx, int cofs) {
    return tx >= 0 ? *(const unsigned*)(PB + (size_t)(b * SEQ + tx) * 1024 + 512 + cofs) : *(const unsigned*)(PLM + (size_t)(NMETA + tx) * 512 + cofs);
}
__device__ __forceinline__ void p4_outputs(const Args& a, LAS unsigned char* lds, int G, int skip = 0) {
    (void)skip;
    const int tid = threadIdx.x, lane = tid & 63, wave = __builtin_amdgcn_readfirstlane(tid >> 6);
    const int r = lane & 15, q = lane >> 4;
    u16* Qb = (u16*)(a.ws + WS_Q); const u16* Gb = (const u16*)(a.ws + WS_G); const u16* Vb = (const u16*)(a.ws + WS_V); const u16* OGb = (const u16*)(a.ws + WS_OG);
    u16* PB = (u16*)(a.ws + WS_PB); const u16* PLM = (const u16*)(a.ws + WS_PLM); const u16* PWT = (const u16*)(a.ws + WS_PWT); const u16* US = (const u16*)a.out;
    LAS unsigned char* PLD = lds + P4_PLD;
    for (int item = blockIdx.x; item < BATCH * NCH * 4; item += G) {
        const int hp = item & 3, bc = item >> 2, c = bc & (NCH - 1), b = bc >> 7;
        const size_t row0 = (size_t)b * SEQ + (size_t)c * CHK;
        const int hs = wave >> 2, tq = wave & 3, h = 2 * hp + hs;
        LAS unsigned char* L = lds + hs * P4_HS;
        LAS unsigned char* KT = L, *QT = L + P4_MAT, *QH = L + 2 * P4_MAT, *VT = L + 3 * P4_MAT;
        LAS float* TOT = (LAS float*)(lds + P4_TOT) + hs * 512;
        const int d0 = 2 * lane; const size_t cofs = (size_t)h * 128 + d0;
        unsigned gp[16], qv[16], vv[16];
#pragma unroll
        for (int i = 0; i < 16; ++i) { const size_t o = (row0 + 16 * tq + i) * 1024 + cofs; gp[i] = __builtin_nontemporal_load((const unsigned*)(Gb + o)); qv[i] = __builtin_nontemporal_load((const unsigned*)(Qb + o)); vv[i] = __builtin_nontemporal_load((const unsigned*)(Vb + o)); }
        const int gi = hp, wlen = 2 << gi; const float inv = 1.0f / (float)wlen;
        const int t0 = 8 * wave, pcofs = gi * 128 + 2 * lane, tx0 = c * CHK + t0;
        unsigned pu[23];
#pragma unroll
        for (int j = 1; j < 16; ++j) pu[15 - j] = (j < wlen) ? ld_pl(PB, PLM, b, tx0 - j, pcofs) : 0u;
#pragma unroll
        for (int i = 0; i < 8; ++i) pu[15 + i] = ld_pl(PB, PLM, b, tx0 + i, pcofs);
        bf16x8 wf[4];
#pragma unroll
        for (int kd = 0; kd < 4; ++kd) wf[kd] = *(const bf16x8*)(PWT + (size_t)(gi * 128 + 16 * wave + r) * 128 + 32 * kd + 8 * q);
        float s0 = 0.f, s1 = 0.f;
#pragma unroll
        for (int i = 0; i < 16; ++i) { s0 += h2f((u16)(gp[i] & 0xffffu)); s1 += h2f((u16)(gp[i] >> 16)); }
        TOT[tq * 128 + d0] = s0; TOT[tq * 128 + d0 + 1] = s1;
        __syncthreads();
        {
            float w0 = 0.f, w1 = 0.f;
#pragma unroll
            for (int j = 1; j < 16; ++j) if (j < wlen) { w0 += bf_lo(pu[15 - j]); w1 += bf_hi(pu[15 - j]); }
#pragma unroll
            for (int i = 0; i < 8; ++i) { const float u0 = bf_lo(pu[15 + i]), u1 = bf_hi(pu[15 + i]); w0 += u0; w1 += u1;
                *(LAS unsigned*)(PLD + (t0 + i) * P4_PITCH + 4 * lane) = cvt_pk_bf16(w0 * inv - u0, w1 * inv - u1);
                const unsigned o = wlen == 2 ? pu[15 + i - 1] : (wlen == 4 ? pu[15 + i - 3] : (wlen == 8 ? pu[15 + i - 7] : pu[15 + i - 15]));
                w0 -= bf_lo(o); w1 -= bf_hi(o); }
        }
        float b0 = 0.f, b1 = 0.f;
#pragma unroll
        for (int t2 = 0; t2 < 3; ++t2) if (t2 < tq) { b0 += TOT[t2 * 128 + d0]; b1 += TOT[t2 * 128 + d0 + 1]; }
        const float bm0 = TOT[d0] + TOT[128 + d0], bm1 = TOT[d0 + 1] + TOT[128 + d0 + 1];
#pragma unroll
        for (int i = 0; i < 16; ++i) { const int t = 16 * tq + i; const float g0 = h2f((u16)(gp[i] & 0xffffu)), g1 = h2f((u16)(gp[i] >> 16)); b0 += g0; b1 += g1;
            const unsigned q2 = qv[i], v2 = vv[i];
            const float q0 = bf_lo(q2), q1 = bf_hi(q2), k0 = 1.0f - fexp(g0), k1 = 1.0f - fexp(g1);
            const float eb0 = fexp(b0), eb1 = fexp(b1), em0 = fexp(fminf(b0 - bm0, 80.f)), em1 = fexp(fminf(b1 - bm1, 80.f)), ek0 = fexp(fminf(bm0 - b0, 80.f)), ek1 = fexp(fminf(bm1 - b1, 80.f));
            *(LAS unsigned*)(QT + t * P4_PITCH + d0 * 2) = cvt_pk_bf16(q0 * em0, q1 * em1);
            *(LAS unsigned*)(QH + t * P4_PITCH + d0 * 2) = cvt_pk_bf16(q0 * eb0, q1 * eb1);
            *(LAS unsigned*)(KT + t * P4_PITCH + d0 * 2) = cvt_pk_bf16(k0 * ek0, k1 * ek1);
            *(LAS u16*)(VT + d0 * P4_VPITCH + t * 2) = (u16)(v2 & 0xffffu); *(LAS u16*)(VT + (d0 + 1) * P4_VPITCH + t * 2) = (u16)(v2 >> 16); }
        const u16* Sp = US + ((size_t)bc * 8 + h) * 16384;
        bf16x8 sfr[8][4];
#pragma unroll
        for (int et = 0; et < 8; ++et)
#pragma unroll
            for (int kd = 0; kd < 4; ++kd) sfr[et][kd] = *(const bf16x8*)(Sp + ((size_t)(et * 4 + kd) * 64 + lane) * 8);
        const int tt = tq;
        const size_t orow = (row0 + 16 * tt + r) * 1024 + (size_t)h * 128;
        __syncthreads();
        u32x2 ogv[8];
#pragma unroll
        for (int et = 0; et < 8; ++et) ogv[et] = __builtin_nontemporal_load((const u32x2*)(OGb + orow + 16 * et + 4 * q));
        {
            f32x4 acc[4];
#pragma unroll
            for (int t4 = 0; t4 < 4; ++t4) acc[t4] = (f32x4){0.f, 0.f, 0.f, 0.f};
#pragma unroll
            for (int kd = 0; kd < 4; ++kd)
#pragma unroll
                for (int t4 = 0; t4 < 4; ++t4) { const bf16x8 pfr = *(const LAS bf16x8*)(PLD + (16 * t4 + r) * P4_PITCH + (32 * kd + 8 * q) * 2); acc[t4] = __builtin_amdgcn_mfma_f32_16x16x32_bf16(wf[kd], pfr, acc[t4], 0, 0, 0); }
            const int n0 = gi * 128 + 16 * wave + 4 * q; const f32x4 psc = *(const f32x4*)(a.pool_scale + n0);
#pragma unroll
            for (int t4 = 0; t4 < 4; ++t4) { u32x2 w; w.x = cvt_pk_bf16(acc[t4][0] * psc[0], acc[t4][1] * psc[1]); w.y = cvt_pk_bf16(acc[t4][2] * psc[2], acc[t4][3] * psc[3]);
                *(u32x2*)(PB + (row0 + 16 * t4 + r) * 1024 + n0) = w; }
        }
        bf16x8 qt[4], qh[4];
#pragma unroll
        for (int kd = 0; kd < 4; ++kd) { qt[kd] = *(const LAS bf16x8*)(QT + (16 * tt + r) * P4_PITCH + (32 * kd + 8 * q) * 2); qh[kd] = *(const LAS bf16x8*)(QH + (16 * tt + r) * P4_PITCH + (32 * kd + 8 * q) * 2); }
        f32x4 sc[4];
#pragma unroll
        for (int st = 0; st < 4; ++st) { f32x4 acc = (f32x4){0.f, 0.f, 0.f, 0.f};
            if (st <= tt) {
#pragma unroll
                for (int kd = 0; kd < 4; ++kd) { const bf16x8 kfr = *(const LAS bf16x8*)(KT + (16 * st + r) * P4_PITCH + (32 * kd + 8 * q) * 2); acc = __builtin_amdgcn_mfma_f32_16x16x32_bf16(kfr, qt[kd], acc, 0, 0, 0); }
                if (st == tt) {
#pragma unroll
                    for (int i = 0; i < 4; ++i) if (4 * q + i > r) acc[i] = 0.f; }
            }
            sc[st] = acc; }
        bf16x8 pf[2];
#pragma unroll
        for (int ks = 0; ks < 2; ++ks) { u32x4 w; w.x = cvt_pk_bf16(sc[2 * ks][0], sc[2 * ks][1]); w.y = cvt_pk_bf16(sc[2 * ks][2], sc[2 * ks][3]); w.z = cvt_pk_bf16(sc[2 * ks + 1][0], sc[2 * ks + 1][1]); w.w = cvt_pk_bf16(sc[2 * ks + 1][2], sc[2 * ks + 1][3]);
            pf[ks] = __builtin_bit_cast(bf16x8, w); }
        f32x4 oa[8]; float ss = 0.f;
#pragma unroll
        for (int et = 0; et < 8; ++et) { f32x4 acc = (f32x4){0.f, 0.f, 0.f, 0.f};
#pragma unroll
            for (int kd = 0; kd < 4; ++kd) acc = __builtin_amdgcn_mfma_f32_16x16x32_bf16(sfr[et][kd], qh[kd], acc, 0, 0, 0);
#pragma unroll
            for (int ks = 0; ks < 2; ++ks) if (2 * ks <= tt) {
                const u32x2 lo = *(const LAS u32x2*)(VT + (16 * et + r) * P4_VPITCH + (32 * ks + 4 * q) * 2), hi = *(const LAS u32x2*)(VT + (16 * et + r) * P4_VPITCH + (32 * ks + 16 + 4 * q) * 2);
                const u32x4 w = (u32x4){lo.x, lo.y, hi.x, hi.y};
                acc = __builtin_amdgcn_mfma_f32_16x16x32_bf16(__builtin_bit_cast(bf16x8, w), pf[ks], acc, 0, 0, 0); }
            oa[et] = acc; ss += (acc[0] * acc[0] + acc[1] * acc[1]) + (acc[2] * acc[2] + acc[3] * acc[3]); }
        ss += __shfl_xor(ss, 16); ss += __shfl_xor(ss, 32);
        const float rstd = rsqrtf(ss * (1.f / 128.f) + EPS);
#pragma unroll
        for (int et = 0; et < 8; ++et) { const int e0 = 16 * et + 4 * q; const f32x4 gn = *(const f32x4*)(a.g_hn + e0); const u32x2 og = ogv[et];
            u32x2 w; w.x = cvt_pk_bf16(oa[et][0] * rstd * gn[0] * bf_lo(og.x), oa[et][1] * rstd * gn[1] * bf_hi(og.x)); w.y = cvt_pk_bf16(oa[et][2] * rstd * gn[2] * bf_lo(og.y), oa[et][3] * rstd * gn[3] * bf_hi(og.y));
            *(LAS u32x2*)(QT + (16 * tt + r) * P4_PITCH + e0 * 2) = w; }
        asm volatile("s_waitcnt lgkmcnt(0)" ::: "memory");
#pragma unroll
        for (int i = 0; i < 4; ++i) { const int rr = 16 * tt + 4 * i + (lane >> 4); const u32x4 v = *(const LAS u32x4*)(QT + rr * P4_PITCH + (lane & 15) * 16);
            *(u32x4*)(Qb + (row0 + rr) * 1024 + (size_t)h * 128 + (lane & 15) * 8) = v; }
    }
    __syncthreads();
}

__device__ __forceinline__ void p9_final(const Args& a, int G) {
    const int tid = threadIdx.x, lane = tid & 63, wave = __builtin_amdgcn_readfirstlane(tid >> 6);
    const float* rsq = (const float*)(a.ws + WS_RSQ);
    const f32x4* gr = (const f32x4*)a.g_fin + lane; f32x4 gv[4];
#pragma unroll
    for (int j = 0; j < 4; ++j) gv[j] = gr[64 * j];
    for (int m = 2 * (blockIdx.x * NWAVES + wave); m < M; m += 2 * G * NWAVES) {
        float p = lane < 32 ? rsq[(size_t)m * 16 + lane] : 0.f;
        f32x4* xr = (f32x4*)(a.out + (size_t)m * DM) + lane; f32x4 v[8];
#pragma unroll
        for (int j = 0; j < 8; ++j) v[j] = xr[64 * j];
        p += __shfl_xor(p, 1); p += __shfl_xor(p, 2); p += __shfl_xor(p, 4); p += __shfl_xor(p, 8);
        const float r0 = rsqrtf(__shfl(p, 0) * (1.f / DM) + EPS), r1 = rsqrtf(__shfl(p, 16) * (1.f / DM) + EPS);
#pragma unroll
        for (int j = 0; j < 8; ++j) { const float rs = j < 4 ? r0 : r1; const f32x4 g4 = gv[j & 3]; xr[64 * j] = (f32x4){v[j].x * rs * g4.x, v[j].y * rs * g4.y, v[j].z * rs * g4.z, v[j].w * rs * g4.w}; }
    }
}

#ifdef PROBE_STOP
__device__ __forceinline__ void p_dump(const Args& a, int G) {
    const u16* Qb = (const u16*)(a.ws + WS_Q); const u16* Gb = (const u16*)(a.ws + WS_G); const u16* Vb = (const u16*)(a.ws + WS_V); const u16* OGb = (const u16*)(a.ws + WS_OG);
    const u16* GAb = (const u16*)(a.ws + WS_GA); const u16* GBb = (const u16*)(a.ws + WS_GB); const u16* PB = (const u16*)(a.ws + WS_PB);
    for (size_t i = (size_t)blockIdx.x * NTHR + threadIdx.x; i < (size_t)M * DM; i += (size_t)G * NTHR) {
        float v = 0.f;
        if (PROBE_STOP == 1) v = bf1(Qb[i]) + h2f(Gb[i]) + bf1(Vb[i]) + bf1(OGb[i]) + bf1(GAb[i]) + bf1(GBb[i]) + bf1(PB[i]);
        else if (PROBE_STOP == 2 || PROBE_STOP == 3) { float t = bf1(((const u16*)a.out)[i]) + bf1(((const u16*)a.out)[i + (size_t)M * DM]); if (!(fabsf(t) < 1e30f)) t = 12345.f; ((float*)(a.ws + WS_GA))[i] = t; continue; }
        else if (PROBE_STOP == 4) v = bf1(Qb[i]) + bf1(PB[i]);
        else if (PROBE_STOP == 5) v = bf1(Gb[i]);
        else continue;
        a.out[i] = v;
    }
}
#endif
__device__ __forceinline__ void flat_barrier(unsigned* cnt) {
    asm volatile("s_waitcnt vmcnt(0)" ::: "memory");
    __syncthreads();
    if (threadIdx.x == 0) {
        const unsigned Gn = gridDim.x;
        __builtin_amdgcn_fence(__ATOMIC_RELEASE, "agent");
        asm volatile("s_waitcnt vmcnt(0)" ::: "memory");
        const unsigned old = __hip_atomic_fetch_add(cnt, 1u, __ATOMIC_RELAXED, __HIP_MEMORY_SCOPE_AGENT);
        const unsigned target = (old / Gn + 1u) * Gn; unsigned sp = 0;
        while (__hip_atomic_load(cnt, __ATOMIC_RELAXED, __HIP_MEMORY_SCOPE_AGENT) < target) { __builtin_amdgcn_s_sleep(1); if (++sp > (1u << 22)) break; }
        __builtin_amdgcn_fence(__ATOMIC_ACQUIRE, "agent");
        asm volatile("s_waitcnt vmcnt(0)" ::: "memory");
    }
    __syncthreads();
}
constexpr int NPH = 10;
__global__ void __launch_bounds__(NTHR, 2) mega(Args a) {
    extern __shared__ __attribute__((aligned(16))) unsigned char lds_raw[];
    LAS unsigned char* lds = (LAS unsigned char*)lds_raw;
    cg::grid_group grid = cg::this_grid();
    const int G = gridDim.x, lo = a.ph_lo, hi = a.ph_hi;
    unsigned char* ws = a.ws;
    volatile LAS unsigned* MISC = (volatile LAS unsigned*)(lds + LDS_BYTES - 64);
    if (threadIdx.x < 16) MISC[threadIdx.x] = 0u;
    __syncthreads();
    XcdBarrier bar; bar.bar = (unsigned*)(ws + WS_BAR); bar.x = 0; bar.st = nullptr;
    if (hi - lo > 1) bar = xcd_barrier_post((unsigned*)(ws + WS_BAR), MISC);
    if (hi < 0) grid.sync();
#ifndef PHMASK
#define PHMASK 0x3ff
#endif
#define IN(k) (((PHMASK >> (k)) & 1) && lo <= (k) && (k) < hi)
#ifndef CG_SEAMS
#define CG_SEAMS 0x0
#endif
#define SEAM(k) do { if (IN(k) && IN((k) + 1)) { if ((CG_SEAMS >> (k)) & 1) grid.sync(); else xcd_barrier(bar); } } while (0)
#ifndef PROBE_DUP
#define PROBE_DUP 0
#endif
#ifndef PROBE_XSYNC
#define PROBE_XSYNC 0
#endif
#define DUP(k) (((PROBE_DUP >> (k)) & 1) ? 2 : 1)
    if (IN(0)) { p0_prologue(a, lds, G); } SEAM(0);
#ifdef PROBE_XBAR
    for (int xs = 0; xs < PROBE_XBAR; ++xs) flat_barrier((unsigned*)(ws + WS_BAR + 14 * KiB));
#endif
    if (IN(1)) { pg8::Gemm g{(const u16*)a.out, (const u16*)(ws + WS_WIN), M, INW, DM, DM, 1 << 30, 0L}; pg8::StaticOrder S; S.init(M, INW, G, (int)blockIdx.x);
        EpiIn E{ws}; pg8::gemm_phase<EpiIn, true>(lds, g, S, E);
        if (G == 256 && blockIdx.x == 255) p2_wave((const u16*)(ws + WS_GM), (const u16*)(ws + WS_VM), NMETA, (int)(threadIdx.x >> 6), (u16*)(ws + WS_UM) + (size_t)(threadIdx.x >> 6) * 16384, nullptr, (int)(threadIdx.x & 63));
        else if (G == 256 && blockIdx.x >= 128) late_weights(a, lds, ((int)blockIdx.x - 128) * NWAVES + (int)(threadIdx.x >> 6), 127 * NWAVES); }
    SEAM(1);
    if (IN(2)) { p2_states(a, G); } SEAM(2);
    if (IN(3)) { p3_scan(a, lds, G); } SEAM(3);
    if (IN(4)) { p4_outputs(a, lds, G); } SEAM(4);
    if (IN(5)) { pg8::Gemm g{(const u16*)(ws + WS_Q), (const u16*)(ws + WS_WAB), M, DM, 1536, DM, 16, (long)(WS_PB - WS_Q) - 16L * 128L}; pg8::StaticOrder S; S.init(M, DM, G, (int)blockIdx.x);
        EpiMerge E{(const u16*)(ws + WS_GA), (const u16*)(ws + WS_GB), (u16*)(ws + WS_MG)}; pg8::gemm_phase<EpiMerge, false>(lds, g, S, E); } SEAM(5);
    if (IN(6)) { pg8::Gemm g{(const u16*)(ws + WS_MG), (const u16*)(ws + WS_WOUT), M, DM, DM, DM, 1 << 30, 0L}; pg8::StaticOrder S; S.init(M, DM, G, (int)blockIdx.x);
        const bool fuse9_ = (G == (M / 256) * (DM / 256)) && (hi - lo > 1);
        EpiRes<true> E{a.x, fuse9_ ? nullptr : a.out, (u16*)(ws + WS_H1B), (float*)(ws + WS_RSQ)}; pg8::gemm_phase<EpiRes<true>, false>(lds, g, S, E); } SEAM(6);
    if (IN(7)) { pg8::Gemm g{(const u16*)(ws + WS_H1B), (const u16*)(ws + WS_WGU), M, NGU, DM, DM, 1 << 30, 0L}; pg8::StaticOrder S; S.init(M, NGU, G, (int)blockIdx.x);
        EpiFfn1 E{(const float*)(ws + WS_RSQ), (u16*)(ws + WS_ACT)}; pg8::gemm_phase<EpiFfn1, true>(lds, g, S, E); } SEAM(7);
    const bool fuse9 = (G == (M / 256) * (DM / 256)) && (hi - lo > 1);
    if (IN(8)) { pg8::Gemm g{(const u16*)(ws + WS_ACT), (const u16*)(ws + WS_WD), M, DM, DFF, DFF, 1 << 30, 0L}; pg8::StaticOrder S; S.init(M, DM, G, (int)blockIdx.x);
        if (fuse9) { EpiResNorm E{(const u16*)(ws + WS_H1B), a.out, a.g_fin, (float*)(ws + WS_RSQ), (unsigned*)(ws + WS_CNT)}; pg8::gemm_phase<EpiResNorm, false>(lds, g, S, E); }
        else { EpiRes<false> E{a.out, a.out, nullptr, (float*)(ws + WS_RSQ)}; pg8::gemm_phase<EpiRes<false>, false>(lds, g, S, E); } }
    if (!fuse9) { SEAM(8);
    if (IN(9)) { p9_final(a, G); } }
#ifdef PROBE_LIST
    if (lo == 20) p0_prologue(a, lds, G, 1);
    if (lo == 30) p0_prologue(a, lds, G, 2);
    if (lo == 40) p0_prologue(a, lds, G, 4);
    if (lo == 14) p4_outputs(a, lds, G, 1);
    if (lo == 24) p4_outputs(a, lds, G, 2);
    if (lo == 34) p4_outputs(a, lds, G, 2 | 4);
    if (lo == 44) p4_outputs(a, lds, G, 2 | 8);
    if (lo == 54) p4_outputs(a, lds, G, 2 | 16);
    if (lo == 64) p4_outputs(a, lds, G, 2 | 32);
    if (lo == 74) p4_outputs(a, lds, G, 2 | 64);
    if (lo == 18) { pg8::Gemm g{(const u16*)(ws + WS_ACT), (const u16*)(ws + WS_WD), M, DM, DFF, DFF, 1 << 30, 0L}; pg8::StaticOrder S; S.init(M, DM, G, (int)blockIdx.x);
        EpiRes<false> E{(const float*)(ws + WS_GA), (float*)(ws + WS_GA), nullptr, (float*)(ws + WS_OG)}; pg8::gemm_phase<EpiRes<false>, false>(lds, g, S, E); }
    if (lo == 19) { Args b = a; b.out = (float*)(ws + WS_GA); p9_final(b, G); }
#endif
#ifdef PROBE_STOP
    if (lo == 10) p_dump(a, G);
    if (lo == 11 && (PROBE_STOP == 2 || PROBE_STOP == 3)) { for (size_t i = (size_t)blockIdx.x * NTHR + threadIdx.x; i < (size_t)M * DM; i += (size_t)G * NTHR) a.out[i] = ((const float*)(a.ws + WS_GA))[i]; }
#endif
#undef IN
#undef SEAM
}

extern "C" void kernel_launch(void* const* d_in, const int* in_sizes, int n_in, void* d_out, int out_size, void* d_ws, size_t ws_size, hipStream_t stream) {
    static int grid = 0;
    if (grid == 0) {
        if (n_in != 16 || in_sizes[0] != M * DM || out_size != M * DM || ws_size < WS_END) { fprintf(stderr, "kernel_launch: unexpected shapes (n_in %d, in0 %d, out %d, ws %zu); nothing launched\n", n_in, n_in > 0 ? in_sizes[0] : -1, out_size, ws_size); grid = -1; return; }
        int dev = 0, cus = 0, per_cu = 0;
        (void)hipGetDevice(&dev); (void)hipDeviceGetAttribute(&cus, hipDeviceAttributeMultiprocessorCount, dev);
        if (hipFuncSetAttribute((const void*)mega, hipFuncAttributeMaxDynamicSharedMemorySize, LDS_BYTES) != hipSuccess) { fprintf(stderr, "kernel_launch: hipFuncSetAttribute failed\n"); }
        if (hipOccupancyMaxActiveBlocksPerMultiprocessor(&per_cu, (const void*)mega, NTHR, LDS_BYTES) != hipSuccess || per_cu < 1) per_cu = 1;
        (void)hipGetLastError();
        if (cus <= 0) cus = 256;
        grid = cus * per_cu;
    }
    if (grid < 0) return;
#if MK_COOP
    if (hipMemsetAsync((char*)d_ws + WS_BAR, 0, CTL_ZERO, stream) != hipSuccess) { fprintf(stderr, "kernel_launch: hipMemsetAsync of the barrier words failed\n"); return; }
#endif
    Args a{};
    a.x = (const float*)d_in[0]; a.meta = (const float*)d_in[1]; a.g_mix = (const float*)d_in[2]; a.w_in = (const float*)d_in[3]; a.lb_raw = (const float*)d_in[4]; a.g_hn = (const float*)d_in[5];
    a.pool_w = (const float*)d_in[6]; a.pool_scale = (const float*)d_in[7]; a.w_a = (const float*)d_in[8]; a.w_b = (const float*)d_in[9]; a.w_out = (const float*)d_in[10]; a.g_ffn = (const float*)d_in[11];
    a.w_gate = (const float*)d_in[12]; a.w_up = (const float*)d_in[13]; a.w_down = (const float*)d_in[14]; a.g_fin = (const float*)d_in[15];
    a.out = (float*)d_out; a.ws = (unsigned char*)d_ws;
#if MK_COOP
    a.ph_lo = 0; a.ph_hi = NPH;
    void* args[] = {&a};
    const hipError_t e = hipLaunchCooperativeKernel((const void*)mega, dim3(grid), dim3(NTHR), args, LDS_BYTES, stream);
    if (e != hipSuccess) fprintf(stderr, "kernel_launch: cooperative launch failed: %s (grid %d)\n", hipGetErrorString(e), grid);
#else
#ifdef PROBE_STOP
    for (int ph = 0; ph <= PROBE_STOP; ++ph) { a.ph_lo = ph; a.ph_hi = ph + 1; hipLaunchKernelGGL(mega, dim3(grid), dim3(NTHR), LDS_BYTES, stream, a); }
    a.ph_lo = 10; a.ph_hi = 11; hipLaunchKernelGGL(mega, dim3(grid), dim3(NTHR), LDS_BYTES, stream, a);
    a.ph_lo = 11; a.ph_hi = 12; hipLaunchKernelGGL(mega, dim3(grid), dim3(NTHR), LDS_BYTES, stream, a);
#else
#ifdef PROBE_LIST
    { const int lst[] = PROBE_LIST; for (int i = 0; i < (int)(sizeof(lst) / sizeof(int)); ++i) { a.ph_lo = lst[i]; a.ph_hi = lst[i] + 1; hipLaunchKernelGGL(mega, dim3(grid), dim3(NTHR), LDS_BYTES, stream, a); } }
#else
    for (int ph = 0; ph < NPH; ++ph) { a.ph_lo = ph; a.ph_hi = ph + 1; hipLaunchKernelGGL(mega, dim3(grid), dim3(NTHR), LDS_BYTES, stream, a); }
#endif
#endif
#endif
}
```
